# Optimizing an MI355X kernel written in HIP

```python
import math
import jax
import jax.numpy as jnp
from jax import lax
import numpy as np

D_MODEL = 1024
BATCH = 8
SEQ = 2048
DEPTH = 4

CHUNK = 64
Q_BLOCK = 128
N_MIXERS = 4
D_MIX = D_MODEL
GROUP_WIDTH = D_MIX // N_MIXERS
N_HEADS = 4
HEAD_DIM = GROUP_WIDTH // N_HEADS
D_FF = 11 * D_MODEL // 4
CONV_K = 4
SSD_GROUPS = 2
SSD_STATE = 64
ROPE_BASE = 10000.0
RET_DECAY_OFFSET = 5.0
RMS_EPS = 1e-6
N_MOD = 9
FOX_COLS = 3 * GROUP_WIDTH + N_HEADS
MLSTM_COLS = 4 * GROUP_WIDTH + 2 * N_HEADS
RET_COLS = 4 * GROUP_WIDTH
SSD_COLS = 2 * GROUP_WIDTH + 2 * SSD_GROUPS * SSD_STATE + N_HEADS
D_IN_PROJ = FOX_COLS + MLSTM_COLS + RET_COLS + SSD_COLS

kernel_name = 'hybrid_chunk_causal_encoder'


def rmsnorm(x, g):
    xf = x.astype(jnp.float32)
    y = xf * lax.rsqrt(jnp.mean(xf * xf, axis=-1, keepdims=True) + RMS_EPS)
    return (y * g.astype(jnp.float32)).astype(x.dtype)


def head_rmsnorm(y, g):
    _, H, _, d = y.shape
    y = y * lax.rsqrt(jnp.mean(y * y, axis=-1, keepdims=True) + RMS_EPS)
    return y * g.astype(jnp.float32).reshape(H, 1, d)


def modulate(h, shift, scale):
    return h * (1 + scale) + shift


def swiglu(u, w13, w2):
    a, g = jnp.split(u @ w13, 2, axis=-1)
    return (jax.nn.silu(g) * a) @ w2


def to_heads(t):
    B, S, _ = t.shape
    return t.reshape(B, S, N_HEADS, -1).transpose(0, 2, 1, 3)


def merge_heads(t):
    B, H, S, d = t.shape
    return t.transpose(0, 2, 1, 3).reshape(B, S, H * d)


def causal_dwconv(x, w, b):
    C = x.shape[-1]
    y = lax.conv_general_dilated(
        x, w[:, None, :].astype(x.dtype), window_strides=(1,),
        padding=[(CONV_K - 1, 0)], dimension_numbers=('NWC', 'WIO', 'NWC'),
        feature_group_count=C)
    return y + b


def rotary(t):
    S, d = t.shape[2], t.shape[3]
    inv = 1.0 / (ROPE_BASE ** (jnp.arange(0, d, 2, dtype=jnp.float32) / d))
    ang = jnp.arange(S, dtype=jnp.float32)[:, None] * inv[None, :]
    cos, sin = jnp.cos(ang), jnp.sin(ang)
    t1, t2 = t[..., : d // 2], t[..., d // 2:]
    return jnp.concatenate([t1 * cos - t2 * sin, t1 * sin + t2 * cos], axis=-1)


def forgetting_attention(q, k, v, log_f):
    S, d = q.shape[2], q.shape[3]
    cum = jnp.cumsum(log_f, axis=-1)
    scale = d ** -0.5
    outs = []
    for blk in range(S // Q_BLOCK):
        lo, hi = blk * Q_BLOCK, (blk + 1) * Q_BLOCK
        logits = (jnp.einsum('bhtd,bhsd->bhts', q[:, :, lo:hi], k[:, :, :hi]) * scale
                  + cum[:, :, lo:hi, None] - cum[:, :, None, :hi])
        causal = (lo + jnp.arange(Q_BLOCK))[:, None] >= jnp.arange(hi)[None, :]
        p = jax.nn.softmax(jnp.where(causal, logits, -jnp.inf), axis=-1)
        outs.append(jnp.einsum('bhts,bhsd->bhtd', p, v[:, :, :hi]))
    return jnp.concatenate(outs, axis=2)


def chunked_decay_attention(q, k, v, log_a):
    B, H, S, dk = q.shape
    dv = v.shape[-1]
    n = S // CHUNK
    qc = q.reshape(B, H, n, CHUNK, dk)
    kc = k.reshape(B, H, n, CHUNK, dk)
    vc = v.reshape(B, H, n, CHUNK, dv)
    cum = jnp.cumsum(log_a.reshape(B, H, n, CHUNK), axis=-1)
    causal = jnp.tril(jnp.ones((CHUNK, CHUNK), dtype=bool))
    decay = jnp.exp(jnp.where(causal, cum[..., :, None] - cum[..., None, :], -jnp.inf))
    scores = jnp.einsum('bhntd,bhnsd->bhnts', qc, kc) * decay
    y = jnp.einsum('bhnts,bhnse->bhnte', scores, vc)
    w_end = jnp.exp(cum[..., -1:] - cum)
    kv = jnp.einsum('bhnsd,bhns,bhnse->nbhde', kc, w_end, vc)
    a_chunk = jnp.exp(cum[..., -1]).transpose(2, 0, 1)

    def step(state, inp):
        a, kv_c = inp
        return a[..., None, None] * state + kv_c, state

    _, states = lax.scan(step, jnp.zeros((B, H, dk, dv), jnp.float32), (a_chunk, kv))
    y = y + jnp.einsum('bhntd,bhnt,nbhde->bhnte', qc, jnp.exp(cum), states)
    return y.reshape(B, H, S, dv)


def mlstm_chunkwise(q, k, v, i_pre, log_f):
    B, H, S, d = q.shape
    n = S // CHUNK
    qc = (q * d ** -0.5).reshape(B, H, n, CHUNK, d)
    kc = k.reshape(B, H, n, CHUNK, d)
    vc = v.reshape(B, H, n, CHUNK, d)
    ic = i_pre.reshape(B, H, n, CHUNK)
    b = jnp.cumsum(log_f.reshape(B, H, n, CHUNK), axis=-1)
    causal = jnp.tril(jnp.ones((CHUNK, CHUNK), dtype=bool))
    logD = jnp.where(causal, b[..., :, None] - b[..., None, :] + ic[..., None, :], -jnp.inf)
    m_intra = jnp.max(logD, axis=-1)
    e = b[..., -1:] - b + ic
    g = jnp.max(e, axis=-1)
    w = jnp.exp(e - g[..., None])
    kv_loc = jnp.einsum('bhns,bhnsd,bhnse->nbhde', w, kc, vc)
    k_loc = jnp.einsum('bhns,bhnsd->nbhd', w, kc)
    b_end = b[..., -1].transpose(2, 0, 1)
    g_t = g.transpose(2, 0, 1)

    def step(carry, inp):
        C, nv, m = carry
        bl, gl, kvl, kl = inp
        m_new = jnp.maximum(bl + m, gl)
        a_old = jnp.exp(bl + m - m_new)
        a_loc = jnp.exp(gl - m_new)
        C_new = a_old[..., None, None] * C + a_loc[..., None, None] * kvl
        n_new = a_old[..., None] * nv + a_loc[..., None] * kl
        return (C_new, n_new, m_new), (C, nv, m)

    init = (jnp.zeros((B, H, d, d), jnp.float32), jnp.zeros((B, H, d), jnp.float32),
            jnp.zeros((B, H), jnp.float32))
    _, (C_in, n_in, m_in) = lax.scan(step, init, (b_end, g_t, kv_loc, k_loc))
    inter_log = b + m_in.transpose(1, 2, 0)[..., None]
    m_t = jnp.maximum(inter_log, m_intra)
    a_inter = jnp.exp(inter_log - m_t)
    P = jnp.exp(logD - m_t[..., None]) * jnp.einsum('bhntd,bhnsd->bhnts', qc, kc)
    num = (jnp.einsum('bhnts,bhnse->bhnte', P, vc)
           + a_inter[..., None] * jnp.einsum('bhntd,nbhde->bhnte', qc, C_in))
    den = P.sum(-1) + a_inter * jnp.einsum('bhntd,nbhd->bhnt', qc, n_in)
    h = num / jnp.maximum(jnp.abs(den), jnp.exp(-m_t))[..., None]
    return h.reshape(B, H, S, d)


def hybrid_mixer(u, w_in, w_out, fox_fb, mlstm_conv_w, mlstm_conv_b, mlstm_ib, mlstm_fb,
                 mlstm_norm_g, ret_norm_g, ssd_conv_w, ssd_conv_b, ssd_dt_bias, ssd_A_log,
                 ssd_D, ssd_norm_g):
    B, S, _ = u.shape
    W, H = GROUP_WIDTH, N_HEADS
    proj = (u @ w_in).astype(jnp.float32)
    fox_p, mlstm_p, ret_p, ssd_p = jnp.split(
        proj, [FOX_COLS, FOX_COLS + MLSTM_COLS, FOX_COLS + MLSTM_COLS + RET_COLS], axis=-1)

    fq, fk, fv, ff = jnp.split(fox_p, [W, 2 * W, 3 * W], axis=-1)
    fox_logf = jax.nn.log_sigmoid(ff + fox_fb).transpose(0, 2, 1)
    y_fox = merge_heads(forgetting_attention(to_heads(fq), to_heads(fk), to_heads(fv), fox_logf))

    mqk, mv, mi, mf, mo = jnp.split(mlstm_p, [2 * W, 3 * W, 3 * W + H, 3 * W + 2 * H], axis=-1)
    mqk = jax.nn.silu(causal_dwconv(mqk, mlstm_conv_w, mlstm_conv_b))
    mq, mk = jnp.split(mqk, 2, axis=-1)
    h_m = mlstm_chunkwise(to_heads(mq), to_heads(mk), to_heads(mv),
                          (mi + mlstm_ib).transpose(0, 2, 1),
                          jax.nn.log_sigmoid(mf + mlstm_fb).transpose(0, 2, 1))
    y_mlstm = jax.nn.sigmoid(mo) * merge_heads(head_rmsnorm(h_m, mlstm_norm_g))

    rq, rk, rv, rg = jnp.split(ret_p, 4, axis=-1)
    rq = rotary(to_heads(rq))
    rk = rotary(to_heads(rk)) * HEAD_DIM ** -0.5
    log_gamma = jnp.log(1.0 - 2.0 ** (-RET_DECAY_OFFSET - jnp.arange(H, dtype=jnp.float32)))
    ret_loga = jnp.broadcast_to(log_gamma[None, :, None], (B, H, S))
    h_r = chunked_decay_attention(rq, rk, to_heads(rv), ret_loga)
    y_ret = jax.nn.silu(rg) * merge_heads(head_rmsnorm(h_r, ret_norm_g))

    sz, sxbc, sdt = jnp.split(ssd_p, [W, 2 * W + 2 * SSD_GROUPS * SSD_STATE], axis=-1)
    sxbc = jax.nn.silu(causal_dwconv(sxbc, ssd_conv_w, ssd_conv_b))
    sx, sB, sC = jnp.split(sxbc, [W, W + SSD_GROUPS * SSD_STATE], axis=-1)
    dt = jax.nn.softplus(sdt + ssd_dt_bias).transpose(0, 2, 1)
    A = -jnp.exp(ssd_A_log.astype(jnp.float32))
    rep = H // SSD_GROUPS
    Bh = jnp.repeat(sB.reshape(B, S, SSD_GROUPS, SSD_STATE), rep, axis=2).transpose(0, 2, 1, 3)
    Ch = jnp.repeat(sC.reshape(B, S, SSD_GROUPS, SSD_STATE), rep, axis=2).transpose(0, 2, 1, 3)
    xh = to_heads(sx)
    h_s = chunked_decay_attention(Ch, Bh, xh * dt[..., None], dt * A[:, None])
    h_s = h_s + ssd_D[:, None, None] * xh
    y_ssd = rmsnorm(merge_heads(h_s) * jax.nn.silu(sz), ssd_norm_g)

    y = jnp.concatenate([y_fox, y_mlstm, y_ret, y_ssd], axis=-1)
    return y.astype(u.dtype) @ w_out


def setup_inputs(seed: int = 0) -> dict:
    key = jax.random.key(seed)
    ks = jax.random.split(key, 25)
    f32 = jnp.float32
    L, D, W, H = DEPTH, D_MODEL, GROUP_WIDTH, N_HEADS

    def nrm(k, shape, s):
        return s * jax.random.normal(k, shape, f32)

    dt0 = jnp.exp(jax.random.uniform(ks[20], (L, H), f32, math.log(1e-3), math.log(1e-1)))
    return {
        'x': nrm(ks[0], (BATCH, SEQ, D), 1.0),
        'c': nrm(ks[1], (BATCH, D), 1.0),
        'ada_w': nrm(ks[2], (L, D, N_MOD * D), 0.5 * D ** -0.5),
        'ada_b': nrm(ks[3], (L, N_MOD * D), 0.02),
        'norm_g': 1.0 + nrm(ks[4], (L, 3, D), 0.02),
        'ffn1_w13': nrm(ks[5], (L, D, 2 * D_FF), D ** -0.5),
        'ffn1_w2': nrm(ks[6], (L, D_FF, D), D_FF ** -0.5),
        'ffn2_w13': nrm(ks[7], (L, D, 2 * D_FF), D ** -0.5),
        'ffn2_w2': nrm(ks[8], (L, D_FF, D), D_FF ** -0.5),
        'w_in': nrm(ks[9], (L, D, D_IN_PROJ), D ** -0.5),
        'w_out': nrm(ks[10], (L, D_MIX, D), D_MIX ** -0.5),
        'fox_fb': 3.0 + nrm(ks[11], (L, H), 0.5),
        'mlstm_conv_w': nrm(ks[12], (L, CONV_K, 2 * W), CONV_K ** -0.5),
        'mlstm_conv_b': nrm(ks[13], (L, 2 * W), 0.02),
        'mlstm_ib': nrm(ks[14], (L, H), 0.1),
        'mlstm_fb': jnp.linspace(3.0, 6.0, H, dtype=f32)[None, :] + nrm(ks[15], (L, H), 0.1),
        'mlstm_norm_g': 1.0 + nrm(ks[16], (L, W), 0.02),
        'ret_norm_g': 1.0 + nrm(ks[17], (L, W), 0.02),
        'ssd_conv_w': nrm(ks[18], (L, CONV_K, W + 2 * SSD_GROUPS * SSD_STATE), CONV_K ** -0.5),
        'ssd_conv_b': nrm(ks[19], (L, W + 2 * SSD_GROUPS * SSD_STATE), 0.02),
        'ssd_dt_bias': dt0 + jnp.log(-jnp.expm1(-dt0)),
        'ssd_A_log': jnp.log(jax.random.uniform(ks[21], (L, H), f32, 1.0, 16.0)),
        'ssd_D': 1.0 + nrm(ks[22], (L, H), 0.1),
        'ssd_norm_g': 1.0 + nrm(ks[23], (L, W), 0.02),
        'final_g': 1.0 + nrm(ks[24], (D,), 0.02),
    }


def reference(x, c, ada_w, ada_b, norm_g, ffn1_w13, ffn1_w2, ffn2_w13, ffn2_w2, w_in, w_out,
              fox_fb, mlstm_conv_w, mlstm_conv_b, mlstm_ib, mlstm_fb, mlstm_norm_g, ret_norm_g,
              ssd_conv_w, ssd_conv_b, ssd_dt_bias, ssd_A_log, ssd_D, ssd_norm_g, final_g):
    c_act = jax.nn.silu(c)
    for l in range(DEPTH):
        cond = (c_act @ ada_w[l] + ada_b[l])[:, None, :]
        sh1, sc1, g1, sh2, sc2, g2, sh3, sc3, g3 = jnp.split(cond, N_MOD, axis=-1)
        h = modulate(rmsnorm(x, norm_g[l, 0]), sh1, sc1)
        x = x + 0.5 * g1 * swiglu(h, ffn1_w13[l], ffn1_w2[l])
        h = modulate(rmsnorm(x, norm_g[l, 1]), sh2, sc2)
        x = x + g2 * hybrid_mixer(h, w_in[l], w_out[l], fox_fb[l], mlstm_conv_w[l], mlstm_conv_b[l],
                                  mlstm_ib[l], mlstm_fb[l], mlstm_norm_g[l], ret_norm_g[l],
                                  ssd_conv_w[l], ssd_conv_b[l], ssd_dt_bias[l], ssd_A_log[l],
                                  ssd_D[l], ssd_norm_g[l])
        h = modulate(rmsnorm(x, norm_g[l, 2]), sh3, sc3)
        x = x + 0.5 * g3 * swiglu(h, ffn2_w13[l], ffn2_w2[l])
    return rmsnorm(x, final_g)
```

```cpp
#include <hip/hip_runtime.h>
#include <cstdio>
#include <cstdint>
namespace pg8 {
#define PG8_LAS __attribute__((address_space(3)))
typedef unsigned short bf16_t;
typedef short bf16x8 __attribute__((ext_vector_type(8)));
typedef float f32x4 __attribute__((ext_vector_type(4)));
typedef unsigned u32x4 __attribute__((ext_vector_type(4)));
constexpr int BM = 256, BK = 64, HALF = 128, HTB = HALF * BK * 2  , STAGE_BYTES = 8 * HTB, NXCD = 8, WGM = 8;

__host__ __device__ __forceinline__ int lds_byte(int r, int c) { const int st = (r >> 4) * 2 + (c >> 5), rr = r & 15, cc = c & 31, ob = rr * 64 + cc * 2; return st * 1024 + (ob ^ (((ob >> 9) & 1) << 5)); }
__host__ __device__ __forceinline__ void stage_rc(int b, int& R, int& C) { const int st = b / 1024, sb = b % 1024, swz = sb ^ (((sb >> 9) & 1) << 5); R = (st >> 1) * 16 + swz / 64; C = (st & 1) * 32 + (swz % 64) / 2; }
__host__ __device__ __forceinline__ int perm32(int rho) { const int n = rho >> 4, i = rho & 15; return 8 * (i >> 2) + 4 * n + (i & 3); }

struct Unit { int pm, pn; };
struct Gemm { const bf16_t* A; const bf16_t* Bt; int M, N, K; };

struct StaticOrder {
    int nM, nN, nwg, G, c;
    __host__ __device__ void init(int M, int N, int G_, int c_) { nM = M / BM; nN = N / BM; nwg = nM * nN; G = G_; c = c_; }
    __host__ __device__ bool next(int i, Unit& u) const {
        const long L = (long)i * G + c; if (L >= nwg) return false;
        int wgid = (int)L; { const int q = nwg / NXCD, r = nwg % NXCD, xcd = wgid % NXCD, off = wgid / NXCD; wgid = (xcd < r ? xcd * (q + 1) : r * (q + 1) + (xcd - r) * q) + off; }
        const int nig = WGM * nN, gid = wgid / nig, fm = gid * WGM, gsz = (nM - fm) < WGM ? (nM - fm) : WGM;
        u.pm = fm + ((wgid % nig) % gsz); u.pn = (wgid % nig) / gsz; return true;
    }
    __device__ __forceinline__ void a_ready(const Unit&) const {}
    __device__ __forceinline__ void done(const Unit&) const {}
};

__device__ __forceinline__ unsigned cvt_pk_bf16(float lo, float hi) { unsigned r; asm volatile("v_cvt_pk_bf16_f32 %0, %1, %2" : "=v"(r) : "v"(lo), "v"(hi)); return r; }

__device__ __forceinline__ float silu_f(float v) { return v * __builtin_amdgcn_rcpf(1.0f + __expf(-v)); }
struct EpiSwiglu {
    static constexpr bool PERM = true, AFTER_DRAIN = false;
    bf16_t* O; int ldo;
    __device__ __forceinline__ void operator()(const f32x4 (&acc)[2][2][4][2], const Unit& u, int wr, int wc, int fr, int fq) const {
        const int row0 = u.pm * BM + wr * 64 + fr, col0 = u.pn * HALF + wc * 32 + 8 * fq;
#pragma unroll
        for (int ai = 0; ai < 2; ++ai)
#pragma unroll
            for (int m = 0; m < 4; ++m) { bf16_t* rowp = O + (size_t)(row0 + ai * HALF + m * 16) * ldo + col0;
                const f32x4 a0 = acc[ai][0][m][0], a1 = acc[ai][0][m][1], g0 = acc[ai][1][m][0], g1 = acc[ai][1][m][1];
                u32x4 w; w.x = cvt_pk_bf16(silu_f(g0[0]) * a0[0], silu_f(g0[1]) * a0[1]); w.y = cvt_pk_bf16(silu_f(g0[2]) * a0[2], silu_f(g0[3]) * a0[3]);
                w.z = cvt_pk_bf16(silu_f(g1[0]) * a1[0], silu_f(g1[1]) * a1[1]); w.w = cvt_pk_bf16(silu_f(g1[2]) * a1[2], silu_f(g1[3]) * a1[3]);
                *(u32x4*)rowp = w; }
    }
};
struct EpiResid {
    static constexpr bool PERM = false, AFTER_DRAIN = false;
    const float* base; float* out; int ldc; const float* gate; int gstride; int rows_per_b; float coef;
    __device__ __forceinline__ void operator()(const f32x4 (&acc)[2][2][4][2], const Unit& u, int wr, int wc, int fr, int fq) const {
        const int col0 = u.pn * BM + wc * 32 + 4 * fq; const int b = (u.pm * BM) / rows_per_b;
        f32x4 gv[2][2];
#pragma unroll
        for (int bj = 0; bj < 2; ++bj)
#pragma unroll
            for (int n = 0; n < 2; ++n) gv[bj][n] = *(const f32x4*)(gate + (size_t)b * gstride + col0 + bj * HALF + n * 16) * coef;
#pragma unroll
        for (int ai = 0; ai < 2; ++ai)
#pragma unroll
            for (int m = 0; m < 4; ++m) { const size_t off = (size_t)(u.pm * BM + ai * HALF + wr * 64 + m * 16 + fr) * ldc + col0;
#pragma unroll
                for (int bj = 0; bj < 2; ++bj)
#pragma unroll
                    for (int n = 0; n < 2; ++n) { const f32x4 bs = *(const f32x4*)(base + off + bj * HALF + n * 16); *(f32x4*)(out + off + bj * HALF + n * 16) = bs + gv[bj][n] * acc[ai][bj][m][n]; }
                if (m & 1) asm volatile("" ::: "memory"); }
    }
};
struct EpiProj {
    static constexpr bool PERM = true, AFTER_DRAIN = false;
    bf16_t* P; int ldp; float* G; int ntile_bf;
    __device__ __forceinline__ void operator()(const f32x4 (&acc)[2][2][4][2], const Unit& u, int wr, int wc, int fr, int fq) const {
        const int row0 = u.pm * BM + wr * 64 + fr;
        if (u.pn < ntile_bf) {
            const int col0 = u.pn * BM + wc * 32 + 8 * fq;
#pragma unroll
            for (int ai = 0; ai < 2; ++ai)
#pragma unroll
                for (int m = 0; m < 4; ++m) { bf16_t* rowp = P + (size_t)(row0 + ai * HALF + m * 16) * ldp + col0;
#pragma unroll
                    for (int bj = 0; bj < 2; ++bj) { const f32x4 v0 = acc[ai][bj][m][0], v1 = acc[ai][bj][m][1];
                        u32x4 w; w.x = cvt_pk_bf16(v0[0], v0[1]); w.y = cvt_pk_bf16(v0[2], v0[3]); w.z = cvt_pk_bf16(v1[0], v1[1]); w.w = cvt_pk_bf16(v1[2], v1[3]);
                        *(u32x4*)(rowp + bj * HALF) = w; } }
        } else if (wc == 0 && fq < 2) {
#pragma unroll
            for (int ai = 0; ai < 2; ++ai)
#pragma unroll
                for (int m = 0; m < 4; ++m) { float* gp = G + (size_t)(row0 + ai * HALF + m * 16) * 16 + 8 * fq;
                    *(f32x4*)gp = acc[ai][0][m][0]; *(f32x4*)(gp + 4) = acc[ai][0][m][1]; }
        }
    }
};

template <class Epi, class Sched, bool ALIGN_EPI = false, bool SP2 = false>
__device__ __forceinline__ void gemm_phase(PG8_LAS unsigned char* lds, const Gemm g, const Sched& S, const Epi& E) {
    int tid_ = threadIdx.x; asm volatile("" : "+v"(tid_));
    const int tid = tid_, wid = __builtin_amdgcn_readfirstlane(tid >> 6), lane = tid & 63, wr = wid >> 2, wc = wid & 3, fr = lane & 15, fq = lane >> 4;
    const int K = g.K, nt = K / BK;
    unsigned voffA[2], voffB[2];
#pragma unroll
    for (int i = 0; i < 2; ++i) { int R, C; stage_rc(tid * 16 + i * 8192, R, C); const int Rb = Epi::PERM ? ((R & ~31) + perm32(R & 31)) : R;
        voffA[i] = (unsigned)(R * K + C) * 2u; voffB[i] = (unsigned)(Rb * K + C) * 2u; }
    const size_t kstep = (size_t)(BK * 2);
    const size_t hstep = (size_t)HALF * K * 2;
    const size_t tstep = 2 * hstep;
    const unsigned ldsw = (unsigned)wid * 1024u;
    const int aoff = lds_byte(wr * 64 + fr, fq * 8), boff = lds_byte(wc * 32 + fr, fq * 8);
#define PG8_SA(b, h) (((b) * 2 + (h)) * HTB)
#define PG8_SB(b, h) ((4 + (b) * 2 + (h)) * HTB)
#define PG8_STAGE(bufoff, gbase, voff) do { _Pragma("unroll") for (int _i = 0; _i < 2; ++_i) \
        __builtin_amdgcn_global_load_lds((const unsigned*)((const char*)(gbase) + (voff)[_i]), (PG8_LAS unsigned*)(lds + (bufoff) + ldsw + _i * 8192), 16, 0, 0); } while (0)
#define PG8_LDA(dst, b, h) do { _Pragma("unroll") for (int m = 0; m < 4; ++m) _Pragma("unroll") for (int k = 0; k < 2; ++k) dst[m][k] = *(const PG8_LAS bf16x8*)(lds + PG8_SA(b, h) + aoff + m * 2048 + k * 1024); } while (0)
#define PG8_LDB(dst, b, h) do { _Pragma("unroll") for (int n = 0; n < 2; ++n) _Pragma("unroll") for (int k = 0; k < 2; ++k) dst[n][k] = *(const PG8_LAS bf16x8*)(lds + PG8_SB(b, h) + boff + n * 2048 + k * 1024); } while (0)
#define PG8_MMA(ai, bj, At, Bt) do { __builtin_amdgcn_s_setprio(1); _Pragma("unroll") for (int m = 0; m < 4; ++m) _Pragma("unroll") for (int n = 0; n < 2; ++n) _Pragma("unroll") for (int k = 0; k < 2; ++k) \
        acc[ai][bj][m][n] = __builtin_amdgcn_mfma_f32_16x16x32_bf16(Bt[n][k], At[m][k], acc[ai][bj][m][n], 0, 0, 0); __builtin_amdgcn_s_setprio(0); } while (0)
#define PG8_WAIT_V(n) asm volatile("s_waitcnt vmcnt(" #n ")" ::: "memory")
#define PG8_WAIT_L(n) asm volatile("s_waitcnt lgkmcnt(" #n ")" ::: "memory")
#define PG8_BAR __builtin_amdgcn_s_barrier()
#define PG8_SCHED __builtin_amdgcn_sched_barrier(0)
    Unit cur, nxt; int ui = 0;
    if (!S.next(0, cur)) return;
    f32x4 acc[2][2][4][2];
#pragma unroll
    for (int a = 0; a < 2; ++a)
#pragma unroll
        for (int b = 0; b < 2; ++b)
#pragma unroll
            for (int m = 0; m < 4; ++m)
#pragma unroll
                for (int n = 0; n < 2; ++n) acc[a][b][m][n] = (f32x4){0.f, 0.f, 0.f, 0.f};
    bf16x8 At[4][2], B0[2][2], B1[2][2];
    const char* cA = (const char*)g.A + (size_t)cur.pm * tstep; const char* cB = (const char*)g.Bt + (size_t)cur.pn * tstep;
    S.a_ready(cur);
    if constexpr (SP2) {
        PG8_STAGE(PG8_SB(0, 0), cB, voffB); PG8_STAGE(PG8_SB(0, 1), cB + hstep, voffB); PG8_STAGE(PG8_SA(0, 0), cA, voffA); PG8_STAGE(PG8_SA(0, 1), cA + hstep, voffA);
        if (wr == 1) PG8_BAR;
        PG8_WAIT_V(2); PG8_BAR;
        PG8_STAGE(PG8_SB(1, 0), cB + kstep, voffB); PG8_STAGE(PG8_SA(1, 0), cA + kstep, voffA); PG8_STAGE(PG8_SB(1, 1), cB + hstep + kstep, voffB);
        PG8_WAIT_V(6); PG8_BAR;
    } else {
        PG8_STAGE(PG8_SB(0, 0), cB, voffB); PG8_STAGE(PG8_SA(0, 0), cA, voffA); PG8_STAGE(PG8_SB(0, 1), cB + hstep, voffB); PG8_STAGE(PG8_SA(0, 1), cA + hstep, voffA);
        if (wr == 1) PG8_BAR;
        PG8_WAIT_V(4); PG8_BAR;
        PG8_STAGE(PG8_SB(1, 0), cB + kstep, voffB); PG8_STAGE(PG8_SA(1, 0), cA + kstep, voffA); PG8_STAGE(PG8_SB(1, 1), cB + hstep + kstep, voffB);
        PG8_WAIT_V(6); PG8_BAR;
    }
    for (;;) {
        const bool has_next = S.next(ui + 1, nxt);
        const char* nA = has_next ? (const char*)g.A + (size_t)nxt.pm * tstep : cA; const char* nB = has_next ? (const char*)g.Bt + (size_t)nxt.pn * tstep : cB;
        for (int t = 0; t < nt; t += 2) {
            const bool last = (t == nt - 2);
            const char* a1 = cA + (size_t)(t + 1) * kstep;
            const char* a2 = last ? nA : cA + (size_t)(t + 2) * kstep; const char* b2 = last ? nB : cB + (size_t)(t + 2) * kstep;
            const char* a3 = a2 + kstep; const char* b3 = b2 + kstep;
            if (last && has_next) S.a_ready(nxt);
            if constexpr (SP2) {
            PG8_LDB(B0, 0, 0); PG8_LDB(B1, 0, 1); PG8_SCHED; PG8_LDA(At, 0, 0); PG8_STAGE(PG8_SA(1, 1), a1 + hstep, voffA);
            PG8_WAIT_V(8); PG8_WAIT_L(0); PG8_BAR; PG8_MMA(0, 0, At, B0); PG8_MMA(0, 1, At, B1); PG8_BAR; PG8_SCHED;
            PG8_LDA(At, 0, 1); PG8_STAGE(PG8_SB(0, 0), b2, voffB); PG8_STAGE(PG8_SB(0, 1), b2 + hstep, voffB); PG8_STAGE(PG8_SA(0, 0), a2, voffA);
            PG8_WAIT_V(8); PG8_WAIT_L(0); PG8_BAR; PG8_MMA(1, 0, At, B0); PG8_MMA(1, 1, At, B1); PG8_BAR; PG8_SCHED;
            PG8_LDB(B0, 1, 0); PG8_LDB(B1, 1, 1); PG8_SCHED; PG8_LDA(At, 1, 0); PG8_STAGE(PG8_SA(0, 1), a2 + hstep, voffA);
            PG8_WAIT_V(8); PG8_WAIT_L(0); PG8_BAR; PG8_MMA(0, 0, At, B0); PG8_MMA(0, 1, At, B1); PG8_BAR; PG8_SCHED;
            PG8_LDA(At, 1, 1); PG8_STAGE(PG8_SB(1, 0), b3, voffB); PG8_STAGE(PG8_SB(1, 1), b3 + hstep, voffB); PG8_STAGE(PG8_SA(1, 0), a3, voffA);
            PG8_WAIT_V(8); PG8_WAIT_L(0); PG8_BAR; PG8_MMA(1, 0, At, B0); PG8_MMA(1, 1, At, B1); PG8_BAR; PG8_SCHED;
            } else {
            PG8_LDB(B0, 0, 0); PG8_SCHED; PG8_LDA(At, 0, 0); PG8_STAGE(PG8_SA(1, 1), a1 + hstep, voffA);
            PG8_WAIT_L(8); PG8_BAR; PG8_WAIT_L(0); PG8_MMA(0, 0, At, B0); PG8_BAR; PG8_SCHED;
            PG8_LDB(B1, 0, 1); PG8_STAGE(PG8_SB(0, 0), b2, voffB);
            PG8_BAR; PG8_WAIT_L(0); PG8_MMA(0, 1, At, B1); PG8_BAR;
            PG8_LDA(At, 0, 1); PG8_STAGE(PG8_SA(0, 0), a2, voffA);
            PG8_BAR; PG8_WAIT_L(0); PG8_MMA(1, 0, At, B0); PG8_BAR; PG8_SCHED;
            PG8_STAGE(PG8_SB(0, 1), b2 + hstep, voffB);
            PG8_WAIT_V(6); PG8_BAR; PG8_MMA(1, 1, At, B1); PG8_BAR;
            PG8_LDB(B0, 1, 0); PG8_SCHED; PG8_LDA(At, 1, 0); PG8_STAGE(PG8_SA(0, 1), a2 + hstep, voffA);
            PG8_WAIT_L(8); PG8_BAR; PG8_WAIT_L(0); PG8_MMA(0, 0, At, B0); PG8_BAR; PG8_SCHED;
            PG8_LDB(B1, 1, 1); PG8_STAGE(PG8_SB(1, 0), b3, voffB);
            PG8_BAR; PG8_WAIT_L(0); PG8_MMA(0, 1, At, B1); PG8_BAR;
            PG8_LDA(At, 1, 1); PG8_STAGE(PG8_SA(1, 0), a3, voffA);
            PG8_BAR; PG8_WAIT_L(0); PG8_MMA(1, 0, At, B0); PG8_BAR; PG8_SCHED;
            PG8_STAGE(PG8_SB(1, 1), b3 + hstep, voffB);
            PG8_WAIT_V(6); PG8_BAR; PG8_MMA(1, 1, At, B1); PG8_BAR;
            }
        }
        if constexpr (ALIGN_EPI) { if (wr == 0) PG8_BAR; }
        if constexpr (!Epi::AFTER_DRAIN) { E(acc, cur, wr, wc, fr, fq); S.done(cur); }
        if (!has_next) break;
#pragma unroll
        for (int a = 0; a < 2; ++a)
#pragma unroll
            for (int b = 0; b < 2; ++b)
#pragma unroll
                for (int m = 0; m < 4; ++m)
#pragma unroll
                    for (int n = 0; n < 2; ++n) acc[a][b][m][n] = (f32x4){0.f, 0.f, 0.f, 0.f};
        cur = nxt; cA = nA; cB = nB; ++ui;
        if constexpr (ALIGN_EPI) { if (wr == 1) PG8_BAR; }
    }
    PG8_WAIT_V(0);
    if constexpr (!ALIGN_EPI) { if (wr == 0) PG8_BAR; }
    PG8_BAR;
    if constexpr (Epi::AFTER_DRAIN) { E.fused(acc, cur, wr, wc, fr, fq, lds, wid, lane); S.done(cur); }
#undef PG8_SA
#undef PG8_SB
#undef PG8_STAGE
#undef PG8_LDA
#undef PG8_LDB
#undef PG8_MMA
#undef PG8_WAIT_V
#undef PG8_WAIT_L
#undef PG8_BAR
#undef PG8_SCHED
}
}
#define GAS __attribute__((address_space(1)))
#define LAS __attribute__((address_space(3)))
typedef unsigned short bf16;
typedef unsigned v4u __attribute__((ext_vector_type(4)));
typedef float f32x4 __attribute__((ext_vector_type(4)));
typedef short bf16x8 __attribute__((ext_vector_type(8)));
typedef GAS unsigned gu32;
typedef GAS unsigned long long gu64;
#define RLX_AGENT __ATOMIC_RELAXED, __HIP_MEMORY_SCOPE_AGENT
#define LDS_WAIT() asm volatile("s_waitcnt lgkmcnt(0)" ::: "memory")
#define VM_WAIT() asm volatile("s_waitcnt vmcnt(0)" ::: "memory")
__device__ __forceinline__ unsigned long long rt() { return __builtin_amdgcn_s_memrealtime(); }
__device__ __forceinline__ unsigned f2bf(float f) { unsigned u = __builtin_bit_cast(unsigned, f); return (u + 0x7fffu + ((u >> 16) & 1u)) >> 16; }
__device__ __forceinline__ unsigned pk2(float lo, float hi) { return f2bf(lo) | (f2bf(hi) << 16); }

#define XB_TMO      128
#define XB_XCNT(j)  (256  + 64 * (j))
#define XB_XSUB(j)  (1280 + 64 * (j))
#define XB_XGEN(j)  (2304 + 64 * (j))
#define XB_TOP      3328
#define XB_TOPGEN   3392
#define XCD_BAR_WORDS 3456
#define XB_SPIN_CAP (1u << 18)

__device__ __forceinline__ unsigned xb_ld(unsigned* p)              { return __hip_atomic_load(p, __ATOMIC_RELAXED, __HIP_MEMORY_SCOPE_AGENT); }
__device__ __forceinline__ unsigned xb_add(unsigned* p, unsigned v) { return __hip_atomic_fetch_add(p, v, __ATOMIC_RELAXED, __HIP_MEMORY_SCOPE_AGENT); }
__device__ __forceinline__ unsigned xb_xcc_id() { return (unsigned)__builtin_amdgcn_s_getreg((3 << 11) | 20) & 0xFu; }
#define XB_SPIN(cond, bar) do { unsigned _sp = 0; while (cond) { __builtin_amdgcn_s_sleep(1); \
    if ((++_sp & 255u) == 0u) { if (xb_ld(&(bar)[XB_TMO])) break; if (_sp > XB_SPIN_CAP) { atomicAdd(&(bar)[XB_TMO], 1u); break; } } } } while (0)

struct XcdBarrier {
    unsigned* bar; unsigned x;
    volatile LAS unsigned* st;
};

__device__ __forceinline__ XcdBarrier xcd_barrier_post(unsigned* bar, volatile LAS unsigned* st) {
    XcdBarrier b; b.bar = bar; b.x = xb_xcc_id(); b.st = st;
    if (threadIdx.x == 0) (void)xb_add(&bar[XB_XCNT(b.x)], 1u);
    return b;
}
__device__ __forceinline__ void xcd_barrier_complete(unsigned* bar, unsigned x, unsigned& nloc, unsigned& nx) {
    const unsigned G = gridDim.x * gridDim.y * gridDim.z;
    unsigned sum, cnt, mine, sp = 0u;
    for (;;) {
        sum = 0u; cnt = 0u; mine = 0u;
#pragma unroll
        for (unsigned j = 0; j < 16; ++j) { const unsigned c = xb_ld(&bar[XB_XCNT(j)]); sum += c; cnt += (c > 0u) ? 1u : 0u; mine = (j == x) ? c : mine; }
        if (sum == G) break;
        __builtin_amdgcn_s_sleep(1);
        if ((++sp & 255u) == 0u) { if (xb_ld(&bar[XB_TMO])) break; if (sp > XB_SPIN_CAP) { atomicAdd(&bar[XB_TMO], 1u); break; } }
    }
    nloc = mine > 0u ? mine : 1u; nx = cnt > 0u ? cnt : 1u;
}

__device__ __forceinline__ void xcd_barrier(const XcdBarrier& b) {
    asm volatile("s_waitcnt vmcnt(0)" ::: "memory");
    __syncthreads();
    if (threadIdx.x == 0) {
        unsigned* bar = b.bar;
        __builtin_amdgcn_s_waitcnt(0);
        unsigned nloc = b.st[0], nx = b.st[1];
        if (nloc == 0u) { xcd_barrier_complete(bar, b.x, nloc, nx); b.st[0] = nloc; b.st[1] = nx; }
        const unsigned old = xb_add(&bar[XB_XSUB(b.x)], 1u);
        const unsigned gen = old / nloc;
        if (old + 1u == (gen + 1u) * nloc) {
            __builtin_amdgcn_fence(__ATOMIC_RELEASE, "agent");
            asm volatile("s_waitcnt vmcnt(0)" ::: "memory");
            const unsigned og = xb_add(&bar[XB_TOP], 1u);
            const unsigned tg = og / nx;
            if (og + 1u == (tg + 1u) * nx) xb_add(&bar[XB_TOPGEN], 1u);
            else XB_SPIN(xb_ld(&bar[XB_TOPGEN]) == tg, bar);
            __builtin_amdgcn_fence(__ATOMIC_ACQUIRE, "agent");
            xb_add(&bar[XB_XGEN(b.x)], 1u);
            asm volatile("s_waitcnt vmcnt(0)" ::: "memory");
        } else {
            XB_SPIN(xb_ld(&bar[XB_XGEN(b.x)]) == gen, bar);
            __builtin_amdgcn_fence(__ATOMIC_ACQUIRE, "agent");
            asm volatile("s_waitcnt vmcnt(0)" ::: "memory");
        }
    }
    __syncthreads();
}

constexpr int NWAVES = 8, NTHR = 512;
constexpr int DM = 1024, BATCH = 8, SEQ = 2048, DEPTH = 4, M = BATCH * SEQ;
constexpr int DFF = 2816, NUP = 2 * DFF, NPROJ = 3840, PROJ_LD = 3584, NIN_SRC = 3600, NCOND = 9 * DM;
constexpr float RMS_EPS = 1e-6f;
constexpr int PC_FQ = 0, PC_FK = 256, PC_FV = 512, PC_MQ = 768, PC_MK = 1024, PC_MV = 1280, PC_MO = 1536, PC_RQ = 1792, PC_RK = 2048, PC_RV = 2304, PC_RG = 2560, PC_SZ = 2816, PC_SX = 3072;
constexpr int PH_FINAL = 1 + 12 * DEPTH, PH_END = PH_FINAL + 1;
constexpr size_t MiB = 1u << 20;
constexpr size_t WS_CTL = 0, CTL_ZERO_BYTES = 1 * MiB;
constexpr size_t WS_COND = 1 * MiB;
constexpr size_t WS_ROPE = 3 * MiB;
constexpr size_t WS_W = 4 * MiB;
constexpr size_t W_UP = (size_t)NUP * DM * 2, W_DN = (size_t)DM * DFF * 2, W_IN = (size_t)NPROJ * DM * 2, W_OUT = (size_t)DM * DM * 2;
constexpr size_t OFF_UP1 = 0, OFF_DN1 = W_UP, OFF_UP2 = W_UP + W_DN, OFF_DN2 = 2 * W_UP + W_DN, OFF_IN = 2 * W_UP + 2 * W_DN, OFF_OUT = OFF_IN + W_IN, LAYER_W = OFF_OUT + W_OUT;
static_assert(LAYER_W * DEPTH == 170 * MiB, "weights");
constexpr size_t WS_HB = 174 * MiB;
constexpr size_t WS_PROJ = 206 * MiB, WS_ACT = 206 * MiB;
constexpr size_t WS_GATES = 318 * MiB;
constexpr size_t WS_PRE = 319 * MiB;
constexpr size_t WS_YRAW = 415 * MiB;
constexpr size_t WS_YBF = 479 * MiB, WS_END = 511 * MiB;
static_assert(WS_PROJ + (size_t)M * PROJ_LD * 2 <= WS_GATES && WS_ACT + (size_t)M * DFF * 2 <= WS_GATES && WS_PRE + (size_t)M * 1536 * 4 <= WS_YRAW && WS_YRAW + (size_t)M * 1024 * 4 <= WS_YBF, "ws map");
constexpr int CW_BAR = 4096;
constexpr int RING_BYTES = 131072, LDSCTL_OFF = RING_BYTES, MISC_OFF = LDSCTL_OFF + 320, LDS_BYTES = 147456;

__device__ const double INVREV[32] = {0.15915494309189535, 0.11934937021124886, 0.089499401608891013, 0.067115083005227255, 0.050329212104487035, 0.037741584717419778, 0.028302195830623395, 0.02122365276477766, 0.015915494309189534, 0.011934937021124886, 0.0089499401608891006, 0.0067115083005227253, 0.0050329212104487037, 0.0037741584717419768, 0.0028302195830623399, 0.0021223652764777662, 0.0015915494309189536, 0.0011934937021124887, 0.00089499401608891024, 0.0006711508300522726, 0.00050329212104487033, 0.00037741584717419769, 0.00028302195830623401, 0.00021223652764777661, 0.00015915494309189535, 0.00011934937021124885, 8.9499401608891018e-05, 6.7115083005227268e-05, 5.0329212104487035e-05, 3.7741584717419777e-05, 2.8302195830623396e-05, 2.1223652764777659e-05};

struct Args { const float* in[25]; float* out; unsigned char* ws; int ph_lo, ph_hi; };
static_assert(sizeof(Args) == 27 * 8 + 8, "Args has no padding");

__device__ __forceinline__ float wave_sum(float v) {
#pragma unroll
    for (int o = 1; o < 64; o <<= 1) v += __shfl_xor(v, o);
    return v;
}
__device__ __forceinline__ float bf2f(unsigned short u) { return __uint_as_float((unsigned)u << 16); }
__device__ __forceinline__ float sigmoid_f(float v) { return 1.0f / (1.0f + __expf(-v)); }
__device__ __forceinline__ float silu_acc(float v) { return v / (1.0f + __expf(-v)); }
__device__ __forceinline__ float log_sigmoid_f(float v) { return fminf(v, 0.f) - log1pf(__expf(-fabsf(v))); }
__device__ __forceinline__ float softplus_f(float v) { return fmaxf(v, 0.f) + log1pf(__expf(-fabsf(v))); }

__device__ __forceinline__ int map_up(int n) { const int t = n >> 8, r = n & 255; return (r < 128) ? (t * 128 + r) : (DFF + t * 128 + (r - 128)); }
__device__ __forceinline__ int map_in(int n) {
    if (n < 768) return n; if (n < 1536) return n + 4; if (n < 3584) return n + 12;
    const int j = n - 3584; if (j < 4) return 768 + j; if (j < 8) return 1540 + (j - 4); if (j < 12) return 1544 + (j - 8); if (j < 16) return 3596 + (j - 12); return -1; }
template <int MAP> __device__ __forceinline__ void tr_item(const float* W, int K, int Nsrc, bf16* WT, int kb, int nb, LAS float* scr, int lane) {
    const int k0 = 64 * kb, n0 = 32 * nb; const int nd = n0 + (lane & 31); const int src = MAP == 1 ? map_up(nd) : (MAP == 2 ? map_in(nd) : nd);
#pragma unroll 8
    for (int i = 0; i < 32; ++i) { const int kk = 2 * i + (lane >> 5); scr[kk * 33 + (lane & 31)] = src >= 0 ? W[(size_t)(k0 + kk) * Nsrc + src] : 0.f; }
    LDS_WAIT(); asm volatile("" ::: "memory");
    const int c = lane & 7;
#pragma unroll
    for (int j = 0; j < 4; ++j) { const int n = (lane >> 3) + 8 * j; const LAS float* s = scr + (8 * c) * 33 + n;
        v4u o; o.x = pk2(s[0 * 33], s[1 * 33]); o.y = pk2(s[2 * 33], s[3 * 33]); o.z = pk2(s[4 * 33], s[5 * 33]); o.w = pk2(s[6 * 33], s[7 * 33]);
        *(GAS v4u*)(WT + (size_t)(n0 + n) * K + k0 + 8 * c) = o; }
    LDS_WAIT(); asm volatile("" ::: "memory");
}
__device__ __forceinline__ void prologue(const Args& a, LAS unsigned char* lds, int tid, int lane, int wave, int G) {
    unsigned char* ws = a.ws;
    LAS float* cact = (LAS float*)(lds + 69632);
    LAS float* red = (LAS float*)(lds + 102400);
    for (int i = tid; i < BATCH * DM; i += NTHR) { const float v = a.in[1][i]; cact[i] = silu_acc(v); }
    __syncthreads();
    float* cond = (float*)(ws + WS_COND);
    for (int item = blockIdx.x; item < DEPTH * (NCOND / 64); item += G) {
        const int l = item / (NCOND / 64), cb = item % (NCOND / 64), col = cb * 64 + lane, ks = wave;
        const float* W = a.in[2] + (size_t)l * DM * NCOND + col;
        float acc[8];
#pragma unroll
        for (int b = 0; b < 8; ++b) acc[b] = 0.f;
        for (int k = ks * 128; k < ks * 128 + 128; ++k) { const float w = W[(size_t)k * NCOND];
#pragma unroll
            for (int b = 0; b < 8; ++b) acc[b] += cact[b * DM + k] * w; }
#pragma unroll
        for (int b = 0; b < 8; ++b) red[(ks * 8 + b) * 64 + lane] = acc[b];
        __syncthreads();
        { const int b = wave; float s = 0.f;
#pragma unroll
          for (int k2 = 0; k2 < 8; ++k2) s += red[(k2 * 8 + b) * 64 + lane];
          cond[((size_t)l * BATCH + b) * NCOND + col] = s + a.in[3][(size_t)l * NCOND + col]; }
        __syncthreads();
    }
    float2* rope = (float2*)(ws + WS_ROPE);
    for (int e = blockIdx.x * NTHR + tid; e < SEQ * 32; e += G * NTHR) { const int s = e >> 5, i = e & 31; const double rev = (double)s * INVREV[i]; const float fr = (float)(rev - rint(rev));
        rope[e] = make_float2(__builtin_amdgcn_cosf(fr), __builtin_amdgcn_sinf(fr)); }
    LAS float* scr = (LAS float*)(lds + wave * 8448);
    const int gw = blockIdx.x * NWAVES + wave, NGW = G * NWAVES;
    constexpr int I_UP = (DM / 64) * (NUP / 32), I_DN = (DFF / 64) * (DM / 32), I_IN = (DM / 64) * (NPROJ / 32), I_OUT = (DM / 64) * (DM / 32), I_LAYER = 2 * I_UP + 2 * I_DN + I_IN + I_OUT;
    for (int it = gw; it < DEPTH * I_LAYER; it += NGW) {
        const int l = it / I_LAYER; int r = it % I_LAYER;
        unsigned char* wl = ws + WS_W + (size_t)l * LAYER_W;
        if (r < I_UP) { tr_item<1>(a.in[5] + (size_t)l * DM * NUP, DM, NUP, (bf16*)(wl + OFF_UP1), r / (NUP / 32), r % (NUP / 32), scr, lane); continue; } r -= I_UP;
        if (r < I_DN) { tr_item<0>(a.in[6] + (size_t)l * DFF * DM, DFF, DM, (bf16*)(wl + OFF_DN1), r / (DM / 32), r % (DM / 32), scr, lane); continue; } r -= I_DN;
        if (r < I_UP) { tr_item<1>(a.in[7] + (size_t)l * DM * NUP, DM, NUP, (bf16*)(wl + OFF_UP2), r / (NUP / 32), r % (NUP / 32), scr, lane); continue; } r -= I_UP;
        if (r < I_DN) { tr_item<0>(a.in[8] + (size_t)l * DFF * DM, DFF, DM, (bf16*)(wl + OFF_DN2), r / (DM / 32), r % (DM / 32), scr, lane); continue; } r -= I_DN;
        if (r < I_IN) { tr_item<2>(a.in[9] + (size_t)l * DM * NIN_SRC, DM, NIN_SRC, (bf16*)(wl + OFF_IN), r / (NPROJ / 32), r % (NPROJ / 32), scr, lane); continue; } r -= I_IN;
        tr_item<0>(a.in[10] + (size_t)l * DM * DM, DM, DM, (bf16*)(wl + OFF_OUT), r / (DM / 32), r % (DM / 32), scr, lane);
    }
}
__device__ __forceinline__ void thin_norm(const float* x, bf16* hb, const float* g, const float* cond_l, int sh_off, int sc_off, int gw, int NGW, int lane) {
    for (int m = gw; m < M; m += NGW) {
        const int b = m >> 11;
        const GAS f32x4* xr = (const GAS f32x4*)(x + (size_t)m * DM) + lane;
        f32x4 v[4]; float s = 0.f;
#pragma unroll
        for (int j = 0; j < 4; ++j) { v[j] = xr[64 * j]; s += (v[j].x * v[j].x + v[j].y * v[j].y) + (v[j].z * v[j].z + v[j].w * v[j].w); }
        const float rstd = 1.0f / sqrtf(wave_sum(s) * (1.0f / DM) + RMS_EPS);
        const f32x4* g4 = (const f32x4*)g + lane; const f32x4* sh4 = (const f32x4*)(cond_l + (size_t)b * NCOND + sh_off) + lane; const f32x4* sc4 = (const f32x4*)(cond_l + (size_t)b * NCOND + sc_off) + lane;
        GAS unsigned long long* o8 = (GAS unsigned long long*)(hb + (size_t)m * DM) + lane;
#pragma unroll
        for (int j = 0; j < 4; ++j) { const f32x4 gg = g4[64 * j], sh = sh4[64 * j], sc = sc4[64 * j]; const f32x4 o = v[j] * rstd * gg * (sc + 1.0f) + sh;
            o8[64 * j] = (unsigned long long)pk2(o.x, o.y) | ((unsigned long long)pk2(o.z, o.w) << 32); }
    }
}
__device__ __forceinline__ void prep_naive(const bf16* proj, float* pre, const float2* rope, const float* mcw, const float* mcb, const float* scw, const float* scb, int gid, int NT) {
    for (size_t e = gid; e < (size_t)M * 1536; e += NT) {
        const int m = (int)(e / 1536), c = (int)(e % 1536), t = m & (SEQ - 1);
        float val;
        if (c < 512 || c >= 1024) {
            const bool isM = c < 512; const int cc = isM ? c : c - 1024, pc = (isM ? PC_MQ : PC_SX) + cc;
            const float* w = isM ? mcw : scw; float acc = (isM ? mcb : scb)[cc];
#pragma unroll
            for (int j = 0; j < 4; ++j) { const int tt = t - 3 + j; if (tt >= 0) acc += w[j * 512 + cc] * bf2f(proj[(size_t)(m - 3 + j) * PROJ_LD + pc]); }
            val = silu_acc(acc);
        } else {
            const bool isQ = c < 768; const int cc = isQ ? c - 512 : c - 768, d = cc & 63, i = d & 31, pc = (isQ ? PC_RQ : PC_RK) + (cc & ~63);
            const float t1 = bf2f(proj[(size_t)m * PROJ_LD + pc + i]), t2 = bf2f(proj[(size_t)m * PROJ_LD + pc + i + 32]);
            const float2 cs = rope[t * 32 + i];
            val = d < 32 ? t1 * cs.x - t2 * cs.y : t1 * cs.y + t2 * cs.x;
            if (!isQ) val *= 0.125f;
        }
        pre[e] = val;
    }
}
__device__ __forceinline__ void mixer_naive(const bf16* proj, const float* gates, const float* pre, float* yraw, const float* fox_fb, const float* mib, const float* mfb, const float* dtb, const float* alog, int tid, int lane) {
    const int blk = blockIdx.x, half = lane & 1;
    if (blk >= 232) {
        const int idx = (blk - 232) * NTHR + tid; const int mixer = __builtin_amdgcn_readfirstlane(idx >> 12), bh = __builtin_amdgcn_readfirstlane((idx & 4095) >> 7), b = bh >> 2, h = bh & 3, e = (idx & 127) >> 1;
        float S[32], nn[32];
#pragma unroll
        for (int d = 0; d < 32; ++d) { S[d] = 0.f; nn[d] = 0.f; }
        const int koff = (mixer == 0 ? 256 + h * 64 : (mixer == 1 ? 768 + h * 64 : 1280 + (h >> 1) * 64)) + 32 * half;
        const int qoff = (mixer == 0 ? h * 64 : (mixer == 1 ? 512 + h * 64 : 1408 + (h >> 1) * 64)) + 32 * half;
        const float qs = mixer == 0 ? 0.125f : 1.0f;
        const float gam = 1.0f - exp2f(-5.0f - (float)h), A = -__expf(alog[h]), ib = mib[h], fb = mfb[h], db = dtb[h];
        for (int t = 0; t < SEQ; ++t) {
            const size_t row = (size_t)(b * SEQ + t);
            float dec, vin, iw = 1.0f;
            if (mixer == 0) { dec = sigmoid_f(gates[row * 16 + 8 + h] + fb); iw = __expf(gates[row * 16 + 4 + h] + ib); vin = bf2f(proj[row * PROJ_LD + PC_MV + h * 64 + e]); }
            else if (mixer == 1) { dec = gam; vin = bf2f(proj[row * PROJ_LD + PC_RV + h * 64 + e]); }
            else { const float dt = softplus_f(gates[row * 16 + 12 + h] + db); dec = __expf(dt * A); vin = pre[row * 1536 + 1024 + h * 64 + e] * dt; }
            const float* kp = pre + row * 1536 + koff; const float* qp = pre + row * 1536 + qoff;
            const float iv = iw * vin; float num = 0.f, den = 0.f;
#pragma unroll
            for (int d = 0; d < 32; ++d) { const float kd = kp[d], qd = qp[d] * qs; S[d] = dec * S[d] + iv * kd; nn[d] = dec * nn[d] + iw * kd; num += qd * S[d]; den += qd * nn[d]; }
            num += __shfl_xor(num, 1); den += __shfl_xor(den, 1);
            const float y = mixer == 0 ? num / fmaxf(fabsf(den), 1.0f) : num;
            if (half == 0) yraw[row * 1024 + 256 * (mixer + 1) + h * 64 + e] = y;
        }
    }
    {
        const int gid = blk * NTHR + tid; const int bh = __builtin_amdgcn_readfirstlane(gid >> 12), b = bh >> 2, h = bh & 3, t = (gid & 4095) >> 1, tmax = __builtin_amdgcn_readfirstlane(((gid & 4095) | 63) >> 1);
        float q[32], o[32];
        { const bf16* qp = proj + (size_t)(b * SEQ + t) * PROJ_LD + PC_FQ + h * 64 + 32 * half;
#pragma unroll
          for (int d = 0; d < 32; ++d) { q[d] = bf2f(qp[d]) * 0.125f; o[d] = 0.f; } }
        const float fb = fox_fb[h]; float mrun = -INFINITY, l = 0.f, cs = 0.f;
        for (int s = 0; s <= tmax; ++s) {
            const size_t row = (size_t)(b * SEQ + s);
            cs += log_sigmoid_f(gates[row * 16 + h] + fb);
            const bf16* kp = proj + row * PROJ_LD + PC_FK + h * 64 + 32 * half; const bf16* vp = proj + row * PROJ_LD + PC_FV + h * 64 + 32 * half;
            float dot = 0.f;
#pragma unroll
            for (int d = 0; d < 32; ++d) dot += q[d] * bf2f(kp[d]);
            dot += __shfl_xor(dot, 1);
            const float logit = dot - cs;
            if (s <= t) { const float mnew = fmaxf(mrun, logit), f = __expf(mrun - mnew), p = __expf(logit - mnew); l = l * f + p; mrun = mnew;
#pragma unroll
                for (int d = 0; d < 32; ++d) o[d] = o[d] * f + p * bf2f(vp[d]); }
        }
        const float rl = 1.0f / l; float* yp = yraw + (size_t)(b * SEQ + t) * 1024 + h * 64 + 32 * half;
#pragma unroll
        for (int d = 0; d < 32; ++d) yp[d] = o[d] * rl;
    }
}
__device__ __forceinline__ void post_naive(const bf16* proj, const float* pre, const float* yraw, bf16* ybf, const float* mng, const float* rng, const float* sng, const float* sD, int gw, int NGW, int lane) {
    for (int m = gw; m < M; m += NGW) {
        const size_t r = (size_t)m; const int c4 = 4 * lane, hd = lane >> 4;
        GAS unsigned long long* o8 = (GAS unsigned long long*)(ybf + r * DM) + lane;
        { const f32x4 v = *(const f32x4*)(yraw + r * 1024 + c4); o8[0] = (unsigned long long)pk2(v.x, v.y) | ((unsigned long long)pk2(v.z, v.w) << 32); }
#pragma unroll
        for (int mx = 0; mx < 2; ++mx) {
            const f32x4 v = *(const f32x4*)(yraw + r * 1024 + 256 * (mx + 1) + c4);
            float ss = (v.x * v.x + v.y * v.y) + (v.z * v.z + v.w * v.w);
            ss += __shfl_xor(ss, 1); ss += __shfl_xor(ss, 2); ss += __shfl_xor(ss, 4); ss += __shfl_xor(ss, 8);
            const float rstd = 1.0f / sqrtf(ss * (1.0f / 64.0f) + RMS_EPS);
            const f32x4 gn = *(const f32x4*)((mx == 0 ? mng : rng) + c4);
            const bf16* gp = proj + r * PROJ_LD + (mx == 0 ? PC_MO : PC_RG) + c4;
            f32x4 gt;
#pragma unroll
            for (int i = 0; i < 4; ++i) { const float gv = bf2f(gp[i]); gt[i] = mx == 0 ? sigmoid_f(gv) : silu_acc(gv); }
            const f32x4 o = gt * (v * rstd * gn);
            o8[64 * (mx + 1)] = (unsigned long long)pk2(o.x, o.y) | ((unsigned long long)pk2(o.z, o.w) << 32);
        }
        { const f32x4 hs = *(const f32x4*)(yraw + r * 1024 + 768 + c4); const f32x4 xx = *(const f32x4*)(pre + r * 1536 + 1024 + c4); const float Dh = sD[hd];
          const bf16* zp = proj + r * PROJ_LD + PC_SZ + c4; f32x4 v;
#pragma unroll
          for (int i = 0; i < 4; ++i) v[i] = (hs[i] + Dh * xx[i]) * silu_acc(bf2f(zp[i]));
          const float ss = wave_sum((v.x * v.x + v.y * v.y) + (v.z * v.z + v.w * v.w));
          const float rstd = 1.0f / sqrtf(ss * (1.0f / 256.0f) + RMS_EPS);
          const f32x4 gn = *(const f32x4*)(sng + c4); const f32x4 o = v * rstd * gn;
          o8[192] = (unsigned long long)pk2(o.x, o.y) | ((unsigned long long)pk2(o.z, o.w) << 32); }
    }
}
__device__ __forceinline__ void final_norm(float* x, const float* g, int gw, int NGW, int lane) {
    for (int m = gw; m < M; m += NGW) {
        GAS f32x4* xr = (GAS f32x4*)(x + (size_t)m * DM) + lane; f32x4 v[4]; float s = 0.f;
#pragma unroll
        for (int j = 0; j < 4; ++j) { v[j] = xr[64 * j]; s += (v[j].x * v[j].x + v[j].y * v[j].y) + (v[j].z * v[j].z + v[j].w * v[j].w); }
        const float rstd = 1.0f / sqrtf(wave_sum(s) * (1.0f / DM) + RMS_EPS);
#pragma unroll
        for (int j = 0; j < 4; ++j) xr[64 * j] = v[j] * rstd * ((const f32x4*)g)[lane + 64 * j];
    }
}

__global__ void __launch_bounds__(NTHR, 2) fwd(Args a) {
    extern __shared__ __attribute__((aligned(16))) unsigned char lds_raw[];
    LAS unsigned char* lds = (LAS unsigned char*)lds_raw;
    const int tid = threadIdx.x, lane = tid & 63, wave = __builtin_amdgcn_readfirstlane(tid >> 6), G = gridDim.x;
    const int gw = blockIdx.x * NWAVES + wave, NGW = G * NWAVES;
    unsigned char* ws = a.ws;
    for (int u = tid; u < (LDS_BYTES - LDSCTL_OFF) / 4; u += NTHR) ((LAS unsigned*)(lds + LDSCTL_OFF))[u] = 0u;
    __syncthreads();
    const int lo = a.ph_lo, hi = a.ph_hi;
    XcdBarrier bar; bar.bar = (unsigned*)(ws + WS_CTL) + CW_BAR; bar.x = 0; bar.st = nullptr;
    if (hi - lo > 1) bar = xcd_barrier_post((unsigned*)(ws + WS_CTL) + CW_BAR, (volatile LAS unsigned*)(lds + MISC_OFF) + 8);
#define IN(k) (lo <= (k) && (k) < hi)
#define PH_IDS int t_ = threadIdx.x; asm volatile("" : "+v"(t_)); const int lane_ = t_ & 63, wave_ = __builtin_amdgcn_readfirstlane(t_ >> 6), gw_ = blockIdx.x * NWAVES + wave_; (void)lane_; (void)gw_;
#define SEAM(k) do { if ((k) + 1 < hi) xcd_barrier(bar); } while (0)
    float* xres = a.out;
    float* cond = (float*)(ws + WS_COND); const float2* rope = (const float2*)(ws + WS_ROPE);
    bf16* HB = (bf16*)(ws + WS_HB); bf16* ACT = (bf16*)(ws + WS_ACT); bf16* PROJ = (bf16*)(ws + WS_PROJ); float* GATES = (float*)(ws + WS_GATES);
    float* PRE = (float*)(ws + WS_PRE); float* YRAW = (float*)(ws + WS_YRAW); bf16* YBF = (bf16*)(ws + WS_YBF);

    if (IN(0)) { PH_IDS prologue(a, lds, t_, lane_, wave_, G); SEAM(0); }
    for (int l = 0; l < DEPTH; ++l) {
        const int pb = 1 + 12 * l;
        if (hi <= pb || lo >= pb + 12) continue;
        const float* cond_l = cond + (size_t)l * BATCH * NCOND;
        unsigned char* wl = ws + WS_W + (size_t)l * LAYER_W;
        const float* xin = (l == 0) ? a.in[0] : xres;
        if (IN(pb + 0)) { PH_IDS thin_norm(xin, HB, a.in[4] + (size_t)(l * 3 + 0) * DM, cond_l, 0 * DM, 1 * DM, gw_, NGW, lane_); SEAM(pb + 0); }
        if (IN(pb + 1)) { pg8::Gemm g{HB, (const bf16*)(wl + OFF_UP1), M, NUP, DM}; pg8::StaticOrder S; S.init(M, NUP, G, (int)blockIdx.x); pg8::EpiSwiglu E{ACT, DFF};
            pg8::gemm_phase<pg8::EpiSwiglu, pg8::StaticOrder, true, true>(lds, g, S, E); SEAM(pb + 1); }
        if (IN(pb + 2)) { pg8::Gemm g{ACT, (const bf16*)(wl + OFF_DN1), M, DM, DFF}; pg8::StaticOrder S; S.init(M, DM, G, (int)blockIdx.x); pg8::EpiResid E{xin, xres, DM, cond_l + 2 * DM, NCOND, SEQ, 0.5f};
            pg8::gemm_phase<pg8::EpiResid, pg8::StaticOrder, true, true>(lds, g, S, E); SEAM(pb + 2); }
        if (IN(pb + 3)) { PH_IDS thin_norm(xres, HB, a.in[4] + (size_t)(l * 3 + 1) * DM, cond_l, 3 * DM, 4 * DM, gw_, NGW, lane_); SEAM(pb + 3); }
        if (IN(pb + 4)) { pg8::Gemm g{HB, (const bf16*)(wl + OFF_IN), M, NPROJ, DM}; pg8::StaticOrder S; S.init(M, NPROJ, G, (int)blockIdx.x); pg8::EpiProj E{PROJ, PROJ_LD, GATES, PROJ_LD / 256};
            pg8::gemm_phase<pg8::EpiProj, pg8::StaticOrder, true, true>(lds, g, S, E); SEAM(pb + 4); }
        if (IN(pb + 5)) { PH_IDS prep_naive(PROJ, PRE, rope, a.in[12] + (size_t)l * 4 * 512, a.in[13] + (size_t)l * 512, a.in[18] + (size_t)l * 4 * 512, a.in[19] + (size_t)l * 512, blockIdx.x * NTHR + t_, G * NTHR); SEAM(pb + 5); }
        if (IN(pb + 6)) { PH_IDS mixer_naive(PROJ, GATES, PRE, YRAW, a.in[11] + l * 4, a.in[14] + l * 4, a.in[15] + l * 4, a.in[20] + l * 4, a.in[21] + l * 4, t_, lane_); SEAM(pb + 6); }
        if (IN(pb + 7)) { PH_IDS post_naive(PROJ, PRE, YRAW, YBF, a.in[16] + (size_t)l * 256, a.in[17] + (size_t)l * 256, a.in[23] + (size_t)l * 256, a.in[22] + l * 4, gw_, NGW, lane_); SEAM(pb + 7); }
        if (IN(pb + 8)) { pg8::Gemm g{YBF, (const bf16*)(wl + OFF_OUT), M, DM, DM}; pg8::StaticOrder S; S.init(M, DM, G, (int)blockIdx.x); pg8::EpiResid E{xres, xres, DM, cond_l + 5 * DM, NCOND, SEQ, 1.0f};
            pg8::gemm_phase<pg8::EpiResid, pg8::StaticOrder, true, true>(lds, g, S, E); SEAM(pb + 8); }
        if (IN(pb + 9)) { PH_IDS thin_norm(xres, HB, a.in[4] + (size_t)(l * 3 + 2) * DM, cond_l, 6 * DM, 7 * DM, gw_, NGW, lane_); SEAM(pb + 9); }
        if (IN(pb + 10)) { pg8::Gemm g{HB, (const bf16*)(wl + OFF_UP2), M, NUP, DM}; pg8::StaticOrder S; S.init(M, NUP, G, (int)blockIdx.x); pg8::EpiSwiglu E{ACT, DFF};
            pg8::gemm_phase<pg8::EpiSwiglu, pg8::StaticOrder, true, true>(lds, g, S, E); SEAM(pb + 10); }
        if (IN(pb + 11)) { pg8::Gemm g{ACT, (const bf16*)(wl + OFF_DN2), M, DM, DFF}; pg8::StaticOrder S; S.init(M, DM, G, (int)blockIdx.x); pg8::EpiResid E{xres, xres, DM, cond_l + 8 * DM, NCOND, SEQ, 0.5f};
            pg8::gemm_phase<pg8::EpiResid, pg8::StaticOrder, true, true>(lds, g, S, E); SEAM(pb + 11); }
    }
    if (IN(PH_FINAL)) { PH_IDS final_norm(xres, a.in[24], gw_, NGW, lane_); }
#undef IN
#undef SEAM
}

#ifndef N_SPLIT
#define N_SPLIT 1
#endif
extern "C" void kernel_launch(void* const* d_in, const int* in_sizes, int n_in, void* d_out, int out_size, void* d_ws, size_t ws_size, hipStream_t stream) {
    static int grid = 0;
    if (grid == 0) {
        if (n_in != 25 || in_sizes[0] != M * DM || out_size != M * DM || ws_size < WS_END) { fprintf(stderr, "kernel_launch: unexpected problem (n_in %d, in0 %d, out %d, ws %zu)\n", n_in, n_in > 0 ? in_sizes[0] : -1, out_size, ws_size); grid = -1; return; }
        int dev = 0, cus = 0, per_cu = 0;
        if (hipGetDevice(&dev) != hipSuccess || hipDeviceGetAttribute(&cus, hipDeviceAttributeMultiprocessorCount, dev) != hipSuccess) { grid = -1; return; }
        if (hipFuncSetAttribute((const void*)fwd, hipFuncAttributeMaxDynamicSharedMemorySize, LDS_BYTES) != hipSuccess) { fprintf(stderr, "kernel_launch: hipFuncSetAttribute failed\n"); grid = -1; return; }
        if (hipOccupancyMaxActiveBlocksPerMultiprocessor(&per_cu, (const void*)fwd, NTHR, LDS_BYTES) != hipSuccess || per_cu < 1) fprintf(stderr, "kernel_launch: occupancy query says %d\n", per_cu);
        (void)hipGetLastError();
        grid = cus;
    }
    if (grid < 0) return;
    if (hipMemsetAsync((char*)d_ws + WS_CTL, 0, CTL_ZERO_BYTES, stream) != hipSuccess) return;
    Args a{};
    for (int i = 0; i < 25; ++i) a.in[i] = (const float*)d_in[i];
    a.out = (float*)d_out; a.ws = (unsigned char*)d_ws;
#if N_SPLIT
    for (int p = 0; p < PH_END; ++p) { a.ph_lo = p; a.ph_hi = p + 1; hipLaunchKernelGGL(fwd, dim3(grid), dim3(NTHR), LDS_BYTES, stream, a); }
#else
    a.ph_lo = 0; a.ph_hi = PH_END; hipLaunchKernelGGL(fwd, dim3(grid), dim3(NTHR), LDS_BYTES, stream, a);
#endif
}
```

```cpp
#include <hip/hip_runtime.h>
#include <cstdio>
#include <cstdint>
#ifndef REP_FOX
#define REP_FOX 1
#endif
#ifndef REP_LIN
#define REP_LIN 1
#endif
#ifndef REP_MIX
#define REP_MIX 1
#endif
#ifndef REP_PREP
#define REP_PREP 1
#endif
#ifndef REP_POST
#define REP_POST 1
#endif
#ifndef REP_THIN
#define REP_THIN 1
#endif
#ifndef REP_UP
#define REP_UP 1
#endif
#ifndef REP_IN
#define REP_IN 1
#endif
namespace pg8 {
#define PG8_LAS __attribute__((address_space(3)))
typedef unsigned short bf16_t;
typedef short bf16x8 __attribute__((ext_vector_type(8)));
typedef float f32x4 __attribute__((ext_vector_type(4)));
typedef unsigned u32x4 __attribute__((ext_vector_type(4)));
constexpr int BM = 256, BK = 64, HALF = 128, HTB = HALF * BK * 2  , STAGE_BYTES = 8 * HTB, NXCD = 8, WGM = 4;

__host__ __device__ __forceinline__ int lds_byte(int r, int c) { const int st = (r >> 4) * 2 + (c >> 5), rr = r & 15, cc = c & 31, ob = rr * 64 + cc * 2; return st * 1024 + (ob ^ (((ob >> 9) & 1) << 5)); }
__host__ __device__ __forceinline__ void stage_rc(int b, int& R, int& C) { const int st = b / 1024, sb = b % 1024, swz = sb ^ (((sb >> 9) & 1) << 5); R = (st >> 1) * 16 + swz / 64; C = (st & 1) * 32 + (swz % 64) / 2; }
__host__ __device__ __forceinline__ int perm32(int rho) { const int n = rho >> 4, i = rho & 15; return 8 * (i >> 2) + 4 * n + (i & 3); }

struct Unit { int pm, pn; };
struct Gemm { const bf16_t* A; const bf16_t* Bt; int M, N, K; int lda; };

struct StaticOrder {
    int nM, nN, nwg, G, c;
    __host__ __device__ void init(int M, int N, int G_, int c_) { nM = M / BM; nN = N / BM; nwg = nM * nN; G = G_; c = c_; }
    __host__ __device__ bool next(int i, Unit& u) const {
        const long L = (long)i * G + c; if (L >= nwg) return false;
        int wgid = (int)L; { const int q = nwg / NXCD, r = nwg % NXCD, xcd = wgid % NXCD, off = wgid / NXCD; wgid = (xcd < r ? xcd * (q + 1) : r * (q + 1) + (xcd - r) * q) + off; }
        const int nig = WGM * nN, gid = wgid / nig, fm = gid * WGM, gsz = (nM - fm) < WGM ? (nM - fm) : WGM;
        u.pm = fm + ((wgid % nig) % gsz); u.pn = (wgid % nig) / gsz; return true;
    }
    __device__ __forceinline__ void a_ready(const Unit&) const {}
    __device__ __forceinline__ void done(const Unit&) const {}
};

__device__ __forceinline__ unsigned cvt_pk_bf16(float lo, float hi) { unsigned r; asm volatile("v_cvt_pk_bf16_f32 %0, %1, %2" : "=v"(r) : "v"(lo), "v"(hi)); return r; }

__device__ __forceinline__ float silu_f(float v) { return v * __builtin_amdgcn_rcpf(1.0f + __expf(-v)); }
__device__ __forceinline__ f32x4 swiglu4(const f32x4 a, const f32x4 g) {
    const f32x4 t = g * (-1.44269504088896341f); f32x4 e;
#pragma unroll
    for (int i = 0; i < 4; ++i) e[i] = __builtin_amdgcn_exp2f(t[i]);
    const f32x4 d = e + 1.0f; f32x4 r;
#pragma unroll
    for (int i = 0; i < 4; ++i) r[i] = __builtin_amdgcn_rcpf(d[i]);
    return (a * g) * r;
}
struct EpiSwiglu {
    static constexpr bool PERM = true, AFTER_DRAIN = false;
    bf16_t* O; int ldo;
    __device__ __forceinline__ void operator()(const f32x4 (&acc)[2][2][4][2], const Unit& u, int wr, int wc, int fr, int fq) const {
        const int row0 = u.pm * BM + wr * 64 + fr, col0 = u.pn * HALF + wc * 32 + 8 * fq;
#pragma unroll
        for (int ai = 0; ai < 2; ++ai)
#pragma unroll
            for (int m = 0; m < 4; ++m) { bf16_t* rowp = O + (size_t)(row0 + ai * HALF + m * 16) * ldo + col0;
                const f32x4 a0 = acc[ai][0][m][0], a1 = acc[ai][0][m][1], g0 = acc[ai][1][m][0], g1 = acc[ai][1][m][1];
                u32x4 w; w.x = cvt_pk_bf16(silu_f(g0[0]) * a0[0], silu_f(g0[1]) * a0[1]); w.y = cvt_pk_bf16(silu_f(g0[2]) * a0[2], silu_f(g0[3]) * a0[3]);
                w.z = cvt_pk_bf16(silu_f(g1[0]) * a1[0], silu_f(g1[1]) * a1[1]); w.w = cvt_pk_bf16(silu_f(g1[2]) * a1[2], silu_f(g1[3]) * a1[3]);
                *(u32x4*)rowp = w; }
    }
};
struct EpiResid {
    static constexpr bool PERM = false, AFTER_DRAIN = false;
    const bf16_t* base; float* out; int ldc; const float* gate; int gstride; int rows_per_b; float coef;
    __device__ __forceinline__ void operator()(const f32x4 (&acc)[2][2][4][2], const Unit& u, int wr, int wc, int fr, int fq) const {
        const int col0 = u.pn * BM + wc * 32 + 4 * fq; const int b = (u.pm * BM) / rows_per_b;
        f32x4 gv[2][2];
#pragma unroll
        for (int bj = 0; bj < 2; ++bj)
#pragma unroll
            for (int n = 0; n < 2; ++n) gv[bj][n] = *(const f32x4*)(gate + (size_t)b * gstride + col0 + bj * HALF + n * 16) * coef;
#pragma unroll
        for (int ai = 0; ai < 2; ++ai)
#pragma unroll
            for (int m = 0; m < 4; ++m) { const size_t off = (size_t)(u.pm * BM + ai * HALF + wr * 64 + m * 16 + fr) * ldc + col0;
#pragma unroll
                for (int bj = 0; bj < 2; ++bj)
#pragma unroll
                    for (int n = 0; n < 2; ++n) { typedef unsigned u32x2r __attribute__((ext_vector_type(2))); const u32x2r rb = *(const u32x2r*)(base + off + bj * HALF + n * 16);
                        const f32x4 bs = (f32x4){__builtin_bit_cast(float, rb.x << 16), __builtin_bit_cast(float, rb.x & 0xffff0000u), __builtin_bit_cast(float, rb.y << 16), __builtin_bit_cast(float, rb.y & 0xffff0000u)};
                        *(f32x4*)(out + off + bj * HALF + n * 16) = bs + gv[bj][n] * acc[ai][bj][m][n]; }
                if (m & 1) asm volatile("" ::: "memory"); }
    }
};
struct EpiProj {
    static constexpr bool PERM = true, AFTER_DRAIN = false;
    bf16_t* P; int ldp; float* G; int ntile_bf; float scale0;
    __device__ __forceinline__ void operator()(const f32x4 (&acc)[2][2][4][2], const Unit& u, int wr, int wc, int fr, int fq) const {
        const int row0 = u.pm * BM + wr * 64 + fr;
        if (u.pn < ntile_bf) {
            const int col0 = u.pn * BM + wc * 32 + 8 * fq; const float sc = (u.pn == 0) ? scale0 : 1.0f;
#pragma unroll
            for (int ai = 0; ai < 2; ++ai)
#pragma unroll
                for (int m = 0; m < 4; ++m) { bf16_t* rowp = P + (size_t)(row0 + ai * HALF + m * 16) * ldp + col0;
#pragma unroll
                    for (int bj = 0; bj < 2; ++bj) { const f32x4 v0 = acc[ai][bj][m][0] * sc, v1 = acc[ai][bj][m][1] * sc;
                        u32x4 w; w.x = cvt_pk_bf16(v0[0], v0[1]); w.y = cvt_pk_bf16(v0[2], v0[3]); w.z = cvt_pk_bf16(v1[0], v1[1]); w.w = cvt_pk_bf16(v1[2], v1[3]);
                        *(u32x4*)(rowp + bj * HALF) = w; } }
        } else if (wc == 0 && fq < 2) {
#pragma unroll
            for (int ai = 0; ai < 2; ++ai)
#pragma unroll
                for (int m = 0; m < 4; ++m) { float* gp = G + (size_t)(row0 + ai * HALF + m * 16) * 16 + 8 * fq;
                    *(f32x4*)gp = acc[ai][0][m][0]; *(f32x4*)(gp + 4) = acc[ai][0][m][1]; }
        }
    }
};

__device__ __forceinline__ float rstd_q(long long q) { const unsigned long long u = (unsigned long long)q; const float f = (float)(unsigned)(u >> 32) * 4294967296.0f + (float)(unsigned)u;
    return __builtin_amdgcn_rsqf(f * (1.0f / (16777216.0f * 1024.0f)) + 1e-6f); }
struct EpiSwigluN {
    static constexpr bool PERM = true, AFTER_DRAIN = false;
    bf16_t* O; int ldo; const long long* ss; const float* bias; int nb;
    __device__ __forceinline__ void operator()(const f32x4 (&acc)[2][2][4][2], const Unit& u, int wr, int wc, int fr, int fq) const {
        const int row0 = u.pm * BM + wr * 64 + fr, col0 = u.pn * HALF + wc * 32 + 8 * fq; const int b = u.pm >> 3;
        const float* bp = bias + (size_t)b * nb + u.pn * BM + wc * 32 + 8 * fq;
        const f32x4 ba0 = *(const f32x4*)bp, ba1 = *(const f32x4*)(bp + 4), bg0 = *(const f32x4*)(bp + HALF), bg1 = *(const f32x4*)(bp + HALF + 4);
        long long ssv[2][4];
#pragma unroll
        for (int ai = 0; ai < 2; ++ai)
#pragma unroll
            for (int m = 0; m < 4; ++m) ssv[ai][m] = ss[row0 + ai * HALF + m * 16];
#pragma unroll
        for (int ai = 0; ai < 2; ++ai)
#pragma unroll
            for (int m = 0; m < 4; ++m) { const int row = row0 + ai * HALF + m * 16; bf16_t* rowp = O + (size_t)row * ldo + col0;
                const float rs = rstd_q(ssv[ai][m]);
                const f32x4 a0 = acc[ai][0][m][0] * rs + ba0, a1 = acc[ai][0][m][1] * rs + ba1, g0 = acc[ai][1][m][0] * rs + bg0, g1 = acc[ai][1][m][1] * rs + bg1;
                const f32x4 o0 = swiglu4(a0, g0), o1 = swiglu4(a1, g1);
                u32x4 w; w.x = cvt_pk_bf16(o0[0], o0[1]); w.y = cvt_pk_bf16(o0[2], o0[3]); w.z = cvt_pk_bf16(o1[0], o1[1]); w.w = cvt_pk_bf16(o1[2], o1[3]);
                *(u32x4*)rowp = w; }
    }
};
struct EpiProjN {
    static constexpr bool PERM = true, AFTER_DRAIN = false;
    bf16_t* P; int ldp; float* G; int ntile_bf; float scale0; const long long* ss; const float* bias; int nb;
    __device__ __forceinline__ void operator()(const f32x4 (&acc)[2][2][4][2], const Unit& u, int wr, int wc, int fr, int fq) const {
        const int row0 = u.pm * BM + wr * 64 + fr; const int b = u.pm >> 3;
        const float* bp = bias + (size_t)b * nb + u.pn * BM + wc * 32 + 8 * fq;
        if (u.pn < ntile_bf) {
            const int col0 = u.pn * BM + wc * 32 + 8 * fq; const float sc = (u.pn == 0) ? scale0 : 1.0f;
            const f32x4 b00 = *(const f32x4*)bp, b01 = *(const f32x4*)(bp + 4), b10 = *(const f32x4*)(bp + HALF), b11 = *(const f32x4*)(bp + HALF + 4);
            long long ssv[2][4];
#pragma unroll
            for (int ai = 0; ai < 2; ++ai)
#pragma unroll
                for (int m = 0; m < 4; ++m) ssv[ai][m] = ss[row0 + ai * HALF + m * 16];
#pragma unroll
            for (int ai = 0; ai < 2; ++ai)
#pragma unroll
                for (int m = 0; m < 4; ++m) { const int row = row0 + ai * HALF + m * 16; bf16_t* rowp = P + (size_t)row * ldp + col0;
                    const float rs = rstd_q(ssv[ai][m]);
#pragma unroll
                    for (int bj = 0; bj < 2; ++bj) { const f32x4 v0 = (acc[ai][bj][m][0] * rs + (bj ? b10 : b00)) * sc, v1 = (acc[ai][bj][m][1] * rs + (bj ? b11 : b01)) * sc;
                        u32x4 w; w.x = cvt_pk_bf16(v0[0], v0[1]); w.y = cvt_pk_bf16(v0[2], v0[3]); w.z = cvt_pk_bf16(v1[0], v1[1]); w.w = cvt_pk_bf16(v1[2], v1[3]);
                        *(u32x4*)(rowp + bj * HALF) = w; } }
        } else if (wc == 0 && fq < 2) {
            const f32x4 b00 = *(const f32x4*)bp, b01 = *(const f32x4*)(bp + 4);
#pragma unroll
            for (int ai = 0; ai < 2; ++ai)
#pragma unroll
                for (int m = 0; m < 4; ++m) { const int row = row0 + ai * HALF + m * 16; float* gp = G + (size_t)row * 16 + 8 * fq;
                    const float rs = rstd_q(ss[row]);
                    *(f32x4*)gp = acc[ai][0][m][0] * rs + b00; *(f32x4*)(gp + 4) = acc[ai][0][m][1] * rs + b01; }
        }
    }
};
struct EpiResidNorm {
    static constexpr bool PERM = false, AFTER_DRAIN = false;
    const float* cnd; const float* ng; unsigned char* wsb; int goff, scoff, hb_off, xb_off, ss_off; float coef;
    __device__ __forceinline__ void operator()(const f32x4 (&acc)[2][2][4][2], const Unit& u, int wr, int wc, int fr, int fq) const {
        typedef unsigned u32x2v __attribute__((ext_vector_type(2)));
        constexpr int ldc = 1024, gstride = 9 * 1024;
        const int col0 = u.pn * BM + wc * 32 + 4 * fq; const int b = u.pm >> 3;
        const float* gate = cnd + goff; const float* scn = cnd + scoff;
        __attribute__((address_space(1))) bf16_t* xg = (__attribute__((address_space(1))) bf16_t*)(wsb + (size_t)hb_off * 1048576);
        unsigned long long* ssn = (unsigned long long*)(wsb + (size_t)ss_off * 8);
        __attribute__((address_space(1))) bf16_t* xb = (__attribute__((address_space(1))) bf16_t*)(wsb + (size_t)xb_off * 1048576);
        float sq[2][4];
#pragma unroll
        for (int ai = 0; ai < 2; ++ai)
#pragma unroll
            for (int m = 0; m < 4; ++m) sq[ai][m] = 0.f;
#pragma unroll
        for (int bj = 0; bj < 2; ++bj)
#pragma unroll
            for (int n = 0; n < 2; ++n) { const int c = col0 + bj * HALF + n * 16;
                const f32x4 gv = *(const f32x4*)(gate + (size_t)b * gstride + c) * coef, gm = *(const f32x4*)(ng + c) * (*(const f32x4*)(scn + (size_t)b * gstride + c) + 1.0f);
#pragma unroll
                for (int ai = 0; ai < 2; ++ai)
#pragma unroll
                    for (int m = 0; m < 4; ++m) { const size_t off = (size_t)(u.pm * BM + ai * HALF + wr * 64 + m * 16 + fr) * ldc + c;
                        const u32x2v rb = *(const __attribute__((address_space(1))) u32x2v*)(xb + off);
                        const f32x4 xn = (f32x4){__builtin_bit_cast(float, rb.x << 16), __builtin_bit_cast(float, rb.x & 0xffff0000u), __builtin_bit_cast(float, rb.y << 16), __builtin_bit_cast(float, rb.y & 0xffff0000u)} + gv * acc[ai][bj][m][n];
                        { u32x2v wx; wx.x = cvt_pk_bf16(xn[0], xn[1]); wx.y = cvt_pk_bf16(xn[2], xn[3]); *(__attribute__((address_space(1))) u32x2v*)(xb + off) = wx; }
                        sq[ai][m] += (xn[0] * xn[0] + xn[1] * xn[1]) + (xn[2] * xn[2] + xn[3] * xn[3]); const f32x4 h = xn * gm;
                        u32x2v w; w.x = cvt_pk_bf16(h[0], h[1]); w.y = cvt_pk_bf16(h[2], h[3]); *(__attribute__((address_space(1))) u32x2v*)(xg + off) = w;
                        asm volatile("" ::: "memory"); } }
#pragma unroll
        for (int ai = 0; ai < 2; ++ai)
#pragma unroll
            for (int m = 0; m < 4; ++m) { float v = sq[ai][m]; v += __shfl_xor(v, 16); v += __shfl_xor(v, 32);
                if (fq == 0) atomicAdd(ssn + (u.pm * BM + ai * HALF + wr * 64 + m * 16 + fr), (unsigned long long)__float2ll_rn(v * 16777216.0f)); }
    }
};

struct EpiResidLast {
    static constexpr bool PERM = false, AFTER_DRAIN = false;
    const float* cnd; const float* ng; unsigned char* wsb; int goff, scoff, hb_off, xb_off, ss_off; float coef;
    __device__ __forceinline__ void operator()(const f32x4 (&acc)[2][2][4][2], const Unit& u, int wr, int wc, int fr, int fq) const {
        typedef unsigned u32x2v __attribute__((ext_vector_type(2)));
        constexpr int ldc = 1024, gstride = 9 * 1024;
        const int col0 = u.pn * BM + wc * 32 + 4 * fq; const int b = u.pm >> 3;
        const float* gate = cnd + goff;
        unsigned long long* ssn = (unsigned long long*)(wsb + (size_t)ss_off * 8);
        __attribute__((address_space(1))) bf16_t* xb = (__attribute__((address_space(1))) bf16_t*)(wsb + (size_t)xb_off * 1048576);
        float sq[2][4];
#pragma unroll
        for (int ai = 0; ai < 2; ++ai)
#pragma unroll
            for (int m = 0; m < 4; ++m) sq[ai][m] = 0.f;
#pragma unroll
        for (int bj = 0; bj < 2; ++bj)
#pragma unroll
            for (int n = 0; n < 2; ++n) { const int c = col0 + bj * HALF + n * 16;
                const f32x4 gv = *(const f32x4*)(gate + (size_t)b * gstride + c) * coef;
#pragma unroll
                for (int ai = 0; ai < 2; ++ai)
#pragma unroll
                    for (int m = 0; m < 4; ++m) { const size_t off = (size_t)(u.pm * BM + ai * HALF + wr * 64 + m * 16 + fr) * ldc + c;
                        const u32x2v rb = *(const __attribute__((address_space(1))) u32x2v*)(xb + off);
                        const f32x4 xn = (f32x4){__builtin_bit_cast(float, rb.x << 16), __builtin_bit_cast(float, rb.x & 0xffff0000u), __builtin_bit_cast(float, rb.y << 16), __builtin_bit_cast(float, rb.y & 0xffff0000u)} + gv * acc[ai][bj][m][n];
                        { u32x2v wx; wx.x = cvt_pk_bf16(xn[0], xn[1]); wx.y = cvt_pk_bf16(xn[2], xn[3]); *(__attribute__((address_space(1))) u32x2v*)(xb + off) = wx; }
                        sq[ai][m] += (xn[0] * xn[0] + xn[1] * xn[1]) + (xn[2] * xn[2] + xn[3] * xn[3]);
                        asm volatile("" ::: "memory"); } }
#pragma unroll
        for (int ai = 0; ai < 2; ++ai)
#pragma unroll
            for (int m = 0; m < 4; ++m) { float v = sq[ai][m]; v += __shfl_xor(v, 16); v += __shfl_xor(v, 32);
                if (fq == 0) atomicAdd(ssn + (u.pm * BM + ai * HALF + wr * 64 + m * 16 + fr), (unsigned long long)__float2ll_rn(v * 16777216.0f)); }
    }
};

template <class Epi, class Sched, bool ALIGN_EPI = false, bool SP2 = false>
__device__ __forceinline__ void gemm_phase(PG8_LAS unsigned char* lds, const Gemm g, const Sched& S, const Epi& E) {
    int tid_ = threadIdx.x; asm volatile("" : "+v"(tid_));
    const int tid = tid_, wid = __builtin_amdgcn_readfirstlane(tid >> 6), lane = tid & 63, wr = wid >> 2, wc = wid & 3, fr = lane & 15, fq = lane >> 4;
    const int K = g.K, nt = K / BK, LDA = g.lda ? g.lda : g.K;
    unsigned voffA[2], voffB[2];
#pragma unroll
    for (int i = 0; i < 2; ++i) { int R, C; stage_rc(tid * 16 + i * 8192, R, C); const int Rb = Epi::PERM ? ((R & ~31) + perm32(R & 31)) : R;
        voffA[i] = (unsigned)(R * LDA + C) * 2u; voffB[i] = (unsigned)(Rb * K + C) * 2u; }
    const size_t kstep = (size_t)(BK * 2);
    const size_t hstep = (size_t)HALF * K * 2;
    const size_t tstep = 2 * hstep;
    const size_t hstepA = (size_t)HALF * LDA * 2, tstepA = 2 * hstepA;
    const unsigned ldsw = (unsigned)wid * 1024u;
    const int aoff = lds_byte(wr * 64 + fr, fq * 8), boff = lds_byte(wc * 32 + fr, fq * 8);
#define PG8_SA(b, h) (((b) * 2 + (h)) * HTB)
#define PG8_SB(b, h) ((4 + (b) * 2 + (h)) * HTB)
#define PG8_STAGE(bufoff, gbase, voff) do { _Pragma("unroll") for (int _i = 0; _i < 2; ++_i) \
        __builtin_amdgcn_global_load_lds((const unsigned*)((const char*)(gbase) + (voff)[_i]), (PG8_LAS unsigned*)(lds + (bufoff) + ldsw + _i * 8192), 16, 0, 0); } while (0)
#define PG8_LDA(dst, b, h) do { _Pragma("unroll") for (int m = 0; m < 4; ++m) _Pragma("unroll") for (int k = 0; k < 2; ++k) dst[m][k] = *(const PG8_LAS bf16x8*)(lds + PG8_SA(b, h) + aoff + m * 2048 + k * 1024); } while (0)
#define PG8_LDB(dst, b, h) do { _Pragma("unroll") for (int n = 0; n < 2; ++n) _Pragma("unroll") for (int k = 0; k < 2; ++k) dst[n][k] = *(const PG8_LAS bf16x8*)(lds + PG8_SB(b, h) + boff + n * 2048 + k * 1024); } while (0)
#define PG8_MMA(ai, bj, At, Bt) do { __builtin_amdgcn_s_setprio(1); _Pragma("unroll") for (int m = 0; m < 4; ++m) _Pragma("unroll") for (int n = 0; n < 2; ++n) _Pragma("unroll") for (int k = 0; k < 2; ++k) \
        acc[ai][bj][m][n] = __builtin_amdgcn_mfma_f32_16x16x32_bf16(Bt[n][k], At[m][k], acc[ai][bj][m][n], 0, 0, 0); __builtin_amdgcn_s_setprio(0); } while (0)
#define PG8_WAIT_V(n) asm volatile("s_waitcnt vmcnt(" #n ")" ::: "memory")
#define PG8_WAIT_L(n) asm volatile("s_waitcnt lgkmcnt(" #n ")" ::: "memory")
#define PG8_BAR __builtin_amdgcn_s_barrier()
#define PG8_SCHED __builtin_amdgcn_sched_barrier(0)
    Unit cur, nxt; int ui = 0;
    if (!S.next(0, cur)) return;
    f32x4 acc[2][2][4][2];
#pragma unroll
    for (int a = 0; a < 2; ++a)
#pragma unroll
        for (int b = 0; b < 2; ++b)
#pragma unroll
            for (int m = 0; m < 4; ++m)
#pragma unroll
                for (int n = 0; n < 2; ++n) acc[a][b][m][n] = (f32x4){0.f, 0.f, 0.f, 0.f};
    bf16x8 At[4][2], B0[2][2], B1[2][2];
    const char* cA = (const char*)g.A + (size_t)cur.pm * tstepA; const char* cB = (const char*)g.Bt + (size_t)cur.pn * tstep;
    S.a_ready(cur);
    if constexpr (SP2) {
        PG8_STAGE(PG8_SB(0, 0), cB, voffB); PG8_STAGE(PG8_SB(0, 1), cB + hstep, voffB); PG8_STAGE(PG8_SA(0, 0), cA, voffA); PG8_STAGE(PG8_SA(0, 1), cA + hstepA, voffA);
        if (wr == 1) PG8_BAR;
        PG8_WAIT_V(2); PG8_BAR;
        PG8_STAGE(PG8_SB(1, 0), cB + kstep, voffB); PG8_STAGE(PG8_SA(1, 0), cA + kstep, voffA); PG8_STAGE(PG8_SB(1, 1), cB + hstep + kstep, voffB);
        PG8_WAIT_V(6); PG8_BAR;
    } else {
        PG8_STAGE(PG8_SB(0, 0), cB, voffB); PG8_STAGE(PG8_SA(0, 0), cA, voffA); PG8_STAGE(PG8_SB(0, 1), cB + hstep, voffB); PG8_STAGE(PG8_SA(0, 1), cA + hstepA, voffA);
        if (wr == 1) PG8_BAR;
        PG8_WAIT_V(4); PG8_BAR;
        PG8_STAGE(PG8_SB(1, 0), cB + kstep, voffB); PG8_STAGE(PG8_SA(1, 0), cA + kstep, voffA); PG8_STAGE(PG8_SB(1, 1), cB + hstep + kstep, voffB);
        PG8_WAIT_V(6); PG8_BAR;
    }
    for (;;) {
        const bool has_next = S.next(ui + 1, nxt);
        const char* nA = has_next ? (const char*)g.A + (size_t)nxt.pm * tstepA : cA; const char* nB = has_next ? (const char*)g.Bt + (size_t)nxt.pn * tstep : cB;
        for (int t = 0; t < nt; t += 2) {
            const bool last = (t == nt - 2);
            const char* a1 = cA + (size_t)(t + 1) * kstep;
            const char* a2 = last ? nA : cA + (size_t)(t + 2) * kstep; const char* b2 = last ? nB : cB + (size_t)(t + 2) * kstep;
            const char* a3 = a2 + kstep; const char* b3 = b2 + kstep;
            if (last && has_next) S.a_ready(nxt);
            if constexpr (SP2) {
            PG8_LDB(B0, 0, 0); PG8_LDB(B1, 0, 1); PG8_SCHED; PG8_LDA(At, 0, 0); PG8_STAGE(PG8_SA(1, 1), a1 + hstepA, voffA);
            PG8_WAIT_V(8); PG8_WAIT_L(0); PG8_BAR; PG8_MMA(0, 0, At, B0); PG8_MMA(0, 1, At, B1); PG8_BAR; PG8_SCHED;
            PG8_LDA(At, 0, 1); PG8_STAGE(PG8_SB(0, 0), b2, voffB); PG8_STAGE(PG8_SB(0, 1), b2 + hstep, voffB); PG8_STAGE(PG8_SA(0, 0), a2, voffA);
            PG8_WAIT_V(8); PG8_WAIT_L(0); PG8_BAR; PG8_MMA(1, 0, At, B0); PG8_MMA(1, 1, At, B1); PG8_BAR; PG8_SCHED;
            PG8_LDB(B0, 1, 0); PG8_LDB(B1, 1, 1); PG8_SCHED; PG8_LDA(At, 1, 0); PG8_STAGE(PG8_SA(0, 1), a2 + hstepA, voffA);
            PG8_WAIT_V(8); PG8_WAIT_L(0); PG8_BAR; PG8_MMA(0, 0, At, B0); PG8_MMA(0, 1, At, B1); PG8_BAR; PG8_SCHED;
            PG8_LDA(At, 1, 1); PG8_STAGE(PG8_SB(1, 0), b3, voffB); PG8_STAGE(PG8_SB(1, 1), b3 + hstep, voffB); PG8_STAGE(PG8_SA(1, 0), a3, voffA);
            PG8_WAIT_V(8); PG8_WAIT_L(0); PG8_BAR; PG8_MMA(1, 0, At, B0); PG8_MMA(1, 1, At, B1); PG8_BAR; PG8_SCHED;
            } else {
            PG8_LDB(B0, 0, 0); PG8_SCHED; PG8_LDA(At, 0, 0); PG8_STAGE(PG8_SA(1, 1), a1 + hstepA, voffA);
            PG8_WAIT_L(8); PG8_BAR; PG8_WAIT_L(0); PG8_MMA(0, 0, At, B0); PG8_BAR; PG8_SCHED;
            PG8_LDB(B1, 0, 1); PG8_STAGE(PG8_SB(0, 0), b2, voffB);
            PG8_BAR; PG8_WAIT_L(0); PG8_MMA(0, 1, At, B1); PG8_BAR;
            PG8_LDA(At, 0, 1); PG8_STAGE(PG8_SA(0, 0), a2, voffA);
            PG8_BAR; PG8_WAIT_L(0); PG8_MMA(1, 0, At, B0); PG8_BAR; PG8_SCHED;
            PG8_STAGE(PG8_SB(0, 1), b2 + hstep, voffB);
            PG8_WAIT_V(6); PG8_BAR; PG8_MMA(1, 1, At, B1); PG8_BAR;
            PG8_LDB(B0, 1, 0); PG8_SCHED; PG8_LDA(At, 1, 0); PG8_STAGE(PG8_SA(0, 1), a2 + hstepA, voffA);
            PG8_WAIT_L(8); PG8_BAR; PG8_WAIT_L(0); PG8_MMA(0, 0, At, B0); PG8_BAR; PG8_SCHED;
            PG8_LDB(B1, 1, 1); PG8_STAGE(PG8_SB(1, 0), b3, voffB);
            PG8_BAR; PG8_WAIT_L(0); PG8_MMA(0, 1, At, B1); PG8_BAR;
            PG8_LDA(At, 1, 1); PG8_STAGE(PG8_SA(1, 0), a3, voffA);
            PG8_BAR; PG8_WAIT_L(0); PG8_MMA(1, 0, At, B0); PG8_BAR; PG8_SCHED;
            PG8_STAGE(PG8_SB(1, 1), b3 + hstep, voffB);
            PG8_WAIT_V(6); PG8_BAR; PG8_MMA(1, 1, At, B1); PG8_BAR;
            }
        }
        if constexpr (ALIGN_EPI) { if (wr == 0) PG8_BAR; }
        if constexpr (!Epi::AFTER_DRAIN) { E(acc, cur, wr, wc, fr, fq); S.done(cur); }
        if (!has_next) break;
#pragma unroll
        for (int a = 0; a < 2; ++a)
#pragma unroll
            for (int b = 0; b < 2; ++b)
#pragma unroll
                for (int m = 0; m < 4; ++m)
#pragma unroll
                    for (int n = 0; n < 2; ++n) acc[a][b][m][n] = (f32x4){0.f, 0.f, 0.f, 0.f};
        cur = nxt; cA = nA; cB = nB; ++ui;
        if constexpr (ALIGN_EPI) { if (wr == 1) PG8_BAR; }
    }
    PG8_WAIT_V(0);
    if constexpr (!ALIGN_EPI) { if (wr == 0) PG8_BAR; }
    PG8_BAR;
    if constexpr (Epi::AFTER_DRAIN) { E.fused(acc, cur, wr, wc, fr, fq, lds, wid, lane); S.done(cur); }
#undef PG8_SA
#undef PG8_SB
#undef PG8_STAGE
#undef PG8_LDA
#undef PG8_LDB
#undef PG8_MMA
#undef PG8_WAIT_V
#undef PG8_WAIT_L
#undef PG8_BAR
#undef PG8_SCHED
}
}
#define GAS __attribute__((address_space(1)))
#define LAS __attribute__((address_space(3)))
typedef unsigned short bf16;
typedef unsigned v4u __attribute__((ext_vector_type(4)));
typedef float f32x4 __attribute__((ext_vector_type(4)));
typedef short bf16x8 __attribute__((ext_vector_type(8)));
typedef GAS unsigned gu32;
typedef GAS unsigned long long gu64;
#define RLX_AGENT __ATOMIC_RELAXED, __HIP_MEMORY_SCOPE_AGENT
#define LDS_WAIT() asm volatile("s_waitcnt lgkmcnt(0)" ::: "memory")
#define VM_WAIT() asm volatile("s_waitcnt vmcnt(0)" ::: "memory")
__device__ __forceinline__ unsigned long long rt() { return __builtin_amdgcn_s_memrealtime(); }
__device__ __forceinline__ unsigned f2bf(float f) { unsigned u = __builtin_bit_cast(unsigned, f); return (u + 0x7fffu + ((u >> 16) & 1u)) >> 16; }
__device__ __forceinline__ unsigned pk2(float lo, float hi) { return f2bf(lo) | (f2bf(hi) << 16); }

#define XB_TMO      128
#define XB_XCNT(j)  (256  + 64 * (j))
#define XB_XSUB(j)  (1280 + 64 * (j))
#define XB_XGEN(j)  (2304 + 64 * (j))
#define XB_TOP      3328
#define XB_TOPGEN   3392
#define XCD_BAR_WORDS 3456
#define XB_SPIN_CAP (1u << 18)

__device__ __forceinline__ unsigned xb_ld(unsigned* p)              { return __hip_atomic_load(p, __ATOMIC_RELAXED, __HIP_MEMORY_SCOPE_AGENT); }
__device__ __forceinline__ unsigned xb_add(unsigned* p, unsigned v) { return __hip_atomic_fetch_add(p, v, __ATOMIC_RELAXED, __HIP_MEMORY_SCOPE_AGENT); }
__device__ __forceinline__ unsigned xb_xcc_id() { return (unsigned)__builtin_amdgcn_s_getreg((3 << 11) | 20) & 0xFu; }
#define XB_SPIN(cond, bar) do { unsigned _sp = 0; while (cond) { __builtin_amdgcn_s_sleep(1); \
    if ((++_sp & 255u) == 0u) { if (xb_ld(&(bar)[XB_TMO])) break; if (_sp > XB_SPIN_CAP) { atomicAdd(&(bar)[XB_TMO], 1u); break; } } } } while (0)

struct XcdBarrier {
    unsigned* bar; unsigned x;
    volatile LAS unsigned* st;
};

__device__ __forceinline__ XcdBarrier xcd_barrier_post(unsigned* bar, volatile LAS unsigned* st) {
    XcdBarrier b; b.bar = bar; b.x = xb_xcc_id(); b.st = st;
    if (threadIdx.x == 0) (void)xb_add(&bar[XB_XCNT(b.x)], 1u);
    return b;
}
__device__ __forceinline__ void xcd_barrier_complete(unsigned* bar, unsigned x, unsigned& nloc, unsigned& nx) {
    const unsigned G = gridDim.x * gridDim.y * gridDim.z;
    unsigned sum, cnt, mine, sp = 0u;
    for (;;) {
        sum = 0u; cnt = 0u; mine = 0u;
#pragma unroll
        for (unsigned j = 0; j < 16; ++j) { const unsigned c = xb_ld(&bar[XB_XCNT(j)]); sum += c; cnt += (c > 0u) ? 1u : 0u; mine = (j == x) ? c : mine; }
        if (sum == G) break;
        __builtin_amdgcn_s_sleep(1);
        if ((++sp & 255u) == 0u) { if (xb_ld(&bar[XB_TMO])) break; if (sp > XB_SPIN_CAP) { atomicAdd(&bar[XB_TMO], 1u); break; } }
    }
    nloc = mine > 0u ? mine : 1u; nx = cnt > 0u ? cnt : 1u;
}

__device__ __forceinline__ void xcd_barrier(const XcdBarrier& b) {
    asm volatile("s_waitcnt vmcnt(0)" ::: "memory");
    __syncthreads();
    if (threadIdx.x == 0) {
        unsigned* bar = b.bar;
        __builtin_amdgcn_s_waitcnt(0);
        unsigned nloc = b.st[0], nx = b.st[1];
        if (nloc == 0u) { xcd_barrier_complete(bar, b.x, nloc, nx); b.st[0] = nloc; b.st[1] = nx; }
        const unsigned old = xb_add(&bar[XB_XSUB(b.x)], 1u);
        const unsigned gen = old / nloc;
        if (old + 1u == (gen + 1u) * nloc) {
            __builtin_amdgcn_fence(__ATOMIC_RELEASE, "agent");
            asm volatile("s_waitcnt vmcnt(0)" ::: "memory");
            const unsigned og = xb_add(&bar[XB_TOP], 1u);
            const unsigned tg = og / nx;
            if (og + 1u == (tg + 1u) * nx) xb_add(&bar[XB_TOPGEN], 1u);
            else XB_SPIN(xb_ld(&bar[XB_TOPGEN]) == tg, bar);
            __builtin_amdgcn_fence(__ATOMIC_ACQUIRE, "agent");
            xb_add(&bar[XB_XGEN(b.x)], 1u);
            asm volatile("s_waitcnt vmcnt(0)" ::: "memory");
        } else {
            XB_SPIN(xb_ld(&bar[XB_XGEN(b.x)]) == gen, bar);
            __builtin_amdgcn_fence(__ATOMIC_ACQUIRE, "agent");
            asm volatile("s_waitcnt vmcnt(0)" ::: "memory");
        }
    }
    __syncthreads();
}

#define XB_LOC(j)   (3584 + 64 * (j))
#define XB_RANK(j)  (4608 + 64 * (j))
#define XB_LGEN(j)  (5632 + 64 * (j))
#define XB_ALL_WORDS 6656
__device__ __forceinline__ void xcd_local_barrier(unsigned* bar, unsigned x, unsigned nloc) {
    asm volatile("s_waitcnt vmcnt(0)" ::: "memory");
    __syncthreads();
    if (threadIdx.x == 0) {
        __builtin_amdgcn_s_waitcnt(0);
        const unsigned old = xb_add(&bar[XB_LOC(x)], 1u); const unsigned gen = old / nloc;
        if (old + 1u == (gen + 1u) * nloc) {
            __builtin_amdgcn_fence(__ATOMIC_RELEASE, "agent");
            asm volatile("s_waitcnt vmcnt(0)" ::: "memory");
            __builtin_amdgcn_fence(__ATOMIC_ACQUIRE, "agent");
            xb_add(&bar[XB_LGEN(x)], 1u);
            asm volatile("s_waitcnt vmcnt(0)" ::: "memory");
        } else {
            XB_SPIN(xb_ld(&bar[XB_LGEN(x)]) == gen, bar);
            __builtin_amdgcn_fence(__ATOMIC_ACQUIRE, "agent");
            asm volatile("s_waitcnt vmcnt(0)" ::: "memory");
        }
    }
    __syncthreads();
}

constexpr int NWAVES = 8, NTHR = 512;
constexpr int DM = 1024, BATCH = 8, SEQ = 2048, DEPTH = 4, M = BATCH * SEQ;
constexpr int DFF = 2816, NUP = 2 * DFF, NPROJ = 3840, PROJ_LD = 3584, NIN_SRC = 3600, NCOND = 9 * DM;
constexpr float RMS_EPS = 1e-6f;
constexpr int PC_FQ = 0, PC_FK = 256, PC_FV = 512, PC_MQ = 768, PC_MK = 1024, PC_MV = 1280, PC_MO = 1536, PC_RQ = 1792, PC_RK = 2048, PC_RV = 2304, PC_RG = 2560, PC_SZ = 2816, PC_SX = 3072;
constexpr int PH_LAYER0 = 2, PH_PER_LAYER = 9, PH_FINAL = PH_LAYER0 + PH_PER_LAYER * DEPTH, PH_END = PH_FINAL + 1;
constexpr size_t MiB = 1u << 20;
constexpr size_t WS_CTL = 0, CTL_ZERO_BYTES = 1 * MiB;
constexpr size_t WS_COND = 1 * MiB;
constexpr size_t WS_ROPE = 3 * MiB;
constexpr size_t WS_W = 4 * MiB;
constexpr size_t W_UP = (size_t)NUP * DM * 2, W_DN = (size_t)DM * DFF * 2, W_IN = (size_t)NPROJ * DM * 2, W_OUT = (size_t)DM * DM * 2;
constexpr size_t OFF_UP1 = 0, OFF_DN1 = W_UP, OFF_UP2 = W_UP + W_DN, OFF_DN2 = 2 * W_UP + W_DN, OFF_IN = 2 * W_UP + 2 * W_DN, OFF_OUT = OFF_IN + W_IN, LAYER_W = OFF_OUT + W_OUT;
static_assert(LAYER_W * DEPTH == 170 * MiB, "weights");
constexpr size_t WS_HB = 174 * MiB;
constexpr size_t WS_PROJ = 206 * MiB, WS_ACT = 206 * MiB;
constexpr size_t WS_GATES = 318 * MiB;
constexpr size_t WS_VTF = 319 * MiB;
constexpr size_t WS_VTL = 327 * MiB;
constexpr size_t WS_QL = 363 * MiB, WS_KL = 387 * MiB;
constexpr size_t WS_COEF = 411 * MiB;
constexpr size_t COEF_A1 = 0, COEF_A2 = 768 * 1024, COEF_BETA = 2 * 768 * 1024, COEF_LCUM = 3 * 768 * 1024, COEF_S1 = COEF_LCUM + 256 * 1024, COEF_S2 = COEF_S1 + 16 * 1024, COEF_CTOT = COEF_S2 + 16 * 1024;
constexpr size_t WS_YRAW = 415 * MiB;
constexpr size_t WS_XB = 447 * MiB;
constexpr size_t WS_YBF = 479 * MiB;
constexpr size_t WS_KT = 511 * MiB;
constexpr size_t WS_XS = 535 * MiB;
constexpr size_t WS_DEN = 551 * MiB;
constexpr size_t WS_BIAS = 552 * MiB;
constexpr size_t BIAS_USE = (size_t)8 * NUP * 4, BIAS_BYTES = (size_t)DEPTH * 3 * BIAS_USE;
constexpr size_t WS_SS = 556 * MiB, SS_BYTES = (size_t)(3 * DEPTH + 1) * M * 8;
constexpr size_t WS_BIASQ = 558 * MiB, BIASQ_BYTES = 2 * BIAS_BYTES, WS_END = 563 * MiB;
static_assert(WS_BIAS + BIAS_BYTES <= 555 * MiB && WS_SS + SS_BYTES <= WS_BIASQ && WS_BIASQ + BIASQ_BYTES <= WS_END, "ws map 2");
static_assert(WS_PROJ + (size_t)M * PROJ_LD * 2 <= WS_GATES && WS_ACT + (size_t)M * DFF * 2 <= WS_GATES && COEF_CTOT + 4096 <= 4 * MiB && WS_YRAW + (size_t)M * 1024 * 4 <= WS_YBF, "ws map");
constexpr int CW_BAR = 4096;
constexpr int RING_BYTES = 131072, LDS_BYTES = 163840, LDSCTL_OFF = LDS_BYTES - 1024, MISC_OFF = LDSCTL_OFF + 320;

__device__ const double INVREV[32] = {0.15915494309189535, 0.11934937021124886, 0.089499401608891013, 0.067115083005227255, 0.050329212104487035, 0.037741584717419778, 0.028302195830623395, 0.02122365276477766, 0.015915494309189534, 0.011934937021124886, 0.0089499401608891006, 0.0067115083005227253, 0.0050329212104487037, 0.0037741584717419768, 0.0028302195830623399, 0.0021223652764777662, 0.0015915494309189536, 0.0011934937021124887, 0.00089499401608891024, 0.0006711508300522726, 0.00050329212104487033, 0.00037741584717419769, 0.00028302195830623401, 0.00021223652764777661, 0.00015915494309189535, 0.00011934937021124885, 8.9499401608891018e-05, 6.7115083005227268e-05, 5.0329212104487035e-05, 3.7741584717419777e-05, 2.8302195830623396e-05, 2.1223652764777659e-05};

struct Args { const float* in[25]; float* out; unsigned char* ws; int ph_lo, ph_hi; };
static_assert(sizeof(Args) == 27 * 8 + 8, "Args has no padding");

__device__ __forceinline__ float wave_sum(float v) {
#pragma unroll
    for (int o = 1; o < 64; o <<= 1) v += __shfl_xor(v, o);
    return v;
}
__device__ __forceinline__ float bf2f(unsigned short u) { return __uint_as_float((unsigned)u << 16); }
__device__ __forceinline__ float sigmoid_f(float v) { return 1.0f / (1.0f + __expf(-v)); }
__device__ __forceinline__ float silu_acc(float v) { return v / (1.0f + __expf(-v)); }
__device__ __forceinline__ float log_sigmoid_f(float v) { return fminf(v, 0.f) - log1pf(__expf(-fabsf(v))); }
__device__ __forceinline__ float softplus_f(float v) { return fmaxf(v, 0.f) + log1pf(__expf(-fabsf(v))); }

__device__ __forceinline__ int map_up(int n) { const int t = n >> 8, r = n & 255; return (r < 128) ? (t * 128 + r) : (DFF + t * 128 + (r - 128)); }
__device__ __forceinline__ int map_in(int n) {
    if (n < 768) return n; if (n < 1536) return n + 4; if (n < 3584) return n + 12;
    const int j = n - 3584; if (j < 4) return 768 + j; if (j < 8) return 1540 + (j - 4); if (j < 12) return 1544 + (j - 8); if (j < 16) return 3596 + (j - 12); return -1; }
template <int MAP> __device__ __forceinline__ void tr_item(const float* W, int K, int Nsrc, bf16* WT, int kb, int nb, LAS float* scr, int lane, const float* shp, long long* biasp, int Ndst) {
    const int k0 = 64 * kb, n0 = 32 * nb; const int nd = n0 + (lane & 31); const int src = MAP == 1 ? map_up(nd) : (MAP == 2 ? map_in(nd) : nd);
    const bool regular = (MAP != 2) || (n0 < 3584);
    if (regular) {
        const int s0c = MAP == 1 ? map_up(n0) : (MAP == 2 ? map_in(n0) : n0); const int kq = lane >> 3, nq = lane & 7;
        f32x4 wv[8];
#pragma unroll
        for (int i = 0; i < 8; ++i) wv[i] = *(const f32x4*)(W + (size_t)(k0 + 8 * i + kq) * Nsrc + s0c + 4 * nq);
#pragma unroll
        for (int i = 0; i < 8; ++i) { LAS float* d = scr + (8 * i + kq) * 33 + 4 * nq; d[0] = wv[i][0]; d[1] = wv[i][1]; d[2] = wv[i][2]; d[3] = wv[i][3]; }
    } else {
#pragma unroll 8
        for (int i = 0; i < 32; ++i) { const int kk = 2 * i + (lane >> 5); scr[kk * 33 + (lane & 31)] = src >= 0 ? W[(size_t)(k0 + kk) * Nsrc + src] : 0.f; }
    }
    if (MAP != 0) {
        LAS float* shs = scr + 64 * 33;
#pragma unroll
        for (int bb = 0; bb < 8; ++bb) shs[lane * 8 + bb] = shp[(size_t)bb * NCOND + k0 + lane];
    }
    LDS_WAIT(); asm volatile("" ::: "memory");
    const int c = lane & 7;
#pragma unroll
    for (int j = 0; j < 4; ++j) { const int n = (lane >> 3) + 8 * j; const LAS float* s = scr + (8 * c) * 33 + n;
        v4u o; o.x = pk2(s[0 * 33], s[1 * 33]); o.y = pk2(s[2 * 33], s[3 * 33]); o.z = pk2(s[4 * 33], s[5 * 33]); o.w = pk2(s[6 * 33], s[7 * 33]);
        *(GAS v4u*)(WT + (size_t)(n0 + n) * K + k0 + 8 * c) = o; }
    if (MAP != 0) {
        const LAS float* shs = scr + 64 * 33; const int n = lane & 31, hf = lane >> 5;
        float acc[8];
#pragma unroll
        for (int bb = 0; bb < 8; ++bb) acc[bb] = 0.f;
#pragma unroll 8
        for (int i = 0; i < 32; ++i) { const int kk = 32 * hf + i; const float w = scr[kk * 33 + n]; const f32x4 s0 = *(const LAS f32x4*)(shs + kk * 8), s1 = *(const LAS f32x4*)(shs + kk * 8 + 4);
            acc[0] += w * s0[0]; acc[1] += w * s0[1]; acc[2] += w * s0[2]; acc[3] += w * s0[3]; acc[4] += w * s1[0]; acc[5] += w * s1[1]; acc[6] += w * s1[2]; acc[7] += w * s1[3]; }
#pragma unroll
        for (int bb = 0; bb < 8; ++bb) { acc[bb] += __shfl_xor(acc[bb], 32); if (hf == 0 && src >= 0) atomicAdd((unsigned long long*)(biasp + (size_t)bb * Ndst + n0 + n), (unsigned long long)__float2ll_rn(acc[bb] * 4294967296.0f)); }
    }
    LDS_WAIT(); asm volatile("" ::: "memory");
}
__device__ __forceinline__ void prologue0(const Args& a, LAS unsigned char* lds, int tid, int lane, int wave, int G) {
    unsigned char* ws = a.ws;
    LAS float* cact = (LAS float*)(lds + 69632);
    LAS float* red = (LAS float*)(lds + 102400);
    for (int i = tid; i < BATCH * DM; i += NTHR) { const float v = a.in[1][i]; cact[i] = silu_acc(v); }
    __syncthreads();
    float* cond = (float*)(ws + WS_COND);
    for (int item = blockIdx.x; item < DEPTH * (NCOND / 64); item += G) {
        const int l = item / (NCOND / 64), cb = item % (NCOND / 64), col = cb * 64 + lane, ks = wave;
        const float* W = a.in[2] + (size_t)l * DM * NCOND + col;
        float acc[8];
#pragma unroll
        for (int b = 0; b < 8; ++b) acc[b] = 0.f;
        for (int k = ks * 128; k < ks * 128 + 128; k += 16) { float w[16];
#pragma unroll
            for (int i = 0; i < 16; ++i) w[i] = W[(size_t)(k + i) * NCOND];
#pragma unroll
            for (int i = 0; i < 16; ++i)
#pragma unroll
                for (int b = 0; b < 8; ++b) acc[b] += cact[b * DM + k + i] * w[i]; }
#pragma unroll
        for (int b = 0; b < 8; ++b) red[(ks * 8 + b) * 64 + lane] = acc[b];
        __syncthreads();
        { const int b = wave; float s = 0.f;
#pragma unroll
          for (int k2 = 0; k2 < 8; ++k2) s += red[(k2 * 8 + b) * 64 + lane];
          cond[((size_t)l * BATCH + b) * NCOND + col] = s + a.in[3][(size_t)l * NCOND + col]; }
        __syncthreads();
    }
    float2* rope = (float2*)(ws + WS_ROPE);
    for (int e = blockIdx.x * NTHR + tid; e < SEQ * 32; e += G * NTHR) { const int s = e >> 5, i = e & 31; const double rev = (double)s * INVREV[i]; const float fr = (float)(rev - rint(rev));
        rope[e] = make_float2(__builtin_amdgcn_cosf(fr), __builtin_amdgcn_sinf(fr)); }
    { GAS f32x4* z = (GAS f32x4*)(ws + WS_BIASQ); for (size_t i = (size_t)blockIdx.x * NTHR + tid; i < BIASQ_BYTES / 16; i += (size_t)G * NTHR) z[i] = (f32x4){0.f, 0.f, 0.f, 0.f};
      GAS f32x4* z2 = (GAS f32x4*)(ws + WS_SS); for (size_t i = (size_t)blockIdx.x * NTHR + tid; i < SS_BYTES / 16; i += (size_t)G * NTHR) z2[i] = (f32x4){0.f, 0.f, 0.f, 0.f}; }
}
__device__ __forceinline__ void prologue1(const Args& a, LAS unsigned char* lds, int lane, int wave, int G) {
    unsigned char* ws = a.ws;
    LAS float* scr = (LAS float*)(lds + wave * 10496);
    const float* cond = (const float*)(ws + WS_COND);
    const int gw = blockIdx.x * NWAVES + wave, NGW = G * NWAVES;
    constexpr int I_UP = (DM / 64) * (NUP / 32), I_DN = (DFF / 64) * (DM / 32), I_IN = (DM / 64) * (NPROJ / 32), I_OUT = (DM / 64) * (DM / 32), I_LAYER = 2 * I_UP + 2 * I_DN + I_IN + I_OUT;
    for (int it = gw; it < DEPTH * I_LAYER; it += NGW) {
        const int l = it / I_LAYER; int r = it % I_LAYER;
        unsigned char* wl = ws + WS_W + (size_t)l * LAYER_W; const float* cl = cond + (size_t)l * BATCH * NCOND; long long* bl = (long long*)(ws + WS_BIASQ + (size_t)l * 3 * 2 * BIAS_USE);
        if (r < I_UP) { tr_item<1>(a.in[5] + (size_t)l * DM * NUP, DM, NUP, (bf16*)(wl + OFF_UP1), r / (NUP / 32), r % (NUP / 32), scr, lane, cl + 0 * DM, bl, NUP); continue; } r -= I_UP;
        if (r < I_DN) { tr_item<0>(a.in[6] + (size_t)l * DFF * DM, DFF, DM, (bf16*)(wl + OFF_DN1), r / (DM / 32), r % (DM / 32), scr, lane, nullptr, nullptr, 0); continue; } r -= I_DN;
        if (r < I_UP) { tr_item<1>(a.in[7] + (size_t)l * DM * NUP, DM, NUP, (bf16*)(wl + OFF_UP2), r / (NUP / 32), r % (NUP / 32), scr, lane, cl + 6 * DM, bl + 2 * 8 * NUP, NUP); continue; } r -= I_UP;
        if (r < I_DN) { tr_item<0>(a.in[8] + (size_t)l * DFF * DM, DFF, DM, (bf16*)(wl + OFF_DN2), r / (DM / 32), r % (DM / 32), scr, lane, nullptr, nullptr, 0); continue; } r -= I_DN;
        if (r < I_IN) { tr_item<2>(a.in[9] + (size_t)l * DM * NIN_SRC, DM, NIN_SRC, (bf16*)(wl + OFF_IN), r / (NPROJ / 32), r % (NPROJ / 32), scr, lane, cl + 3 * DM, bl + 1 * 8 * NUP, NPROJ); continue; } r -= I_IN;
        tr_item<0>(a.in[10] + (size_t)l * DM * DM, DM, DM, (bf16*)(wl + OFF_OUT), r / (DM / 32), r % (DM / 32), scr, lane, nullptr, nullptr, 0);
    }
}
__device__ __forceinline__ void thin_xg(const float* x, bf16* hb, bf16* xb, const float* g, const float* cond_l, int sc_off, long long* ss, int gw, int NGW, int lane) {
    for (int m = gw; m < M; m += NGW) {
        const int b = m >> 11;
        const GAS f32x4* xr = (const GAS f32x4*)(x + (size_t)m * DM) + lane;
        f32x4 v[4]; float s = 0.f;
#pragma unroll
        for (int j = 0; j < 4; ++j) { v[j] = xr[64 * j]; s += (v[j].x * v[j].x + v[j].y * v[j].y) + (v[j].z * v[j].z + v[j].w * v[j].w); }
        s = wave_sum(s); if (lane == 0) ss[m] = __float2ll_rn(s * 16777216.0f);
        const f32x4* g4 = (const f32x4*)g + lane; const f32x4* sc4 = (const f32x4*)(cond_l + (size_t)b * NCOND + sc_off) + lane;
        GAS unsigned long long* o8 = (GAS unsigned long long*)(hb + (size_t)m * DM) + lane;
#pragma unroll
        for (int j = 0; j < 4; ++j) { const f32x4 o = v[j] * g4[64 * j] * (sc4[64 * j] + 1.0f);
            o8[64 * j] = (unsigned long long)pk2(o.x, o.y) | ((unsigned long long)pk2(o.z, o.w) << 32); }
        GAS unsigned long long* x8 = (GAS unsigned long long*)(xb + (size_t)m * DM) + lane;
#pragma unroll
        for (int j = 0; j < 4; ++j) x8[64 * j] = (unsigned long long)pk2(v[j].x, v[j].y) | ((unsigned long long)pk2(v[j].z, v[j].w) << 32);
    }
}
__device__ __forceinline__ void thin_norm(const float* x, bf16* hb, const float* g, const float* cond_l, int sh_off, int sc_off, int gw, int NGW, int lane) {
    for (int m = gw; m < M; m += NGW) {
        const int b = m >> 11;
        const GAS f32x4* xr = (const GAS f32x4*)(x + (size_t)m * DM) + lane;
        f32x4 v[4]; float s = 0.f;
#pragma unroll
        for (int j = 0; j < 4; ++j) { v[j] = xr[64 * j]; s += (v[j].x * v[j].x + v[j].y * v[j].y) + (v[j].z * v[j].z + v[j].w * v[j].w); }
        const float rstd = 1.0f / sqrtf(wave_sum(s) * (1.0f / DM) + RMS_EPS);
        const f32x4* g4 = (const f32x4*)g + lane; const f32x4* sh4 = (const f32x4*)(cond_l + (size_t)b * NCOND + sh_off) + lane; const f32x4* sc4 = (const f32x4*)(cond_l + (size_t)b * NCOND + sc_off) + lane;
        GAS unsigned long long* o8 = (GAS unsigned long long*)(hb + (size_t)m * DM) + lane;
#pragma unroll
        for (int j = 0; j < 4; ++j) { const f32x4 gg = g4[64 * j], sh = sh4[64 * j], sc = sc4[64 * j]; const f32x4 o = v[j] * rstd * gg * (sc + 1.0f) + sh;
            o8[64 * j] = (unsigned long long)pk2(o.x, o.y) | ((unsigned long long)pk2(o.z, o.w) << 32); }
    }
}

typedef float f32x16 __attribute__((ext_vector_type(16)));
typedef short s16x4 __attribute__((ext_vector_type(4)));
typedef float f32x2_t __attribute__((ext_vector_type(2))); typedef __bf16 bf16x2_t __attribute__((ext_vector_type(2)));
#define MFMA32(a, b, c) __builtin_amdgcn_mfma_f32_32x32x16_bf16((a), (b), (c), 0, 0, 0)
constexpr float LOG2E = 1.4426950408889634f;
__device__ __forceinline__ unsigned cvtpk(float lo, float hi) { f32x2_t v = {lo, hi}; bf16x2_t b = __builtin_convertvector(v, bf16x2_t); return __builtin_bit_cast(unsigned, b); }
template <int KAP> __device__ __forceinline__ bf16x8 pack8(const f32x16& x) {
    v4u p; p.x = cvtpk(x[8 * KAP + 0], x[8 * KAP + 1]); p.y = cvtpk(x[8 * KAP + 2], x[8 * KAP + 3]); p.z = cvtpk(x[8 * KAP + 4], x[8 * KAP + 5]); p.w = cvtpk(x[8 * KAP + 6], x[8 * KAP + 7]);
    return __builtin_bit_cast(bf16x8, p); }
__device__ __forceinline__ bf16x8 ld_perm(const bf16* p) { const s16x4 lo = *(const s16x4*)p, hi = *(const s16x4*)(p + 8); return __builtin_shufflevector(lo, hi, 0, 1, 2, 3, 4, 5, 6, 7); }
__device__ __forceinline__ float fmax16(const f32x16& a) { float m0 = fmaxf(fmaxf(a[0], a[1]), fmaxf(a[2], a[3])), m1 = fmaxf(fmaxf(a[4], a[5]), fmaxf(a[6], a[7])), m2 = fmaxf(fmaxf(a[8], a[9]), fmaxf(a[10], a[11])), m3 = fmaxf(fmaxf(a[12], a[13]), fmaxf(a[14], a[15])); return fmaxf(fmaxf(m0, m1), fmaxf(m2, m3)); }

struct MixBufs {
    const bf16* proj; const float* gates;
    bf16* vtf;
    float* lcum;
    float* ctot;
    bf16* ql;
    bf16* kl;
    bf16* kt;
    bf16* vtl;
    float* xs;
    float* a1; float* a2; float* beta;
    float* s1; float* s2;
    float* den;
    float* yraw;
};
__device__ __forceinline__ float wave_scan_add(float v, int lane) {
#pragma unroll
    for (int o = 1; o < 64; o <<= 1) { const float u = __shfl_up(v, o); if (lane >= o) v += u; }
    return v; }
__device__ __forceinline__ float wave_scan_max(float v, int lane) {
#pragma unroll
    for (int o = 1; o < 64; o <<= 1) { const float u = __shfl_up(v, o); if (lane >= o) v = fmaxf(v, u); }
    return v; }

struct PrepW { const float* mcw; const float* mcb; const float* scw; const float* scb; const float* fox_fb; const float* mib; const float* mfb; const float* dtb; const float* alog; const float2* rope; };
__device__ __forceinline__ void prep_unit(const MixBufs& B, const PrepW& W, int u, int wave, int lane) {
    const int b = u >> 5, c = u & 31, s0 = 64 * c; const size_t m0 = (size_t)b * SEQ + s0;
    for (int job = wave; job < 52; job += NWAVES) {
        if (job < 36) {
            const int kind = job < 32 ? (job >> 2) : (job < 34 ? 8 : 9), h = job < 32 ? (job & 3) : (job & 1);
            const int cg = lane & 7, tb = lane >> 3, tok0 = 8 * tb;
            const int pc = (kind == 0 ? PC_FV + h * 64 : kind == 1 ? PC_MV + h * 64 : kind == 2 ? PC_RV + h * 64 : kind == 3 ? PC_MQ + h * 64 : kind == 4 ? PC_MK + h * 64 : kind == 5 ? PC_RQ + h * 64 : kind == 6 ? PC_RK + h * 64
                         : kind == 7 ? PC_SX + h * 64 : kind == 8 ? PC_SX + 256 + h * 64 : PC_SX + 384 + h * 64);
            const bf16* src = B.proj + (m0 + tok0) * PROJ_LD + pc + 8 * cg;
            const bool is_conv = (kind == 3 || kind == 4 || kind >= 7), is_rot = (kind == 5 || kind == 6);
            v4u raw[8];
#pragma unroll
            for (int i = 0; i < 8; ++i) raw[i] = *(const v4u*)(src + (size_t)i * PROJ_LD);
            float v[8][8];
#pragma unroll
            for (int i = 0; i < 8; ++i)
#pragma unroll
                for (int j = 0; j < 4; ++j) { v[i][2 * j] = __uint_as_float(raw[i][j] << 16); v[i][2 * j + 1] = __uint_as_float(raw[i][j] & 0xffff0000u); }
            if (is_conv) {
                const int cc = (kind == 3 ? h * 64 : kind == 4 ? 256 + h * 64 : kind == 7 ? h * 64 : kind == 8 ? 256 + h * 64 : 384 + h * 64) + 8 * cg; const float* cw = (kind <= 4) ? W.mcw : W.scw; const float* cbp = (kind <= 4) ? W.mcb : W.scb;
                float wt[4][8], cb[8], xh[3][8];
#pragma unroll
                for (int k = 0; k < 4; ++k) { const f32x4 a = *(const f32x4*)(cw + k * 512 + cc), d = *(const f32x4*)(cw + k * 512 + cc + 4);
#pragma unroll
                    for (int j = 0; j < 4; ++j) { wt[k][j] = a[j]; wt[k][4 + j] = d[j]; } }
                { const f32x4 a = *(const f32x4*)(cbp + cc), d = *(const f32x4*)(cbp + cc + 4);
#pragma unroll
                  for (int j = 0; j < 4; ++j) { cb[j] = a[j]; cb[4 + j] = d[j]; } }
                const bool has_halo = (c > 0) || (tb > 0);
#pragma unroll
                for (int k = 0; k < 3; ++k) { v4u hr = (v4u){0u, 0u, 0u, 0u}; if (has_halo) hr = *(const v4u*)(src - (size_t)(3 - k) * PROJ_LD);
#pragma unroll
                    for (int j = 0; j < 4; ++j) { xh[k][2 * j] = __uint_as_float(hr[j] << 16); xh[k][2 * j + 1] = __uint_as_float(hr[j] & 0xffff0000u); } }
#pragma unroll
                for (int j = 0; j < 8; ++j) { float x0 = xh[0][j], x1 = xh[1][j], x2 = xh[2][j];
#pragma unroll
                    for (int i = 0; i < 8; ++i) { const float x3 = v[i][j]; float o = pg8::silu_f(cb[j] + wt[0][j] * x0 + wt[1][j] * x1 + wt[2][j] * x2 + wt[3][j] * x3); if (kind == 3) o *= 0.125f; v[i][j] = o; x0 = x1; x1 = x2; x2 = x3; } }
            } else if (is_rot) {
                const bf16* src2 = B.proj + (m0 + tok0) * PROJ_LD + pc + 8 * (cg ^ 4);
                const bool lowh = cg < 4; const float sc = (kind == 6) ? 0.125f : 1.0f;
#pragma unroll
                for (int i = 0; i < 8; ++i) { const v4u pr = *(const v4u*)(src2 + (size_t)i * PROJ_LD); const float2* rp = W.rope + (size_t)(s0 + tok0 + i) * 32 + 8 * (cg & 3);
                    const f32x4 r0 = *(const f32x4*)rp, r1 = *(const f32x4*)(rp + 2), r2 = *(const f32x4*)(rp + 4), r3 = *(const f32x4*)(rp + 6);
                    const float cs[8] = {r0[0], r0[2], r1[0], r1[2], r2[0], r2[2], r3[0], r3[2]}, sn[8] = {r0[1], r0[3], r1[1], r1[3], r2[1], r2[3], r3[1], r3[3]};
#pragma unroll
                    for (int j = 0; j < 8; ++j) { const float pv = (j & 1) ? __uint_as_float(pr[j >> 1] & 0xffff0000u) : __uint_as_float(pr[j >> 1] << 16);
                        v[i][j] = (lowh ? v[i][j] * cs[j] - pv * sn[j] : pv * sn[j] + v[i][j] * cs[j]) * sc; } }
            }
            if (kind == 7) {
                const float dtb_h = W.dtb[h];
#pragma unroll
                for (int i = 0; i < 8; ++i) { bf16* xp = (bf16*)B.xs + (m0 + tok0 + i) * 256 + h * 64 + 8 * cg; *(GAS v4u*)xp = (v4u){cvtpk(v[i][0], v[i][1]), cvtpk(v[i][2], v[i][3]), cvtpk(v[i][4], v[i][5]), cvtpk(v[i][6], v[i][7])};
                    const float dt = softplus_f(B.gates[(m0 + tok0 + i) * 16 + 12 + h] + dtb_h);
#pragma unroll
                    for (int j = 0; j < 8; ++j) v[i][j] *= dt; }
            }
            unsigned P[8][4];
#pragma unroll
            for (int i = 0; i < 8; ++i)
#pragma unroll
                for (int j = 0; j < 4; ++j) P[i][j] = cvtpk(v[i][2 * j], v[i][2 * j + 1]);
            bf16* rm = nullptr;
            if (kind == 3) rm = B.ql + (0 * (size_t)M + m0) * 256 + h * 64; else if (kind == 4) rm = B.kl + (0 * (size_t)M + m0) * 256 + h * 64;
            else if (kind == 5) rm = B.ql + (1 * (size_t)M + m0) * 256 + h * 64; else if (kind == 6) rm = B.kl + (1 * (size_t)M + m0) * 256 + h * 64;
            else if (kind == 8) rm = B.kl + (2 * (size_t)M + m0) * 256 + h * 64; else if (kind == 9) rm = B.ql + (2 * (size_t)M + m0) * 256 + h * 64;
            if (rm) {
#pragma unroll
                for (int i = 0; i < 8; ++i) *(GAS v4u*)(rm + (size_t)(tok0 + i) * 256 + 8 * cg) = (v4u){P[i][0], P[i][1], P[i][2], P[i][3]};
            }
            bf16* tr = nullptr;
            if (kind == 0) tr = B.vtf + ((size_t)(b * 4 + h) * 64) * SEQ;
            else if (kind == 1) tr = B.vtl + (((size_t)(0 * BATCH + b) * 4 + h) * 96) * SEQ;
            else if (kind == 2) tr = B.vtl + (((size_t)(1 * BATCH + b) * 4 + h) * 96) * SEQ;
            else if (kind == 7) tr = B.vtl + (((size_t)(2 * BATCH + b) * 4 + h) * 96) * SEQ;
            else if (kind == 4) tr = B.kt + (((size_t)(0 * BATCH + b) * 4 + h) * 64) * SEQ;
            else if (kind == 6) tr = B.kt + (((size_t)(1 * BATCH + b) * 4 + h) * 64) * SEQ;
            else if (kind == 8) tr = B.kt + (((size_t)(2 * BATCH + b) * 4 + h) * 64) * SEQ;
            if (tr) {
                tr += s0 + tok0;
#pragma unroll
                for (int j = 0; j < 8; ++j) { v4u o;
#pragma unroll
                    for (int ip = 0; ip < 4; ++ip) o[ip] = (j & 1) ? ((P[2 * ip][j >> 1] >> 16) | (P[2 * ip + 1][j >> 1] & 0xffff0000u)) : ((P[2 * ip][j >> 1] & 0xffffu) | (P[2 * ip + 1][j >> 1] << 16));
                    *(GAS v4u*)(tr + (size_t)(8 * cg + j) * SEQ) = o; }
                if (kind == 1 && cg < 4) {
#pragma unroll
                    for (int j = 0; j < 8; ++j) { const unsigned w = (cg == 0 && j == 0) ? 0x3f803f80u : 0u; *(GAS v4u*)(tr + (size_t)(64 + 8 * cg + j) * SEQ) = (v4u){w, w, w, w}; }
                }
            }
        } else {
            const int gj = job - 36, mixer = gj >> 2, h = gj & 3;
            const size_t m = m0 + lane;
            if (mixer == 0) {
                const float cum = wave_scan_add(log_sigmoid_f(B.gates[m * 16 + h] + W.fox_fb[h]), lane);
                B.lcum[(size_t)(b * 4 + h) * SEQ + s0 + lane] = cum; if (lane == 63) B.ctot[(b * 4 + h) * 32 + c] = cum;
            } else {
                const int mx = mixer - 1; const size_t ci = ((size_t)(mx * BATCH + b) * 4 + h) * SEQ + s0 + lane; const int si = ((mx * BATCH + b) * 4 + h) * 32 + c;
                if (mx == 0) {
                    const float bb = wave_scan_add(log_sigmoid_f(B.gates[m * 16 + 8 + h] + W.mfb[h]), lane), ic = B.gates[m * 16 + 4 + h] + W.mib[h], be = bb - ic, pm = wave_scan_max(-be, lane);
                    B.a1[ci] = bb; B.a2[ci] = bb + pm; B.beta[ci] = be; if (lane == 63) { B.s1[si] = bb; B.s2[si] = bb + pm; }
                } else if (mx == 1) {
                    const float lg = log1pf(-exp2f(-5.0f - (float)h)), v = (float)(lane + 1) * lg;
                    B.a1[ci] = v; B.a2[ci] = 0.f; B.beta[ci] = v; if (lane == 63) { B.s1[si] = v; B.s2[si] = 0.f; }
                } else {
                    const float dt = softplus_f(B.gates[m * 16 + 12 + h] + W.dtb[h]), cum = wave_scan_add(dt * (-__expf(W.alog[h])), lane);
                    B.a1[ci] = cum; B.a2[ci] = 0.f; B.beta[ci] = cum; if (lane == 63) { B.s1[si] = cum; B.s2[si] = 0.f; }
                }
            }
        }
    }
}

__device__ __forceinline__ int sig32(int i) { return (i & ~0xC) | ((i & 4) << 1) | ((i & 8) >> 1); }
#define GLDS16(gp, lp) __builtin_amdgcn_global_load_lds((const unsigned*)(gp), (LAS unsigned*)(lp), 16, 0, 0)
#define VMWAIT(n) asm volatile("s_waitcnt vmcnt(" #n ")" ::: "memory")
#define WGBAR() do { asm volatile("" ::: "memory"); __builtin_amdgcn_s_barrier(); asm volatile("" ::: "memory"); } while (0)
constexpr int FOX_SLOT = 16384, FOX_LC = 3 * FOX_SLOT;
__device__ __forceinline__ void fox_wg_unit(const MixBufs& B, bf16* ybf, LAS unsigned char* lds, int b, int h, int qb8, int wave, int lane) {
    const int col = lane & 31, hi = lane >> 5, t0 = 256 * qb8 + 32 * wave;
    const size_t rowq = (size_t)b * SEQ + t0 + col;
    bf16x8 qf[4];
#pragma unroll
    for (int ks = 0; ks < 4; ++ks) qf[ks] = *(const bf16x8*)(B.proj + rowq * PROJ_LD + PC_FQ + h * 64 + 16 * ks + 8 * hi);
    float offv; { const float cv = (lane < 32) ? B.ctot[(b * 4 + h) * 32 + lane] : 0.f; offv = wave_scan_add(cv, lane) - cv; }
    if (wave <= qb8) GLDS16(B.lcum + (size_t)(b * 4 + h) * SEQ + 256 * wave + 4 * lane, lds + FOX_LC + 1024 * wave);
    const bf16* ksrc = B.proj + ((size_t)b * SEQ + 32 * (wave >> 2) + sig32(col)) * PROJ_LD + PC_FK + h * 64 + 16 * (wave & 3) + 8 * hi;
    const bf16* vsrc = B.vtf + ((size_t)(b * 4 + h) * 64 + 32 * (wave >> 2) + col) * SEQ + 16 * (wave & 3) + 8 * hi;
    const int nkt = 4 * (qb8 + 1), tdiag = 4 * qb8 + (wave >> 1);
#define FOX_ISSUE(t, slot) do { GLDS16(ksrc + (size_t)(64 * (t)) * PROJ_LD, lds + (slot) * FOX_SLOT + 1024 * wave); GLDS16(vsrc + 64 * (t), lds + (slot) * FOX_SLOT + 8192 + 1024 * wave); } while (0)
    VMWAIT(0); WGBAR();
    if (wave <= qb8) {
        LAS f32x4* lp = (LAS f32x4*)(lds + FOX_LC + 1024 * wave) + lane; const f32x4 cv = *lp;
        const float o = __shfl(offv, 4 * wave + (lane >> 4));
        *lp = (cv + o) * (-LOG2E);
    }
    asm volatile("s_waitcnt lgkmcnt(0)" ::: "memory"); WGBAR();
    FOX_ISSUE(0, 0); FOX_ISSUE(1, 1);
    float mrun = -INFINITY, lsum = 0.f; f32x16 O0, O1;
#pragma unroll
    for (int r = 0; r < 16; ++r) { O0[r] = 0.f; O1[r] = 0.f; }
    int slot = 0;
    for (int kt = 0; kt < nkt; ++kt) {
        VMWAIT(2); WGBAR();
        { const int tn = (kt + 2 < nkt) ? kt + 2 : nkt - 1; const int sn = (slot == 0) ? 2 : slot - 1; FOX_ISSUE(tn, sn); }
        if (kt <= tdiag) {
            const int s0 = 64 * kt;
            const LAS unsigned char* sp = lds + slot * FOX_SLOT + 16 * lane;
            const LAS float* lc = (const LAS float*)(lds + FOX_LC) + s0 + 8 * hi;
            f32x16 S0, S1;
#pragma unroll
            for (int j = 0; j < 4; ++j) { const f32x4 c0 = *(const LAS f32x4*)(lc + 16 * j), c1 = *(const LAS f32x4*)(lc + 16 * j + 4);
#pragma unroll
                for (int i = 0; i < 4; ++i) { if (j < 2) { S0[8 * j + i] = c0[i]; S0[8 * j + 4 + i] = c1[i]; } else { S1[8 * (j - 2) + i] = c0[i]; S1[8 * (j - 2) + 4 + i] = c1[i]; } } }
#pragma unroll
            for (int ks = 0; ks < 4; ++ks) { S0 = MFMA32(*(const LAS bf16x8*)(sp + ks * 1024), qf[ks], S0); S1 = MFMA32(*(const LAS bf16x8*)(sp + (4 + ks) * 1024), qf[ks], S1); }
            if (kt == tdiag) {
                const int tq = t0 + col - s0;
#pragma unroll
                for (int r = 0; r < 16; ++r) { const int sl = 16 * (r >> 3) + 8 * hi + (r & 7); if (sl > tq) S0[r] = -INFINITY; if (sl + 32 > tq) S1[r] = -INFINITY; }
            }
            float mloc = fmaxf(fmax16(S0), fmax16(S1)); mloc = fmaxf(mloc, __shfl_xor(mloc, 32));
            const float mnew = fmaxf(mrun, mloc), alpha = __builtin_amdgcn_exp2f(mrun - mnew); mrun = mnew;
            float psum = 0.f;
#pragma unroll
            for (int r = 0; r < 16; ++r) { S0[r] = __builtin_amdgcn_exp2f(S0[r] - mnew); S1[r] = __builtin_amdgcn_exp2f(S1[r] - mnew); psum += S0[r] + S1[r]; }
            lsum = lsum * alpha + psum;
#pragma unroll
            for (int r = 0; r < 16; ++r) { O0[r] *= alpha; O1[r] *= alpha; }
            { const bf16x8 p00 = pack8<0>(S0), p01 = pack8<1>(S0), p10 = pack8<0>(S1), p11 = pack8<1>(S1);
              const LAS unsigned char* vp = sp + 8192;
              O0 = MFMA32(*(const LAS bf16x8*)(vp), p00, O0); O0 = MFMA32(*(const LAS bf16x8*)(vp + 1024), p01, O0); O0 = MFMA32(*(const LAS bf16x8*)(vp + 2048), p10, O0); O0 = MFMA32(*(const LAS bf16x8*)(vp + 3072), p11, O0);
              O1 = MFMA32(*(const LAS bf16x8*)(vp + 4096), p00, O1); O1 = MFMA32(*(const LAS bf16x8*)(vp + 5120), p01, O1); O1 = MFMA32(*(const LAS bf16x8*)(vp + 6144), p10, O1); O1 = MFMA32(*(const LAS bf16x8*)(vp + 7168), p11, O1); }
        }
        asm volatile("" ::: "memory");
        slot = (slot == 2) ? 0 : slot + 1;
    }
#undef FOX_ISSUE
    const float rl = 1.0f / (lsum + __shfl_xor(lsum, 32));
    bf16* yp = ybf + rowq * DM + h * 64 + 4 * hi;
#pragma unroll
    for (int g = 0; g < 4; ++g) { *(unsigned long long*)(yp + 8 * g) = (unsigned long long)cvtpk(O0[4 * g] * rl, O0[4 * g + 1] * rl) | ((unsigned long long)cvtpk(O0[4 * g + 2] * rl, O0[4 * g + 3] * rl) << 32);
                                  *(unsigned long long*)(yp + 32 + 8 * g) = (unsigned long long)cvtpk(O1[4 * g] * rl, O1[4 * g + 1] * rl) | ((unsigned long long)cvtpk(O1[4 * g + 2] * rl, O1[4 * g + 3] * rl) << 32); }
    VMWAIT(0); WGBAR();
}

constexpr int LIN_BUF = 30720, LIN_STF = 3 * LIN_BUF;
__device__ __forceinline__ void lin_wg_unit(const MixBufs& B, LAS unsigned char* lbuf, int mx, int b, int h, int es, int wave, int lane) {
    const int col = lane & 31, hi = lane >> 5, hk = (mx == 2) ? (h >> 1) : h; const bool ml = (mx == 0);
    const size_t cbase = (((size_t)mx * BATCH + b) * 4 + h) * SEQ; const int sbase = ((mx * BATCH + b) * 4 + h) * 32;
    if (wave >= 1 && wave <= 4) {
        const bf16* src; size_t step_c, step_hi, step_lo; int np, f0;
        if (wave == 1)      { src = B.ql + ((size_t)mx * M + (size_t)b * SEQ + col) * 256 + hk * 64 + 8 * hi;            step_c = 64 * 256; step_hi = 32 * 256; step_lo = 16; np = 8; f0 = 0; }
        else if (wave == 2) { src = B.kl + ((size_t)mx * M + (size_t)b * SEQ + sig32(col)) * 256 + hk * 64 + 8 * hi;     step_c = 64 * 256; step_hi = 32 * 256; step_lo = 16; np = 8; f0 = 8; }
        else if (wave == 3) { src = B.kt + ((((size_t)mx * BATCH + b) * 4 + hk) * 64 + sig32(col)) * SEQ + 8 * hi;      step_c = 64; step_hi = (size_t)32 * SEQ; step_lo = 16; np = 8; f0 = 16; }
        else                { src = B.vtl + ((((size_t)mx * BATCH + b) * 4 + h) * 96 + 32 * es + col) * SEQ + 8 * hi;   step_c = 64; step_hi = 0; step_lo = 16; np = 4; f0 = 24; }
        const int cl = lane & 15; const bool sc_lane = (lane == 48 || lane == 49);
        const float* cfp = (lane < 16) ? B.a1 + cbase + 4 * cl : (lane < 32) ? B.a2 + cbase + 4 * cl : (lane < 48) ? B.beta + cbase + 4 * cl : (lane == 48) ? B.s1 + sbase : (lane == 49) ? B.s2 + sbase : B.a1 + cbase;
#define LIN_ISSUE(c, bi) do { LAS unsigned char* bb_ = lbuf + (bi) * LIN_BUF + f0 * 1024; const bf16* sc_ = src + (size_t)(c) * step_c; \
            _Pragma("unroll") for (int f = 0; f < 8; ++f) if (f < np) GLDS16(sc_ + (size_t)(f >> 2) * step_hi + (size_t)(f & 3) * step_lo, bb_ + f * 1024); \
            if (wave == 4) GLDS16(cfp + (sc_lane ? 4 * ((c) >> 2) : 64 * (c)), lbuf + (bi) * LIN_BUF + 28 * 1024); } while (0)
        LIN_ISSUE(0, 0); LIN_ISSUE(1, 1);
        if (wave == 4) VMWAIT(5); else VMWAIT(8);
        WGBAR();
        int bi = 2;
        for (int c = 0; c < 32; ++c) {
            const int cc = (c + 2 < 32) ? c + 2 : 31;
            LIN_ISSUE(cc, bi);
            if (wave == 4) VMWAIT(5); else VMWAIT(8);
            WGBAR();
            bi = (bi == 2) ? 0 : bi + 1;
        }
#undef LIN_ISSUE
        VMWAIT(0);
    } else if (wave == 0 || wave == 5) {
        const int tt = (wave == 5) ? 1 : 0;
        float mst = 0.f; int bi = 0;
        WGBAR();
        for (int c = 0; c < 32; ++c) {
            const int s0 = 64 * c;
            const LAS unsigned char* bp = lbuf + bi * LIN_BUF + 16 * lane;
            const LAS unsigned char* sf = lbuf + LIN_STF + (c & 1) * 4096 + 16 * lane;
            const LAS float* cf = (const LAS float*)(lbuf + bi * LIN_BUF + 28 * 1024);
#define LFR(f) (*(const LAS bf16x8*)(bp + (f) * 1024))
            const float S1v = cf[192 + (c & 3)], S2v = cf[196 + (c & 3)];
            float mnew = 0.f;
            if (ml) mnew = fmaxf(S1v + mst, S2v);
            const float a1 = cf[32 * tt + col]; float al = a1, rho = a1, mt = 0.f;
            if (ml) { mt = fmaxf(a1 + mst, cf[64 + 32 * tt + col]); al = a1 - mt; rho = a1 + mst - mt; }
            f32x16 y;
#pragma unroll
            for (int r = 0; r < 16; ++r) y[r] = 0.f;
#pragma unroll
            for (int j = 0; j < 4; ++j) y = MFMA32(*(const LAS bf16x8*)(sf + j * 1024), LFR(tt * 4 + j), y);
            const float er = __expf(rho);
#pragma unroll
            for (int r = 0; r < 16; ++r) y[r] *= er;
            for (int st = 0; st <= tt; ++st) {
                f32x4 bD[2][2];
#pragma unroll
                for (int k = 0; k < 2; ++k) { bD[k][0] = *(const LAS f32x4*)(cf + 128 + 16 * (2 * st + k) + 8 * hi); bD[k][1] = *(const LAS f32x4*)(cf + 128 + 16 * (2 * st + k) + 8 * hi + 4); }
                f32x16 p;
#pragma unroll
                for (int r = 0; r < 16; ++r) p[r] = 0.f;
#pragma unroll
                for (int ks = 0; ks < 4; ++ks) p = MFMA32(LFR(8 + st * 4 + ks), LFR(tt * 4 + ks), p);
#pragma unroll
                for (int r = 0; r < 16; ++r) { float v = p[r] * __expf(al - bD[r >> 3][(r >> 2) & 1][r & 3]); if (st == tt && (16 * (r >> 3) + 8 * hi + (r & 7)) > col) v = 0.f; p[r] = v; }
                y = MFMA32(LFR(24 + 2 * st), pack8<0>(p), y); y = MFMA32(LFR(24 + 2 * st + 1), pack8<1>(p), y);
            }
            { const size_t row = (size_t)b * SEQ + s0 + 32 * tt + col;
              if (es < 2) { bf16* yp = (bf16*)B.yraw + row * 1024 + 256 * (mx + 1) + h * 64 + 32 * es + 4 * hi;
#pragma unroll
                  for (int g = 0; g < 4; ++g) *(unsigned long long*)(yp + 8 * g) = (unsigned long long)cvtpk(y[4 * g], y[4 * g + 1]) | ((unsigned long long)cvtpk(y[4 * g + 2], y[4 * g + 3]) << 32); }
              else if (hi == 0) { B.den[row * 8 + h * 2] = y[0]; B.den[row * 8 + h * 2 + 1] = mt; } }
#undef LFR
            if (ml) mst = mnew;
            asm volatile("s_waitcnt lgkmcnt(0)" ::: "memory");
            WGBAR();
            bi = (bi == 2) ? 0 : bi + 1;
        }
    } else if (wave == 6) {
        f32x16 st0, st1;
#pragma unroll
        for (int r = 0; r < 16; ++r) { st0[r] = 0.f; st1[r] = 0.f; }
        { LAS unsigned char* sf = lbuf + LIN_STF + 16 * lane;
#pragma unroll
          for (int j = 0; j < 4; ++j) *(LAS v4u*)(sf + j * 1024) = (v4u){0u, 0u, 0u, 0u}; }
        float mst = 0.f; int bi = 0;
        asm volatile("s_waitcnt lgkmcnt(0)" ::: "memory");
        WGBAR();
        for (int c = 0; c < 32; ++c) {
            const LAS unsigned char* bp = lbuf + bi * LIN_BUF + 16 * lane;
            const LAS float* cf = (const LAS float*)(lbuf + bi * LIN_BUF + 28 * 1024);
#define LFR(f) (*(const LAS bf16x8*)(bp + (f) * 1024))
            const float S1v = cf[192 + (c & 3)], S2v = cf[196 + (c & 3)];
            float gam = S1v, dlt = S1v, mnew = 0.f;
            if (ml) { mnew = fmaxf(S1v + mst, S2v); gam = S1v - mnew; dlt = S1v + mst - mnew; }
            const float ed = __expf(dlt);
#pragma unroll
            for (int r = 0; r < 16; ++r) { st0[r] *= ed; st1[r] *= ed; }
#pragma unroll
            for (int k4 = 0; k4 < 4; ++k4) {
                const bf16x8 vr = LFR(24 + k4); const f32x4 b0 = *(const LAS f32x4*)(cf + 128 + 16 * k4 + 8 * hi), b1 = *(const LAS f32x4*)(cf + 128 + 16 * k4 + 8 * hi + 4);
                v4u wv; wv.x = cvtpk(bf2f((unsigned short)vr[0]) * __expf(gam - b0[0]), bf2f((unsigned short)vr[1]) * __expf(gam - b0[1])); wv.y = cvtpk(bf2f((unsigned short)vr[2]) * __expf(gam - b0[2]), bf2f((unsigned short)vr[3]) * __expf(gam - b0[3]));
                wv.z = cvtpk(bf2f((unsigned short)vr[4]) * __expf(gam - b1[0]), bf2f((unsigned short)vr[5]) * __expf(gam - b1[1])); wv.w = cvtpk(bf2f((unsigned short)vr[6]) * __expf(gam - b1[2]), bf2f((unsigned short)vr[7]) * __expf(gam - b1[3]));
                const bf16x8 wvf = __builtin_bit_cast(bf16x8, wv);
                st0 = MFMA32(LFR(16 + k4), wvf, st0); st1 = MFMA32(LFR(20 + k4), wvf, st1);
            }
#undef LFR
            { LAS unsigned char* sf = lbuf + LIN_STF + ((c + 1) & 1) * 4096 + 16 * lane;
              *(LAS bf16x8*)(sf) = pack8<0>(st0); *(LAS bf16x8*)(sf + 1024) = pack8<1>(st0); *(LAS bf16x8*)(sf + 2048) = pack8<0>(st1); *(LAS bf16x8*)(sf + 3072) = pack8<1>(st1); }
            if (ml) mst = mnew;
            asm volatile("s_waitcnt lgkmcnt(0)" ::: "memory");
            WGBAR();
            bi = (bi == 2) ? 0 : bi + 1;
        }
    } else {
        for (int c = 0; c < 33; ++c) WGBAR();
    }
    VMWAIT(0); WGBAR();
}
constexpr int MX_LC = 3 * 16384, MX_LIN = MX_LC + 8192, MX_STF = MX_LIN + 3 * LIN_BUF;
static_assert(MX_STF + 8192 <= LDSCTL_OFF, "mixer LDS map");
__device__ __forceinline__ void mixer_phase(const MixBufs& B, bf16* ybf, LAS unsigned char* lds, int vcu, int wave, int lane) {
    const int G = gridDim.x;
    const int col = lane & 31, hi = lane >> 5;
    for (int v = vcu; v < 256; v += G) {
        const int bh = v >> 3, i8 = v & 7, fb = bh >> 2, fh = bh & 3;
        const int nktA = 2 * i8 + 2, NF = 34;
        const bool has_lin = i8 < 7; const int lj = (bh & 3) * 7 + i8;
        int mx, lh, es; const int lb = fb; if (lj < 12) { mx = 0; lh = lj / 3; es = lj % 3; } else { const int w2 = lj - 12; mx = 1 + (w2 >> 3); lh = (w2 >> 1) & 3; es = w2 & 1; }
        const int hk = (mx == 2) ? (lh >> 1) : lh; const bool ml = (mx == 0);
        const size_t cbase = (((size_t)mx * BATCH + lb) * 4 + lh) * SEQ; const int sbase = ((mx * BATCH + lb) * 4 + lh) * 32;
        if (wave < 4) {
            int qb16 = i8, t0 = 128 * qb16 + 32 * wave, tdiag = 2 * qb16 + (wave >> 1);
            size_t rowq = (size_t)fb * SEQ + t0 + col;
            bf16x8 qf[4];
#pragma unroll
            for (int ks = 0; ks < 4; ++ks) qf[ks] = *(const bf16x8*)(B.proj + rowq * PROJ_LD + PC_FQ + fh * 64 + 16 * ks + 8 * hi);
            float offv; { const float cv = (lane < 32) ? B.ctot[(fb * 4 + fh) * 32 + lane] : 0.f; offv = wave_scan_add(cv, lane) - cv; }
            GLDS16(B.lcum + (size_t)(fb * 4 + fh) * SEQ + 256 * wave + 4 * lane, lds + MX_LC + 1024 * wave);
            GLDS16(B.lcum + (size_t)(fb * 4 + fh) * SEQ + 256 * (wave + 4) + 4 * lane, lds + MX_LC + 1024 * (wave + 4));
            const bf16* ksrc = B.proj + ((size_t)fb * SEQ + sig32(col)) * PROJ_LD + PC_FK + fh * 64 + 16 * wave + 8 * hi;
            const bf16* vsrc = B.vtf + ((size_t)(fb * 4 + fh) * 64 + col) * SEQ + 16 * wave + 8 * hi;
#define FOX_ISSUE(kt, slot) do { LAS unsigned char* d_ = lds + (slot) * FOX_SLOT + 1024 * wave; const bf16* k_ = ksrc + (size_t)(64 * (kt)) * PROJ_LD; const bf16* v_ = vsrc + 64 * (kt); \
                GLDS16(k_, d_); GLDS16(k_ + (size_t)32 * PROJ_LD, d_ + 4096); GLDS16(v_, d_ + 8192); GLDS16(v_ + (size_t)32 * SEQ, d_ + 12288); } while (0)
            FOX_ISSUE(0, 0); FOX_ISSUE(1, 1);
            VMWAIT(8); WGBAR();
#pragma unroll
            for (int pz = 0; pz < 2; ++pz) { const int pc_ = wave + 4 * pz;
                LAS f32x4* lp = (LAS f32x4*)(lds + MX_LC + 1024 * pc_) + lane; const f32x4 cv = *lp; const float o = __shfl(offv, 4 * pc_ + (lane >> 4)); *lp = (cv + o) * (-LOG2E); }
            asm volatile("s_waitcnt lgkmcnt(0)" ::: "memory"); WGBAR();
            float mrun = -INFINITY, lsum = 0.f; f32x16 O0, O1;
#pragma unroll
            for (int r = 0; r < 16; ++r) { O0[r] = 0.f; O1[r] = 0.f; }
            int sl = 0;
            for (int f = 0; f < NF; ++f) {
                if (f + 1 < NF) VMWAIT(4); else VMWAIT(0);
                WGBAR();
                if (f + 2 < NF) { const int kn = (f + 2 < nktA) ? f + 2 : f + 2 - nktA; FOX_ISSUE(kn, (sl == 0) ? 2 : sl - 1); }
                if (f == nktA) {
                    const float rl = 1.0f / (lsum + __shfl_xor(lsum, 32));
                    bf16* yp = ybf + rowq * DM + fh * 64 + 4 * hi;
#pragma unroll
                    for (int g = 0; g < 4; ++g) { *(unsigned long long*)(yp + 8 * g) = (unsigned long long)cvtpk(O0[4 * g] * rl, O0[4 * g + 1] * rl) | ((unsigned long long)cvtpk(O0[4 * g + 2] * rl, O0[4 * g + 3] * rl) << 32);
                                                  *(unsigned long long*)(yp + 32 + 8 * g) = (unsigned long long)cvtpk(O1[4 * g] * rl, O1[4 * g + 1] * rl) | ((unsigned long long)cvtpk(O1[4 * g + 2] * rl, O1[4 * g + 3] * rl) << 32); }
                    qb16 = 15 - i8; t0 = 128 * qb16 + 32 * wave; tdiag = 2 * qb16 + (wave >> 1); rowq = (size_t)fb * SEQ + t0 + col;
#pragma unroll
                    for (int ks = 0; ks < 4; ++ks) qf[ks] = *(const bf16x8*)(B.proj + rowq * PROJ_LD + PC_FQ + fh * 64 + 16 * ks + 8 * hi);
                    mrun = -INFINITY; lsum = 0.f;
#pragma unroll
                    for (int r = 0; r < 16; ++r) { O0[r] = 0.f; O1[r] = 0.f; }
                }
                const int kt = (f < nktA) ? f : f - nktA;
                if (kt <= tdiag) {
                    const int s0 = 64 * kt;
                    const LAS unsigned char* sp = lds + sl * FOX_SLOT + 16 * lane;
                    const LAS float* lc = (const LAS float*)(lds + MX_LC) + s0 + 8 * hi;
                    f32x16 S0, S1;
#pragma unroll
                    for (int j = 0; j < 4; ++j) { const f32x4 c0 = *(const LAS f32x4*)(lc + 16 * j), c1 = *(const LAS f32x4*)(lc + 16 * j + 4);
#pragma unroll
                        for (int i = 0; i < 4; ++i) { if (j < 2) { S0[8 * j + i] = c0[i]; S0[8 * j + 4 + i] = c1[i]; } else { S1[8 * (j - 2) + i] = c0[i]; S1[8 * (j - 2) + 4 + i] = c1[i]; } } }
#pragma unroll
                    for (int ks = 0; ks < 4; ++ks) { S0 = MFMA32(*(const LAS bf16x8*)(sp + ks * 1024), qf[ks], S0); S1 = MFMA32(*(const LAS bf16x8*)(sp + (4 + ks) * 1024), qf[ks], S1); }
                    if (kt == tdiag) {
                        const int tq = t0 + col - s0;
#pragma unroll
                        for (int r = 0; r < 16; ++r) { const int sl = 16 * (r >> 3) + 8 * hi + (r & 7); if (sl > tq) S0[r] = -INFINITY; if (sl + 32 > tq) S1[r] = -INFINITY; }
                    }
                    float mloc = fmaxf(fmax16(S0), fmax16(S1)); mloc = fmaxf(mloc, __shfl_xor(mloc, 32));
                    const float mnew = fmaxf(mrun, mloc), alpha = __builtin_amdgcn_exp2f(mrun - mnew); mrun = mnew;
                    float psum = 0.f;
#pragma unroll
                    for (int r = 0; r < 16; ++r) { S0[r] = __builtin_amdgcn_exp2f(S0[r] - mnew); S1[r] = __builtin_amdgcn_exp2f(S1[r] - mnew); psum += S0[r] + S1[r]; }
                    lsum = lsum * alpha + psum;
#pragma unroll
                    for (int r = 0; r < 16; ++r) { O0[r] *= alpha; O1[r] *= alpha; }
                    { const bf16x8 p00 = pack8<0>(S0), p01 = pack8<1>(S0), p10 = pack8<0>(S1), p11 = pack8<1>(S1);
                      const LAS unsigned char* vp = sp + 8192;
                      O0 = MFMA32(*(const LAS bf16x8*)(vp), p00, O0); O0 = MFMA32(*(const LAS bf16x8*)(vp + 1024), p01, O0); O0 = MFMA32(*(const LAS bf16x8*)(vp + 2048), p10, O0); O0 = MFMA32(*(const LAS bf16x8*)(vp + 3072), p11, O0);
                      O1 = MFMA32(*(const LAS bf16x8*)(vp + 4096), p00, O1); O1 = MFMA32(*(const LAS bf16x8*)(vp + 5120), p01, O1); O1 = MFMA32(*(const LAS bf16x8*)(vp + 6144), p10, O1); O1 = MFMA32(*(const LAS bf16x8*)(vp + 7168), p11, O1); }
                }
                asm volatile("s_waitcnt lgkmcnt(0)" ::: "memory");
                sl = (sl == 2) ? 0 : sl + 1;
            }
#undef FOX_ISSUE
            { const float rl = 1.0f / (lsum + __shfl_xor(lsum, 32));
              bf16* yp = ybf + rowq * DM + fh * 64 + 4 * hi;
#pragma unroll
              for (int g = 0; g < 4; ++g) { *(unsigned long long*)(yp + 8 * g) = (unsigned long long)cvtpk(O0[4 * g] * rl, O0[4 * g + 1] * rl) | ((unsigned long long)cvtpk(O0[4 * g + 2] * rl, O0[4 * g + 3] * rl) << 32);
                                            *(unsigned long long*)(yp + 32 + 8 * g) = (unsigned long long)cvtpk(O1[4 * g] * rl, O1[4 * g + 1] * rl) | ((unsigned long long)cvtpk(O1[4 * g + 2] * rl, O1[4 * g + 3] * rl) << 32); } }
        } else {
            const bf16* src; size_t step_c, step_hi; int np, f0;
            if (wave == 4)      { src = B.ql + ((size_t)mx * M + (size_t)lb * SEQ + col) * 256 + hk * 64 + 8 * hi;            step_c = 64 * 256; step_hi = 32 * 256; np = 8; f0 = 0; }
            else if (wave == 6) { src = B.kt + ((((size_t)mx * BATCH + lb) * 4 + hk) * 64 + sig32(col)) * SEQ + 8 * hi;      step_c = 64; step_hi = (size_t)32 * SEQ; np = 8; f0 = 16; }
            else if (wave == 7) { src = B.vtl + ((((size_t)mx * BATCH + lb) * 4 + lh) * 96 + 32 * es + col) * SEQ + 8 * hi;  step_c = 64; step_hi = 0; np = 4; f0 = 24; }
            else                { src = B.ql; step_c = 0; step_hi = 0; np = 0; f0 = 0; }
            const bf16* srck = B.kl + ((size_t)mx * M + (size_t)lb * SEQ + sig32(col)) * 256 + hk * 64 + 8 * hi;
            const int cl = lane & 15; const bool sc_lane = (lane == 48 || lane == 49);
            const float* cfp = (lane < 16) ? B.a1 + cbase + 4 * cl : (lane < 32) ? B.a2 + cbase + 4 * cl : (lane < 48) ? B.beta + cbase + 4 * cl : (lane == 48) ? B.s1 + sbase : (lane == 49) ? B.s2 + sbase : B.a1 + cbase;
            LAS unsigned char* lbuf = lds + MX_LIN;
#define LIN_ISSUE(c, bi) do { LAS unsigned char* bb_ = lbuf + (bi) * LIN_BUF + f0 * 1024; const bf16* sc_ = src + (size_t)(c) * step_c; \
                _Pragma("unroll") for (int f = 0; f < 8; ++f) if (f < np) GLDS16(sc_ + (size_t)(f >> 2) * step_hi + (size_t)(f & 3) * 16, bb_ + f * 1024); \
                if (wave == 7) { const bf16* sk_ = srck + (size_t)(c) * (64 * 256); LAS unsigned char* bk_ = lbuf + (bi) * LIN_BUF + 8 * 1024; \
                    _Pragma("unroll") for (int f = 0; f < 8; ++f) GLDS16(sk_ + (size_t)(f >> 2) * (32 * 256) + (size_t)(f & 3) * 16, bk_ + f * 1024); \
                    GLDS16(cfp + (sc_lane ? 4 * ((c) >> 2) : 64 * (c)), lbuf + (bi) * LIN_BUF + 28 * 1024); } } while (0)
            if (has_lin) { LIN_ISSUE(0, 0); LIN_ISSUE(1, 1); }
            f32x16 st0, st1;
#pragma unroll
            for (int r = 0; r < 16; ++r) { st0[r] = 0.f; st1[r] = 0.f; }
            if (wave == 6) { LAS unsigned char* sf = lds + MX_STF + 16 * lane;
#pragma unroll
                for (int j = 0; j < 4; ++j) *(LAS v4u*)(sf + j * 1024) = (v4u){0u, 0u, 0u, 0u}; }
            asm volatile("s_waitcnt lgkmcnt(0)" ::: "memory"); WGBAR();
            WGBAR();
            float mst = 0.f; int bi = 0;
            for (int c = 0; c < NF; ++c) {
                if (c + 1 < 32) { if (wave == 7) VMWAIT(13); else if (wave == 5) VMWAIT(0); else VMWAIT(8); } else VMWAIT(0);
                WGBAR();
                if (has_lin && c < 32) {
                    if (c + 2 < 32) LIN_ISSUE(c + 2, (bi == 0) ? 2 : bi - 1);
                    const LAS unsigned char* bp = lbuf + bi * LIN_BUF + 16 * lane;
                    const LAS float* cf = (const LAS float*)(lbuf + bi * LIN_BUF + 28 * 1024);
#define LFR(f) (*(const LAS bf16x8*)(bp + (f) * 1024))
                    if (wave == 4 || wave == 5) {
                        const int tt = wave - 4, s0 = 64 * c;
                        const LAS unsigned char* sf = lds + MX_STF + (c & 1) * 4096 + 16 * lane;
                        const float S1v = cf[192 + (c & 3)], S2v = cf[196 + (c & 3)];
                        float mnew = 0.f;
                        if (ml) mnew = fmaxf(S1v + mst, S2v);
                        const float a1 = cf[32 * tt + col]; float al = a1, rho = a1, mt = 0.f;
                        if (ml) { mt = fmaxf(a1 + mst, cf[64 + 32 * tt + col]); al = a1 - mt; rho = a1 + mst - mt; }
                        f32x16 y;
#pragma unroll
                        for (int r = 0; r < 16; ++r) y[r] = 0.f;
#pragma unroll
                        for (int j = 0; j < 4; ++j) y = MFMA32(*(const LAS bf16x8*)(sf + j * 1024), LFR(tt * 4 + j), y);
                        const float er = __expf(rho);
#pragma unroll
                        for (int r = 0; r < 16; ++r) y[r] *= er;
                        for (int st = 0; st <= tt; ++st) {
                            f32x4 bD[2][2];
#pragma unroll
                            for (int k = 0; k < 2; ++k) { bD[k][0] = *(const LAS f32x4*)(cf + 128 + 16 * (2 * st + k) + 8 * hi); bD[k][1] = *(const LAS f32x4*)(cf + 128 + 16 * (2 * st + k) + 8 * hi + 4); }
                            f32x16 p;
#pragma unroll
                            for (int r = 0; r < 16; ++r) p[r] = 0.f;
#pragma unroll
                            for (int ks = 0; ks < 4; ++ks) p = MFMA32(LFR(8 + st * 4 + ks), LFR(tt * 4 + ks), p);
#pragma unroll
                            for (int r = 0; r < 16; ++r) { float vv = p[r] * __expf(al - bD[r >> 3][(r >> 2) & 1][r & 3]); if (st == tt && (16 * (r >> 3) + 8 * hi + (r & 7)) > col) vv = 0.f; p[r] = vv; }
                            y = MFMA32(LFR(24 + 2 * st), pack8<0>(p), y); y = MFMA32(LFR(24 + 2 * st + 1), pack8<1>(p), y);
                        }
                        { const size_t row = (size_t)lb * SEQ + s0 + 32 * tt + col;
                          if (es < 2) { bf16* yp = (bf16*)B.yraw + row * 1024 + 256 * (mx + 1) + lh * 64 + 32 * es + 4 * hi;
#pragma unroll
                              for (int g = 0; g < 4; ++g) *(unsigned long long*)(yp + 8 * g) = (unsigned long long)cvtpk(y[4 * g], y[4 * g + 1]) | ((unsigned long long)cvtpk(y[4 * g + 2], y[4 * g + 3]) << 32); }
                          else if (hi == 0) { B.den[row * 8 + lh * 2] = y[0]; B.den[row * 8 + lh * 2 + 1] = mt; } }
                        if (ml) mst = mnew;
                    } else if (wave == 6) {
                        const float S1v = cf[192 + (c & 3)], S2v = cf[196 + (c & 3)];
                        float gam = S1v, dlt = S1v, mnew = 0.f;
                        if (ml) { mnew = fmaxf(S1v + mst, S2v); gam = S1v - mnew; dlt = S1v + mst - mnew; }
                        const float ed = __expf(dlt);
#pragma unroll
                        for (int r = 0; r < 16; ++r) { st0[r] *= ed; st1[r] *= ed; }
#pragma unroll
                        for (int k4 = 0; k4 < 4; ++k4) {
                            const bf16x8 vr = LFR(24 + k4); const f32x4 b0 = *(const LAS f32x4*)(cf + 128 + 16 * k4 + 8 * hi), b1 = *(const LAS f32x4*)(cf + 128 + 16 * k4 + 8 * hi + 4);
                            v4u wv; wv.x = cvtpk(bf2f((unsigned short)vr[0]) * __expf(gam - b0[0]), bf2f((unsigned short)vr[1]) * __expf(gam - b0[1])); wv.y = cvtpk(bf2f((unsigned short)vr[2]) * __expf(gam - b0[2]), bf2f((unsigned short)vr[3]) * __expf(gam - b0[3]));
                            wv.z = cvtpk(bf2f((unsigned short)vr[4]) * __expf(gam - b1[0]), bf2f((unsigned short)vr[5]) * __expf(gam - b1[1])); wv.w = cvtpk(bf2f((unsigned short)vr[6]) * __expf(gam - b1[2]), bf2f((unsigned short)vr[7]) * __expf(gam - b1[3]));
                            const bf16x8 wvf = __builtin_bit_cast(bf16x8, wv);
                            st0 = MFMA32(LFR(16 + k4), wvf, st0); st1 = MFMA32(LFR(20 + k4), wvf, st1);
                        }
                        { LAS unsigned char* sf = lds + MX_STF + ((c + 1) & 1) * 4096 + 16 * lane;
                          *(LAS bf16x8*)(sf) = pack8<0>(st0); *(LAS bf16x8*)(sf + 1024) = pack8<1>(st0); *(LAS bf16x8*)(sf + 2048) = pack8<0>(st1); *(LAS bf16x8*)(sf + 3072) = pack8<1>(st1); }
                        if (ml) mst = mnew;
                    }
#undef LFR
                }
                asm volatile("s_waitcnt lgkmcnt(0)" ::: "memory");
                bi = (bi == 2) ? 0 : bi + 1;
            }
#undef LIN_ISSUE
        }
        VMWAIT(0); WGBAR();
    }
}
__device__ __forceinline__ f32x4 unpack4bf(unsigned long long q) { return (f32x4){__uint_as_float((unsigned)q << 16), __uint_as_float((unsigned)q & 0xffff0000u), __uint_as_float((unsigned)(q >> 32) << 16), __uint_as_float((unsigned)(q >> 32) & 0xffff0000u)}; }
__device__ __forceinline__ void post_new(const MixBufs& B, bf16* ybf, const float* mng, const float* rng, const float* sng, const float* sD, int gw, int NGW, int lane) {
    constexpr int R = 4;
    const int c4 = 4 * lane, hd = lane >> 4;
    const f32x4 gnm = *(const f32x4*)(mng + c4), gnr = *(const f32x4*)(rng + c4), gns = *(const f32x4*)(sng + c4); const float Dh = sD[hd];
    for (int k0 = 0; k0 < M / NGW; k0 += R) {
        unsigned long long yq[R][3], gq[R][3]; f32x4 xx[R]; float dn[R], mt[R];
#pragma unroll
        for (int j = 0; j < R; ++j) { const int m = (NGW == 2048) ? ((gw >> 8) * SEQ + (gw & 255) + 256 * (k0 + j)) : (gw + (k0 + j) * NGW); const size_t r = (size_t)m;
#pragma unroll
            for (int mx = 0; mx < 3; ++mx) yq[j][mx] = *(const unsigned long long*)((const bf16*)B.yraw + r * 1024 + 256 * (mx + 1) + c4);
            gq[j][0] = *(const unsigned long long*)(B.proj + r * PROJ_LD + PC_MO + c4); gq[j][1] = *(const unsigned long long*)(B.proj + r * PROJ_LD + PC_RG + c4); gq[j][2] = *(const unsigned long long*)(B.proj + r * PROJ_LD + PC_SZ + c4);
            xx[j] = unpack4bf(*(const unsigned long long*)((const bf16*)B.xs + r * 256 + c4)); dn[j] = B.den[r * 8 + hd * 2]; mt[j] = B.den[r * 8 + hd * 2 + 1]; }
#pragma unroll
        for (int j = 0; j < R; ++j) { const int m = (NGW == 2048) ? ((gw >> 8) * SEQ + (gw & 255) + 256 * (k0 + j)) : (gw + (k0 + j) * NGW); const size_t r = (size_t)m;
            GAS unsigned long long* o8 = (GAS unsigned long long*)(ybf + r * DM) + lane;
#pragma unroll
            for (int mx = 0; mx < 2; ++mx) {
                f32x4 v = unpack4bf(yq[j][mx]);
                if (mx == 0) v = v * (1.0f / fmaxf(fabsf(dn[j]), __expf(-mt[j])));
                float ss = (v.x * v.x + v.y * v.y) + (v.z * v.z + v.w * v.w);
                ss += __shfl_xor(ss, 1); ss += __shfl_xor(ss, 2); ss += __shfl_xor(ss, 4); ss += __shfl_xor(ss, 8);
                const float rstd = 1.0f / sqrtf(ss * (1.0f / 64.0f) + RMS_EPS);
                const f32x4 gr = unpack4bf(gq[j][mx]); f32x4 gt;
#pragma unroll
                for (int i = 0; i < 4; ++i) gt[i] = mx == 0 ? sigmoid_f(gr[i]) : silu_acc(gr[i]);
                const f32x4 o = gt * (v * rstd * (mx == 0 ? gnm : gnr));
                o8[64 * (mx + 1)] = (unsigned long long)pk2(o.x, o.y) | ((unsigned long long)pk2(o.z, o.w) << 32);
            }
            { const f32x4 hs = unpack4bf(yq[j][2]), zr = unpack4bf(gq[j][2]); f32x4 v;
#pragma unroll
              for (int i = 0; i < 4; ++i) v[i] = (hs[i] + Dh * xx[j][i]) * silu_acc(zr[i]);
              const float ss = wave_sum((v.x * v.x + v.y * v.y) + (v.z * v.z + v.w * v.w));
              const float rstd = 1.0f / sqrtf(ss * (1.0f / 256.0f) + RMS_EPS);
              const f32x4 o = v * rstd * gns;
              o8[192] = (unsigned long long)pk2(o.x, o.y) | ((unsigned long long)pk2(o.z, o.w) << 32); }
        }
    }
}
__device__ __forceinline__ void final_norm(const bf16* xb, const long long* ss, float* out, const float* g, int gw, int NGW, int lane) {
    constexpr int R = 4;
    f32x4 gv[4];
#pragma unroll
    for (int j = 0; j < 4; ++j) gv[j] = ((const f32x4*)g)[lane + 64 * j];
    for (int k0 = 0; k0 < M / NGW; k0 += R) {
        unsigned long long v[R][4]; long long q[R];
#pragma unroll
        for (int r = 0; r < R; ++r) { const int m = (NGW == 2048) ? ((gw >> 8) * SEQ + (gw & 255) + 256 * (k0 + r)) : (gw + (k0 + r) * NGW);
            const GAS unsigned long long* xr = (const GAS unsigned long long*)(xb + (size_t)m * DM) + lane; q[r] = ss[m];
#pragma unroll
            for (int j = 0; j < 4; ++j) v[r][j] = xr[64 * j]; }
#pragma unroll
        for (int r = 0; r < R; ++r) { const int m = (NGW == 2048) ? ((gw >> 8) * SEQ + (gw & 255) + 256 * (k0 + r)) : (gw + (k0 + r) * NGW);
            GAS f32x4* orow = (GAS f32x4*)(out + (size_t)m * DM) + lane; const float rstd = pg8::rstd_q(q[r]);
#pragma unroll
            for (int j = 0; j < 4; ++j) orow[64 * j] = unpack4bf(v[r][j]) * rstd * gv[j]; }
    }
}

__global__ void __launch_bounds__(NTHR, 2) fwd(Args a) {
    extern __shared__ __attribute__((aligned(16))) unsigned char lds_raw[];
    LAS unsigned char* lds = (LAS unsigned char*)lds_raw;
    const int tid = threadIdx.x, lane = tid & 63, wave = __builtin_amdgcn_readfirstlane(tid >> 6), G = gridDim.x;
    const int gw = blockIdx.x * NWAVES + wave, NGW = G * NWAVES;
    unsigned char* ws = a.ws;
    for (int u = tid; u < (LDS_BYTES - LDSCTL_OFF) / 4; u += NTHR) ((LAS unsigned*)(lds + LDSCTL_OFF))[u] = 0u;
    __syncthreads();
    const int lo = a.ph_lo, hi = a.ph_hi;
    XcdBarrier bar; bar.bar = (unsigned*)(ws + WS_CTL) + CW_BAR; bar.x = 0; bar.st = nullptr;
    if (hi - lo > 1) bar = xcd_barrier_post((unsigned*)(ws + WS_CTL) + CW_BAR, (volatile LAS unsigned*)(lds + MISC_OFF) + 8);
    volatile LAS unsigned* MISCW = (volatile LAS unsigned*)(lds + MISC_OFF);
    if (hi - lo > 1 && tid == 0) MISCW[16] = xb_add(&bar.bar[XB_RANK(bar.x)], 1u);
    int bid = (int)blockIdx.x; bool loc = false;
#define IN(k) (lo <= (k) && (k) < hi)
#define PH_IDS int t_ = threadIdx.x; asm volatile("" : "+v"(t_)); const int lane_ = t_ & 63, wave_ = __builtin_amdgcn_readfirstlane(t_ >> 6), gw_ = blockIdx.x * NWAVES + wave_; (void)lane_; (void)gw_; (void)wave_;
#define SEAM(k) do { if ((k) + 1 < hi) { if (loc) xcd_local_barrier(bar.bar, bar.x, 32u); else xcd_barrier(bar); } } while (0)
    float* xres = a.out;
    float* cond = (float*)(ws + WS_COND); const float2* rope = (const float2*)(ws + WS_ROPE);
    bf16* HB = (bf16*)(ws + WS_HB); bf16* ACT = (bf16*)(ws + WS_ACT); bf16* PROJ = (bf16*)(ws + WS_PROJ); float* GATES = (float*)(ws + WS_GATES);
    bf16* YBF = (bf16*)(ws + WS_YBF);
#define MK_MB unsigned char* ws_ = a.ws; asm volatile("" : "+s"(ws_)); MixBufs MB; MB.proj = (const bf16*)(ws_ + WS_PROJ); MB.gates = (const float*)(ws_ + WS_GATES); MB.vtf = (bf16*)(ws_ + WS_VTF); MB.lcum = (float*)(ws_ + WS_COEF + COEF_LCUM); MB.ctot = (float*)(ws_ + WS_COEF + COEF_CTOT); \
    MB.ql = (bf16*)(ws_ + WS_QL); MB.kl = (bf16*)(ws_ + WS_KL); MB.kt = (bf16*)(ws_ + WS_KT); MB.vtl = (bf16*)(ws_ + WS_VTL); MB.xs = (float*)(ws_ + WS_XS); \
    MB.a1 = (float*)(ws_ + WS_COEF + COEF_A1); MB.a2 = (float*)(ws_ + WS_COEF + COEF_A2); MB.beta = (float*)(ws_ + WS_COEF + COEF_BETA); MB.s1 = (float*)(ws_ + WS_COEF + COEF_S1); MB.s2 = (float*)(ws_ + WS_COEF + COEF_S2); \
    MB.den = (float*)(ws_ + WS_DEN); MB.yraw = (float*)(ws_ + WS_YRAW); bf16* YBF_ = (bf16*)(ws_ + WS_YBF); (void)YBF_;
    long long* SS = (long long*)(ws + WS_SS);
    if (IN(0)) { PH_IDS prologue0(a, lds, t_, lane_, wave_, G); SEAM(0); }
    if (IN(1)) { PH_IDS prologue1(a, lds, lane_, wave_, G); thin_xg(a.in[0], HB, (bf16*)(ws + WS_XB), a.in[4], cond, 1 * DM, SS, gw_, NGW, lane_); SEAM(1);
        { const long long* q = (const long long*)(ws + WS_BIASQ); float* bf = (float*)(ws + WS_BIAS);
          for (int i = blockIdx.x * NTHR + t_; i < (int)(BIAS_BYTES / 4); i += G * NTHR) bf[i] = (float)((double)q[i] * (1.0 / 4294967296.0)); }
        SEAM(1); }
    if (lo == 0 && hi == PH_END && G == 256) {
        if (tid == 0) { bool ok = true;
#pragma unroll
            for (unsigned j = 0; j < 16; ++j) { const unsigned cnt = xb_ld(&bar.bar[XB_RANK(j)]); ok = ok && (cnt == (j < 8 ? 32u : 0u)); }
            MISCW[17] = ok ? 1u : 0u; }
        __syncthreads();
        if (MISCW[17]) { loc = true; bid = __builtin_amdgcn_readfirstlane((int)(MISCW[16] * 8u + bar.x)); }
    }
    const int vcu = (G % 8 == 0) ? (bid % 8) * (G / 8) + bid / 8 : bid;
    for (int l = 0; l < DEPTH; ++l) {
        const int pb = PH_LAYER0 + PH_PER_LAYER * l;
        if (hi <= pb || lo >= pb + PH_PER_LAYER) continue;
        const float* cond_l = cond + (size_t)l * BATCH * NCOND;
        unsigned char* wl = ws + WS_W + (size_t)l * LAYER_W;
        const float* xin = (l == 0) ? a.in[0] : xres;
        const float* bias_l = (const float*)(ws + WS_BIAS + (size_t)l * 3 * BIAS_USE);
        long long* ss0 = SS + (size_t)(3 * l) * M;
        const float* ng = a.in[4] + (size_t)(l * 3) * DM;
        if (IN(pb + 0)) { pg8::Gemm g{HB, (const bf16*)(wl + OFF_UP1), M, NUP, DM}; pg8::StaticOrder S; S.init(M, NUP, G, bid); pg8::EpiSwigluN E{ACT, PROJ_LD, ss0, bias_l, NUP};
            pg8::gemm_phase<pg8::EpiSwigluN, pg8::StaticOrder, true, true>(lds, g, S, E); if (REP_UP > 1) { __syncthreads(); pg8::gemm_phase<pg8::EpiSwigluN, pg8::StaticOrder, true, true>(lds, g, S, E); } SEAM(pb + 0); }
        if (IN(pb + 1)) { pg8::Gemm g{ACT, (const bf16*)(wl + OFF_DN1), M, DM, DFF, PROJ_LD}; pg8::StaticOrder S; S.init(M, DM, G, bid);
            pg8::EpiResidNorm E{cond_l, ng + DM, ws, 2 * DM, 4 * DM, (int)(WS_HB / MiB), (int)(WS_XB / MiB), (int)(WS_SS / 8) + (3 * l + 1) * M, 0.5f};
            pg8::gemm_phase<pg8::EpiResidNorm, pg8::StaticOrder, true, true>(lds, g, S, E); SEAM(pb + 1); }
        if (IN(pb + 2)) { pg8::Gemm g{HB, (const bf16*)(wl + OFF_IN), M, NPROJ, DM}; pg8::StaticOrder S; S.init(M, NPROJ, G, bid); pg8::EpiProjN E{PROJ, PROJ_LD, GATES, PROJ_LD / 256, 0.125f * LOG2E, ss0 + M, bias_l + 8 * NUP, NPROJ};
            pg8::gemm_phase<pg8::EpiProjN, pg8::StaticOrder, true, true>(lds, g, S, E); SEAM(pb + 2); }
        if (IN(pb + 3)) { PH_IDS MK_MB PrepW PW{a.in[12] + (size_t)l * 4 * 512, a.in[13] + (size_t)l * 512, a.in[18] + (size_t)l * 4 * 512, a.in[19] + (size_t)l * 512, a.in[11] + l * 4, a.in[14] + l * 4, a.in[15] + l * 4, a.in[20] + l * 4, a.in[21] + l * 4, (const float2*)(ws_ + WS_ROPE)};
            for (int rep = 0; rep < REP_PREP; ++rep) for (int u = vcu; u < BATCH * 32; u += G) prep_unit(MB, PW, u, wave_, lane_); SEAM(pb + 3); }
        if (IN(pb + 4)) { PH_IDS MK_MB mixer_phase(MB, YBF_, lds, vcu, wave_, lane_); if (REP_MIX > 1) { asm volatile("" ::: "memory"); mixer_phase(MB, YBF_, lds, vcu, wave_, lane_); } SEAM(pb + 4); }
        if (IN(pb + 5)) { PH_IDS MK_MB for (int rep = 0; rep < REP_POST; ++rep) post_new(MB, YBF_, a.in[16] + (size_t)l * 256, a.in[17] + (size_t)l * 256, a.in[23] + (size_t)l * 256, a.in[22] + l * 4, vcu * NWAVES + wave_, NGW, lane_); SEAM(pb + 5); }
        if (IN(pb + 6)) { pg8::Gemm g{YBF, (const bf16*)(wl + OFF_OUT), M, DM, DM}; pg8::StaticOrder S; S.init(M, DM, G, bid);
            pg8::EpiResidNorm E{cond_l, ng + 2 * DM, ws, 5 * DM, 7 * DM, (int)(WS_HB / MiB), (int)(WS_XB / MiB), (int)(WS_SS / 8) + (3 * l + 2) * M, 1.0f};
            pg8::gemm_phase<pg8::EpiResidNorm, pg8::StaticOrder, true, true>(lds, g, S, E); SEAM(pb + 6); }
        if (IN(pb + 7)) { pg8::Gemm g{HB, (const bf16*)(wl + OFF_UP2), M, NUP, DM}; pg8::StaticOrder S; S.init(M, NUP, G, bid); pg8::EpiSwigluN E{ACT, PROJ_LD, ss0 + 2 * M, bias_l + 2 * 8 * NUP, NUP};
            pg8::gemm_phase<pg8::EpiSwigluN, pg8::StaticOrder, true, true>(lds, g, S, E); SEAM(pb + 7); }
        if (IN(pb + 8)) { pg8::Gemm g{ACT, (const bf16*)(wl + OFF_DN2), M, DM, DFF, PROJ_LD}; pg8::StaticOrder S; S.init(M, DM, G, bid);
            if (l + 1 < DEPTH) { pg8::EpiResidNorm E{cond_l, ng + 3 * DM, ws, 8 * DM, BATCH * NCOND + 1 * DM, (int)(WS_HB / MiB), (int)(WS_XB / MiB), (int)(WS_SS / 8) + (3 * l + 3) * M, 0.5f};
                pg8::gemm_phase<pg8::EpiResidNorm, pg8::StaticOrder, true, true>(lds, g, S, E); }
            else { pg8::EpiResidLast E{cond_l, ng, ws, 8 * DM, 0, 0, (int)(WS_XB / MiB), (int)(WS_SS / 8) + (3 * l + 3) * M, 0.5f}; pg8::gemm_phase<pg8::EpiResidLast, pg8::StaticOrder, true, true>(lds, g, S, E); }
            SEAM(pb + 8); }
    }
    if (IN(PH_FINAL)) { PH_IDS final_norm((const bf16*)(ws + WS_XB), SS + (size_t)(3 * DEPTH) * M, xres, a.in[24], vcu * NWAVES + wave_, NGW, lane_); }
#undef IN
#undef SEAM
}

#ifndef N_SPLIT
#define N_SPLIT 0
#endif
extern "C" void kernel_launch(void* const* d_in, const int* in_sizes, int n_in, void* d_out, int out_size, void* d_ws, size_t ws_size, hipStream_t stream) {
    static int grid = 0;
    if (grid == 0) {
        if (n_in != 25 || in_sizes[0] != M * DM || out_size != M * DM || ws_size < WS_END) { fprintf(stderr, "kernel_launch: unexpected problem (n_in %d, in0 %d, out %d, ws %zu)\n", n_in, n_in > 0 ? in_sizes[0] : -1, out_size, ws_size); grid = -1; return; }
        int dev = 0, cus = 0, per_cu = 0;
        if (hipGetDevice(&dev) != hipSuccess || hipDeviceGetAttribute(&cus, hipDeviceAttributeMultiprocessorCount, dev) != hipSuccess) { grid = -1; return; }
        if (hipFuncSetAttribute((const void*)fwd, hipFuncAttributeMaxDynamicSharedMemorySize, LDS_BYTES) != hipSuccess) { fprintf(stderr, "kernel_launch: hipFuncSetAttribute failed\n"); grid = -1; return; }
        if (hipOccupancyMaxActiveBlocksPerMultiprocessor(&per_cu, (const void*)fwd, NTHR, LDS_BYTES) != hipSuccess || per_cu < 1) fprintf(stderr, "kernel_launch: occupancy query says %d\n", per_cu);
        (void)hipGetLastError();
        grid = cus;
    }
    if (grid < 0) return;
    if (hipMemsetAsync((char*)d_ws + WS_CTL, 0, CTL_ZERO_BYTES, stream) != hipSuccess) return;
    Args a{};
    for (int i = 0; i < 25; ++i) a.in[i] = (const float*)d_in[i];
    a.out = (float*)d_out; a.ws = (unsigned char*)d_ws;
#if N_SPLIT
    for (int p = 0; p < PH_END; ++p) { a.ph_lo = p; a.ph_hi = p + 1; hipLaunchKernelGGL(fwd, dim3(grid), dim3(NTHR), LDS_BYTES, stream, a); }
#else
    a.ph_lo = 0; a.ph_hi = PH_END; hipLaunchKernelGGL(fwd, dim3(grid), dim3(NTHR), LDS_BYTES, stream, a);
#endif
}
```

```cpp
#include <hip/hip_runtime.h>
#include <cstdio>
#include <cstdint>
#ifndef REP_FOX
#define REP_FOX 1
#endif
#ifndef REP_LIN
#define REP_LIN 1
#endif
#ifndef REP_MIX
#define REP_MIX 1
#endif
#ifndef REP_PREP
#define REP_PREP 1
#endif
#ifndef REP_POST
#define REP_POST 1
#endif
#ifndef REP_THIN
#define REP_THIN 1
#endif
#ifndef REP_UP
#define REP_UP 1
#endif
#ifndef REP_IN
#define REP_IN 1
#endif
namespace pg8 {
#define PG8_LAS __attribute__((address_space(3)))
typedef unsigned short bf16_t;
typedef short bf16x8 __attribute__((ext_vector_type(8)));
typedef float f32x4 __attribute__((ext_vector_type(4)));
typedef unsigned u32x4 __attribute__((ext_vector_type(4)));
constexpr int BM = 256, BK = 64, HALF = 128, HTB = HALF * BK * 2  , STAGE_BYTES = 8 * HTB, NXCD = 8, WGM = 4;

__host__ __device__ __forceinline__ int lds_byte(int r, int c) { const int st = (r >> 4) * 2 + (c >> 5), rr = r & 15, cc = c & 31, ob = rr * 64 + cc * 2; return st * 1024 + (ob ^ (((ob >> 9) & 1) << 5)); }
__host__ __device__ __forceinline__ void stage_rc(int b, int& R, int& C) { const int st = b / 1024, sb = b % 1024, swz = sb ^ (((sb >> 9) & 1) << 5); R = (st >> 1) * 16 + swz / 64; C = (st & 1) * 32 + (swz % 64) / 2; }
__host__ __device__ __forceinline__ int perm32(int rho) { const int n = rho >> 4, i = rho & 15; return 8 * (i >> 2) + 4 * n + (i & 3); }

struct Unit { int pm, pn; };
struct Gemm { const bf16_t* A; const bf16_t* Bt; int M, N, K; int lda; };

struct StaticOrder {
    int nM, nN, nwg, G, c;
    __host__ __device__ void init(int M, int N, int G_, int c_) { nM = M / BM; nN = N / BM; nwg = nM * nN; G = G_; c = c_; }
    __host__ __device__ bool next(int i, Unit& u) const {
        const long L = (long)i * G + c; if (L >= nwg) return false;
        int wgid = (int)L; { const int q = nwg / NXCD, r = nwg % NXCD, xcd = wgid % NXCD, off = wgid / NXCD; wgid = (xcd < r ? xcd * (q + 1) : r * (q + 1) + (xcd - r) * q) + off; }
        const int nig = WGM * nN, gid = wgid / nig, fm = gid * WGM, gsz = (nM - fm) < WGM ? (nM - fm) : WGM;
        u.pm = fm + ((wgid % nig) % gsz); u.pn = (wgid % nig) / gsz; return true;
    }
    __device__ __forceinline__ void a_ready(const Unit&) const {}
    __device__ __forceinline__ void done(const Unit&) const {}
};

__device__ __forceinline__ unsigned cvt_pk_bf16(float lo, float hi) { unsigned r; asm volatile("v_cvt_pk_bf16_f32 %0, %1, %2" : "=v"(r) : "v"(lo), "v"(hi)); return r; }

__device__ __forceinline__ float silu_f(float v) { return v * __builtin_amdgcn_rcpf(1.0f + __expf(-v)); }
__device__ __forceinline__ f32x4 swiglu4(const f32x4 a, const f32x4 g) {
    const f32x4 t = g * (-1.44269504088896341f); f32x4 e;
#pragma unroll
    for (int i = 0; i < 4; ++i) e[i] = __builtin_amdgcn_exp2f(t[i]);
    const f32x4 d = e + 1.0f; f32x4 r;
#pragma unroll
    for (int i = 0; i < 4; ++i) r[i] = __builtin_amdgcn_rcpf(d[i]);
    return (a * g) * r;
}
struct EpiSwiglu {
    static constexpr bool PERM = true, AFTER_DRAIN = false;
    bf16_t* O; int ldo;
    __device__ __forceinline__ void operator()(const f32x4 (&acc)[2][2][4][2], const Unit& u, int wr, int wc, int fr, int fq) const {
        const int row0 = u.pm * BM + wr * 64 + fr, col0 = u.pn * HALF + wc * 32 + 8 * fq;
#pragma unroll
        for (int ai = 0; ai < 2; ++ai)
#pragma unroll
            for (int m = 0; m < 4; ++m) { bf16_t* rowp = O + (size_t)(row0 + ai * HALF + m * 16) * ldo + col0;
                const f32x4 a0 = acc[ai][0][m][0], a1 = acc[ai][0][m][1], g0 = acc[ai][1][m][0], g1 = acc[ai][1][m][1];
                u32x4 w; w.x = cvt_pk_bf16(silu_f(g0[0]) * a0[0], silu_f(g0[1]) * a0[1]); w.y = cvt_pk_bf16(silu_f(g0[2]) * a0[2], silu_f(g0[3]) * a0[3]);
                w.z = cvt_pk_bf16(silu_f(g1[0]) * a1[0], silu_f(g1[1]) * a1[1]); w.w = cvt_pk_bf16(silu_f(g1[2]) * a1[2], silu_f(g1[3]) * a1[3]);
                *(u32x4*)rowp = w; }
    }
};
struct EpiResid {
    static constexpr bool PERM = false, AFTER_DRAIN = false;
    const bf16_t* base; float* out; int ldc; const float* gate; int gstride; int rows_per_b; float coef;
    __device__ __forceinline__ void operator()(const f32x4 (&acc)[2][2][4][2], const Unit& u, int wr, int wc, int fr, int fq) const {
        const int col0 = u.pn * BM + wc * 32 + 4 * fq; const int b = (u.pm * BM) / rows_per_b;
        f32x4 gv[2][2];
#pragma unroll
        for (int bj = 0; bj < 2; ++bj)
#pragma unroll
            for (int n = 0; n < 2; ++n) gv[bj][n] = *(const f32x4*)(gate + (size_t)b * gstride + col0 + bj * HALF + n * 16) * coef;
#pragma unroll
        for (int ai = 0; ai < 2; ++ai)
#pragma unroll
            for (int m = 0; m < 4; ++m) { const size_t off = (size_t)(u.pm * BM + ai * HALF + wr * 64 + m * 16 + fr) * ldc + col0;
#pragma unroll
                for (int bj = 0; bj < 2; ++bj)
#pragma unroll
                    for (int n = 0; n < 2; ++n) { typedef unsigned u32x2r __attribute__((ext_vector_type(2))); const u32x2r rb = *(const u32x2r*)(base + off + bj * HALF + n * 16);
                        const f32x4 bs = (f32x4){__builtin_bit_cast(float, rb.x << 16), __builtin_bit_cast(float, rb.x & 0xffff0000u), __builtin_bit_cast(float, rb.y << 16), __builtin_bit_cast(float, rb.y & 0xffff0000u)};
                        *(f32x4*)(out + off + bj * HALF + n * 16) = bs + gv[bj][n] * acc[ai][bj][m][n]; }
                if (m & 1) asm volatile("" ::: "memory"); }
    }
};
struct EpiProj {
    static constexpr bool PERM = true, AFTER_DRAIN = false;
    bf16_t* P; int ldp; float* G; int ntile_bf; float scale0;
    __device__ __forceinline__ void operator()(const f32x4 (&acc)[2][2][4][2], const Unit& u, int wr, int wc, int fr, int fq) const {
        const int row0 = u.pm * BM + wr * 64 + fr;
        if (u.pn < ntile_bf) {
            const int col0 = u.pn * BM + wc * 32 + 8 * fq; const float sc = (u.pn == 0) ? scale0 : 1.0f;
#pragma unroll
            for (int ai = 0; ai < 2; ++ai)
#pragma unroll
                for (int m = 0; m < 4; ++m) { bf16_t* rowp = P + (size_t)(row0 + ai * HALF + m * 16) * ldp + col0;
#pragma unroll
                    for (int bj = 0; bj < 2; ++bj) { const f32x4 v0 = acc[ai][bj][m][0] * sc, v1 = acc[ai][bj][m][1] * sc;
                        u32x4 w; w.x = cvt_pk_bf16(v0[0], v0[1]); w.y = cvt_pk_bf16(v0[2], v0[3]); w.z = cvt_pk_bf16(v1[0], v1[1]); w.w = cvt_pk_bf16(v1[2], v1[3]);
                        *(u32x4*)(rowp + bj * HALF) = w; } }
        } else if (wc == 0 && fq < 2) {
#pragma unroll
            for (int ai = 0; ai < 2; ++ai)
#pragma unroll
                for (int m = 0; m < 4; ++m) { float* gp = G + (size_t)(row0 + ai * HALF + m * 16) * 16 + 8 * fq;
                    *(f32x4*)gp = acc[ai][0][m][0]; *(f32x4*)(gp + 4) = acc[ai][0][m][1]; }
        }
    }
};

__device__ __forceinline__ float rstd_q(long long q) { const unsigned long long u = (unsigned long long)q; const float f = (float)(unsigned)(u >> 32) * 4294967296.0f + (float)(unsigned)u;
    return __builtin_amdgcn_rsqf(f * (1.0f / (16777216.0f * 1024.0f)) + 1e-6f); }
struct EpiSwigluN {
    static constexpr bool PERM = true, AFTER_DRAIN = false;
    bf16_t* O; int ldo; const long long* ss; const float* bias; int nb;
    __device__ __forceinline__ void operator()(const f32x4 (&acc)[2][2][4][2], const Unit& u, int wr, int wc, int fr, int fq) const {
        const int row0 = u.pm * BM + wr * 64 + fr, col0 = u.pn * HALF + wc * 32 + 8 * fq; const int b = u.pm >> 3;
        const float* bp = bias + (size_t)b * nb + u.pn * BM + wc * 32 + 8 * fq;
        const f32x4 ba0 = *(const f32x4*)bp, ba1 = *(const f32x4*)(bp + 4), bg0 = *(const f32x4*)(bp + HALF), bg1 = *(const f32x4*)(bp + HALF + 4);
        long long ssv[2][4];
#pragma unroll
        for (int ai = 0; ai < 2; ++ai)
#pragma unroll
            for (int m = 0; m < 4; ++m) ssv[ai][m] = ss[row0 + ai * HALF + m * 16];
#pragma unroll
        for (int ai = 0; ai < 2; ++ai)
#pragma unroll
            for (int m = 0; m < 4; ++m) { const int row = row0 + ai * HALF + m * 16; bf16_t* rowp = O + (size_t)row * ldo + col0;
                const float rs = rstd_q(ssv[ai][m]);
                const f32x4 a0 = acc[ai][0][m][0] * rs + ba0, a1 = acc[ai][0][m][1] * rs + ba1, g0 = acc[ai][1][m][0] * rs + bg0, g1 = acc[ai][1][m][1] * rs + bg1;
                const f32x4 o0 = swiglu4(a0, g0), o1 = swiglu4(a1, g1);
                u32x4 w; w.x = cvt_pk_bf16(o0[0], o0[1]); w.y = cvt_pk_bf16(o0[2], o0[3]); w.z = cvt_pk_bf16(o1[0], o1[1]); w.w = cvt_pk_bf16(o1[2], o1[3]);
                *(u32x4*)rowp = w; }
    }
};
struct EpiProjN {
    static constexpr bool PERM = true, AFTER_DRAIN = false;
    bf16_t* P; int ldp; float* G; int ntile_bf; float scale0; const long long* ss; const float* bias; int nb;
    __device__ __forceinline__ void operator()(const f32x4 (&acc)[2][2][4][2], const Unit& u, int wr, int wc, int fr, int fq) const {
        const int row0 = u.pm * BM + wr * 64 + fr; const int b = u.pm >> 3;
        const float* bp = bias + (size_t)b * nb + u.pn * BM + wc * 32 + 8 * fq;
        if (u.pn < ntile_bf) {
            const int col0 = u.pn * BM + wc * 32 + 8 * fq; const float sc = (u.pn == 0) ? scale0 : 1.0f;
            const f32x4 b00 = *(const f32x4*)bp, b01 = *(const f32x4*)(bp + 4), b10 = *(const f32x4*)(bp + HALF), b11 = *(const f32x4*)(bp + HALF + 4);
            long long ssv[2][4];
#pragma unroll
            for (int ai = 0; ai < 2; ++ai)
#pragma unroll
                for (int m = 0; m < 4; ++m) ssv[ai][m] = ss[row0 + ai * HALF + m * 16];
#pragma unroll
            for (int ai = 0; ai < 2; ++ai)
#pragma unroll
                for (int m = 0; m < 4; ++m) { const int row = row0 + ai * HALF + m * 16; bf16_t* rowp = P + (size_t)row * ldp + col0;
                    const float rs = rstd_q(ssv[ai][m]);
#pragma unroll
                    for (int bj = 0; bj < 2; ++bj) { const f32x4 v0 = (acc[ai][bj][m][0] * rs + (bj ? b10 : b00)) * sc, v1 = (acc[ai][bj][m][1] * rs + (bj ? b11 : b01)) * sc;
                        u32x4 w; w.x = cvt_pk_bf16(v0[0], v0[1]); w.y = cvt_pk_bf16(v0[2], v0[3]); w.z = cvt_pk_bf16(v1[0], v1[1]); w.w = cvt_pk_bf16(v1[2], v1[3]);
                        *(u32x4*)(rowp + bj * HALF) = w; } }
        } else if (wc == 0 && fq < 2) {
            const f32x4 b00 = *(const f32x4*)bp, b01 = *(const f32x4*)(bp + 4);
#pragma unroll
            for (int ai = 0; ai < 2; ++ai)
#pragma unroll
                for (int m = 0; m < 4; ++m) { const int row = row0 + ai * HALF + m * 16; float* gp = G + (size_t)row * 16 + 8 * fq;
                    const float rs = rstd_q(ss[row]);
                    *(f32x4*)gp = acc[ai][0][m][0] * rs + b00; *(f32x4*)(gp + 4) = acc[ai][0][m][1] * rs + b01; }
        }
    }
};
struct EpiResidNorm {
    static constexpr bool PERM = false, AFTER_DRAIN = false;
    const float* cnd; const float* ng; unsigned char* wsb; int goff, scoff, hb_off, xb_off, ss_off; float coef;
    __device__ __forceinline__ void operator()(const f32x4 (&acc)[2][2][4][2], const Unit& u, int wr, int wc, int fr, int fq) const {
        typedef unsigned u32x2v __attribute__((ext_vector_type(2)));
        constexpr int ldc = 1024, gstride = 9 * 1024;
        const int col0 = u.pn * BM + wc * 32 + 4 * fq; const int b = u.pm >> 3;
        const float* gate = cnd + goff; const float* scn = cnd + scoff;
        __attribute__((address_space(1))) bf16_t* xg = (__attribute__((address_space(1))) bf16_t*)(wsb + (size_t)hb_off * 1048576);
        unsigned long long* ssn = (unsigned long long*)(wsb + (size_t)ss_off * 8);
        __attribute__((address_space(1))) bf16_t* xb = (__attribute__((address_space(1))) bf16_t*)(wsb + (size_t)xb_off * 1048576);
        float sq[2][4];
#pragma unroll
        for (int ai = 0; ai < 2; ++ai)
#pragma unroll
            for (int m = 0; m < 4; ++m) sq[ai][m] = 0.f;
#pragma unroll
        for (int bj = 0; bj < 2; ++bj)
#pragma unroll
            for (int n = 0; n < 2; ++n) { const int c = col0 + bj * HALF + n * 16;
                const f32x4 gv = *(const f32x4*)(gate + (size_t)b * gstride + c) * coef, gm = *(const f32x4*)(ng + c) * (*(const f32x4*)(scn + (size_t)b * gstride + c) + 1.0f);
                u32x2v rbv[2][4];
                const unsigned off0 = (unsigned)(u.pm * BM + wr * 64 + fr) * (unsigned)ldc + (unsigned)c;
#pragma unroll
                for (int ai = 0; ai < 2; ++ai)
#pragma unroll
                    for (int m = 0; m < 4; ++m) rbv[ai][m] = *(const __attribute__((address_space(1))) u32x2v*)(xb + (off0 + (unsigned)((ai * HALF + m * 16) * ldc)));
#pragma unroll
                for (int ai = 0; ai < 2; ++ai)
#pragma unroll
                    for (int m = 0; m < 4; ++m) { const unsigned off = off0 + (unsigned)((ai * HALF + m * 16) * ldc); const u32x2v rb = rbv[ai][m];
                        const f32x4 xn = (f32x4){__builtin_bit_cast(float, rb.x << 16), __builtin_bit_cast(float, rb.x & 0xffff0000u), __builtin_bit_cast(float, rb.y << 16), __builtin_bit_cast(float, rb.y & 0xffff0000u)} + gv * acc[ai][bj][m][n];
                        { u32x2v wx; wx.x = cvt_pk_bf16(xn[0], xn[1]); wx.y = cvt_pk_bf16(xn[2], xn[3]); *(__attribute__((address_space(1))) u32x2v*)(xb + off) = wx; }
                        sq[ai][m] += (xn[0] * xn[0] + xn[1] * xn[1]) + (xn[2] * xn[2] + xn[3] * xn[3]); const f32x4 h = xn * gm;
                        u32x2v w; w.x = cvt_pk_bf16(h[0], h[1]); w.y = cvt_pk_bf16(h[2], h[3]); *(__attribute__((address_space(1))) u32x2v*)(xg + off) = w; }
                asm volatile("" ::: "memory"); }
#pragma unroll
        for (int ai = 0; ai < 2; ++ai)
#pragma unroll
            for (int m = 0; m < 4; ++m) { float v = sq[ai][m]; v += __shfl_xor(v, 16); v += __shfl_xor(v, 32);
                if (fq == 0) atomicAdd(ssn + (u.pm * BM + ai * HALF + wr * 64 + m * 16 + fr), (unsigned long long)__float2ll_rn(v * 16777216.0f)); }
    }
};

template <class Epi, class Sched, bool ALIGN_EPI = false, bool SP2 = false>
__device__ __forceinline__ void gemm_phase(PG8_LAS unsigned char* lds, const Gemm g, const Sched& S, const Epi& E) {
    int tid_ = threadIdx.x; asm volatile("" : "+v"(tid_));
    const int tid = tid_, wid = __builtin_amdgcn_readfirstlane(tid >> 6), lane = tid & 63, wr = wid >> 2, wc = wid & 3, fr = lane & 15, fq = lane >> 4;
    const int K = g.K, nt = K / BK, LDA = g.lda ? g.lda : g.K;
    unsigned voffA[2], voffB[2];
#pragma unroll
    for (int i = 0; i < 2; ++i) { int R, C; stage_rc(tid * 16 + i * 8192, R, C); const int Rb = Epi::PERM ? ((R & ~31) + perm32(R & 31)) : R;
        voffA[i] = (unsigned)(R * LDA + C) * 2u; voffB[i] = (unsigned)(Rb * K + C) * 2u; }
    const size_t kstep = (size_t)(BK * 2);
    const size_t hstep = (size_t)HALF * K * 2;
    const size_t tstep = 2 * hstep;
    const size_t hstepA = (size_t)HALF * LDA * 2, tstepA = 2 * hstepA;
    const unsigned ldsw = (unsigned)wid * 1024u;
    const int aoff = lds_byte(wr * 64 + fr, fq * 8), boff = lds_byte(wc * 32 + fr, fq * 8);
#define PG8_SA(b, h) (((b) * 2 + (h)) * HTB)
#define PG8_SB(b, h) ((4 + (b) * 2 + (h)) * HTB)
#define PG8_STAGE(bufoff, gbase, voff) do { _Pragma("unroll") for (int _i = 0; _i < 2; ++_i) \
        __builtin_amdgcn_global_load_lds((const unsigned*)((const char*)(gbase) + (voff)[_i]), (PG8_LAS unsigned*)(lds + (bufoff) + ldsw + _i * 8192), 16, 0, 0); } while (0)
#define PG8_LDA(dst, b, h) do { _Pragma("unroll") for (int m = 0; m < 4; ++m) _Pragma("unroll") for (int k = 0; k < 2; ++k) dst[m][k] = *(const PG8_LAS bf16x8*)(lds + PG8_SA(b, h) + aoff + m * 2048 + k * 1024); } while (0)
#define PG8_LDB(dst, b, h) do { _Pragma("unroll") for (int n = 0; n < 2; ++n) _Pragma("unroll") for (int k = 0; k < 2; ++k) dst[n][k] = *(const PG8_LAS bf16x8*)(lds + PG8_SB(b, h) + boff + n * 2048 + k * 1024); } while (0)
#define PG8_MMA(ai, bj, At, Bt) do { __builtin_amdgcn_s_setprio(1); _Pragma("unroll") for (int m = 0; m < 4; ++m) _Pragma("unroll") for (int n = 0; n < 2; ++n) _Pragma("unroll") for (int k = 0; k < 2; ++k) \
        acc[ai][bj][m][n] = __builtin_amdgcn_mfma_f32_16x16x32_bf16(Bt[n][k], At[m][k], acc[ai][bj][m][n], 0, 0, 0); __builtin_amdgcn_s_setprio(0); } while (0)
#define PG8_WAIT_V(n) asm volatile("s_waitcnt vmcnt(" #n ")" ::: "memory")
#define PG8_WAIT_L(n) asm volatile("s_waitcnt lgkmcnt(" #n ")" ::: "memory")
#define PG8_BAR __builtin_amdgcn_s_barrier()
#define PG8_SCHED __builtin_amdgcn_sched_barrier(0)
    Unit cur, nxt; int ui = 0;
    if (!S.next(0, cur)) return;
    f32x4 acc[2][2][4][2];
#pragma unroll
    for (int a = 0; a < 2; ++a)
#pragma unroll
        for (int b = 0; b < 2; ++b)
#pragma unroll
            for (int m = 0; m < 4; ++m)
#pragma unroll
                for (int n = 0; n < 2; ++n) acc[a][b][m][n] = (f32x4){0.f, 0.f, 0.f, 0.f};
    bf16x8 At[4][2], B0[2][2], B1[2][2];
    const char* cA = (const char*)g.A + (size_t)cur.pm * tstepA; const char* cB = (const char*)g.Bt + (size_t)cur.pn * tstep;
    S.a_ready(cur);
    if constexpr (SP2) {
        PG8_STAGE(PG8_SB(0, 0), cB, voffB); PG8_STAGE(PG8_SB(0, 1), cB + hstep, voffB); PG8_STAGE(PG8_SA(0, 0), cA, voffA); PG8_STAGE(PG8_SA(0, 1), cA + hstepA, voffA);
        if (wr == 1) PG8_BAR;
        PG8_WAIT_V(2); PG8_BAR;
        PG8_STAGE(PG8_SB(1, 0), cB + kstep, voffB); PG8_STAGE(PG8_SA(1, 0), cA + kstep, voffA); PG8_STAGE(PG8_SB(1, 1), cB + hstep + kstep, voffB);
        PG8_WAIT_V(6); PG8_BAR;
    } else {
        PG8_STAGE(PG8_SB(0, 0), cB, voffB); PG8_STAGE(PG8_SA(0, 0), cA, voffA); PG8_STAGE(PG8_SB(0, 1), cB + hstep, voffB); PG8_STAGE(PG8_SA(0, 1), cA + hstepA, voffA);
        if (wr == 1) PG8_BAR;
        PG8_WAIT_V(4); PG8_BAR;
        PG8_STAGE(PG8_SB(1, 0), cB + kstep, voffB); PG8_STAGE(PG8_SA(1, 0), cA + kstep, voffA); PG8_STAGE(PG8_SB(1, 1), cB + hstep + kstep, voffB);
        PG8_WAIT_V(6); PG8_BAR;
    }
    for (;;) {
        const bool has_next = S.next(ui + 1, nxt);
        const char* nA = has_next ? (const char*)g.A + (size_t)nxt.pm * tstepA : cA; const char* nB = has_next ? (const char*)g.Bt + (size_t)nxt.pn * tstep : cB;
        for (int t = 0; t < nt; t += 2) {
            const bool last = (t == nt - 2);
            const char* a1 = cA + (size_t)(t + 1) * kstep;
            const char* a2 = last ? nA : cA + (size_t)(t + 2) * kstep; const char* b2 = last ? nB : cB + (size_t)(t + 2) * kstep;
            const char* a3 = a2 + kstep; const char* b3 = b2 + kstep;
            if (last && has_next) S.a_ready(nxt);
            if constexpr (SP2) {
            PG8_LDB(B0, 0, 0); PG8_LDB(B1, 0, 1); PG8_SCHED; PG8_LDA(At, 0, 0); PG8_STAGE(PG8_SA(1, 1), a1 + hstepA, voffA);
            PG8_WAIT_V(8); PG8_WAIT_L(0); PG8_BAR; PG8_MMA(0, 0, At, B0); PG8_MMA(0, 1, At, B1); PG8_BAR; PG8_SCHED;
            PG8_LDA(At, 0, 1); PG8_STAGE(PG8_SB(0, 0), b2, voffB); PG8_STAGE(PG8_SB(0, 1), b2 + hstep, voffB); PG8_STAGE(PG8_SA(0, 0), a2, voffA);
            PG8_WAIT_V(8); PG8_WAIT_L(0); PG8_BAR; PG8_MMA(1, 0, At, B0); PG8_MMA(1, 1, At, B1); PG8_BAR; PG8_SCHED;
            PG8_LDB(B0, 1, 0); PG8_LDB(B1, 1, 1); PG8_SCHED; PG8_LDA(At, 1, 0); PG8_STAGE(PG8_SA(0, 1), a2 + hstepA, voffA);
            PG8_WAIT_V(8); PG8_WAIT_L(0); PG8_BAR; PG8_MMA(0, 0, At, B0); PG8_MMA(0, 1, At, B1); PG8_BAR; PG8_SCHED;
            PG8_LDA(At, 1, 1); PG8_STAGE(PG8_SB(1, 0), b3, voffB); PG8_STAGE(PG8_SB(1, 1), b3 + hstep, voffB); PG8_STAGE(PG8_SA(1, 0), a3, voffA);
            PG8_WAIT_V(8); PG8_WAIT_L(0); PG8_BAR; PG8_MMA(1, 0, At, B0); PG8_MMA(1, 1, At, B1); PG8_BAR; PG8_SCHED;
            } else {
            PG8_LDB(B0, 0, 0); PG8_SCHED; PG8_LDA(At, 0, 0); PG8_STAGE(PG8_SA(1, 1), a1 + hstepA, voffA);
            PG8_WAIT_L(8); PG8_BAR; PG8_WAIT_L(0); PG8_MMA(0, 0, At, B0); PG8_BAR; PG8_SCHED;
            PG8_LDB(B1, 0, 1); PG8_STAGE(PG8_SB(0, 0), b2, voffB);
            PG8_BAR; PG8_WAIT_L(0); PG8_MMA(0, 1, At, B1); PG8_BAR;
            PG8_LDA(At, 0, 1); PG8_STAGE(PG8_SA(0, 0), a2, voffA);
            PG8_BAR; PG8_WAIT_L(0); PG8_MMA(1, 0, At, B0); PG8_BAR; PG8_SCHED;
            PG8_STAGE(PG8_SB(0, 1), b2 + hstep, voffB);
            PG8_WAIT_V(6); PG8_BAR; PG8_MMA(1, 1, At, B1); PG8_BAR;
            PG8_LDB(B0, 1, 0); PG8_SCHED; PG8_LDA(At, 1, 0); PG8_STAGE(PG8_SA(0, 1), a2 + hstepA, voffA);
            PG8_WAIT_L(8); PG8_BAR; PG8_WAIT_L(0); PG8_MMA(0, 0, At, B0); PG8_BAR; PG8_SCHED;
            PG8_LDB(B1, 1, 1); PG8_STAGE(PG8_SB(1, 0), b3, voffB);
            PG8_BAR; PG8_WAIT_L(0); PG8_MMA(0, 1, At, B1); PG8_BAR;
            PG8_LDA(At, 1, 1); PG8_STAGE(PG8_SA(1, 0), a3, voffA);
            PG8_BAR; PG8_WAIT_L(0); PG8_MMA(1, 0, At, B0); PG8_BAR; PG8_SCHED;
            PG8_STAGE(PG8_SB(1, 1), b3 + hstep, voffB);
            PG8_WAIT_V(6); PG8_BAR; PG8_MMA(1, 1, At, B1); PG8_BAR;
            }
        }
        if constexpr (ALIGN_EPI) { if (wr == 0) PG8_BAR; }
        if constexpr (!Epi::AFTER_DRAIN) { E(acc, cur, wr, wc, fr, fq); S.done(cur); }
        if (!has_next) break;
#pragma unroll
        for (int a = 0; a < 2; ++a)
#pragma unroll
            for (int b = 0; b < 2; ++b)
#pragma unroll
                for (int m = 0; m < 4; ++m)
#pragma unroll
                    for (int n = 0; n < 2; ++n) acc[a][b][m][n] = (f32x4){0.f, 0.f, 0.f, 0.f};
        cur = nxt; cA = nA; cB = nB; ++ui;
        if constexpr (ALIGN_EPI) { if (wr == 1) PG8_BAR; }
    }
    PG8_WAIT_V(0);
    if constexpr (!ALIGN_EPI) { if (wr == 0) PG8_BAR; }
    PG8_BAR;
    if constexpr (Epi::AFTER_DRAIN) { E.fused(acc, cur, wr, wc, fr, fq, lds, wid, lane); S.done(cur); }
#undef PG8_SA
#undef PG8_SB
#undef PG8_STAGE
#undef PG8_LDA
#undef PG8_LDB
#undef PG8_MMA
#undef PG8_WAIT_V
#undef PG8_WAIT_L
#undef PG8_BAR
#undef PG8_SCHED
}
}
#define GAS __attribute__((address_space(1)))
#define LAS __attribute__((address_space(3)))
typedef unsigned short bf16;
typedef unsigned v4u __attribute__((ext_vector_type(4)));
typedef float f32x4 __attribute__((ext_vector_type(4)));
typedef short bf16x8 __attribute__((ext_vector_type(8)));
typedef GAS unsigned gu32;
typedef GAS unsigned long long gu64;
#define RLX_AGENT __ATOMIC_RELAXED, __HIP_MEMORY_SCOPE_AGENT
#define LDS_WAIT() asm volatile("s_waitcnt lgkmcnt(0)" ::: "memory")
#define VM_WAIT() asm volatile("s_waitcnt vmcnt(0)" ::: "memory")
__device__ __forceinline__ unsigned long long rt() { return __builtin_amdgcn_s_memrealtime(); }
__device__ __forceinline__ unsigned f2bf(float f) { unsigned u = __builtin_bit_cast(unsigned, f); return (u + 0x7fffu + ((u >> 16) & 1u)) >> 16; }
__device__ __forceinline__ unsigned pk2(float lo, float hi) { return f2bf(lo) | (f2bf(hi) << 16); }

#define XB_TMO      128
#define XB_XCNT(j)  (256  + 64 * (j))
#define XB_XSUB(j)  (1280 + 64 * (j))
#define XB_XGEN(j)  (2304 + 64 * (j))
#define XB_TOP      3328
#define XB_TOPGEN   3392
#define XCD_BAR_WORDS 3456
#define XB_SPIN_CAP (1u << 18)

__device__ __forceinline__ unsigned xb_ld(unsigned* p)              { return __hip_atomic_load(p, __ATOMIC_RELAXED, __HIP_MEMORY_SCOPE_AGENT); }
__device__ __forceinline__ unsigned xb_add(unsigned* p, unsigned v) { return __hip_atomic_fetch_add(p, v, __ATOMIC_RELAXED, __HIP_MEMORY_SCOPE_AGENT); }
__device__ __forceinline__ unsigned xb_xcc_id() { return (unsigned)__builtin_amdgcn_s_getreg((3 << 11) | 20) & 0xFu; }
#define XB_SPIN(cond, bar) do { unsigned _sp = 0; while (cond) { __builtin_amdgcn_s_sleep(1); \
    if ((++_sp & 255u) == 0u) { if (xb_ld(&(bar)[XB_TMO])) break; if (_sp > XB_SPIN_CAP) { atomicAdd(&(bar)[XB_TMO], 1u); break; } } } } while (0)

struct XcdBarrier {
    unsigned* bar; unsigned x;
    volatile LAS unsigned* st;
};

__device__ __forceinline__ XcdBarrier xcd_barrier_post(unsigned* bar, volatile LAS unsigned* st) {
    XcdBarrier b; b.bar = bar; b.x = xb_xcc_id(); b.st = st;
    if (threadIdx.x == 0) (void)xb_add(&bar[XB_XCNT(b.x)], 1u);
    return b;
}
__device__ __forceinline__ void xcd_barrier_complete(unsigned* bar, unsigned x, unsigned& nloc, unsigned& nx) {
    const unsigned G = gridDim.x * gridDim.y * gridDim.z;
    unsigned sum, cnt, mine, sp = 0u;
    for (;;) {
        sum = 0u; cnt = 0u; mine = 0u;
#pragma unroll
        for (unsigned j = 0; j < 16; ++j) { const unsigned c = xb_ld(&bar[XB_XCNT(j)]); sum += c; cnt += (c > 0u) ? 1u : 0u; mine = (j == x) ? c : mine; }
        if (sum == G) break;
        __builtin_amdgcn_s_sleep(1);
        if ((++sp & 255u) == 0u) { if (xb_ld(&bar[XB_TMO])) break; if (sp > XB_SPIN_CAP) { atomicAdd(&bar[XB_TMO], 1u); break; } }
    }
    nloc = mine > 0u ? mine : 1u; nx = cnt > 0u ? cnt : 1u;
}

__device__ __forceinline__ void xcd_barrier(const XcdBarrier& b) {
    asm volatile("s_waitcnt vmcnt(0)" ::: "memory");
    __syncthreads();
    if (threadIdx.x == 0) {
        unsigned* bar = b.bar;
        __builtin_amdgcn_s_waitcnt(0);
        unsigned nloc = b.st[0], nx = b.st[1];
        if (nloc == 0u) { xcd_barrier_complete(bar, b.x, nloc, nx); b.st[0] = nloc; b.st[1] = nx; }
        const unsigned old = xb_add(&bar[XB_XSUB(b.x)], 1u);
        const unsigned gen = old / nloc;
        if (old + 1u == (gen + 1u) * nloc) {
            __builtin_amdgcn_fence(__ATOMIC_RELEASE, "agent");
            asm volatile("s_waitcnt vmcnt(0)" ::: "memory");
            const unsigned og = xb_add(&bar[XB_TOP], 1u);
            const unsigned tg = og / nx;
            if (og + 1u == (tg + 1u) * nx) xb_add(&bar[XB_TOPGEN], 1u);
            else XB_SPIN(xb_ld(&bar[XB_TOPGEN]) == tg, bar);
            __builtin_amdgcn_fence(__ATOMIC_ACQUIRE, "agent");
            xb_add(&bar[XB_XGEN(b.x)], 1u);
            asm volatile("s_waitcnt vmcnt(0)" ::: "memory");
        } else {
            XB_SPIN(xb_ld(&bar[XB_XGEN(b.x)]) == gen, bar);
            __builtin_amdgcn_fence(__ATOMIC_ACQUIRE, "agent");
            asm volatile("s_waitcnt vmcnt(0)" ::: "memory");
        }
    }
    __syncthreads();
}

#define XB_LOC(j)   (3584 + 64 * (j))
#define XB_RANK(j)  (4608 + 64 * (j))
#define XB_LGEN(j)  (5632 + 64 * (j))
#define XB_ALL_WORDS 6656
__device__ __forceinline__ void xcd_local_barrier(unsigned* bar, unsigned x, unsigned nloc) {
    asm volatile("s_waitcnt vmcnt(0)" ::: "memory");
    __syncthreads();
    if (threadIdx.x == 0) {
        __builtin_amdgcn_s_waitcnt(0);
        const unsigned old = xb_add(&bar[XB_LOC(x)], 1u); const unsigned gen = old / nloc;
        if (old + 1u == (gen + 1u) * nloc) {
            __builtin_amdgcn_fence(__ATOMIC_RELEASE, "agent");
            asm volatile("s_waitcnt vmcnt(0)" ::: "memory");
            __builtin_amdgcn_fence(__ATOMIC_ACQUIRE, "agent");
            xb_add(&bar[XB_LGEN(x)], 1u);
            asm volatile("s_waitcnt vmcnt(0)" ::: "memory");
        } else {
            XB_SPIN(xb_ld(&bar[XB_LGEN(x)]) == gen, bar);
            __builtin_amdgcn_fence(__ATOMIC_ACQUIRE, "agent");
            asm volatile("s_waitcnt vmcnt(0)" ::: "memory");
        }
    }
    __syncthreads();
}

constexpr int NWAVES = 8, NTHR = 512;
constexpr int DM = 1024, BATCH = 8, SEQ = 2048, DEPTH = 4, M = BATCH * SEQ;
constexpr int DFF = 2816, NUP = 2 * DFF, NPROJ = 3840, PROJ_LD = 3584, NIN_SRC = 3600, NCOND = 9 * DM;
constexpr float RMS_EPS = 1e-6f;
constexpr int PC_FQ = 0, PC_FK = 256, PC_FV = 512, PC_MQ = 768, PC_MK = 1024, PC_MV = 1280, PC_MO = 1536, PC_RQ = 1792, PC_RK = 2048, PC_RV = 2304, PC_RG = 2560, PC_SZ = 2816, PC_SX = 3072;
constexpr int PH_LAYER0 = 2, PH_PER_LAYER = 9, PH_FINAL = PH_LAYER0 + PH_PER_LAYER * DEPTH, PH_END = PH_FINAL + 1;
constexpr size_t MiB = 1u << 20;
constexpr size_t WS_CTL = 0, CTL_ZERO_BYTES = 1 * MiB;
constexpr size_t WS_COND = 1 * MiB;
constexpr size_t WS_ROPE = 3 * MiB;
constexpr size_t WS_W = 4 * MiB;
constexpr size_t W_UP = (size_t)NUP * DM * 2, W_DN = (size_t)DM * DFF * 2, W_IN = (size_t)NPROJ * DM * 2, W_OUT = (size_t)DM * DM * 2;
constexpr size_t OFF_UP1 = 0, OFF_DN1 = W_UP, OFF_UP2 = W_UP + W_DN, OFF_DN2 = 2 * W_UP + W_DN, OFF_IN = 2 * W_UP + 2 * W_DN, OFF_OUT = OFF_IN + W_IN, LAYER_W = OFF_OUT + W_OUT;
static_assert(LAYER_W * DEPTH == 170 * MiB, "weights");
constexpr size_t WS_HB = 174 * MiB;
constexpr size_t WS_PROJ = 206 * MiB, WS_ACT = 206 * MiB;
constexpr size_t WS_GATES = 318 * MiB;
constexpr size_t WS_VTF = 319 * MiB;
constexpr size_t WS_VTL = 327 * MiB;
constexpr size_t WS_QL = 363 * MiB, WS_KL = 387 * MiB;
constexpr size_t WS_COEF = 411 * MiB;
constexpr size_t COEF_A1 = 0, COEF_A2 = 768 * 1024, COEF_BETA = 2 * 768 * 1024, COEF_LCUM = 3 * 768 * 1024, COEF_S1 = COEF_LCUM + 256 * 1024, COEF_S2 = COEF_S1 + 16 * 1024, COEF_CTOT = COEF_S2 + 16 * 1024;
constexpr size_t WS_YRAW = 415 * MiB;
constexpr size_t WS_XB = 447 * MiB;
constexpr size_t WS_YBF = 479 * MiB;
constexpr size_t WS_KT = 511 * MiB;
constexpr size_t WS_XS = 535 * MiB;
constexpr size_t WS_DEN = 551 * MiB;
constexpr size_t WS_BIAS = 552 * MiB;
constexpr size_t BIAS_USE = (size_t)8 * NUP * 4, BIAS_BYTES = (size_t)DEPTH * 3 * BIAS_USE;
constexpr size_t WS_SS = 556 * MiB, SS_BYTES = (size_t)3 * DEPTH * M * 8;
constexpr size_t WS_BIASQ = 558 * MiB, BIASQ_BYTES = 2 * BIAS_BYTES, WS_END = 563 * MiB;
static_assert(WS_BIAS + BIAS_BYTES <= 555 * MiB && WS_SS + SS_BYTES <= WS_BIASQ && WS_BIASQ + BIASQ_BYTES <= WS_END, "ws map 2");
static_assert(WS_PROJ + (size_t)M * PROJ_LD * 2 <= WS_GATES && WS_ACT + (size_t)M * DFF * 2 <= WS_GATES && COEF_CTOT + 4096 <= 4 * MiB && WS_YRAW + (size_t)M * 1024 * 4 <= WS_YBF, "ws map");
constexpr int CW_BAR = 4096;
constexpr int RING_BYTES = 131072, LDS_BYTES = 163840, LDSCTL_OFF = LDS_BYTES - 1024, MISC_OFF = LDSCTL_OFF + 320;

__device__ const double INVREV[32] = {0.15915494309189535, 0.11934937021124886, 0.089499401608891013, 0.067115083005227255, 0.050329212104487035, 0.037741584717419778, 0.028302195830623395, 0.02122365276477766, 0.015915494309189534, 0.011934937021124886, 0.0089499401608891006, 0.0067115083005227253, 0.0050329212104487037, 0.0037741584717419768, 0.0028302195830623399, 0.0021223652764777662, 0.0015915494309189536, 0.0011934937021124887, 0.00089499401608891024, 0.0006711508300522726, 0.00050329212104487033, 0.00037741584717419769, 0.00028302195830623401, 0.00021223652764777661, 0.00015915494309189535, 0.00011934937021124885, 8.9499401608891018e-05, 6.7115083005227268e-05, 5.0329212104487035e-05, 3.7741584717419777e-05, 2.8302195830623396e-05, 2.1223652764777659e-05};

struct Args { const float* in[25]; float* out; unsigned char* ws; int ph_lo, ph_hi; };
static_assert(sizeof(Args) == 27 * 8 + 8, "Args has no padding");

__device__ __forceinline__ float wave_sum(float v) {
#pragma unroll
    for (int o = 1; o < 64; o <<= 1) v += __shfl_xor(v, o);
    return v;
}
__device__ __forceinline__ float bf2f(unsigned short u) { return __uint_as_float((unsigned)u << 16); }
__device__ __forceinline__ float sigmoid_f(float v) { return 1.0f / (1.0f + __expf(-v)); }
__device__ __forceinline__ float silu_acc(float v) { return v / (1.0f + __expf(-v)); }
__device__ __forceinline__ float log_sigmoid_f(float v) { return fminf(v, 0.f) - log1pf(__expf(-fabsf(v))); }
__device__ __forceinline__ float softplus_f(float v) { return fmaxf(v, 0.f) + log1pf(__expf(-fabsf(v))); }

__device__ __forceinline__ int map_up(int n) { const int t = n >> 8, r = n & 255; return (r < 128) ? (t * 128 + r) : (DFF + t * 128 + (r - 128)); }
__device__ __forceinline__ int map_in(int n) {
    if (n < 768) return n; if (n < 1536) return n + 4; if (n < 3584) return n + 12;
    const int j = n - 3584; if (j < 4) return 768 + j; if (j < 8) return 1540 + (j - 4); if (j < 12) return 1544 + (j - 8); if (j < 16) return 3596 + (j - 12); return -1; }
template <int MAP> __device__ __forceinline__ void tr_item(const float* W, int K, int Nsrc, bf16* WT, int kb, int nb, LAS float* scr, int lane, const float* shp, long long* biasp, int Ndst) {
    const int k0 = 64 * kb, n0 = 32 * nb; const int nd = n0 + (lane & 31); const int src = MAP == 1 ? map_up(nd) : (MAP == 2 ? map_in(nd) : nd);
    const bool regular = (MAP != 2) || (n0 < 3584);
    if (regular) {
        const int s0c = MAP == 1 ? map_up(n0) : (MAP == 2 ? map_in(n0) : n0); const int kq = lane >> 3, nq = lane & 7;
        f32x4 wv[8];
#pragma unroll
        for (int i = 0; i < 8; ++i) wv[i] = *(const f32x4*)(W + (size_t)(k0 + 8 * i + kq) * Nsrc + s0c + 4 * nq);
#pragma unroll
        for (int i = 0; i < 8; ++i) { LAS float* d = scr + (8 * i + kq) * 33 + 4 * nq; d[0] = wv[i][0]; d[1] = wv[i][1]; d[2] = wv[i][2]; d[3] = wv[i][3]; }
    } else {
#pragma unroll 8
        for (int i = 0; i < 32; ++i) { const int kk = 2 * i + (lane >> 5); scr[kk * 33 + (lane & 31)] = src >= 0 ? W[(size_t)(k0 + kk) * Nsrc + src] : 0.f; }
    }
    if (MAP != 0) {
        LAS float* shs = scr + 64 * 33;
#pragma unroll
        for (int bb = 0; bb < 8; ++bb) shs[lane * 8 + bb] = shp[(size_t)bb * NCOND + k0 + lane];
    }
    LDS_WAIT(); asm volatile("" ::: "memory");
    const int c = lane & 7;
#pragma unroll
    for (int j = 0; j < 4; ++j) { const int n = (lane >> 3) + 8 * j; const LAS float* s = scr + (8 * c) * 33 + n;
        v4u o; o.x = pk2(s[0 * 33], s[1 * 33]); o.y = pk2(s[2 * 33], s[3 * 33]); o.z = pk2(s[4 * 33], s[5 * 33]); o.w = pk2(s[6 * 33], s[7 * 33]);
        *(GAS v4u*)(WT + (size_t)(n0 + n) * K + k0 + 8 * c) = o; }
    if (MAP != 0) {
        const LAS float* shs = scr + 64 * 33; const int n = lane & 31, hf = lane >> 5;
        float acc[8];
#pragma unroll
        for (int bb = 0; bb < 8; ++bb) acc[bb] = 0.f;
#pragma unroll 8
        for (int i = 0; i < 32; ++i) { const int kk = 32 * hf + i; const float w = scr[kk * 33 + n]; const f32x4 s0 = *(const LAS f32x4*)(shs + kk * 8), s1 = *(const LAS f32x4*)(shs + kk * 8 + 4);
            acc[0] += w * s0[0]; acc[1] += w * s0[1]; acc[2] += w * s0[2]; acc[3] += w * s0[3]; acc[4] += w * s1[0]; acc[5] += w * s1[1]; acc[6] += w * s1[2]; acc[7] += w * s1[3]; }
#pragma unroll
        for (int bb = 0; bb < 8; ++bb) { acc[bb] += __shfl_xor(acc[bb], 32); if (hf == 0 && src >= 0) atomicAdd((unsigned long long*)(biasp + (size_t)bb * Ndst + n0 + n), (unsigned long long)__float2ll_rn(acc[bb] * 4294967296.0f)); }
    }
    LDS_WAIT(); asm volatile("" ::: "memory");
}
__device__ __forceinline__ void prologue0(const Args& a, LAS unsigned char* lds, int tid, int lane, int wave, int G) {
    unsigned char* ws = a.ws;
    LAS float* cact = (LAS float*)(lds + 69632);
    LAS float* red = (LAS float*)(lds + 102400);
    for (int i = tid; i < BATCH * DM; i += NTHR) { const float v = a.in[1][i]; cact[i] = silu_acc(v); }
    __syncthreads();
    float* cond = (float*)(ws + WS_COND);
    for (int item = blockIdx.x; item < DEPTH * (NCOND / 64); item += G) {
        const int l = item / (NCOND / 64), cb = item % (NCOND / 64), col = cb * 64 + lane, ks = wave;
        const float* W = a.in[2] + (size_t)l * DM * NCOND + col;
        float acc[8];
#pragma unroll
        for (int b = 0; b < 8; ++b) acc[b] = 0.f;
        for (int k = ks * 128; k < ks * 128 + 128; k += 16) { float w[16];
#pragma unroll
            for (int i = 0; i < 16; ++i) w[i] = W[(size_t)(k + i) * NCOND];
#pragma unroll
            for (int i = 0; i < 16; ++i)
#pragma unroll
                for (int b = 0; b < 8; ++b) acc[b] += cact[b * DM + k + i] * w[i]; }
#pragma unroll
        for (int b = 0; b < 8; ++b) red[(ks * 8 + b) * 64 + lane] = acc[b];
        __syncthreads();
        { const int b = wave; float s = 0.f;
#pragma unroll
          for (int k2 = 0; k2 < 8; ++k2) s += red[(k2 * 8 + b) * 64 + lane];
          cond[((size_t)l * BATCH + b) * NCOND + col] = s + a.in[3][(size_t)l * NCOND + col]; }
        __syncthreads();
    }
    float2* rope = (float2*)(ws + WS_ROPE);
    for (int e = blockIdx.x * NTHR + tid; e < SEQ * 32; e += G * NTHR) { const int s = e >> 5, i = e & 31; const double rev = (double)s * INVREV[i]; const float fr = (float)(rev - rint(rev));
        rope[e] = make_float2(__builtin_amdgcn_cosf(fr), __builtin_amdgcn_sinf(fr)); }
    { GAS f32x4* z = (GAS f32x4*)(ws + WS_BIASQ); for (size_t i = (size_t)blockIdx.x * NTHR + tid; i < BIASQ_BYTES / 16; i += (size_t)G * NTHR) z[i] = (f32x4){0.f, 0.f, 0.f, 0.f};
      GAS f32x4* z2 = (GAS f32x4*)(ws + WS_SS); for (size_t i = (size_t)blockIdx.x * NTHR + tid; i < SS_BYTES / 16; i += (size_t)G * NTHR) z2[i] = (f32x4){0.f, 0.f, 0.f, 0.f}; }
}
__device__ __forceinline__ void prologue1(const Args& a, LAS unsigned char* lds, int lane, int wave, int G) {
    unsigned char* ws = a.ws;
    LAS float* scr = (LAS float*)(lds + wave * 10496);
    const float* cond = (const float*)(ws + WS_COND);
    const int gw = blockIdx.x * NWAVES + wave, NGW = G * NWAVES;
    constexpr int I_UP = (DM / 64) * (NUP / 32), I_DN = (DFF / 64) * (DM / 32), I_IN = (DM / 64) * (NPROJ / 32), I_OUT = (DM / 64) * (DM / 32), I_LAYER = 2 * I_UP + 2 * I_DN + I_IN + I_OUT;
    for (int it = gw; it < DEPTH * I_LAYER; it += NGW) {
        const int l = it / I_LAYER; int r = it % I_LAYER;
        unsigned char* wl = ws + WS_W + (size_t)l * LAYER_W; const float* cl = cond + (size_t)l * BATCH * NCOND; long long* bl = (long long*)(ws + WS_BIASQ + (size_t)l * 3 * 2 * BIAS_USE);
        if (r < I_UP) { tr_item<1>(a.in[5] + (size_t)l * DM * NUP, DM, NUP, (bf16*)(wl + OFF_UP1), r / (NUP / 32), r % (NUP / 32), scr, lane, cl + 0 * DM, bl, NUP); continue; } r -= I_UP;
        if (r < I_DN) { tr_item<0>(a.in[6] + (size_t)l * DFF * DM, DFF, DM, (bf16*)(wl + OFF_DN1), r / (DM / 32), r % (DM / 32), scr, lane, nullptr, nullptr, 0); continue; } r -= I_DN;
        if (r < I_UP) { tr_item<1>(a.in[7] + (size_t)l * DM * NUP, DM, NUP, (bf16*)(wl + OFF_UP2), r / (NUP / 32), r % (NUP / 32), scr, lane, cl + 6 * DM, bl + 2 * 8 * NUP, NUP); continue; } r -= I_UP;
        if (r < I_DN) { tr_item<0>(a.in[8] + (size_t)l * DFF * DM, DFF, DM, (bf16*)(wl + OFF_DN2), r / (DM / 32), r % (DM / 32), scr, lane, nullptr, nullptr, 0); continue; } r -= I_DN;
        if (r < I_IN) { tr_item<2>(a.in[9] + (size_t)l * DM * NIN_SRC, DM, NIN_SRC, (bf16*)(wl + OFF_IN), r / (NPROJ / 32), r % (NPROJ / 32), scr, lane, cl + 3 * DM, bl + 1 * 8 * NUP, NPROJ); continue; } r -= I_IN;
        tr_item<0>(a.in[10] + (size_t)l * DM * DM, DM, DM, (bf16*)(wl + OFF_OUT), r / (DM / 32), r % (DM / 32), scr, lane, nullptr, nullptr, 0);
    }
}
__device__ __forceinline__ void thin_xg(const float* x, bf16* hb, bf16* xb, const float* g, const float* cond_l, int sc_off, long long* ss, int gw, int NGW, int lane) {
    for (int m = gw; m < M; m += NGW) {
        const int b = m >> 11;
        const GAS f32x4* xr = (const GAS f32x4*)(x + (size_t)m * DM) + lane;
        f32x4 v[4]; float s = 0.f;
#pragma unroll
        for (int j = 0; j < 4; ++j) { v[j] = xr[64 * j]; s += (v[j].x * v[j].x + v[j].y * v[j].y) + (v[j].z * v[j].z + v[j].w * v[j].w); }
        s = wave_sum(s); if (lane == 0) ss[m] = __float2ll_rn(s * 16777216.0f);
        const f32x4* g4 = (const f32x4*)g + lane; const f32x4* sc4 = (const f32x4*)(cond_l + (size_t)b * NCOND + sc_off) + lane;
        GAS unsigned long long* o8 = (GAS unsigned long long*)(hb + (size_t)m * DM) + lane;
#pragma unroll
        for (int j = 0; j < 4; ++j) { const f32x4 o = v[j] * g4[64 * j] * (sc4[64 * j] + 1.0f);
            o8[64 * j] = (unsigned long long)pk2(o.x, o.y) | ((unsigned long long)pk2(o.z, o.w) << 32); }
        GAS unsigned long long* x8 = (GAS unsigned long long*)(xb + (size_t)m * DM) + lane;
#pragma unroll
        for (int j = 0; j < 4; ++j) x8[64 * j] = (unsigned long long)pk2(v[j].x, v[j].y) | ((unsigned long long)pk2(v[j].z, v[j].w) << 32);
    }
}
__device__ __forceinline__ void thin_norm(const float* x, bf16* hb, const float* g, const float* cond_l, int sh_off, int sc_off, int gw, int NGW, int lane) {
    for (int m = gw; m < M; m += NGW) {
        const int b = m >> 11;
        const GAS f32x4* xr = (const GAS f32x4*)(x + (size_t)m * DM) + lane;
        f32x4 v[4]; float s = 0.f;
#pragma unroll
        for (int j = 0; j < 4; ++j) { v[j] = xr[64 * j]; s += (v[j].x * v[j].x + v[j].y * v[j].y) + (v[j].z * v[j].z + v[j].w * v[j].w); }
        const float rstd = 1.0f / sqrtf(wave_sum(s) * (1.0f / DM) + RMS_EPS);
        const f32x4* g4 = (const f32x4*)g + lane; const f32x4* sh4 = (const f32x4*)(cond_l + (size_t)b * NCOND + sh_off) + lane; const f32x4* sc4 = (const f32x4*)(cond_l + (size_t)b * NCOND + sc_off) + lane;
        GAS unsigned long long* o8 = (GAS unsigned long long*)(hb + (size_t)m * DM) + lane;
#pragma unroll
        for (int j = 0; j < 4; ++j) { const f32x4 gg = g4[64 * j], sh = sh4[64 * j], sc = sc4[64 * j]; const f32x4 o = v[j] * rstd * gg * (sc + 1.0f) + sh;
            o8[64 * j] = (unsigned long long)pk2(o.x, o.y) | ((unsigned long long)pk2(o.z, o.w) << 32); }
    }
}

typedef float f32x16 __attribute__((ext_vector_type(16)));
typedef short s16x4 __attribute__((ext_vector_type(4)));
typedef float f32x2_t __attribute__((ext_vector_type(2))); typedef __bf16 bf16x2_t __attribute__((ext_vector_type(2)));
#define MFMA32(a, b, c) __builtin_amdgcn_mfma_f32_32x32x16_bf16((a), (b), (c), 0, 0, 0)
constexpr float LOG2E = 1.4426950408889634f;
__device__ __forceinline__ unsigned cvtpk(float lo, float hi) { f32x2_t v = {lo, hi}; bf16x2_t b = __builtin_convertvector(v, bf16x2_t); return __builtin_bit_cast(unsigned, b); }
template <int KAP> __device__ __forceinline__ bf16x8 pack8(const f32x16& x) {
    v4u p; p.x = cvtpk(x[8 * KAP + 0], x[8 * KAP + 1]); p.y = cvtpk(x[8 * KAP + 2], x[8 * KAP + 3]); p.z = cvtpk(x[8 * KAP + 4], x[8 * KAP + 5]); p.w = cvtpk(x[8 * KAP + 6], x[8 * KAP + 7]);
    return __builtin_bit_cast(bf16x8, p); }
__device__ __forceinline__ bf16x8 ld_perm(const bf16* p) { const s16x4 lo = *(const s16x4*)p, hi = *(const s16x4*)(p + 8); return __builtin_shufflevector(lo, hi, 0, 1, 2, 3, 4, 5, 6, 7); }
__device__ __forceinline__ float fmax16(const f32x16& a) { float m0 = fmaxf(fmaxf(a[0], a[1]), fmaxf(a[2], a[3])), m1 = fmaxf(fmaxf(a[4], a[5]), fmaxf(a[6], a[7])), m2 = fmaxf(fmaxf(a[8], a[9]), fmaxf(a[10], a[11])), m3 = fmaxf(fmaxf(a[12], a[13]), fmaxf(a[14], a[15])); return fmaxf(fmaxf(m0, m1), fmaxf(m2, m3)); }

struct MixBufs {
    const bf16* proj; const float* gates;
    bf16* vtf;
    float* lcum;
    float* ctot;
    bf16* ql;
    bf16* kl;
    bf16* kt;
    bf16* vtl;
    float* xs;
    float* a1; float* a2; float* beta;
    float* s1; float* s2;
    float* den;
    float* yraw;
};
__device__ __forceinline__ float wave_scan_add(float v, int lane) {
#pragma unroll
    for (int o = 1; o < 64; o <<= 1) { const float u = __shfl_up(v, o); if (lane >= o) v += u; }
    return v; }
__device__ __forceinline__ float wave_scan_max(float v, int lane) {
#pragma unroll
    for (int o = 1; o < 64; o <<= 1) { const float u = __shfl_up(v, o); if (lane >= o) v = fmaxf(v, u); }
    return v; }

struct PrepW { const float* mcw; const float* mcb; const float* scw; const float* scb; const float* fox_fb; const float* mib; const float* mfb; const float* dtb; const float* alog; const float2* rope; };
__device__ __forceinline__ void prep_unit(const MixBufs& B, const PrepW& W, int u, int wave, int lane) {
    const int b = u >> 5, c = u & 31, s0 = 64 * c; const size_t m0 = (size_t)b * SEQ + s0;
    for (int job = wave; job < 52; job += NWAVES) {
        if (job < 36) {
            const int kind = job < 32 ? (job >> 2) : (job < 34 ? 8 : 9), h = job < 32 ? (job & 3) : (job & 1);
            const int cg = lane & 7, tb = lane >> 3, tok0 = 8 * tb;
            const int pc = (kind == 0 ? PC_FV + h * 64 : kind == 1 ? PC_MV + h * 64 : kind == 2 ? PC_RV + h * 64 : kind == 3 ? PC_MQ + h * 64 : kind == 4 ? PC_MK + h * 64 : kind == 5 ? PC_RQ + h * 64 : kind == 6 ? PC_RK + h * 64
                         : kind == 7 ? PC_SX + h * 64 : kind == 8 ? PC_SX + 256 + h * 64 : PC_SX + 384 + h * 64);
            const bf16* src = B.proj + (m0 + tok0) * PROJ_LD + pc + 8 * cg;
            const bool is_conv = (kind == 3 || kind == 4 || kind >= 7), is_rot = (kind == 5 || kind == 6);
            v4u raw[8];
#pragma unroll
            for (int i = 0; i < 8; ++i) raw[i] = *(const v4u*)(src + (size_t)i * PROJ_LD);
            float v[8][8];
#pragma unroll
            for (int i = 0; i < 8; ++i)
#pragma unroll
                for (int j = 0; j < 4; ++j) { v[i][2 * j] = __uint_as_float(raw[i][j] << 16); v[i][2 * j + 1] = __uint_as_float(raw[i][j] & 0xffff0000u); }
            if (is_conv) {
                const int cc = (kind == 3 ? h * 64 : kind == 4 ? 256 + h * 64 : kind == 7 ? h * 64 : kind == 8 ? 256 + h * 64 : 384 + h * 64) + 8 * cg; const float* cw = (kind <= 4) ? W.mcw : W.scw; const float* cbp = (kind <= 4) ? W.mcb : W.scb;
                float wt[4][8], cb[8], xh[3][8];
#pragma unroll
                for (int k = 0; k < 4; ++k) { const f32x4 a = *(const f32x4*)(cw + k * 512 + cc), d = *(const f32x4*)(cw + k * 512 + cc + 4);
#pragma unroll
                    for (int j = 0; j < 4; ++j) { wt[k][j] = a[j]; wt[k][4 + j] = d[j]; } }
                { const f32x4 a = *(const f32x4*)(cbp + cc), d = *(const f32x4*)(cbp + cc + 4);
#pragma unroll
                  for (int j = 0; j < 4; ++j) { cb[j] = a[j]; cb[4 + j] = d[j]; } }
                const bool has_halo = (c > 0) || (tb > 0);
#pragma unroll
                for (int k = 0; k < 3; ++k) { v4u hr = (v4u){0u, 0u, 0u, 0u}; if (has_halo) hr = *(const v4u*)(src - (size_t)(3 - k) * PROJ_LD);
#pragma unroll
                    for (int j = 0; j < 4; ++j) { xh[k][2 * j] = __uint_as_float(hr[j] << 16); xh[k][2 * j + 1] = __uint_as_float(hr[j] & 0xffff0000u); } }
#pragma unroll
                for (int j = 0; j < 8; ++j) { float x0 = xh[0][j], x1 = xh[1][j], x2 = xh[2][j];
#pragma unroll
                    for (int i = 0; i < 8; ++i) { const float x3 = v[i][j]; float o = pg8::silu_f(cb[j] + wt[0][j] * x0 + wt[1][j] * x1 + wt[2][j] * x2 + wt[3][j] * x3); if (kind == 3) o *= 0.125f; v[i][j] = o; x0 = x1; x1 = x2; x2 = x3; } }
            } else if (is_rot) {
                const bf16* src2 = B.proj + (m0 + tok0) * PROJ_LD + pc + 8 * (cg ^ 4);
                const bool lowh = cg < 4; const float sc = (kind == 6) ? 0.125f : 1.0f;
#pragma unroll
                for (int i = 0; i < 8; ++i) { const v4u pr = *(const v4u*)(src2 + (size_t)i * PROJ_LD); const float2* rp = W.rope + (size_t)(s0 + tok0 + i) * 32 + 8 * (cg & 3);
                    const f32x4 r0 = *(const f32x4*)rp, r1 = *(const f32x4*)(rp + 2), r2 = *(const f32x4*)(rp + 4), r3 = *(const f32x4*)(rp + 6);
                    const float cs[8] = {r0[0], r0[2], r1[0], r1[2], r2[0], r2[2], r3[0], r3[2]}, sn[8] = {r0[1], r0[3], r1[1], r1[3], r2[1], r2[3], r3[1], r3[3]};
#pragma unroll
                    for (int j = 0; j < 8; ++j) { const float pv = (j & 1) ? __uint_as_float(pr[j >> 1] & 0xffff0000u) : __uint_as_float(pr[j >> 1] << 16);
                        v[i][j] = (lowh ? v[i][j] * cs[j] - pv * sn[j] : pv * sn[j] + v[i][j] * cs[j]) * sc; } }
            }
            if (kind == 7) {
                const float dtb_h = W.dtb[h];
#pragma unroll
                for (int i = 0; i < 8; ++i) { bf16* xp = (bf16*)B.xs + (m0 + tok0 + i) * 256 + h * 64 + 8 * cg; *(GAS v4u*)xp = (v4u){cvtpk(v[i][0], v[i][1]), cvtpk(v[i][2], v[i][3]), cvtpk(v[i][4], v[i][5]), cvtpk(v[i][6], v[i][7])};
                    const float dt = softplus_f(B.gates[(m0 + tok0 + i) * 16 + 12 + h] + dtb_h);
#pragma unroll
                    for (int j = 0; j < 8; ++j) v[i][j] *= dt; }
            }
            unsigned P[8][4];
#pragma unroll
            for (int i = 0; i < 8; ++i)
#pragma unroll
                for (int j = 0; j < 4; ++j) P[i][j] = cvtpk(v[i][2 * j], v[i][2 * j + 1]);
            bf16* rm = nullptr;
            if (kind == 3) rm = B.ql + (0 * (size_t)M + m0) * 256 + h * 64; else if (kind == 4) rm = B.kl + (0 * (size_t)M + m0) * 256 + h * 64;
            else if (kind == 5) rm = B.ql + (1 * (size_t)M + m0) * 256 + h * 64; else if (kind == 6) rm = B.kl + (1 * (size_t)M + m0) * 256 + h * 64;
            else if (kind == 8) rm = B.kl + (2 * (size_t)M + m0) * 256 + h * 64; else if (kind == 9) rm = B.ql + (2 * (size_t)M + m0) * 256 + h * 64;
            if (rm) {
#pragma unroll
                for (int i = 0; i < 8; ++i) *(GAS v4u*)(rm + (size_t)(tok0 + i) * 256 + 8 * cg) = (v4u){P[i][0], P[i][1], P[i][2], P[i][3]};
            }
            bf16* tr = nullptr;
            if (kind == 0) tr = B.vtf + ((size_t)(b * 4 + h) * 64) * SEQ;
            else if (kind == 1) tr = B.vtl + (((size_t)(0 * BATCH + b) * 4 + h) * 96) * SEQ;
            else if (kind == 2) tr = B.vtl + (((size_t)(1 * BATCH + b) * 4 + h) * 96) * SEQ;
            else if (kind == 7) tr = B.vtl + (((size_t)(2 * BATCH + b) * 4 + h) * 96) * SEQ;
            else if (kind == 4) tr = B.kt + (((size_t)(0 * BATCH + b) * 4 + h) * 64) * SEQ;
            else if (kind == 6) tr = B.kt + (((size_t)(1 * BATCH + b) * 4 + h) * 64) * SEQ;
            else if (kind == 8) tr = B.kt + (((size_t)(2 * BATCH + b) * 4 + h) * 64) * SEQ;
            if (tr) {
                tr += s0 + tok0;
#pragma unroll
                for (int j = 0; j < 8; ++j) { v4u o;
#pragma unroll
                    for (int ip = 0; ip < 4; ++ip) o[ip] = (j & 1) ? ((P[2 * ip][j >> 1] >> 16) | (P[2 * ip + 1][j >> 1] & 0xffff0000u)) : ((P[2 * ip][j >> 1] & 0xffffu) | (P[2 * ip + 1][j >> 1] << 16));
                    *(GAS v4u*)(tr + (size_t)(8 * cg + j) * SEQ) = o; }
                if (kind == 1 && cg < 4) {
#pragma unroll
                    for (int j = 0; j < 8; ++j) { const unsigned w = (cg == 0 && j == 0) ? 0x3f803f80u : 0u; *(GAS v4u*)(tr + (size_t)(64 + 8 * cg + j) * SEQ) = (v4u){w, w, w, w}; }
                }
            }
        } else {
            const int gj = job - 36, mixer = gj >> 2, h = gj & 3;
            const size_t m = m0 + lane;
            if (mixer == 0) {
                const float cum = wave_scan_add(log_sigmoid_f(B.gates[m * 16 + h] + W.fox_fb[h]), lane);
                B.lcum[(size_t)(b * 4 + h) * SEQ + s0 + lane] = cum; if (lane == 63) B.ctot[(b * 4 + h) * 32 + c] = cum;
            } else {
                const int mx = mixer - 1; const size_t ci = ((size_t)(mx * BATCH + b) * 4 + h) * SEQ + s0 + lane; const int si = ((mx * BATCH + b) * 4 + h) * 32 + c;
                if (mx == 0) {
                    const float bb = wave_scan_add(log_sigmoid_f(B.gates[m * 16 + 8 + h] + W.mfb[h]), lane), ic = B.gates[m * 16 + 4 + h] + W.mib[h], be = bb - ic, pm = wave_scan_max(-be, lane);
                    B.a1[ci] = bb; B.a2[ci] = bb + pm; B.beta[ci] = be; if (lane == 63) { B.s1[si] = bb; B.s2[si] = bb + pm; }
                } else if (mx == 1) {
                    const float lg = log1pf(-exp2f(-5.0f - (float)h)), v = (float)(lane + 1) * lg;
                    B.a1[ci] = v; B.a2[ci] = 0.f; B.beta[ci] = v; if (lane == 63) { B.s1[si] = v; B.s2[si] = 0.f; }
                } else {
                    const float dt = softplus_f(B.gates[m * 16 + 12 + h] + W.dtb[h]), cum = wave_scan_add(dt * (-__expf(W.alog[h])), lane);
                    B.a1[ci] = cum; B.a2[ci] = 0.f; B.beta[ci] = cum; if (lane == 63) { B.s1[si] = cum; B.s2[si] = 0.f; }
                }
            }
        }
    }
}

__device__ __forceinline__ int sig32(int i) { return (i & ~0xC) | ((i & 4) << 1) | ((i & 8) >> 1); }
#define GLDS16(gp, lp) __builtin_amdgcn_global_load_lds((const unsigned*)(gp), (LAS unsigned*)(lp), 16, 0, 0)
#define VMWAIT(n) asm volatile("s_waitcnt vmcnt(" #n ")" ::: "memory")
#define WGBAR() do { asm volatile("" ::: "memory"); __builtin_amdgcn_s_barrier(); asm volatile("" ::: "memory"); } while (0)
constexpr int FOX_SLOT = 16384, FOX_LC = 3 * FOX_SLOT;
__device__ __forceinline__ void fox_wg_unit(const MixBufs& B, bf16* ybf, LAS unsigned char* lds, int b, int h, int qb8, int wave, int lane) {
    const int col = lane & 31, hi = lane >> 5, t0 = 256 * qb8 + 32 * wave;
    const size_t rowq = (size_t)b * SEQ + t0 + col;
    bf16x8 qf[4];
#pragma unroll
    for (int ks = 0; ks < 4; ++ks) qf[ks] = *(const bf16x8*)(B.proj + rowq * PROJ_LD + PC_FQ + h * 64 + 16 * ks + 8 * hi);
    float offv; { const float cv = (lane < 32) ? B.ctot[(b * 4 + h) * 32 + lane] : 0.f; offv = wave_scan_add(cv, lane) - cv; }
    if (wave <= qb8) GLDS16(B.lcum + (size_t)(b * 4 + h) * SEQ + 256 * wave + 4 * lane, lds + FOX_LC + 1024 * wave);
    const bf16* ksrc = B.proj + ((size_t)b * SEQ + 32 * (wave >> 2) + sig32(col)) * PROJ_LD + PC_FK + h * 64 + 16 * (wave & 3) + 8 * hi;
    const bf16* vsrc = B.vtf + ((size_t)(b * 4 + h) * 64 + 32 * (wave >> 2) + col) * SEQ + 16 * (wave & 3) + 8 * hi;
    const int nkt = 4 * (qb8 + 1), tdiag = 4 * qb8 + (wave >> 1);
#define FOX_ISSUE(t, slot) do { GLDS16(ksrc + (size_t)(64 * (t)) * PROJ_LD, lds + (slot) * FOX_SLOT + 1024 * wave); GLDS16(vsrc + 64 * (t), lds + (slot) * FOX_SLOT + 8192 + 1024 * wave); } while (0)
    VMWAIT(0); WGBAR();
    if (wave <= qb8) {
        LAS f32x4* lp = (LAS f32x4*)(lds + FOX_LC + 1024 * wave) + lane; const f32x4 cv = *lp;
        const float o = __shfl(offv, 4 * wave + (lane >> 4));
        *lp = (cv + o) * (-LOG2E);
    }
    asm volatile("s_waitcnt lgkmcnt(0)" ::: "memory"); WGBAR();
    FOX_ISSUE(0, 0); FOX_ISSUE(1, 1);
    float mrun = -INFINITY, lsum = 0.f; f32x16 O0, O1;
#pragma unroll
    for (int r = 0; r < 16; ++r) { O0[r] = 0.f; O1[r] = 0.f; }
    int slot = 0;
    for (int kt = 0; kt < nkt; ++kt) {
        VMWAIT(2); WGBAR();
        { const int tn = (kt + 2 < nkt) ? kt + 2 : nkt - 1; const int sn = (slot == 0) ? 2 : slot - 1; FOX_ISSUE(tn, sn); }
        if (kt <= tdiag) {
            const int s0 = 64 * kt;
            const LAS unsigned char* sp = lds + slot * FOX_SLOT + 16 * lane;
            const LAS float* lc = (const LAS float*)(lds + FOX_LC) + s0 + 8 * hi;
            f32x16 S0, S1;
#pragma unroll
            for (int j = 0; j < 4; ++j) { const f32x4 c0 = *(const LAS f32x4*)(lc + 16 * j), c1 = *(const LAS f32x4*)(lc + 16 * j + 4);
#pragma unroll
                for (int i = 0; i < 4; ++i) { if (j < 2) { S0[8 * j + i] = c0[i]; S0[8 * j + 4 + i] = c1[i]; } else { S1[8 * (j - 2) + i] = c0[i]; S1[8 * (j - 2) + 4 + i] = c1[i]; } } }
#pragma unroll
            for (int ks = 0; ks < 4; ++ks) { S0 = MFMA32(*(const LAS bf16x8*)(sp + ks * 1024), qf[ks], S0); S1 = MFMA32(*(const LAS bf16x8*)(sp + (4 + ks) * 1024), qf[ks], S1); }
            if (kt == tdiag) {
                const int tq = t0 + col - s0;
#pragma unroll
                for (int r = 0; r < 16; ++r) { const int sl = 16 * (r >> 3) + 8 * hi + (r & 7); if (sl > tq) S0[r] = -INFINITY; if (sl + 32 > tq) S1[r] = -INFINITY; }
            }
            float mloc = fmaxf(fmax16(S0), fmax16(S1)); mloc = fmaxf(mloc, __shfl_xor(mloc, 32));
            const float mnew = fmaxf(mrun, mloc), alpha = __builtin_amdgcn_exp2f(mrun - mnew); mrun = mnew;
            float psum = 0.f;
#pragma unroll
            for (int r = 0; r < 16; ++r) { S0[r] = __builtin_amdgcn_exp2f(S0[r] - mnew); S1[r] = __builtin_amdgcn_exp2f(S1[r] - mnew); psum += S0[r] + S1[r]; }
            lsum = lsum * alpha + psum;
#pragma unroll
            for (int r = 0; r < 16; ++r) { O0[r] *= alpha; O1[r] *= alpha; }
            { const bf16x8 p00 = pack8<0>(S0), p01 = pack8<1>(S0), p10 = pack8<0>(S1), p11 = pack8<1>(S1);
              const LAS unsigned char* vp = sp + 8192;
              O0 = MFMA32(*(const LAS bf16x8*)(vp), p00, O0); O0 = MFMA32(*(const LAS bf16x8*)(vp + 1024), p01, O0); O0 = MFMA32(*(const LAS bf16x8*)(vp + 2048), p10, O0); O0 = MFMA32(*(const LAS bf16x8*)(vp + 3072), p11, O0);
              O1 = MFMA32(*(const LAS bf16x8*)(vp + 4096), p00, O1); O1 = MFMA32(*(const LAS bf16x8*)(vp + 5120), p01, O1); O1 = MFMA32(*(const LAS bf16x8*)(vp + 6144), p10, O1); O1 = MFMA32(*(const LAS bf16x8*)(vp + 7168), p11, O1); }
        }
        asm volatile("" ::: "memory");
        slot = (slot == 2) ? 0 : slot + 1;
    }
#undef FOX_ISSUE
    const float rl = 1.0f / (lsum + __shfl_xor(lsum, 32));
    bf16* yp = ybf + rowq * DM + h * 64 + 4 * hi;
#pragma unroll
    for (int g = 0; g < 4; ++g) { *(unsigned long long*)(yp + 8 * g) = (unsigned long long)cvtpk(O0[4 * g] * rl, O0[4 * g + 1] * rl) | ((unsigned long long)cvtpk(O0[4 * g + 2] * rl, O0[4 * g + 3] * rl) << 32);
                                  *(unsigned long long*)(yp + 32 + 8 * g) = (unsigned long long)cvtpk(O1[4 * g] * rl, O1[4 * g + 1] * rl) | ((unsigned long long)cvtpk(O1[4 * g + 2] * rl, O1[4 * g + 3] * rl) << 32); }
    VMWAIT(0); WGBAR();
}

constexpr int LIN_BUF = 30720, LIN_STF = 3 * LIN_BUF;
__device__ __forceinline__ void lin_wg_unit(const MixBufs& B, LAS unsigned char* lbuf, int mx, int b, int h, int es, int wave, int lane) {
    const int col = lane & 31, hi = lane >> 5, hk = (mx == 2) ? (h >> 1) : h; const bool ml = (mx == 0);
    const size_t cbase = (((size_t)mx * BATCH + b) * 4 + h) * SEQ; const int sbase = ((mx * BATCH + b) * 4 + h) * 32;
    if (wave >= 1 && wave <= 4) {
        const bf16* src; size_t step_c, step_hi, step_lo; int np, f0;
        if (wave == 1)      { src = B.ql + ((size_t)mx * M + (size_t)b * SEQ + col) * 256 + hk * 64 + 8 * hi;            step_c = 64 * 256; step_hi = 32 * 256; step_lo = 16; np = 8; f0 = 0; }
        else if (wave == 2) { src = B.kl + ((size_t)mx * M + (size_t)b * SEQ + sig32(col)) * 256 + hk * 64 + 8 * hi;     step_c = 64 * 256; step_hi = 32 * 256; step_lo = 16; np = 8; f0 = 8; }
        else if (wave == 3) { src = B.kt + ((((size_t)mx * BATCH + b) * 4 + hk) * 64 + sig32(col)) * SEQ + 8 * hi;      step_c = 64; step_hi = (size_t)32 * SEQ; step_lo = 16; np = 8; f0 = 16; }
        else                { src = B.vtl + ((((size_t)mx * BATCH + b) * 4 + h) * 96 + 32 * es + col) * SEQ + 8 * hi;   step_c = 64; step_hi = 0; step_lo = 16; np = 4; f0 = 24; }
        const int cl = lane & 15; const bool sc_lane = (lane == 48 || lane == 49);
        const float* cfp = (lane < 16) ? B.a1 + cbase + 4 * cl : (lane < 32) ? B.a2 + cbase + 4 * cl : (lane < 48) ? B.beta + cbase + 4 * cl : (lane == 48) ? B.s1 + sbase : (lane == 49) ? B.s2 + sbase : B.a1 + cbase;
#define LIN_ISSUE(c, bi) do { LAS unsigned char* bb_ = lbuf + (bi) * LIN_BUF + f0 * 1024; const bf16* sc_ = src + (size_t)(c) * step_c; \
            _Pragma("unroll") for (int f = 0; f < 8; ++f) if (f < np) GLDS16(sc_ + (size_t)(f >> 2) * step_hi + (size_t)(f & 3) * step_lo, bb_ + f * 1024); \
            if (wave == 4) GLDS16(cfp + (sc_lane ? 4 * ((c) >> 2) : 64 * (c)), lbuf + (bi) * LIN_BUF + 28 * 1024); } while (0)
        LIN_ISSUE(0, 0); LIN_ISSUE(1, 1);
        if (wave == 4) VMWAIT(5); else VMWAIT(8);
        WGBAR();
        int bi = 2;
        for (int c = 0; c < 32; ++c) {
            const int cc = (c + 2 < 32) ? c + 2 : 31;
            LIN_ISSUE(cc, bi);
            if (wave == 4) VMWAIT(5); else VMWAIT(8);
            WGBAR();
            bi = (bi == 2) ? 0 : bi + 1;
        }
#undef LIN_ISSUE
        VMWAIT(0);
    } else if (wave == 0 || wave == 5) {
        const int tt = (wave == 5) ? 1 : 0;
        float mst = 0.f; int bi = 0;
        WGBAR();
        for (int c = 0; c < 32; ++c) {
            const int s0 = 64 * c;
            const LAS unsigned char* bp = lbuf + bi * LIN_BUF + 16 * lane;
            const LAS unsigned char* sf = lbuf + LIN_STF + (c & 1) * 4096 + 16 * lane;
            const LAS float* cf = (const LAS float*)(lbuf + bi * LIN_BUF + 28 * 1024);
#define LFR(f) (*(const LAS bf16x8*)(bp + (f) * 1024))
            const float S1v = cf[192 + (c & 3)], S2v = cf[196 + (c & 3)];
            float mnew = 0.f;
            if (ml) mnew = fmaxf(S1v + mst, S2v);
            const float a1 = cf[32 * tt + col]; float al = a1, rho = a1, mt = 0.f;
            if (ml) { mt = fmaxf(a1 + mst, cf[64 + 32 * tt + col]); al = a1 - mt; rho = a1 + mst - mt; }
            f32x16 y;
#pragma unroll
            for (int r = 0; r < 16; ++r) y[r] = 0.f;
#pragma unroll
            for (int j = 0; j < 4; ++j) y = MFMA32(*(const LAS bf16x8*)(sf + j * 1024), LFR(tt * 4 + j), y);
            const float er = __expf(rho);
#pragma unroll
            for (int r = 0; r < 16; ++r) y[r] *= er;
            for (int st = 0; st <= tt; ++st) {
                f32x4 bD[2][2];
#pragma unroll
                for (int k = 0; k < 2; ++k) { bD[k][0] = *(const LAS f32x4*)(cf + 128 + 16 * (2 * st + k) + 8 * hi); bD[k][1] = *(const LAS f32x4*)(cf + 128 + 16 * (2 * st + k) + 8 * hi + 4); }
                f32x16 p;
#pragma unroll
                for (int r = 0; r < 16; ++r) p[r] = 0.f;
#pragma unroll
                for (int ks = 0; ks < 4; ++ks) p = MFMA32(LFR(8 + st * 4 + ks), LFR(tt * 4 + ks), p);
#pragma unroll
                for (int r = 0; r < 16; ++r) { float v = p[r] * __expf(al - bD[r >> 3][(r >> 2) & 1][r & 3]); if (st == tt && (16 * (r >> 3) + 8 * hi + (r & 7)) > col) v = 0.f; p[r] = v; }
                y = MFMA32(LFR(24 + 2 * st), pack8<0>(p), y); y = MFMA32(LFR(24 + 2 * st + 1), pack8<1>(p), y);
            }
            { const size_t row = (size_t)b * SEQ + s0 + 32 * tt + col;
              if (es < 2) { bf16* yp = (bf16*)B.yraw + row * 1024 + 256 * (mx + 1) + h * 64 + 32 * es + 4 * hi;
#pragma unroll
                  for (int g = 0; g < 4; ++g) *(unsigned long long*)(yp + 8 * g) = (unsigned long long)cvtpk(y[4 * g], y[4 * g + 1]) | ((unsigned long long)cvtpk(y[4 * g + 2], y[4 * g + 3]) << 32); }
              else if (hi == 0) { B.den[row * 8 + h * 2] = y[0]; B.den[row * 8 + h * 2 + 1] = mt; } }
#undef LFR
            if (ml) mst = mnew;
            asm volatile("s_waitcnt lgkmcnt(0)" ::: "memory");
            WGBAR();
            bi = (bi == 2) ? 0 : bi + 1;
        }
    } else if (wave == 6) {
        f32x16 st0, st1;
#pragma unroll
        for (int r = 0; r < 16; ++r) { st0[r] = 0.f; st1[r] = 0.f; }
        { LAS unsigned char* sf = lbuf + LIN_STF + 16 * lane;
#pragma unroll
          for (int j = 0; j < 4; ++j) *(LAS v4u*)(sf + j * 1024) = (v4u){0u, 0u, 0u, 0u}; }
        float mst = 0.f; int bi = 0;
        asm volatile("s_waitcnt lgkmcnt(0)" ::: "memory");
        WGBAR();
        for (int c = 0; c < 32; ++c) {
            const LAS unsigned char* bp = lbuf + bi * LIN_BUF + 16 * lane;
            const LAS float* cf = (const LAS float*)(lbuf + bi * LIN_BUF + 28 * 1024);
#define LFR(f) (*(const LAS bf16x8*)(bp + (f) * 1024))
            const float S1v = cf[192 + (c & 3)], S2v = cf[196 + (c & 3)];
            float gam = S1v, dlt = S1v, mnew = 0.f;
            if (ml) { mnew = fmaxf(S1v + mst, S2v); gam = S1v - mnew; dlt = S1v + mst - mnew; }
            const float ed = __expf(dlt);
#pragma unroll
            for (int r = 0; r < 16; ++r) { st0[r] *= ed; st1[r] *= ed; }
#pragma unroll
            for (int k4 = 0; k4 < 4; ++k4) {
                const bf16x8 vr = LFR(24 + k4); const f32x4 b0 = *(const LAS f32x4*)(cf + 128 + 16 * k4 + 8 * hi), b1 = *(const LAS f32x4*)(cf + 128 + 16 * k4 + 8 * hi + 4);
                v4u wv; wv.x = cvtpk(bf2f((unsigned short)vr[0]) * __expf(gam - b0[0]), bf2f((unsigned short)vr[1]) * __expf(gam - b0[1])); wv.y = cvtpk(bf2f((unsigned short)vr[2]) * __expf(gam - b0[2]), bf2f((unsigned short)vr[3]) * __expf(gam - b0[3]));
                wv.z = cvtpk(bf2f((unsigned short)vr[4]) * __expf(gam - b1[0]), bf2f((unsigned short)vr[5]) * __expf(gam - b1[1])); wv.w = cvtpk(bf2f((unsigned short)vr[6]) * __expf(gam - b1[2]), bf2f((unsigned short)vr[7]) * __expf(gam - b1[3]));
                const bf16x8 wvf = __builtin_bit_cast(bf16x8, wv);
                st0 = MFMA32(LFR(16 + k4), wvf, st0); st1 = MFMA32(LFR(20 + k4), wvf, st1);
            }
#undef LFR
            { LAS unsigned char* sf = lbuf + LIN_STF + ((c + 1) & 1) * 4096 + 16 * lane;
              *(LAS bf16x8*)(sf) = pack8<0>(st0); *(LAS bf16x8*)(sf + 1024) = pack8<1>(st0); *(LAS bf16x8*)(sf + 2048) = pack8<0>(st1); *(LAS bf16x8*)(sf + 3072) = pack8<1>(st1); }
            if (ml) mst = mnew;
            asm volatile("s_waitcnt lgkmcnt(0)" ::: "memory");
            WGBAR();
            bi = (bi == 2) ? 0 : bi + 1;
        }
    } else {
        for (int c = 0; c < 33; ++c) WGBAR();
    }
    VMWAIT(0); WGBAR();
}
constexpr int MX_LC = 3 * 16384, MX_LIN = MX_LC + 8192, MX_STF = MX_LIN + 3 * LIN_BUF;
static_assert(MX_STF + 8192 <= LDSCTL_OFF, "mixer LDS map");
__device__ __forceinline__ void mixer_phase(const MixBufs& B, bf16* ybf, LAS unsigned char* lds, int vcu, int wave, int lane) {
    const int G = gridDim.x;
    const int col = lane & 31, hi = lane >> 5;
    for (int v = vcu; v < 256; v += G) {
        const int bh = v >> 3, i8 = v & 7, fb = bh >> 2, fh = bh & 3;
        const int nktA = 2 * i8 + 2, NF = 34;
        const bool has_lin = i8 < 7; const int lj = (bh & 3) * 7 + i8;
        int mx, lh, es; const int lb = fb; if (lj < 12) { mx = 0; lh = lj / 3; es = lj % 3; } else { const int w2 = lj - 12; mx = 1 + (w2 >> 3); lh = (w2 >> 1) & 3; es = w2 & 1; }
        const int hk = (mx == 2) ? (lh >> 1) : lh; const bool ml = (mx == 0);
        const size_t cbase = (((size_t)mx * BATCH + lb) * 4 + lh) * SEQ; const int sbase = ((mx * BATCH + lb) * 4 + lh) * 32;
        if (wave < 4) {
            int qb16 = i8, t0 = 128 * qb16 + 32 * wave, tdiag = 2 * qb16 + (wave >> 1);
            size_t rowq = (size_t)fb * SEQ + t0 + col;
            bf16x8 qf[4];
#pragma unroll
            for (int ks = 0; ks < 4; ++ks) qf[ks] = *(const bf16x8*)(B.proj + rowq * PROJ_LD + PC_FQ + fh * 64 + 16 * ks + 8 * hi);
            float offv; { const float cv = (lane < 32) ? B.ctot[(fb * 4 + fh) * 32 + lane] : 0.f; offv = wave_scan_add(cv, lane) - cv; }
            GLDS16(B.lcum + (size_t)(fb * 4 + fh) * SEQ + 256 * wave + 4 * lane, lds + MX_LC + 1024 * wave);
            GLDS16(B.lcum + (size_t)(fb * 4 + fh) * SEQ + 256 * (wave + 4) + 4 * lane, lds + MX_LC + 1024 * (wave + 4));
            const bf16* ksrc = B.proj + ((size_t)fb * SEQ + sig32(col)) * PROJ_LD + PC_FK + fh * 64 + 16 * wave + 8 * hi;
            const bf16* vsrc = B.vtf + ((size_t)(fb * 4 + fh) * 64 + col) * SEQ + 16 * wave + 8 * hi;
#define FOX_ISSUE(kt, slot) do { LAS unsigned char* d_ = lds + (slot) * FOX_SLOT + 1024 * wave; const bf16* k_ = ksrc + (size_t)(64 * (kt)) * PROJ_LD; const bf16* v_ = vsrc + 64 * (kt); \
                GLDS16(k_, d_); GLDS16(k_ + (size_t)32 * PROJ_LD, d_ + 4096); GLDS16(v_, d_ + 8192); GLDS16(v_ + (size_t)32 * SEQ, d_ + 12288); } while (0)
            FOX_ISSUE(0, 0); FOX_ISSUE(1, 1);
            VMWAIT(8); WGBAR();
#pragma unroll
            for (int pz = 0; pz < 2; ++pz) { const int pc_ = wave + 4 * pz;
                LAS f32x4* lp = (LAS f32x4*)(lds + MX_LC + 1024 * pc_) + lane; const f32x4 cv = *lp; const float o = __shfl(offv, 4 * pc_ + (lane >> 4)); *lp = (cv + o) * (-LOG2E); }
            asm volatile("s_waitcnt lgkmcnt(0)" ::: "memory"); WGBAR();
            float mrun = -INFINITY, lsum = 0.f; f32x16 O0, O1;
#pragma unroll
            for (int r = 0; r < 16; ++r) { O0[r] = 0.f; O1[r] = 0.f; }
            int sl = 0;
            for (int f = 0; f < NF; ++f) {
                if (f + 1 < NF) VMWAIT(4); else VMWAIT(0);
                WGBAR();
                if (f + 2 < NF) { const int kn = (f + 2 < nktA) ? f + 2 : f + 2 - nktA; FOX_ISSUE(kn, (sl == 0) ? 2 : sl - 1); }
                if (f == nktA) {
                    const float rl = 1.0f / (lsum + __shfl_xor(lsum, 32));
                    bf16* yp = ybf + rowq * DM + fh * 64 + 4 * hi;
#pragma unroll
                    for (int g = 0; g < 4; ++g) { *(unsigned long long*)(yp + 8 * g) = (unsigned long long)cvtpk(O0[4 * g] * rl, O0[4 * g + 1] * rl) | ((unsigned long long)cvtpk(O0[4 * g + 2] * rl, O0[4 * g + 3] * rl) << 32);
                                                  *(unsigned long long*)(yp + 32 + 8 * g) = (unsigned long long)cvtpk(O1[4 * g] * rl, O1[4 * g + 1] * rl) | ((unsigned long long)cvtpk(O1[4 * g + 2] * rl, O1[4 * g + 3] * rl) << 32); }
                    qb16 = 15 - i8; t0 = 128 * qb16 + 32 * wave; tdiag = 2 * qb16 + (wave >> 1); rowq = (size_t)fb * SEQ + t0 + col;
#pragma unroll
                    for (int ks = 0; ks < 4; ++ks) qf[ks] = *(const bf16x8*)(B.proj + rowq * PROJ_LD + PC_FQ + fh * 64 + 16 * ks + 8 * hi);
                    mrun = -INFINITY; lsum = 0.f;
#pragma unroll
                    for (int r = 0; r < 16; ++r) { O0[r] = 0.f; O1[r] = 0.f; }
                }
                const int kt = (f < nktA) ? f : f - nktA;
                if (kt <= tdiag) {
                    const int s0 = 64 * kt;
                    const LAS unsigned char* sp = lds + sl * FOX_SLOT + 16 * lane;
                    const LAS float* lc = (const LAS float*)(lds + MX_LC) + s0 + 8 * hi;
                    f32x16 S0, S1;
#pragma unroll
                    for (int j = 0; j < 4; ++j) { const f32x4 c0 = *(const LAS f32x4*)(lc + 16 * j), c1 = *(const LAS f32x4*)(lc + 16 * j + 4);
#pragma unroll
                        for (int i = 0; i < 4; ++i) { if (j < 2) { S0[8 * j + i] = c0[i]; S0[8 * j + 4 + i] = c1[i]; } else { S1[8 * (j - 2) + i] = c0[i]; S1[8 * (j - 2) + 4 + i] = c1[i]; } } }
#pragma unroll
                    for (int ks = 0; ks < 4; ++ks) { S0 = MFMA32(*(const LAS bf16x8*)(sp + ks * 1024), qf[ks], S0); S1 = MFMA32(*(const LAS bf16x8*)(sp + (4 + ks) * 1024), qf[ks], S1); }
                    if (kt == tdiag) {
                        const int tq = t0 + col - s0;
#pragma unroll
                        for (int r = 0; r < 16; ++r) { const int sl = 16 * (r >> 3) + 8 * hi + (r & 7); if (sl > tq) S0[r] = -INFINITY; if (sl + 32 > tq) S1[r] = -INFINITY; }
                    }
                    float mloc = fmaxf(fmax16(S0), fmax16(S1)); mloc = fmaxf(mloc, __shfl_xor(mloc, 32));
                    const float mnew = fmaxf(mrun, mloc), alpha = __builtin_amdgcn_exp2f(mrun - mnew); mrun = mnew;
                    float psum = 0.f;
#pragma unroll
                    for (int r = 0; r < 16; ++r) { S0[r] = __builtin_amdgcn_exp2f(S0[r] - mnew); S1[r] = __builtin_amdgcn_exp2f(S1[r] - mnew); psum += S0[r] + S1[r]; }
                    lsum = lsum * alpha + psum;
#pragma unroll
                    for (int r = 0; r < 16; ++r) { O0[r] *= alpha; O1[r] *= alpha; }
                    { const bf16x8 p00 = pack8<0>(S0), p01 = pack8<1>(S0), p10 = pack8<0>(S1), p11 = pack8<1>(S1);
                      const LAS unsigned char* vp = sp + 8192;
                      O0 = MFMA32(*(const LAS bf16x8*)(vp), p00, O0); O0 = MFMA32(*(const LAS bf16x8*)(vp + 1024), p01, O0); O0 = MFMA32(*(const LAS bf16x8*)(vp + 2048), p10, O0); O0 = MFMA32(*(const LAS bf16x8*)(vp + 3072), p11, O0);
                      O1 = MFMA32(*(const LAS bf16x8*)(vp + 4096), p00, O1); O1 = MFMA32(*(const LAS bf16x8*)(vp + 5120), p01, O1); O1 = MFMA32(*(const LAS bf16x8*)(vp + 6144), p10, O1); O1 = MFMA32(*(const LAS bf16x8*)(vp + 7168), p11, O1); }
                }
                asm volatile("s_waitcnt lgkmcnt(0)" ::: "memory");
                sl = (sl == 2) ? 0 : sl + 1;
            }
#undef FOX_ISSUE
            { const float rl = 1.0f / (lsum + __shfl_xor(lsum, 32));
              bf16* yp = ybf + rowq * DM + fh * 64 + 4 * hi;
#pragma unroll
              for (int g = 0; g < 4; ++g) { *(unsigned long long*)(yp + 8 * g) = (unsigned long long)cvtpk(O0[4 * g] * rl, O0[4 * g + 1] * rl) | ((unsigned long long)cvtpk(O0[4 * g + 2] * rl, O0[4 * g + 3] * rl) << 32);
                                            *(unsigned long long*)(yp + 32 + 8 * g) = (unsigned long long)cvtpk(O1[4 * g] * rl, O1[4 * g + 1] * rl) | ((unsigned long long)cvtpk(O1[4 * g + 2] * rl, O1[4 * g + 3] * rl) << 32); } }
        } else {
            const bf16* src; size_t step_c, step_hi; int np, f0;
            if (wave == 4)      { src = B.ql + ((size_t)mx * M + (size_t)lb * SEQ + col) * 256 + hk * 64 + 8 * hi;            step_c = 64 * 256; step_hi = 32 * 256; np = 8; f0 = 0; }
            else if (wave == 6) { src = B.kt + ((((size_t)mx * BATCH + lb) * 4 + hk) * 64 + sig32(col)) * SEQ + 8 * hi;      step_c = 64; step_hi = (size_t)32 * SEQ; np = 8; f0 = 16; }
            else if (wave == 7) { src = B.vtl + ((((size_t)mx * BATCH + lb) * 4 + lh) * 96 + 32 * es + col) * SEQ + 8 * hi;  step_c = 64; step_hi = 0; np = 4; f0 = 24; }
            else                { src = B.ql; step_c = 0; step_hi = 0; np = 0; f0 = 0; }
            const bf16* srck = B.kl + ((size_t)mx * M + (size_t)lb * SEQ + sig32(col)) * 256 + hk * 64 + 8 * hi;
            const int cl = lane & 15; const bool sc_lane = (lane == 48 || lane == 49);
            const float* cfp = (lane < 16) ? B.a1 + cbase + 4 * cl : (lane < 32) ? B.a2 + cbase + 4 * cl : (lane < 48) ? B.beta + cbase + 4 * cl : (lane == 48) ? B.s1 + sbase : (lane == 49) ? B.s2 + sbase : B.a1 + cbase;
            LAS unsigned char* lbuf = lds + MX_LIN;
#define LIN_ISSUE(c, bi) do { LAS unsigned char* bb_ = lbuf + (bi) * LIN_BUF + f0 * 1024; const bf16* sc_ = src + (size_t)(c) * step_c; \
                _Pragma("unroll") for (int f = 0; f < 8; ++f) if (f < np) GLDS16(sc_ + (size_t)(f >> 2) * step_hi + (size_t)(f & 3) * 16, bb_ + f * 1024); \
                if (wave == 7) { const bf16* sk_ = srck + (size_t)(c) * (64 * 256); LAS unsigned char* bk_ = lbuf + (bi) * LIN_BUF + 8 * 1024; \
                    _Pragma("unroll") for (int f = 0; f < 8; ++f) GLDS16(sk_ + (size_t)(f >> 2) * (32 * 256) + (size_t)(f & 3) * 16, bk_ + f * 1024); \
                    GLDS16(cfp + (sc_lane ? 4 * ((c) >> 2) : 64 * (c)), lbuf + (bi) * LIN_BUF + 28 * 1024); } } while (0)
            if (has_lin) { LIN_ISSUE(0, 0); LIN_ISSUE(1, 1); }
            f32x16 st0, st1;
#pragma unroll
            for (int r = 0; r < 16; ++r) { st0[r] = 0.f; st1[r] = 0.f; }
            if (wave == 6) { LAS unsigned char* sf = lds + MX_STF + 16 * lane;
#pragma unroll
                for (int j = 0; j < 4; ++j) *(LAS v4u*)(sf + j * 1024) = (v4u){0u, 0u, 0u, 0u}; }
            asm volatile("s_waitcnt lgkmcnt(0)" ::: "memory"); WGBAR();
            WGBAR();
            float mst = 0.f; int bi = 0;
            for (int c = 0; c < NF; ++c) {
                if (c + 1 < 32) { if (wave == 7) VMWAIT(13); else if (wave == 5) VMWAIT(0); else VMWAIT(8); } else VMWAIT(0);
                WGBAR();
                if (has_lin && c < 32) {
                    if (c + 2 < 32) LIN_ISSUE(c + 2, (bi == 0) ? 2 : bi - 1);
                    const LAS unsigned char* bp = lbuf + bi * LIN_BUF + 16 * lane;
                    const LAS float* cf = (const LAS float*)(lbuf + bi * LIN_BUF + 28 * 1024);
#define LFR(f) (*(const LAS bf16x8*)(bp + (f) * 1024))
                    if (wave == 4 || wave == 5) {
                        const int tt = wave - 4, s0 = 64 * c;
                        const LAS unsigned char* sf = lds + MX_STF + (c & 1) * 4096 + 16 * lane;
                        const float S1v = cf[192 + (c & 3)], S2v = cf[196 + (c & 3)];
                        float mnew = 0.f;
                        if (ml) mnew = fmaxf(S1v + mst, S2v);
                        const float a1 = cf[32 * tt + col]; float al = a1, rho = a1, mt = 0.f;
                        if (ml) { mt = fmaxf(a1 + mst, cf[64 + 32 * tt + col]); al = a1 - mt; rho = a1 + mst - mt; }
                        f32x16 y;
#pragma unroll
                        for (int r = 0; r < 16; ++r) y[r] = 0.f;
#pragma unroll
                        for (int j = 0; j < 4; ++j) y = MFMA32(*(const LAS bf16x8*)(sf + j * 1024), LFR(tt * 4 + j), y);
                        const float er = __expf(rho);
#pragma unroll
                        for (int r = 0; r < 16; ++r) y[r] *= er;
                        for (int st = 0; st <= tt; ++st) {
                            f32x4 bD[2][2];
#pragma unroll
                            for (int k = 0; k < 2; ++k) { bD[k][0] = *(const LAS f32x4*)(cf + 128 + 16 * (2 * st + k) + 8 * hi); bD[k][1] = *(const LAS f32x4*)(cf + 128 + 16 * (2 * st + k) + 8 * hi + 4); }
                            f32x16 p;
#pragma unroll
                            for (int r = 0; r < 16; ++r) p[r] = 0.f;
#pragma unroll
                            for (int ks = 0; ks < 4; ++ks) p = MFMA32(LFR(8 + st * 4 + ks), LFR(tt * 4 + ks), p);
#pragma unroll
                            for (int r = 0; r < 16; ++r) { float vv = p[r] * __expf(al - bD[r >> 3][(r >> 2) & 1][r & 3]); if (st == tt && (16 * (r >> 3) + 8 * hi + (r & 7)) > col) vv = 0.f; p[r] = vv; }
                            y = MFMA32(LFR(24 + 2 * st), pack8<0>(p), y); y = MFMA32(LFR(24 + 2 * st + 1), pack8<1>(p), y);
                        }
                        { const size_t row = (size_t)lb * SEQ + s0 + 32 * tt + col;
                          if (es < 2) { bf16* yp = (bf16*)B.yraw + row * 1024 + 256 * (mx + 1) + lh * 64 + 32 * es + 4 * hi;
#pragma unroll
                              for (int g = 0; g < 4; ++g) *(unsigned long long*)(yp + 8 * g) = (unsigned long long)cvtpk(y[4 * g], y[4 * g + 1]) | ((unsigned long long)cvtpk(y[4 * g + 2], y[4 * g + 3]) << 32); }
                          else if (hi == 0) { B.den[row * 8 + lh * 2] = y[0]; B.den[row * 8 + lh * 2 + 1] = mt; } }
                        if (ml) mst = mnew;
                    } else if (wave == 6) {
                        const float S1v = cf[192 + (c & 3)], S2v = cf[196 + (c & 3)];
                        float gam = S1v, dlt = S1v, mnew = 0.f;
                        if (ml) { mnew = fmaxf(S1v + mst, S2v); gam = S1v - mnew; dlt = S1v + mst - mnew; }
                        const float ed = __expf(dlt);
#pragma unroll
                        for (int r = 0; r < 16; ++r) { st0[r] *= ed; st1[r] *= ed; }
#pragma unroll
                        for (int k4 = 0; k4 < 4; ++k4) {
                            const bf16x8 vr = LFR(24 + k4); const f32x4 b0 = *(const LAS f32x4*)(cf + 128 + 16 * k4 + 8 * hi), b1 = *(const LAS f32x4*)(cf + 128 + 16 * k4 + 8 * hi + 4);
                            v4u wv; wv.x = cvtpk(bf2f((unsigned short)vr[0]) * __expf(gam - b0[0]), bf2f((unsigned short)vr[1]) * __expf(gam - b0[1])); wv.y = cvtpk(bf2f((unsigned short)vr[2]) * __expf(gam - b0[2]), bf2f((unsigned short)vr[3]) * __expf(gam - b0[3]));
                            wv.z = cvtpk(bf2f((unsigned short)vr[4]) * __expf(gam - b1[0]), bf2f((unsigned short)vr[5]) * __expf(gam - b1[1])); wv.w = cvtpk(bf2f((unsigned short)vr[6]) * __expf(gam - b1[2]), bf2f((unsigned short)vr[7]) * __expf(gam - b1[3]));
                            const bf16x8 wvf = __builtin_bit_cast(bf16x8, wv);
                            st0 = MFMA32(LFR(16 + k4), wvf, st0); st1 = MFMA32(LFR(20 + k4), wvf, st1);
                        }
                        { LAS unsigned char* sf = lds + MX_STF + ((c + 1) & 1) * 4096 + 16 * lane;
                          *(LAS bf16x8*)(sf) = pack8<0>(st0); *(LAS bf16x8*)(sf + 1024) = pack8<1>(st0); *(LAS bf16x8*)(sf + 2048) = pack8<0>(st1); *(LAS bf16x8*)(sf + 3072) = pack8<1>(st1); }
                        if (ml) mst = mnew;
                    }
#undef LFR
                }
                asm volatile("s_waitcnt lgkmcnt(0)" ::: "memory");
                bi = (bi == 2) ? 0 : bi + 1;
            }
#undef LIN_ISSUE
        }
        VMWAIT(0); WGBAR();
    }
}
__device__ __forceinline__ f32x4 unpack4bf(unsigned long long q) { return (f32x4){__uint_as_float((unsigned)q << 16), __uint_as_float((unsigned)q & 0xffff0000u), __uint_as_float((unsigned)(q >> 32) << 16), __uint_as_float((unsigned)(q >> 32) & 0xffff0000u)}; }
__device__ __forceinline__ void post_new(const MixBufs& B, bf16* ybf, const float* mng, const float* rng, const float* sng, const float* sD, int gw, int NGW, int lane) {
    constexpr int R = 4;
    const int c4 = 4 * lane, hd = lane >> 4;
    const f32x4 gnm = *(const f32x4*)(mng + c4), gnr = *(const f32x4*)(rng + c4), gns = *(const f32x4*)(sng + c4); const float Dh = sD[hd];
    for (int k0 = 0; k0 < M / NGW; k0 += R) {
        unsigned long long yq[R][3], gq[R][3]; f32x4 xx[R]; float dn[R], mt[R];
#pragma unroll
        for (int j = 0; j < R; ++j) { const int m = (NGW == 2048) ? ((gw >> 8) * SEQ + (gw & 255) + 256 * (k0 + j)) : (gw + (k0 + j) * NGW); const size_t r = (size_t)m;
#pragma unroll
            for (int mx = 0; mx < 3; ++mx) yq[j][mx] = *(const unsigned long long*)((const bf16*)B.yraw + r * 1024 + 256 * (mx + 1) + c4);
            gq[j][0] = *(const unsigned long long*)(B.proj + r * PROJ_LD + PC_MO + c4); gq[j][1] = *(const unsigned long long*)(B.proj + r * PROJ_LD + PC_RG + c4); gq[j][2] = *(const unsigned long long*)(B.proj + r * PROJ_LD + PC_SZ + c4);
            xx[j] = unpack4bf(*(const unsigned long long*)((const bf16*)B.xs + r * 256 + c4)); dn[j] = B.den[r * 8 + hd * 2]; mt[j] = B.den[r * 8 + hd * 2 + 1]; }
#pragma unroll
        for (int j = 0; j < R; ++j) { const int m = (NGW == 2048) ? ((gw >> 8) * SEQ + (gw & 255) + 256 * (k0 + j)) : (gw + (k0 + j) * NGW); const size_t r = (size_t)m;
            GAS unsigned long long* o8 = (GAS unsigned long long*)(ybf + r * DM) + lane;
#pragma unroll
            for (int mx = 0; mx < 2; ++mx) {
                f32x4 v = unpack4bf(yq[j][mx]);
                if (mx == 0) v = v * (1.0f / fmaxf(fabsf(dn[j]), __expf(-mt[j])));
                float ss = (v.x * v.x + v.y * v.y) + (v.z * v.z + v.w * v.w);
                ss += __shfl_xor(ss, 1); ss += __shfl_xor(ss, 2); ss += __shfl_xor(ss, 4); ss += __shfl_xor(ss, 8);
                const float rstd = 1.0f / sqrtf(ss * (1.0f / 64.0f) + RMS_EPS);
                const f32x4 gr = unpack4bf(gq[j][mx]); f32x4 gt;
#pragma unroll
                for (int i = 0; i < 4; ++i) gt[i] = mx == 0 ? sigmoid_f(gr[i]) : silu_acc(gr[i]);
                const f32x4 o = gt * (v * rstd * (mx == 0 ? gnm : gnr));
                o8[64 * (mx + 1)] = (unsigned long long)pk2(o.x, o.y) | ((unsigned long long)pk2(o.z, o.w) << 32);
            }
            { const f32x4 hs = unpack4bf(yq[j][2]), zr = unpack4bf(gq[j][2]); f32x4 v;
#pragma unroll
              for (int i = 0; i < 4; ++i) v[i] = (hs[i] + Dh * xx[j][i]) * silu_acc(zr[i]);
              const float ss = wave_sum((v.x * v.x + v.y * v.y) + (v.z * v.z + v.w * v.w));
              const float rstd = 1.0f / sqrtf(ss * (1.0f / 256.0f) + RMS_EPS);
              const f32x4 o = v * rstd * gns;
              o8[192] = (unsigned long long)pk2(o.x, o.y) | ((unsigned long long)pk2(o.z, o.w) << 32); }
        }
    }
}
__device__ __forceinline__ void final_norm(float* x, const float* g, int gw, int NGW, int lane) {
    constexpr int R = 4;
    f32x4 gv[4];
#pragma unroll
    for (int j = 0; j < 4; ++j) gv[j] = ((const f32x4*)g)[lane + 64 * j];
    for (int k0 = 0; k0 < M / NGW; k0 += R) {
        f32x4 v[R][4];
#pragma unroll
        for (int q = 0; q < R; ++q) { const int m = (NGW == 2048) ? ((gw >> 8) * SEQ + (gw & 255) + 256 * (k0 + q)) : (gw + (k0 + q) * NGW);
            const GAS f32x4* xr = (const GAS f32x4*)(x + (size_t)m * DM) + lane;
#pragma unroll
            for (int j = 0; j < 4; ++j) v[q][j] = xr[64 * j]; }
#pragma unroll
        for (int q = 0; q < R; ++q) { const int m = (NGW == 2048) ? ((gw >> 8) * SEQ + (gw & 255) + 256 * (k0 + q)) : (gw + (k0 + q) * NGW);
            GAS f32x4* xr = (GAS f32x4*)(x + (size_t)m * DM) + lane; float s = 0.f;
#pragma unroll
            for (int j = 0; j < 4; ++j) s += (v[q][j].x * v[q][j].x + v[q][j].y * v[q][j].y) + (v[q][j].z * v[q][j].z + v[q][j].w * v[q][j].w);
            const float rstd = 1.0f / sqrtf(wave_sum(s) * (1.0f / DM) + RMS_EPS);
#pragma unroll
            for (int j = 0; j < 4; ++j) xr[64 * j] = v[q][j] * rstd * gv[j]; }
    }
}

__global__ void __launch_bounds__(NTHR, 2) fwd(Args a) {
    extern __shared__ __attribute__((aligned(16))) unsigned char lds_raw[];
    LAS unsigned char* lds = (LAS unsigned char*)lds_raw;
    const int tid = threadIdx.x, lane = tid & 63, wave = __builtin_amdgcn_readfirstlane(tid >> 6), G = gridDim.x;
    const int gw = blockIdx.x * NWAVES + wave, NGW = G * NWAVES;
    unsigned char* ws = a.ws;
    for (int u = tid; u < (LDS_BYTES - LDSCTL_OFF) / 4; u += NTHR) ((LAS unsigned*)(lds + LDSCTL_OFF))[u] = 0u;
    __syncthreads();
    const int lo = a.ph_lo, hi = a.ph_hi;
    XcdBarrier bar; bar.bar = (unsigned*)(ws + WS_CTL) + CW_BAR; bar.x = 0; bar.st = nullptr;
    if (hi - lo > 1) bar = xcd_barrier_post((unsigned*)(ws + WS_CTL) + CW_BAR, (volatile LAS unsigned*)(lds + MISC_OFF) + 8);
    volatile LAS unsigned* MISCW = (volatile LAS unsigned*)(lds + MISC_OFF);
    if (hi - lo > 1 && tid == 0) MISCW[16] = xb_add(&bar.bar[XB_RANK(bar.x)], 1u);
    int bid = (int)blockIdx.x; bool loc = false;
#define IN(k) (lo <= (k) && (k) < hi)
#define PH_IDS int t_ = threadIdx.x; asm volatile("" : "+v"(t_)); const int lane_ = t_ & 63, wave_ = __builtin_amdgcn_readfirstlane(t_ >> 6), gw_ = blockIdx.x * NWAVES + wave_; (void)lane_; (void)gw_; (void)wave_;
#define SEAM(k) do { if ((k) + 1 < hi) { if (loc) xcd_local_barrier(bar.bar, bar.x, 32u); else xcd_barrier(bar); } } while (0)
    float* xres = a.out;
    float* cond = (float*)(ws + WS_COND); const float2* rope = (const float2*)(ws + WS_ROPE);
    bf16* HB = (bf16*)(ws + WS_HB); bf16* ACT = (bf16*)(ws + WS_ACT); bf16* PROJ = (bf16*)(ws + WS_PROJ); float* GATES = (float*)(ws + WS_GATES);
    bf16* YBF = (bf16*)(ws + WS_YBF);
#define MK_MB unsigned char* ws_ = a.ws; asm volatile("" : "+s"(ws_)); MixBufs MB; MB.proj = (const bf16*)(ws_ + WS_PROJ); MB.gates = (const float*)(ws_ + WS_GATES); MB.vtf = (bf16*)(ws_ + WS_VTF); MB.lcum = (float*)(ws_ + WS_COEF + COEF_LCUM); MB.ctot = (float*)(ws_ + WS_COEF + COEF_CTOT); \
    MB.ql = (bf16*)(ws_ + WS_QL); MB.kl = (bf16*)(ws_ + WS_KL); MB.kt = (bf16*)(ws_ + WS_KT); MB.vtl = (bf16*)(ws_ + WS_VTL); MB.xs = (float*)(ws_ + WS_XS); \
    MB.a1 = (float*)(ws_ + WS_COEF + COEF_A1); MB.a2 = (float*)(ws_ + WS_COEF + COEF_A2); MB.beta = (float*)(ws_ + WS_COEF + COEF_BETA); MB.s1 = (float*)(ws_ + WS_COEF + COEF_S1); MB.s2 = (float*)(ws_ + WS_COEF + COEF_S2); \
    MB.den = (float*)(ws_ + WS_DEN); MB.yraw = (float*)(ws_ + WS_YRAW); bf16* YBF_ = (bf16*)(ws_ + WS_YBF); (void)YBF_;
    long long* SS = (long long*)(ws + WS_SS);
    if (IN(0)) { PH_IDS prologue0(a, lds, t_, lane_, wave_, G); SEAM(0); }
    if (IN(1)) { PH_IDS prologue1(a, lds, lane_, wave_, G); thin_xg(a.in[0], HB, (bf16*)(ws + WS_XB), a.in[4], cond, 1 * DM, SS, gw_, NGW, lane_); SEAM(1);
        { const long long* q = (const long long*)(ws + WS_BIASQ); float* bf = (float*)(ws + WS_BIAS);
          for (int i = blockIdx.x * NTHR + t_; i < (int)(BIAS_BYTES / 4); i += G * NTHR) bf[i] = (float)((double)q[i] * (1.0 / 4294967296.0)); }
        SEAM(1); }
    if (lo == 0 && hi == PH_END && G == 256) {
        if (tid == 0) { bool ok = true;
#pragma unroll
            for (unsigned j = 0; j < 16; ++j) { const unsigned cnt = xb_ld(&bar.bar[XB_RANK(j)]); ok = ok && (cnt == (j < 8 ? 32u : 0u)); }
            MISCW[17] = ok ? 1u : 0u; }
        __syncthreads();
        if (MISCW[17]) { loc = true; bid = __builtin_amdgcn_readfirstlane((int)(MISCW[16] * 8u + bar.x)); }
    }
    const int vcu = (G % 8 == 0) ? (bid % 8) * (G / 8) + bid / 8 : bid;
    for (int l = 0; l < DEPTH; ++l) {
        const int pb = PH_LAYER0 + PH_PER_LAYER * l;
        if (hi <= pb || lo >= pb + PH_PER_LAYER) continue;
        const float* cond_l = cond + (size_t)l * BATCH * NCOND;
        unsigned char* wl = ws + WS_W + (size_t)l * LAYER_W;
        const float* xin = (l == 0) ? a.in[0] : xres;
        const float* bias_l = (const float*)(ws + WS_BIAS + (size_t)l * 3 * BIAS_USE);
        long long* ss0 = SS + (size_t)(3 * l) * M;
        const float* ng = a.in[4] + (size_t)(l * 3) * DM;
        if (IN(pb + 0)) { pg8::Gemm g{HB, (const bf16*)(wl + OFF_UP1), M, NUP, DM}; pg8::StaticOrder S; S.init(M, NUP, G, bid); pg8::EpiSwigluN E{ACT, PROJ_LD, ss0, bias_l, NUP};
            pg8::gemm_phase<pg8::EpiSwigluN, pg8::StaticOrder, true, true>(lds, g, S, E); if (REP_UP > 1) { __syncthreads(); pg8::gemm_phase<pg8::EpiSwigluN, pg8::StaticOrder, true, true>(lds, g, S, E); } SEAM(pb + 0); }
        if (IN(pb + 1)) { pg8::Gemm g{ACT, (const bf16*)(wl + OFF_DN1), M, DM, DFF, PROJ_LD}; pg8::StaticOrder S; S.init(M, DM, G, bid);
            pg8::EpiResidNorm E{cond_l, ng + DM, ws, 2 * DM, 4 * DM, (int)(WS_HB / MiB), (int)(WS_XB / MiB), (int)(WS_SS / 8) + (3 * l + 1) * M, 0.5f};
            pg8::gemm_phase<pg8::EpiResidNorm, pg8::StaticOrder, true, true>(lds, g, S, E); SEAM(pb + 1); }
        if (IN(pb + 2)) { pg8::Gemm g{HB, (const bf16*)(wl + OFF_IN), M, NPROJ, DM}; pg8::StaticOrder S; S.init(M, NPROJ, G, bid); pg8::EpiProjN E{PROJ, PROJ_LD, GATES, PROJ_LD / 256, 0.125f * LOG2E, ss0 + M, bias_l + 8 * NUP, NPROJ};
            pg8::gemm_phase<pg8::EpiProjN, pg8::StaticOrder, true, true>(lds, g, S, E); SEAM(pb + 2); }
        if (IN(pb + 3)) { PH_IDS MK_MB PrepW PW{a.in[12] + (size_t)l * 4 * 512, a.in[13] + (size_t)l * 512, a.in[18] + (size_t)l * 4 * 512, a.in[19] + (size_t)l * 512, a.in[11] + l * 4, a.in[14] + l * 4, a.in[15] + l * 4, a.in[20] + l * 4, a.in[21] + l * 4, (const float2*)(ws_ + WS_ROPE)};
            for (int rep = 0; rep < REP_PREP; ++rep) for (int u = vcu; u < BATCH * 32; u += G) prep_unit(MB, PW, u, wave_, lane_); SEAM(pb + 3); }
        if (IN(pb + 4)) { PH_IDS MK_MB mixer_phase(MB, YBF_, lds, vcu, wave_, lane_); if (REP_MIX > 1) { asm volatile("" ::: "memory"); mixer_phase(MB, YBF_, lds, vcu, wave_, lane_); } SEAM(pb + 4); }
        if (IN(pb + 5)) { PH_IDS MK_MB for (int rep = 0; rep < REP_POST; ++rep) post_new(MB, YBF_, a.in[16] + (size_t)l * 256, a.in[17] + (size_t)l * 256, a.in[23] + (size_t)l * 256, a.in[22] + l * 4, vcu * NWAVES + wave_, NGW, lane_); SEAM(pb + 5); }
        if (IN(pb + 6)) { pg8::Gemm g{YBF, (const bf16*)(wl + OFF_OUT), M, DM, DM}; pg8::StaticOrder S; S.init(M, DM, G, bid);
            pg8::EpiResidNorm E{cond_l, ng + 2 * DM, ws, 5 * DM, 7 * DM, (int)(WS_HB / MiB), (int)(WS_XB / MiB), (int)(WS_SS / 8) + (3 * l + 2) * M, 1.0f};
            pg8::gemm_phase<pg8::EpiResidNorm, pg8::StaticOrder, true, true>(lds, g, S, E); SEAM(pb + 6); }
        if (IN(pb + 7)) { pg8::Gemm g{HB, (const bf16*)(wl + OFF_UP2), M, NUP, DM}; pg8::StaticOrder S; S.init(M, NUP, G, bid); pg8::EpiSwigluN E{ACT, PROJ_LD, ss0 + 2 * M, bias_l + 2 * 8 * NUP, NUP};
            pg8::gemm_phase<pg8::EpiSwigluN, pg8::StaticOrder, true, true>(lds, g, S, E); SEAM(pb + 7); }
        if (IN(pb + 8)) { pg8::Gemm g{ACT, (const bf16*)(wl + OFF_DN2), M, DM, DFF, PROJ_LD}; pg8::StaticOrder S; S.init(M, DM, G, bid);
            if (l + 1 < DEPTH) { pg8::EpiResidNorm E{cond_l, ng + 3 * DM, ws, 8 * DM, BATCH * NCOND + 1 * DM, (int)(WS_HB / MiB), (int)(WS_XB / MiB), (int)(WS_SS / 8) + (3 * l + 3) * M, 0.5f};
                pg8::gemm_phase<pg8::EpiResidNorm, pg8::StaticOrder, true, true>(lds, g, S, E); }
            else { pg8::EpiResid E{(const bf16*)(ws + WS_XB), xres, DM, cond_l + 8 * DM, NCOND, SEQ, 0.5f}; pg8::gemm_phase<pg8::EpiResid, pg8::StaticOrder, true, true>(lds, g, S, E); }
            SEAM(pb + 8); }
    }
    if (IN(PH_FINAL)) { PH_IDS final_norm(xres, a.in[24], vcu * NWAVES + wave_, NGW, lane_); }
#undef IN
#undef SEAM
}

#ifndef N_SPLIT
#define N_SPLIT 0
#endif
extern "C" void kernel_launch(void* const* d_in, const int* in_sizes, int n_in, void* d_out, int out_size, void* d_ws, size_t ws_size, hipStream_t stream) {
    static int grid = 0;
    if (grid == 0) {
        if (n_in != 25 || in_sizes[0] != M * DM || out_size != M * DM || ws_size < WS_END) { fprintf(stderr, "kernel_launch: unexpected problem (n_in %d, in0 %d, out %d, ws %zu)\n", n_in, n_in > 0 ? in_sizes[0] : -1, out_size, ws_size); grid = -1; return; }
        int dev = 0, cus = 0, per_cu = 0;
        if (hipGetDevice(&dev) != hipSuccess || hipDeviceGetAttribute(&cus, hipDeviceAttributeMultiprocessorCount, dev) != hipSuccess) { grid = -1; return; }
        if (hipFuncSetAttribute((const void*)fwd, hipFuncAttributeMaxDynamicSharedMemorySize, LDS_BYTES) != hipSuccess) { fprintf(stderr, "kernel_launch: hipFuncSetAttribute failed\n"); grid = -1; return; }
        if (hipOccupancyMaxActiveBlocksPerMultiprocessor(&per_cu, (const void*)fwd, NTHR, LDS_BYTES) != hipSuccess || per_cu < 1) fprintf(stderr, "kernel_launch: occupancy query says %d\n", per_cu);
        (void)hipGetLastError();
        grid = cus;
    }
    if (grid < 0) return;
    if (hipMemsetAsync((char*)d_ws + WS_CTL, 0, CTL_ZERO_BYTES, stream) != hipSuccess) return;
    Args a{};
    for (int i = 0; i < 25; ++i) a.in[i] = (const float*)d_in[i];
    a.out = (float*)d_out; a.ws = (unsigned char*)d_ws;
#if N_SPLIT
    for (int p = 0; p < PH_END; ++p) { a.ph_lo = p; a.ph_hi = p + 1; hipLaunchKernelGGL(fwd, dim3(grid), dim3(NTHR), LDS_BYTES, stream, a); }
#else
    a.ph_lo = 0; a.ph_hi = PH_END; hipLaunchKernelGGL(fwd, dim3(grid), dim3(NTHR), LDS_BYTES, stream, a);
#endif
}
```

```cpp
#include <hip/hip_runtime.h>
#include <cstdio>
#include <cstdint>
#ifndef REP_FOX
#define REP_FOX 1
#endif
#ifndef REP_LIN
#define REP_LIN 1
#endif
#ifndef REP_MIX
#define REP_MIX 1
#endif
#ifndef REP_PREP
#define REP_PREP 1
#endif
#ifndef REP_POST
#define REP_POST 1
#endif
#ifndef REP_THIN
#define REP_THIN 1
#endif
#ifndef REP_UP
#define REP_UP 1
#endif
#ifndef REP_IN
#define REP_IN 1
#endif
namespace pg8 {
#define PG8_LAS __attribute__((address_space(3)))
typedef unsigned short bf16_t;
typedef short bf16x8 __attribute__((ext_vector_type(8)));
typedef float f32x4 __attribute__((ext_vector_type(4)));
typedef unsigned u32x4 __attribute__((ext_vector_type(4)));
constexpr int BM = 256, BK = 64, HALF = 128, HTB = HALF * BK * 2  , STAGE_BYTES = 8 * HTB, NXCD = 8, WGM = 4;

__host__ __device__ __forceinline__ int lds_byte(int r, int c) { const int st = (r >> 4) * 2 + (c >> 5), rr = r & 15, cc = c & 31, ob = rr * 64 + cc * 2; return st * 1024 + (ob ^ (((ob >> 9) & 1) << 5)); }
__host__ __device__ __forceinline__ void stage_rc(int b, int& R, int& C) { const int st = b / 1024, sb = b % 1024, swz = sb ^ (((sb >> 9) & 1) << 5); R = (st >> 1) * 16 + swz / 64; C = (st & 1) * 32 + (swz % 64) / 2; }
__host__ __device__ __forceinline__ int perm32(int rho) { const int n = rho >> 4, i = rho & 15; return 8 * (i >> 2) + 4 * n + (i & 3); }

struct Unit { int pm, pn; };
struct Gemm { const bf16_t* A; const bf16_t* Bt; int M, N, K; int lda; };

struct StaticOrder {
    int nM, nN, nwg, G, c;
    __host__ __device__ void init(int M, int N, int G_, int c_) { nM = M / BM; nN = N / BM; nwg = nM * nN; G = G_; c = c_; }
    __host__ __device__ bool next(int i, Unit& u) const {
        const long L = (long)i * G + c; if (L >= nwg) return false;
        int wgid = (int)L; { const int q = nwg / NXCD, r = nwg % NXCD, xcd = wgid % NXCD, off = wgid / NXCD; wgid = (xcd < r ? xcd * (q + 1) : r * (q + 1) + (xcd - r) * q) + off; }
        const int nig = WGM * nN, gid = wgid / nig, fm = gid * WGM, gsz = (nM - fm) < WGM ? (nM - fm) : WGM;
        u.pm = fm + ((wgid % nig) % gsz); u.pn = (wgid % nig) / gsz; return true;
    }
    __device__ __forceinline__ void a_ready(const Unit&) const {}
    __device__ __forceinline__ void done(const Unit&) const {}
};

__device__ __forceinline__ unsigned cvt_pk_bf16(float lo, float hi) { unsigned r; asm volatile("v_cvt_pk_bf16_f32 %0, %1, %2" : "=v"(r) : "v"(lo), "v"(hi)); return r; }

__device__ __forceinline__ float silu_f(float v) { return v * __builtin_amdgcn_rcpf(1.0f + __expf(-v)); }
__device__ __forceinline__ f32x4 swiglu4(const f32x4 a, const f32x4 g) {
    const f32x4 t = g * (-1.44269504088896341f); f32x4 e;
#pragma unroll
    for (int i = 0; i < 4; ++i) e[i] = __builtin_amdgcn_exp2f(t[i]);
    const f32x4 d = e + 1.0f; f32x4 r;
#pragma unroll
    for (int i = 0; i < 4; ++i) r[i] = __builtin_amdgcn_rcpf(d[i]);
    return (a * g) * r;
}
struct EpiSwiglu {
    static constexpr bool PERM = true, AFTER_DRAIN = false;
    bf16_t* O; int ldo;
    __device__ __forceinline__ void operator()(const f32x4 (&acc)[2][2][4][2], const Unit& u, int wr, int wc, int fr, int fq) const {
        const int row0 = u.pm * BM + wr * 64 + fr, col0 = u.pn * HALF + wc * 32 + 8 * fq;
#pragma unroll
        for (int ai = 0; ai < 2; ++ai)
#pragma unroll
            for (int m = 0; m < 4; ++m) { bf16_t* rowp = O + (size_t)(row0 + ai * HALF + m * 16) * ldo + col0;
                const f32x4 a0 = acc[ai][0][m][0], a1 = acc[ai][0][m][1], g0 = acc[ai][1][m][0], g1 = acc[ai][1][m][1];
                u32x4 w; w.x = cvt_pk_bf16(silu_f(g0[0]) * a0[0], silu_f(g0[1]) * a0[1]); w.y = cvt_pk_bf16(silu_f(g0[2]) * a0[2], silu_f(g0[3]) * a0[3]);
                w.z = cvt_pk_bf16(silu_f(g1[0]) * a1[0], silu_f(g1[1]) * a1[1]); w.w = cvt_pk_bf16(silu_f(g1[2]) * a1[2], silu_f(g1[3]) * a1[3]);
                *(u32x4*)rowp = w; }
    }
};
struct EpiResid {
    static constexpr bool PERM = false, AFTER_DRAIN = false;
    const bf16_t* base; float* out; int ldc; const float* gate; int gstride; int rows_per_b; float coef;
    __device__ __forceinline__ void operator()(const f32x4 (&acc)[2][2][4][2], const Unit& u, int wr, int wc, int fr, int fq) const {
        const int col0 = u.pn * BM + wc * 32 + 4 * fq; const int b = (u.pm * BM) / rows_per_b;
        f32x4 gv[2][2];
#pragma unroll
        for (int bj = 0; bj < 2; ++bj)
#pragma unroll
            for (int n = 0; n < 2; ++n) gv[bj][n] = *(const f32x4*)(gate + (size_t)b * gstride + col0 + bj * HALF + n * 16) * coef;
#pragma unroll
        for (int ai = 0; ai < 2; ++ai)
#pragma unroll
            for (int m = 0; m < 4; ++m) { const size_t off = (size_t)(u.pm * BM + ai * HALF + wr * 64 + m * 16 + fr) * ldc + col0;
#pragma unroll
                for (int bj = 0; bj < 2; ++bj)
#pragma unroll
                    for (int n = 0; n < 2; ++n) { typedef unsigned u32x2r __attribute__((ext_vector_type(2))); const u32x2r rb = *(const u32x2r*)(base + off + bj * HALF + n * 16);
                        const f32x4 bs = (f32x4){__builtin_bit_cast(float, rb.x << 16), __builtin_bit_cast(float, rb.x & 0xffff0000u), __builtin_bit_cast(float, rb.y << 16), __builtin_bit_cast(float, rb.y & 0xffff0000u)};
                        *(f32x4*)(out + off + bj * HALF + n * 16) = bs + gv[bj][n] * acc[ai][bj][m][n]; }
                if (m & 1) asm volatile("" ::: "memory"); }
    }
};
struct EpiProj {
    static constexpr bool PERM = true, AFTER_DRAIN = false;
    bf16_t* P; int ldp; float* G; int ntile_bf; float scale0;
    __device__ __forceinline__ void operator()(const f32x4 (&acc)[2][2][4][2], const Unit& u, int wr, int wc, int fr, int fq) const {
        const int row0 = u.pm * BM + wr * 64 + fr;
        if (u.pn < ntile_bf) {
            const int col0 = u.pn * BM + wc * 32 + 8 * fq; const float sc = (u.pn == 0) ? scale0 : 1.0f;
#pragma unroll
            for (int ai = 0; ai < 2; ++ai)
#pragma unroll
                for (int m = 0; m < 4; ++m) { bf16_t* rowp = P + (size_t)(row0 + ai * HALF + m * 16) * ldp + col0;
#pragma unroll
                    for (int bj = 0; bj < 2; ++bj) { const f32x4 v0 = acc[ai][bj][m][0] * sc, v1 = acc[ai][bj][m][1] * sc;
                        u32x4 w; w.x = cvt_pk_bf16(v0[0], v0[1]); w.y = cvt_pk_bf16(v0[2], v0[3]); w.z = cvt_pk_bf16(v1[0], v1[1]); w.w = cvt_pk_bf16(v1[2], v1[3]);
                        *(u32x4*)(rowp + bj * HALF) = w; } }
        } else if (wc == 0 && fq < 2) {
#pragma unroll
            for (int ai = 0; ai < 2; ++ai)
#pragma unroll
                for (int m = 0; m < 4; ++m) { float* gp = G + (size_t)(row0 + ai * HALF + m * 16) * 16 + 8 * fq;
                    *(f32x4*)gp = acc[ai][0][m][0]; *(f32x4*)(gp + 4) = acc[ai][0][m][1]; }
        }
    }
};

__device__ __forceinline__ float rstd_q(long long q) { const unsigned long long u = (unsigned long long)q; const float f = (float)(unsigned)(u >> 32) * 4294967296.0f + (float)(unsigned)u;
    return __builtin_amdgcn_rsqf(f * (1.0f / (16777216.0f * 1024.0f)) + 1e-6f); }
struct EpiSwigluN {
    static constexpr bool PERM = true, AFTER_DRAIN = false;
    bf16_t* O; int ldo; const long long* ss; const float* bias; int nb;
    __device__ __forceinline__ void operator()(const f32x4 (&acc)[2][2][4][2], const Unit& u, int wr, int wc, int fr, int fq) const {
        const int row0 = u.pm * BM + wr * 64 + fr, col0 = u.pn * HALF + wc * 32 + 8 * fq; const int b = u.pm >> 3;
        const float* bp = bias + (size_t)b * nb + u.pn * BM + wc * 32 + 8 * fq;
        const f32x4 ba0 = *(const f32x4*)bp, ba1 = *(const f32x4*)(bp + 4), bg0 = *(const f32x4*)(bp + HALF), bg1 = *(const f32x4*)(bp + HALF + 4);
        long long ssv[2][4];
#pragma unroll
        for (int ai = 0; ai < 2; ++ai)
#pragma unroll
            for (int m = 0; m < 4; ++m) ssv[ai][m] = ss[row0 + ai * HALF + m * 16];
#pragma unroll
        for (int ai = 0; ai < 2; ++ai)
#pragma unroll
            for (int m = 0; m < 4; ++m) { const int row = row0 + ai * HALF + m * 16; bf16_t* rowp = O + (size_t)row * ldo + col0;
                const float rs = rstd_q(ssv[ai][m]);
                const f32x4 a0 = acc[ai][0][m][0] * rs + ba0, a1 = acc[ai][0][m][1] * rs + ba1, g0 = acc[ai][1][m][0] * rs + bg0, g1 = acc[ai][1][m][1] * rs + bg1;
                const f32x4 o0 = swiglu4(a0, g0), o1 = swiglu4(a1, g1);
                u32x4 w; w.x = cvt_pk_bf16(o0[0], o0[1]); w.y = cvt_pk_bf16(o0[2], o0[3]); w.z = cvt_pk_bf16(o1[0], o1[1]); w.w = cvt_pk_bf16(o1[2], o1[3]);
                *(u32x4*)rowp = w; }
    }
};
struct EpiProjN {
    static constexpr bool PERM = true, AFTER_DRAIN = false;
    bf16_t* P; int ldp; float* G; int ntile_bf; float scale0; const long long* ss; const float* bias; int nb;
    __device__ __forceinline__ void operator()(const f32x4 (&acc)[2][2][4][2], const Unit& u, int wr, int wc, int fr, int fq) const {
        const int row0 = u.pm * BM + wr * 64 + fr; const int b = u.pm >> 3;
        const float* bp = bias + (size_t)b * nb + u.pn * BM + wc * 32 + 8 * fq;
        if (u.pn < ntile_bf) {
            const int col0 = u.pn * BM + wc * 32 + 8 * fq; const float sc = (u.pn == 0) ? scale0 : 1.0f;
            const f32x4 b00 = *(const f32x4*)bp, b01 = *(const f32x4*)(bp + 4), b10 = *(const f32x4*)(bp + HALF), b11 = *(const f32x4*)(bp + HALF + 4);
            long long ssv[2][4];
#pragma unroll
            for (int ai = 0; ai < 2; ++ai)
#pragma unroll
                for (int m = 0; m < 4; ++m) ssv[ai][m] = ss[row0 + ai * HALF + m * 16];
#pragma unroll
            for (int ai = 0; ai < 2; ++ai)
#pragma unroll
                for (int m = 0; m < 4; ++m) { const int row = row0 + ai * HALF + m * 16; bf16_t* rowp = P + (size_t)row * ldp + col0;
                    const float rs = rstd_q(ssv[ai][m]);
#pragma unroll
                    for (int bj = 0; bj < 2; ++bj) { const f32x4 v0 = (acc[ai][bj][m][0] * rs + (bj ? b10 : b00)) * sc, v1 = (acc[ai][bj][m][1] * rs + (bj ? b11 : b01)) * sc;
                        u32x4 w; w.x = cvt_pk_bf16(v0[0], v0[1]); w.y = cvt_pk_bf16(v0[2], v0[3]); w.z = cvt_pk_bf16(v1[0], v1[1]); w.w = cvt_pk_bf16(v1[2], v1[3]);
                        *(u32x4*)(rowp + bj * HALF) = w; } }
        } else if (wc == 0 && fq < 2) {
            const f32x4 b00 = *(const f32x4*)bp, b01 = *(const f32x4*)(bp + 4);
#pragma unroll
            for (int ai = 0; ai < 2; ++ai)
#pragma unroll
                for (int m = 0; m < 4; ++m) { const int row = row0 + ai * HALF + m * 16; float* gp = G + (size_t)row * 16 + 8 * fq;
                    const float rs = rstd_q(ss[row]);
                    *(f32x4*)gp = acc[ai][0][m][0] * rs + b00; *(f32x4*)(gp + 4) = acc[ai][0][m][1] * rs + b01; }
        }
    }
};
struct EpiResidNorm {
    static constexpr bool PERM = true, AFTER_DRAIN = false;
    const float* cnd; const float* ng; unsigned char* wsb; int goff, scoff, hb_off, xb_off, ss_off; float coef;
    __device__ __forceinline__ void operator()(const f32x4 (&acc)[2][2][4][2], const Unit& u, int wr, int wc, int fr, int fq) const {
        constexpr int ldc = 1024, gstride = 9 * 1024;
        const int col0 = u.pn * BM + wc * 32 + 8 * fq; const int b = u.pm >> 3;
        const float* gate = cnd + goff; const float* scn = cnd + scoff;
        __attribute__((address_space(1))) bf16_t* xg = (__attribute__((address_space(1))) bf16_t*)(wsb + (size_t)hb_off * 1048576);
        unsigned long long* ssn = (unsigned long long*)(wsb + (size_t)ss_off * 8);
        __attribute__((address_space(1))) bf16_t* xb = (__attribute__((address_space(1))) bf16_t*)(wsb + (size_t)xb_off * 1048576);
        float sq[2][4];
#pragma unroll
        for (int ai = 0; ai < 2; ++ai)
#pragma unroll
            for (int m = 0; m < 4; ++m) sq[ai][m] = 0.f;
#pragma unroll
        for (int bj = 0; bj < 2; ++bj) { const int c = col0 + bj * HALF;
            const f32x4 gv0 = *(const f32x4*)(gate + (size_t)b * gstride + c) * coef, gv1 = *(const f32x4*)(gate + (size_t)b * gstride + c + 4) * coef;
            const f32x4 gm0 = *(const f32x4*)(ng + c) * (*(const f32x4*)(scn + (size_t)b * gstride + c) + 1.0f), gm1 = *(const f32x4*)(ng + c + 4) * (*(const f32x4*)(scn + (size_t)b * gstride + c + 4) + 1.0f);
#pragma unroll
            for (int ai = 0; ai < 2; ++ai) { u32x4 rbv[4];
                const unsigned off0 = (unsigned)(u.pm * BM + ai * HALF + wr * 64 + fr) * (unsigned)ldc + (unsigned)c;
#pragma unroll
                for (int m = 0; m < 4; ++m) rbv[m] = *(const __attribute__((address_space(1))) u32x4*)(xb + (off0 + (unsigned)(m * 16 * ldc)));
#pragma unroll
                for (int m = 0; m < 4; ++m) { const unsigned off = off0 + (unsigned)(m * 16 * ldc); const u32x4 rb = rbv[m];
                    const f32x4 xn0 = (f32x4){__builtin_bit_cast(float, rb.x << 16), __builtin_bit_cast(float, rb.x & 0xffff0000u), __builtin_bit_cast(float, rb.y << 16), __builtin_bit_cast(float, rb.y & 0xffff0000u)} + gv0 * acc[ai][bj][m][0];
                    const f32x4 xn1 = (f32x4){__builtin_bit_cast(float, rb.z << 16), __builtin_bit_cast(float, rb.z & 0xffff0000u), __builtin_bit_cast(float, rb.w << 16), __builtin_bit_cast(float, rb.w & 0xffff0000u)} + gv1 * acc[ai][bj][m][1];
                    { u32x4 wx; wx.x = cvt_pk_bf16(xn0[0], xn0[1]); wx.y = cvt_pk_bf16(xn0[2], xn0[3]); wx.z = cvt_pk_bf16(xn1[0], xn1[1]); wx.w = cvt_pk_bf16(xn1[2], xn1[3]); *(__attribute__((address_space(1))) u32x4*)(xb + off) = wx; }
                    sq[ai][m] += ((xn0[0] * xn0[0] + xn0[1] * xn0[1]) + (xn0[2] * xn0[2] + xn0[3] * xn0[3])) + ((xn1[0] * xn1[0] + xn1[1] * xn1[1]) + (xn1[2] * xn1[2] + xn1[3] * xn1[3]));
                    const f32x4 h0 = xn0 * gm0, h1 = xn1 * gm1;
                    u32x4 w; w.x = cvt_pk_bf16(h0[0], h0[1]); w.y = cvt_pk_bf16(h0[2], h0[3]); w.z = cvt_pk_bf16(h1[0], h1[1]); w.w = cvt_pk_bf16(h1[2], h1[3]); *(__attribute__((address_space(1))) u32x4*)(xg + off) = w; }
                asm volatile("" ::: "memory"); } }
#pragma unroll
        for (int ai = 0; ai < 2; ++ai)
#pragma unroll
            for (int m = 0; m < 4; ++m) { float v = sq[ai][m]; v += __shfl_xor(v, 16); v += __shfl_xor(v, 32);
                if (fq == 0) atomicAdd(ssn + (u.pm * BM + ai * HALF + wr * 64 + m * 16 + fr), (unsigned long long)__float2ll_rn(v * 16777216.0f)); }
    }
};

template <class Epi, class Sched, bool ALIGN_EPI = false, bool SP2 = false>
__device__ __forceinline__ void gemm_phase(PG8_LAS unsigned char* lds, const Gemm g, const Sched& S, const Epi& E) {
    int tid_ = threadIdx.x; asm volatile("" : "+v"(tid_));
    const int tid = tid_, wid = __builtin_amdgcn_readfirstlane(tid >> 6), lane = tid & 63, wr = wid >> 2, wc = wid & 3, fr = lane & 15, fq = lane >> 4;
    const int K = g.K, nt = K / BK, LDA = g.lda ? g.lda : g.K;
    unsigned voffA[2], voffB[2];
#pragma unroll
    for (int i = 0; i < 2; ++i) { int R, C; stage_rc(tid * 16 + i * 8192, R, C); const int Rb = Epi::PERM ? ((R & ~31) + perm32(R & 31)) : R;
        voffA[i] = (unsigned)(R * LDA + C) * 2u; voffB[i] = (unsigned)(Rb * K + C) * 2u; }
    const size_t kstep = (size_t)(BK * 2);
    const size_t hstep = (size_t)HALF * K * 2;
    const size_t tstep = 2 * hstep;
    const size_t hstepA = (size_t)HALF * LDA * 2, tstepA = 2 * hstepA;
    const unsigned ldsw = (unsigned)wid * 1024u;
    const int aoff = lds_byte(wr * 64 + fr, fq * 8), boff = lds_byte(wc * 32 + fr, fq * 8);
#define PG8_SA(b, h) (((b) * 2 + (h)) * HTB)
#define PG8_SB(b, h) ((4 + (b) * 2 + (h)) * HTB)
#define PG8_STAGE(bufoff, gbase, voff) do { _Pragma("unroll") for (int _i = 0; _i < 2; ++_i) \
        __builtin_amdgcn_global_load_lds((const unsigned*)((const char*)(gbase) + (voff)[_i]), (PG8_LAS unsigned*)(lds + (bufoff) + ldsw + _i * 8192), 16, 0, 0); } while (0)
#define PG8_LDA(dst, b, h) do { _Pragma("unroll") for (int m = 0; m < 4; ++m) _Pragma("unroll") for (int k = 0; k < 2; ++k) dst[m][k] = *(const PG8_LAS bf16x8*)(lds + PG8_SA(b, h) + aoff + m * 2048 + k * 1024); } while (0)
#define PG8_LDB(dst, b, h) do { _Pragma("unroll") for (int n = 0; n < 2; ++n) _Pragma("unroll") for (int k = 0; k < 2; ++k) dst[n][k] = *(const PG8_LAS bf16x8*)(lds + PG8_SB(b, h) + boff + n * 2048 + k * 1024); } while (0)
#define PG8_MMA(ai, bj, At, Bt) do { __builtin_amdgcn_s_setprio(1); _Pragma("unroll") for (int m = 0; m < 4; ++m) _Pragma("unroll") for (int n = 0; n < 2; ++n) _Pragma("unroll") for (int k = 0; k < 2; ++k) \
        acc[ai][bj][m][n] = __builtin_amdgcn_mfma_f32_16x16x32_bf16(Bt[n][k], At[m][k], acc[ai][bj][m][n], 0, 0, 0); __builtin_amdgcn_s_setprio(0); } while (0)
#define PG8_WAIT_V(n) asm volatile("s_waitcnt vmcnt(" #n ")" ::: "memory")
#define PG8_WAIT_L(n) asm volatile("s_waitcnt lgkmcnt(" #n ")" ::: "memory")
#define PG8_BAR __builtin_amdgcn_s_barrier()
#define PG8_SCHED __builtin_amdgcn_sched_barrier(0)
    Unit cur, nxt; int ui = 0;
    if (!S.next(0, cur)) return;
    f32x4 acc[2][2][4][2];
#pragma unroll
    for (int a = 0; a < 2; ++a)
#pragma unroll
        for (int b = 0; b < 2; ++b)
#pragma unroll
            for (int m = 0; m < 4; ++m)
#pragma unroll
                for (int n = 0; n < 2; ++n) acc[a][b][m][n] = (f32x4){0.f, 0.f, 0.f, 0.f};
    bf16x8 At[4][2], B0[2][2], B1[2][2];
    const char* cA = (const char*)g.A + (size_t)cur.pm * tstepA; const char* cB = (const char*)g.Bt + (size_t)cur.pn * tstep;
    S.a_ready(cur);
    if constexpr (SP2) {
        PG8_STAGE(PG8_SB(0, 0), cB, voffB); PG8_STAGE(PG8_SB(0, 1), cB + hstep, voffB); PG8_STAGE(PG8_SA(0, 0), cA, voffA); PG8_STAGE(PG8_SA(0, 1), cA + hstepA, voffA);
        if (wr == 1) PG8_BAR;
        PG8_WAIT_V(2); PG8_BAR;
        PG8_STAGE(PG8_SB(1, 0), cB + kstep, voffB); PG8_STAGE(PG8_SA(1, 0), cA + kstep, voffA); PG8_STAGE(PG8_SB(1, 1), cB + hstep + kstep, voffB);
        PG8_WAIT_V(6); PG8_BAR;
    } else {
        PG8_STAGE(PG8_SB(0, 0), cB, voffB); PG8_STAGE(PG8_SA(0, 0), cA, voffA); PG8_STAGE(PG8_SB(0, 1), cB + hstep, voffB); PG8_STAGE(PG8_SA(0, 1), cA + hstepA, voffA);
        if (wr == 1) PG8_BAR;
        PG8_WAIT_V(4); PG8_BAR;
        PG8_STAGE(PG8_SB(1, 0), cB + kstep, voffB); PG8_STAGE(PG8_SA(1, 0), cA + kstep, voffA); PG8_STAGE(PG8_SB(1, 1), cB + hstep + kstep, voffB);
        PG8_WAIT_V(6); PG8_BAR;
    }
    for (;;) {
        const bool has_next = S.next(ui + 1, nxt);
        const char* nA = has_next ? (const char*)g.A + (size_t)nxt.pm * tstepA : cA; const char* nB = has_next ? (const char*)g.Bt + (size_t)nxt.pn * tstep : cB;
        for (int t = 0; t < nt; t += 2) {
            const bool last = (t == nt - 2);
            const char* a1 = cA + (size_t)(t + 1) * kstep;
            const char* a2 = last ? nA : cA + (size_t)(t + 2) * kstep; const char* b2 = last ? nB : cB + (size_t)(t + 2) * kstep;
            const char* a3 = a2 + kstep; const char* b3 = b2 + kstep;
            if (last && has_next) S.a_ready(nxt);
            if constexpr (SP2) {
            PG8_LDB(B0, 0, 0); PG8_LDB(B1, 0, 1); PG8_SCHED; PG8_LDA(At, 0, 0); PG8_STAGE(PG8_SA(1, 1), a1 + hstepA, voffA);
            PG8_WAIT_V(8); PG8_WAIT_L(0); PG8_BAR; PG8_MMA(0, 0, At, B0); PG8_MMA(0, 1, At, B1); PG8_BAR; PG8_SCHED;
            PG8_LDA(At, 0, 1); PG8_STAGE(PG8_SB(0, 0), b2, voffB); PG8_STAGE(PG8_SB(0, 1), b2 + hstep, voffB); PG8_STAGE(PG8_SA(0, 0), a2, voffA);
            PG8_WAIT_V(8); PG8_WAIT_L(0); PG8_BAR; PG8_MMA(1, 0, At, B0); PG8_MMA(1, 1, At, B1); PG8_BAR; PG8_SCHED;
            PG8_LDB(B0, 1, 0); PG8_LDB(B1, 1, 1); PG8_SCHED; PG8_LDA(At, 1, 0); PG8_STAGE(PG8_SA(0, 1), a2 + hstepA, voffA);
            PG8_WAIT_V(8); PG8_WAIT_L(0); PG8_BAR; PG8_MMA(0, 0, At, B0); PG8_MMA(0, 1, At, B1); PG8_BAR; PG8_SCHED;
            PG8_LDA(At, 1, 1); PG8_STAGE(PG8_SB(1, 0), b3, voffB); PG8_STAGE(PG8_SB(1, 1), b3 + hstep, voffB); PG8_STAGE(PG8_SA(1, 0), a3, voffA);
            PG8_WAIT_V(8); PG8_WAIT_L(0); PG8_BAR; PG8_MMA(1, 0, At, B0); PG8_MMA(1, 1, At, B1); PG8_BAR; PG8_SCHED;
            } else {
            PG8_LDB(B0, 0, 0); PG8_SCHED; PG8_LDA(At, 0, 0); PG8_STAGE(PG8_SA(1, 1), a1 + hstepA, voffA);
            PG8_WAIT_L(8); PG8_BAR; PG8_WAIT_L(0); PG8_MMA(0, 0, At, B0); PG8_BAR; PG8_SCHED;
            PG8_LDB(B1, 0, 1); PG8_STAGE(PG8_SB(0, 0), b2, voffB);
            PG8_BAR; PG8_WAIT_L(0); PG8_MMA(0, 1, At, B1); PG8_BAR;
            PG8_LDA(At, 0, 1); PG8_STAGE(PG8_SA(0, 0), a2, voffA);
            PG8_BAR; PG8_WAIT_L(0); PG8_MMA(1, 0, At, B0); PG8_BAR; PG8_SCHED;
            PG8_STAGE(PG8_SB(0, 1), b2 + hstep, voffB);
            PG8_WAIT_V(6); PG8_BAR; PG8_MMA(1, 1, At, B1); PG8_BAR;
            PG8_LDB(B0, 1, 0); PG8_SCHED; PG8_LDA(At, 1, 0); PG8_STAGE(PG8_SA(0, 1), a2 + hstepA, voffA);
            PG8_WAIT_L(8); PG8_BAR; PG8_WAIT_L(0); PG8_MMA(0, 0, At, B0); PG8_BAR; PG8_SCHED;
            PG8_LDB(B1, 1, 1); PG8_STAGE(PG8_SB(1, 0), b3, voffB);
            PG8_BAR; PG8_WAIT_L(0); PG8_MMA(0, 1, At, B1); PG8_BAR;
            PG8_LDA(At, 1, 1); PG8_STAGE(PG8_SA(1, 0), a3, voffA);
            PG8_BAR; PG8_WAIT_L(0); PG8_MMA(1, 0, At, B0); PG8_BAR; PG8_SCHED;
            PG8_STAGE(PG8_SB(1, 1), b3 + hstep, voffB);
            PG8_WAIT_V(6); PG8_BAR; PG8_MMA(1, 1, At, B1); PG8_BAR;
            }
        }
        if constexpr (ALIGN_EPI) { if (wr == 0) PG8_BAR; }
        if constexpr (!Epi::AFTER_DRAIN) { E(acc, cur, wr, wc, fr, fq); S.done(cur); }
        if (!has_next) break;
#pragma unroll
        for (int a = 0; a < 2; ++a)
#pragma unroll
            for (int b = 0; b < 2; ++b)
#pragma unroll
                for (int m = 0; m < 4; ++m)
#pragma unroll
                    for (int n = 0; n < 2; ++n) acc[a][b][m][n] = (f32x4){0.f, 0.f, 0.f, 0.f};
        cur = nxt; cA = nA; cB = nB; ++ui;
        if constexpr (ALIGN_EPI) { if (wr == 1) PG8_BAR; }
    }
    PG8_WAIT_V(0);
    if constexpr (!ALIGN_EPI) { if (wr == 0) PG8_BAR; }
    PG8_BAR;
    if constexpr (Epi::AFTER_DRAIN) { E.fused(acc, cur, wr, wc, fr, fq, lds, wid, lane); S.done(cur); }
#undef PG8_SA
#undef PG8_SB
#undef PG8_STAGE
#undef PG8_LDA
#undef PG8_LDB
#undef PG8_MMA
#undef PG8_WAIT_V
#undef PG8_WAIT_L
#undef PG8_BAR
#undef PG8_SCHED
}
}
#define GAS __attribute__((address_space(1)))
#define LAS __attribute__((address_space(3)))
typedef unsigned short bf16;
typedef unsigned v4u __attribute__((ext_vector_type(4)));
typedef float f32x4 __attribute__((ext_vector_type(4)));
typedef short bf16x8 __attribute__((ext_vector_type(8)));
typedef GAS unsigned gu32;
typedef GAS unsigned long long gu64;
#define RLX_AGENT __ATOMIC_RELAXED, __HIP_MEMORY_SCOPE_AGENT
#define LDS_WAIT() asm volatile("s_waitcnt lgkmcnt(0)" ::: "memory")
#define VM_WAIT() asm volatile("s_waitcnt vmcnt(0)" ::: "memory")
__device__ __forceinline__ unsigned long long rt() { return __builtin_amdgcn_s_memrealtime(); }
__device__ __forceinline__ unsigned f2bf(float f) { unsigned u = __builtin_bit_cast(unsigned, f); return (u + 0x7fffu + ((u >> 16) & 1u)) >> 16; }
__device__ __forceinline__ unsigned pk2(float lo, float hi) { return f2bf(lo) | (f2bf(hi) << 16); }

#define XB_TMO      128
#define XB_XCNT(j)  (256  + 64 * (j))
#define XB_XSUB(j)  (1280 + 64 * (j))
#define XB_XGEN(j)  (2304 + 64 * (j))
#define XB_TOP      3328
#define XB_TOPGEN   3392
#define XCD_BAR_WORDS 3456
#define XB_SPIN_CAP (1u << 18)

__device__ __forceinline__ unsigned xb_ld(unsigned* p)              { return __hip_atomic_load(p, __ATOMIC_RELAXED, __HIP_MEMORY_SCOPE_AGENT); }
__device__ __forceinline__ unsigned xb_add(unsigned* p, unsigned v) { return __hip_atomic_fetch_add(p, v, __ATOMIC_RELAXED, __HIP_MEMORY_SCOPE_AGENT); }
__device__ __forceinline__ unsigned xb_xcc_id() { return (unsigned)__builtin_amdgcn_s_getreg((3 << 11) | 20) & 0xFu; }
#define XB_SPIN(cond, bar) do { unsigned _sp = 0; while (cond) { __builtin_amdgcn_s_sleep(1); \
    if ((++_sp & 255u) == 0u) { if (xb_ld(&(bar)[XB_TMO])) break; if (_sp > XB_SPIN_CAP) { atomicAdd(&(bar)[XB_TMO], 1u); break; } } } } while (0)

struct XcdBarrier {
    unsigned* bar; unsigned x;
    volatile LAS unsigned* st;
};

__device__ __forceinline__ XcdBarrier xcd_barrier_post(unsigned* bar, volatile LAS unsigned* st) {
    XcdBarrier b; b.bar = bar; b.x = xb_xcc_id(); b.st = st;
    if (threadIdx.x == 0) (void)xb_add(&bar[XB_XCNT(b.x)], 1u);
    return b;
}
__device__ __forceinline__ void xcd_barrier_complete(unsigned* bar, unsigned x, unsigned& nloc, unsigned& nx) {
    const unsigned G = gridDim.x * gridDim.y * gridDim.z;
    unsigned sum, cnt, mine, sp = 0u;
    for (;;) {
        sum = 0u; cnt = 0u; mine = 0u;
#pragma unroll
        for (unsigned j = 0; j < 16; ++j) { const unsigned c = xb_ld(&bar[XB_XCNT(j)]); sum += c; cnt += (c > 0u) ? 1u : 0u; mine = (j == x) ? c : mine; }
        if (sum == G) break;
        __builtin_amdgcn_s_sleep(1);
        if ((++sp & 255u) == 0u) { if (xb_ld(&bar[XB_TMO])) break; if (sp > XB_SPIN_CAP) { atomicAdd(&bar[XB_TMO], 1u); break; } }
    }
    nloc = mine > 0u ? mine : 1u; nx = cnt > 0u ? cnt : 1u;
}

__device__ __forceinline__ void xcd_barrier(const XcdBarrier& b) {
    asm volatile("s_waitcnt vmcnt(0)" ::: "memory");
    __syncthreads();
    if (threadIdx.x == 0) {
        unsigned* bar = b.bar;
        __builtin_amdgcn_s_waitcnt(0);
        unsigned nloc = b.st[0], nx = b.st[1];
        if (nloc == 0u) { xcd_barrier_complete(bar, b.x, nloc, nx); b.st[0] = nloc; b.st[1] = nx; }
        const unsigned old = xb_add(&bar[XB_XSUB(b.x)], 1u);
        const unsigned gen = old / nloc;
        if (old + 1u == (gen + 1u) * nloc) {
            __builtin_amdgcn_fence(__ATOMIC_RELEASE, "agent");
            asm volatile("s_waitcnt vmcnt(0)" ::: "memory");
            const unsigned og = xb_add(&bar[XB_TOP], 1u);
            const unsigned tg = og / nx;
            if (og + 1u == (tg + 1u) * nx) xb_add(&bar[XB_TOPGEN], 1u);
            else XB_SPIN(xb_ld(&bar[XB_TOPGEN]) == tg, bar);
            __builtin_amdgcn_fence(__ATOMIC_ACQUIRE, "agent");
            xb_add(&bar[XB_XGEN(b.x)], 1u);
            asm volatile("s_waitcnt vmcnt(0)" ::: "memory");
        } else {
            XB_SPIN(xb_ld(&bar[XB_XGEN(b.x)]) == gen, bar);
            __builtin_amdgcn_fence(__ATOMIC_ACQUIRE, "agent");
            asm volatile("s_waitcnt vmcnt(0)" ::: "memory");
        }
    }
    __syncthreads();
}

#define XB_LOC(j)   (3584 + 64 * (j))
#define XB_RANK(j)  (4608 + 64 * (j))
#define XB_LGEN(j)  (5632 + 64 * (j))
#define XB_ALL_WORDS 6656
__device__ __forceinline__ void xcd_local_barrier(unsigned* bar, unsigned x, unsigned nloc) {
    asm volatile("s_waitcnt vmcnt(0)" ::: "memory");
    __syncthreads();
    if (threadIdx.x == 0) {
        __builtin_amdgcn_s_waitcnt(0);
        const unsigned old = xb_add(&bar[XB_LOC(x)], 1u); const unsigned gen = old / nloc;
        if (old + 1u == (gen + 1u) * nloc) {
            __builtin_amdgcn_fence(__ATOMIC_RELEASE, "agent");
            asm volatile("s_waitcnt vmcnt(0)" ::: "memory");
            __builtin_amdgcn_fence(__ATOMIC_ACQUIRE, "agent");
            xb_add(&bar[XB_LGEN(x)], 1u);
            asm volatile("s_waitcnt vmcnt(0)" ::: "memory");
        } else {
            XB_SPIN(xb_ld(&bar[XB_LGEN(x)]) == gen, bar);
            __builtin_amdgcn_fence(__ATOMIC_ACQUIRE, "agent");
            asm volatile("s_waitcnt vmcnt(0)" ::: "memory");
        }
    }
    __syncthreads();
}

constexpr int NWAVES = 8, NTHR = 512;
constexpr int DM = 1024, BATCH = 8, SEQ = 2048, DEPTH = 4, M = BATCH * SEQ;
constexpr int DFF = 2816, NUP = 2 * DFF, NPROJ = 3840, PROJ_LD = 3584, NIN_SRC = 3600, NCOND = 9 * DM;
constexpr float RMS_EPS = 1e-6f;
constexpr int PC_FQ = 0, PC_FK = 256, PC_FV = 512, PC_MQ = 768, PC_MK = 1024, PC_MV = 1280, PC_MO = 1536, PC_RQ = 1792, PC_RK = 2048, PC_RV = 2304, PC_RG = 2560, PC_SZ = 2816, PC_SX = 3072;
constexpr int PH_LAYER0 = 2, PH_PER_LAYER = 9, PH_FINAL = PH_LAYER0 + PH_PER_LAYER * DEPTH, PH_END = PH_FINAL + 1;
constexpr size_t MiB = 1u << 20;
constexpr size_t WS_CTL = 0, CTL_ZERO_BYTES = 1 * MiB;
constexpr size_t WS_COND = 1 * MiB;
constexpr size_t WS_ROPE = 3 * MiB;
constexpr size_t WS_W = 4 * MiB;
constexpr size_t W_UP = (size_t)NUP * DM * 2, W_DN = (size_t)DM * DFF * 2, W_IN = (size_t)NPROJ * DM * 2, W_OUT = (size_t)DM * DM * 2;
constexpr size_t OFF_UP1 = 0, OFF_DN1 = W_UP, OFF_UP2 = W_UP + W_DN, OFF_DN2 = 2 * W_UP + W_DN, OFF_IN = 2 * W_UP + 2 * W_DN, OFF_OUT = OFF_IN + W_IN, LAYER_W = OFF_OUT + W_OUT;
static_assert(LAYER_W * DEPTH == 170 * MiB, "weights");
constexpr size_t WS_HB = 174 * MiB;
constexpr size_t WS_PROJ = 206 * MiB, WS_ACT = 206 * MiB;
constexpr size_t WS_GATES = 318 * MiB;
constexpr size_t WS_VTF = 319 * MiB;
constexpr size_t WS_VTL = 327 * MiB;
constexpr size_t WS_QL = 363 * MiB, WS_KL = 387 * MiB;
constexpr size_t WS_COEF = 411 * MiB;
constexpr size_t COEF_A1 = 0, COEF_A2 = 768 * 1024, COEF_BETA = 2 * 768 * 1024, COEF_LCUM = 3 * 768 * 1024, COEF_S1 = COEF_LCUM + 256 * 1024, COEF_S2 = COEF_S1 + 16 * 1024, COEF_CTOT = COEF_S2 + 16 * 1024;
constexpr size_t WS_YRAW = 415 * MiB;
constexpr size_t WS_XB = 447 * MiB;
constexpr size_t WS_YBF = 479 * MiB;
constexpr size_t WS_KT = 511 * MiB;
constexpr size_t WS_XS = 535 * MiB;
constexpr size_t WS_DEN = 551 * MiB;
constexpr size_t WS_BIAS = 552 * MiB;
constexpr size_t BIAS_USE = (size_t)8 * NUP * 4, BIAS_BYTES = (size_t)DEPTH * 3 * BIAS_USE;
constexpr size_t WS_SS = 556 * MiB, SS_BYTES = (size_t)3 * DEPTH * M * 8;
constexpr size_t WS_BIASQ = 558 * MiB, BIASQ_BYTES = 2 * BIAS_BYTES, WS_END = 563 * MiB;
static_assert(WS_BIAS + BIAS_BYTES <= 555 * MiB && WS_SS + SS_BYTES <= WS_BIASQ && WS_BIASQ + BIASQ_BYTES <= WS_END, "ws map 2");
static_assert(WS_PROJ + (size_t)M * PROJ_LD * 2 <= WS_GATES && WS_ACT + (size_t)M * DFF * 2 <= WS_GATES && COEF_CTOT + 4096 <= 4 * MiB && WS_YRAW + (size_t)M * 1024 * 4 <= WS_YBF, "ws map");
constexpr int CW_BAR = 4096;
constexpr int RING_BYTES = 131072, LDS_BYTES = 163840, LDSCTL_OFF = LDS_BYTES - 1024, MISC_OFF = LDSCTL_OFF + 320;

__device__ const double INVREV[32] = {0.15915494309189535, 0.11934937021124886, 0.089499401608891013, 0.067115083005227255, 0.050329212104487035, 0.037741584717419778, 0.028302195830623395, 0.02122365276477766, 0.015915494309189534, 0.011934937021124886, 0.0089499401608891006, 0.0067115083005227253, 0.0050329212104487037, 0.0037741584717419768, 0.0028302195830623399, 0.0021223652764777662, 0.0015915494309189536, 0.0011934937021124887, 0.00089499401608891024, 0.0006711508300522726, 0.00050329212104487033, 0.00037741584717419769, 0.00028302195830623401, 0.00021223652764777661, 0.00015915494309189535, 0.00011934937021124885, 8.9499401608891018e-05, 6.7115083005227268e-05, 5.0329212104487035e-05, 3.7741584717419777e-05, 2.8302195830623396e-05, 2.1223652764777659e-05};

struct Args { const float* in[25]; float* out; unsigned char* ws; int ph_lo, ph_hi; };
static_assert(sizeof(Args) == 27 * 8 + 8, "Args has no padding");

__device__ __forceinline__ float wave_sum(float v) {
#pragma unroll
    for (int o = 1; o < 64; o <<= 1) v += __shfl_xor(v, o);
    return v;
}
__device__ __forceinline__ float bf2f(unsigned short u) { return __uint_as_float((unsigned)u << 16); }
__device__ __forceinline__ float sigmoid_f(float v) { return 1.0f / (1.0f + __expf(-v)); }
__device__ __forceinline__ float silu_acc(float v) { return v / (1.0f + __expf(-v)); }
__device__ __forceinline__ float log_sigmoid_f(float v) { return fminf(v, 0.f) - log1pf(__expf(-fabsf(v))); }
__device__ __forceinline__ float softplus_f(float v) { return fmaxf(v, 0.f) + log1pf(__expf(-fabsf(v))); }

__device__ __forceinline__ int map_up(int n) { const int t = n >> 8, r = n & 255; return (r < 128) ? (t * 128 + r) : (DFF + t * 128 + (r - 128)); }
__device__ __forceinline__ int map_in(int n) {
    if (n < 768) return n; if (n < 1536) return n + 4; if (n < 3584) return n + 12;
    const int j = n - 3584; if (j < 4) return 768 + j; if (j < 8) return 1540 + (j - 4); if (j < 12) return 1544 + (j - 8); if (j < 16) return 3596 + (j - 12); return -1; }
template <int MAP> __device__ __forceinline__ void tr_item(const float* W, int K, int Nsrc, bf16* WT, int kb, int nb, LAS float* scr, int lane, const float* shp, long long* biasp, int Ndst) {
    const int k0 = 64 * kb, n0 = 32 * nb; const int nd = n0 + (lane & 31); const int src = MAP == 1 ? map_up(nd) : (MAP == 2 ? map_in(nd) : nd);
    const bool regular = (MAP != 2) || (n0 < 3584);
    if (regular) {
        const int s0c = MAP == 1 ? map_up(n0) : (MAP == 2 ? map_in(n0) : n0); const int kq = lane >> 3, nq = lane & 7;
        f32x4 wv[8];
#pragma unroll
        for (int i = 0; i < 8; ++i) wv[i] = *(const f32x4*)(W + (size_t)(k0 + 8 * i + kq) * Nsrc + s0c + 4 * nq);
#pragma unroll
        for (int i = 0; i < 8; ++i) { LAS float* d = scr + (8 * i + kq) * 33 + 4 * nq; d[0] = wv[i][0]; d[1] = wv[i][1]; d[2] = wv[i][2]; d[3] = wv[i][3]; }
    } else {
#pragma unroll 8
        for (int i = 0; i < 32; ++i) { const int kk = 2 * i + (lane >> 5); scr[kk * 33 + (lane & 31)] = src >= 0 ? W[(size_t)(k0 + kk) * Nsrc + src] : 0.f; }
    }
    if (MAP != 0) {
        LAS float* shs = scr + 64 * 33;
#pragma unroll
        for (int bb = 0; bb < 8; ++bb) shs[lane * 8 + bb] = shp[(size_t)bb * NCOND + k0 + lane];
    }
    LDS_WAIT(); asm volatile("" ::: "memory");
    const int c = lane & 7;
#pragma unroll
    for (int j = 0; j < 4; ++j) { const int n = (lane >> 3) + 8 * j; const LAS float* s = scr + (8 * c) * 33 + n;
        v4u o; o.x = pk2(s[0 * 33], s[1 * 33]); o.y = pk2(s[2 * 33], s[3 * 33]); o.z = pk2(s[4 * 33], s[5 * 33]); o.w = pk2(s[6 * 33], s[7 * 33]);
        *(GAS v4u*)(WT + (size_t)(n0 + n) * K + k0 + 8 * c) = o; }
    if (MAP != 0) {
        const LAS float* shs = scr + 64 * 33; const int n = lane & 31, hf = lane >> 5;
        float acc[8];
#pragma unroll
        for (int bb = 0; bb < 8; ++bb) acc[bb] = 0.f;
#pragma unroll 8
        for (int i = 0; i < 32; ++i) { const int kk = 32 * hf + i; const float w = scr[kk * 33 + n]; const f32x4 s0 = *(const LAS f32x4*)(shs + kk * 8), s1 = *(const LAS f32x4*)(shs + kk * 8 + 4);
            acc[0] += w * s0[0]; acc[1] += w * s0[1]; acc[2] += w * s0[2]; acc[3] += w * s0[3]; acc[4] += w * s1[0]; acc[5] += w * s1[1]; acc[6] += w * s1[2]; acc[7] += w * s1[3]; }
#pragma unroll
        for (int bb = 0; bb < 8; ++bb) { acc[bb] += __shfl_xor(acc[bb], 32); if (hf == 0 && src >= 0) atomicAdd((unsigned long long*)(biasp + (size_t)bb * Ndst + n0 + n), (unsigned long long)__float2ll_rn(acc[bb] * 4294967296.0f)); }
    }
    LDS_WAIT(); asm volatile("" ::: "memory");
}
__device__ __forceinline__ void prologue0(const Args& a, LAS unsigned char* lds, int tid, int lane, int wave, int G) {
    unsigned char* ws = a.ws;
    LAS float* cact = (LAS float*)(lds + 69632);
    LAS float* red = (LAS float*)(lds + 102400);
    for (int i = tid; i < BATCH * DM; i += NTHR) { const float v = a.in[1][i]; cact[i] = silu_acc(v); }
    __syncthreads();
    float* cond = (float*)(ws + WS_COND);
    for (int item = blockIdx.x; item < DEPTH * (NCOND / 64); item += G) {
        const int l = item / (NCOND / 64), cb = item % (NCOND / 64), col = cb * 64 + lane, ks = wave;
        const float* W = a.in[2] + (size_t)l * DM * NCOND + col;
        float acc[8];
#pragma unroll
        for (int b = 0; b < 8; ++b) acc[b] = 0.f;
        for (int k = ks * 128; k < ks * 128 + 128; k += 16) { float w[16];
#pragma unroll
            for (int i = 0; i < 16; ++i) w[i] = W[(size_t)(k + i) * NCOND];
#pragma unroll
            for (int i = 0; i < 16; ++i)
#pragma unroll
                for (int b = 0; b < 8; ++b) acc[b] += cact[b * DM + k + i] * w[i]; }
#pragma unroll
        for (int b = 0; b < 8; ++b) red[(ks * 8 + b) * 64 + lane] = acc[b];
        __syncthreads();
        { const int b = wave; float s = 0.f;
#pragma unroll
          for (int k2 = 0; k2 < 8; ++k2) s += red[(k2 * 8 + b) * 64 + lane];
          cond[((size_t)l * BATCH + b) * NCOND + col] = s + a.in[3][(size_t)l * NCOND + col]; }
        __syncthreads();
    }
    float2* rope = (float2*)(ws + WS_ROPE);
    for (int e = blockIdx.x * NTHR + tid; e < SEQ * 32; e += G * NTHR) { const int s = e >> 5, i = e & 31; const double rev = (double)s * INVREV[i]; const float fr = (float)(rev - rint(rev));
        rope[e] = make_float2(__builtin_amdgcn_cosf(fr), __builtin_amdgcn_sinf(fr)); }
    { GAS f32x4* z = (GAS f32x4*)(ws + WS_BIASQ); for (size_t i = (size_t)blockIdx.x * NTHR + tid; i < BIASQ_BYTES / 16; i += (size_t)G * NTHR) z[i] = (f32x4){0.f, 0.f, 0.f, 0.f};
      GAS f32x4* z2 = (GAS f32x4*)(ws + WS_SS); for (size_t i = (size_t)blockIdx.x * NTHR + tid; i < SS_BYTES / 16; i += (size_t)G * NTHR) z2[i] = (f32x4){0.f, 0.f, 0.f, 0.f}; }
}
__device__ __forceinline__ void prologue1(const Args& a, LAS unsigned char* lds, int lane, int wave, int G) {
    unsigned char* ws = a.ws;
    LAS float* scr = (LAS float*)(lds + wave * 10496);
    const float* cond = (const float*)(ws + WS_COND);
    const int gw = blockIdx.x * NWAVES + wave, NGW = G * NWAVES;
    constexpr int I_UP = (DM / 64) * (NUP / 32), I_DN = (DFF / 64) * (DM / 32), I_IN = (DM / 64) * (NPROJ / 32), I_OUT = (DM / 64) * (DM / 32), I_LAYER = 2 * I_UP + 2 * I_DN + I_IN + I_OUT;
    for (int it = gw; it < DEPTH * I_LAYER; it += NGW) {
        const int l = it / I_LAYER; int r = it % I_LAYER;
        unsigned char* wl = ws + WS_W + (size_t)l * LAYER_W; const float* cl = cond + (size_t)l * BATCH * NCOND; long long* bl = (long long*)(ws + WS_BIASQ + (size_t)l * 3 * 2 * BIAS_USE);
        if (r < I_UP) { tr_item<1>(a.in[5] + (size_t)l * DM * NUP, DM, NUP, (bf16*)(wl + OFF_UP1), r / (NUP / 32), r % (NUP / 32), scr, lane, cl + 0 * DM, bl, NUP); continue; } r -= I_UP;
        if (r < I_DN) { tr_item<0>(a.in[6] + (size_t)l * DFF * DM, DFF, DM, (bf16*)(wl + OFF_DN1), r / (DM / 32), r % (DM / 32), scr, lane, nullptr, nullptr, 0); continue; } r -= I_DN;
        if (r < I_UP) { tr_item<1>(a.in[7] + (size_t)l * DM * NUP, DM, NUP, (bf16*)(wl + OFF_UP2), r / (NUP / 32), r % (NUP / 32), scr, lane, cl + 6 * DM, bl + 2 * 8 * NUP, NUP); continue; } r -= I_UP;
        if (r < I_DN) { tr_item<0>(a.in[8] + (size_t)l * DFF * DM, DFF, DM, (bf16*)(wl + OFF_DN2), r / (DM / 32), r % (DM / 32), scr, lane, nullptr, nullptr, 0); continue; } r -= I_DN;
        if (r < I_IN) { tr_item<2>(a.in[9] + (size_t)l * DM * NIN_SRC, DM, NIN_SRC, (bf16*)(wl + OFF_IN), r / (NPROJ / 32), r % (NPROJ / 32), scr, lane, cl + 3 * DM, bl + 1 * 8 * NUP, NPROJ); continue; } r -= I_IN;
        tr_item<0>(a.in[10] + (size_t)l * DM * DM, DM, DM, (bf16*)(wl + OFF_OUT), r / (DM / 32), r % (DM / 32), scr, lane, nullptr, nullptr, 0);
    }
}
__device__ __forceinline__ void thin_xg(const float* x, bf16* hb, bf16* xb, const float* g, const float* cond_l, int sc_off, long long* ss, int gw, int NGW, int lane) {
    for (int m = gw; m < M; m += NGW) {
        const int b = m >> 11;
        const GAS f32x4* xr = (const GAS f32x4*)(x + (size_t)m * DM) + lane;
        f32x4 v[4]; float s = 0.f;
#pragma unroll
        for (int j = 0; j < 4; ++j) { v[j] = xr[64 * j]; s += (v[j].x * v[j].x + v[j].y * v[j].y) + (v[j].z * v[j].z + v[j].w * v[j].w); }
        s = wave_sum(s); if (lane == 0) ss[m] = __float2ll_rn(s * 16777216.0f);
        const f32x4* g4 = (const f32x4*)g + lane; const f32x4* sc4 = (const f32x4*)(cond_l + (size_t)b * NCOND + sc_off) + lane;
        GAS unsigned long long* o8 = (GAS unsigned long long*)(hb + (size_t)m * DM) + lane;
#pragma unroll
        for (int j = 0; j < 4; ++j) { const f32x4 o = v[j] * g4[64 * j] * (sc4[64 * j] + 1.0f);
            o8[64 * j] = (unsigned long long)pk2(o.x, o.y) | ((unsigned long long)pk2(o.z, o.w) << 32); }
        GAS unsigned long long* x8 = (GAS unsigned long long*)(xb + (size_t)m * DM) + lane;
#pragma unroll
        for (int j = 0; j < 4; ++j) x8[64 * j] = (unsigned long long)pk2(v[j].x, v[j].y) | ((unsigned long long)pk2(v[j].z, v[j].w) << 32);
    }
}
__device__ __forceinline__ void thin_norm(const float* x, bf16* hb, const float* g, const float* cond_l, int sh_off, int sc_off, int gw, int NGW, int lane) {
    for (int m = gw; m < M; m += NGW) {
        const int b = m >> 11;
        const GAS f32x4* xr = (const GAS f32x4*)(x + (size_t)m * DM) + lane;
        f32x4 v[4]; float s = 0.f;
#pragma unroll
        for (int j = 0; j < 4; ++j) { v[j] = xr[64 * j]; s += (v[j].x * v[j].x + v[j].y * v[j].y) + (v[j].z * v[j].z + v[j].w * v[j].w); }
        const float rstd = 1.0f / sqrtf(wave_sum(s) * (1.0f / DM) + RMS_EPS);
        const f32x4* g4 = (const f32x4*)g + lane; const f32x4* sh4 = (const f32x4*)(cond_l + (size_t)b * NCOND + sh_off) + lane; const f32x4* sc4 = (const f32x4*)(cond_l + (size_t)b * NCOND + sc_off) + lane;
        GAS unsigned long long* o8 = (GAS unsigned long long*)(hb + (size_t)m * DM) + lane;
#pragma unroll
        for (int j = 0; j < 4; ++j) { const f32x4 gg = g4[64 * j], sh = sh4[64 * j], sc = sc4[64 * j]; const f32x4 o = v[j] * rstd * gg * (sc + 1.0f) + sh;
            o8[64 * j] = (unsigned long long)pk2(o.x, o.y) | ((unsigned long long)pk2(o.z, o.w) << 32); }
    }
}

typedef float f32x16 __attribute__((ext_vector_type(16)));
typedef short s16x4 __attribute__((ext_vector_type(4)));
typedef float f32x2_t __attribute__((ext_vector_type(2))); typedef __bf16 bf16x2_t __attribute__((ext_vector_type(2)));
#define MFMA32(a, b, c) __builtin_amdgcn_mfma_f32_32x32x16_bf16((a), (b), (c), 0, 0, 0)
constexpr float LOG2E = 1.4426950408889634f;
__device__ __forceinline__ unsigned cvtpk(float lo, float hi) { f32x2_t v = {lo, hi}; bf16x2_t b = __builtin_convertvector(v, bf16x2_t); return __builtin_bit_cast(unsigned, b); }
template <int KAP> __device__ __forceinline__ bf16x8 pack8(const f32x16& x) {
    v4u p; p.x = cvtpk(x[8 * KAP + 0], x[8 * KAP + 1]); p.y = cvtpk(x[8 * KAP + 2], x[8 * KAP + 3]); p.z = cvtpk(x[8 * KAP + 4], x[8 * KAP + 5]); p.w = cvtpk(x[8 * KAP + 6], x[8 * KAP + 7]);
    return __builtin_bit_cast(bf16x8, p); }
__device__ __forceinline__ bf16x8 ld_perm(const bf16* p) { const s16x4 lo = *(const s16x4*)p, hi = *(const s16x4*)(p + 8); return __builtin_shufflevector(lo, hi, 0, 1, 2, 3, 4, 5, 6, 7); }
__device__ __forceinline__ float fmax16(const f32x16& a) { float m0 = fmaxf(fmaxf(a[0], a[1]), fmaxf(a[2], a[3])), m1 = fmaxf(fmaxf(a[4], a[5]), fmaxf(a[6], a[7])), m2 = fmaxf(fmaxf(a[8], a[9]), fmaxf(a[10], a[11])), m3 = fmaxf(fmaxf(a[12], a[13]), fmaxf(a[14], a[15])); return fmaxf(fmaxf(m0, m1), fmaxf(m2, m3)); }

struct MixBufs {
    const bf16* proj; const float* gates;
    bf16* vtf;
    float* lcum;
    float* ctot;
    bf16* ql;
    bf16* kl;
    bf16* kt;
    bf16* vtl;
    float* xs;
    float* a1; float* a2; float* beta;
    float* s1; float* s2;
    float* den;
    float* yraw;
};
__device__ __forceinline__ float wave_scan_add(float v, int lane) {
#pragma unroll
    for (int o = 1; o < 64; o <<= 1) { const float u = __shfl_up(v, o); if (lane >= o) v += u; }
    return v; }
__device__ __forceinline__ float wave_scan_max(float v, int lane) {
#pragma unroll
    for (int o = 1; o < 64; o <<= 1) { const float u = __shfl_up(v, o); if (lane >= o) v = fmaxf(v, u); }
    return v; }

struct PrepW { const float* mcw; const float* mcb; const float* scw; const float* scb; const float* fox_fb; const float* mib; const float* mfb; const float* dtb; const float* alog; const float2* rope; };
__device__ __forceinline__ void prep_unit(const MixBufs& B, const PrepW& W, int u, int wave, int lane) {
    const int b = u >> 5, c = u & 31, s0 = 64 * c; const size_t m0 = (size_t)b * SEQ + s0;
    for (int job = wave; job < 52; job += NWAVES) {
        if (job < 36) {
            const int kind = job < 32 ? (job >> 2) : (job < 34 ? 8 : 9), h = job < 32 ? (job & 3) : (job & 1);
            const int cg = lane & 7, tb = lane >> 3, tok0 = 8 * tb;
            const int pc = (kind == 0 ? PC_FV + h * 64 : kind == 1 ? PC_MV + h * 64 : kind == 2 ? PC_RV + h * 64 : kind == 3 ? PC_MQ + h * 64 : kind == 4 ? PC_MK + h * 64 : kind == 5 ? PC_RQ + h * 64 : kind == 6 ? PC_RK + h * 64
                         : kind == 7 ? PC_SX + h * 64 : kind == 8 ? PC_SX + 256 + h * 64 : PC_SX + 384 + h * 64);
            const bf16* src = B.proj + (m0 + tok0) * PROJ_LD + pc + 8 * cg;
            const bool is_conv = (kind == 3 || kind == 4 || kind >= 7), is_rot = (kind == 5 || kind == 6);
            v4u raw[8];
#pragma unroll
            for (int i = 0; i < 8; ++i) raw[i] = *(const v4u*)(src + (size_t)i * PROJ_LD);
            float v[8][8];
#pragma unroll
            for (int i = 0; i < 8; ++i)
#pragma unroll
                for (int j = 0; j < 4; ++j) { v[i][2 * j] = __uint_as_float(raw[i][j] << 16); v[i][2 * j + 1] = __uint_as_float(raw[i][j] & 0xffff0000u); }
            if (is_conv) {
                const int cc = (kind == 3 ? h * 64 : kind == 4 ? 256 + h * 64 : kind == 7 ? h * 64 : kind == 8 ? 256 + h * 64 : 384 + h * 64) + 8 * cg; const float* cw = (kind <= 4) ? W.mcw : W.scw; const float* cbp = (kind <= 4) ? W.mcb : W.scb;
                float wt[4][8], cb[8], xh[3][8];
#pragma unroll
                for (int k = 0; k < 4; ++k) { const f32x4 a = *(const f32x4*)(cw + k * 512 + cc), d = *(const f32x4*)(cw + k * 512 + cc + 4);
#pragma unroll
                    for (int j = 0; j < 4; ++j) { wt[k][j] = a[j]; wt[k][4 + j] = d[j]; } }
                { const f32x4 a = *(const f32x4*)(cbp + cc), d = *(const f32x4*)(cbp + cc + 4);
#pragma unroll
                  for (int j = 0; j < 4; ++j) { cb[j] = a[j]; cb[4 + j] = d[j]; } }
                const bool has_halo = (c > 0) || (tb > 0);
#pragma unroll
                for (int k = 0; k < 3; ++k) { v4u hr = (v4u){0u, 0u, 0u, 0u}; if (has_halo) hr = *(const v4u*)(src - (size_t)(3 - k) * PROJ_LD);
#pragma unroll
                    for (int j = 0; j < 4; ++j) { xh[k][2 * j] = __uint_as_float(hr[j] << 16); xh[k][2 * j + 1] = __uint_as_float(hr[j] & 0xffff0000u); } }
#pragma unroll
                for (int j = 0; j < 8; ++j) { float x0 = xh[0][j], x1 = xh[1][j], x2 = xh[2][j];
#pragma unroll
                    for (int i = 0; i < 8; ++i) { const float x3 = v[i][j]; float o = pg8::silu_f(cb[j] + wt[0][j] * x0 + wt[1][j] * x1 + wt[2][j] * x2 + wt[3][j] * x3); if (kind == 3) o *= 0.125f; v[i][j] = o; x0 = x1; x1 = x2; x2 = x3; } }
            } else if (is_rot) {
                const bf16* src2 = B.proj + (m0 + tok0) * PROJ_LD + pc + 8 * (cg ^ 4);
                const bool lowh = cg < 4; const float sc = (kind == 6) ? 0.125f : 1.0f;
#pragma unroll
                for (int i = 0; i < 8; ++i) { const v4u pr = *(const v4u*)(src2 + (size_t)i * PROJ_LD); const float2* rp = W.rope + (size_t)(s0 + tok0 + i) * 32 + 8 * (cg & 3);
                    const f32x4 r0 = *(const f32x4*)rp, r1 = *(const f32x4*)(rp + 2), r2 = *(const f32x4*)(rp + 4), r3 = *(const f32x4*)(rp + 6);
                    const float cs[8] = {r0[0], r0[2], r1[0], r1[2], r2[0], r2[2], r3[0], r3[2]}, sn[8] = {r0[1], r0[3], r1[1], r1[3], r2[1], r2[3], r3[1], r3[3]};
#pragma unroll
                    for (int j = 0; j < 8; ++j) { const float pv = (j & 1) ? __uint_as_float(pr[j >> 1] & 0xffff0000u) : __uint_as_float(pr[j >> 1] << 16);
                        v[i][j] = (lowh ? v[i][j] * cs[j] - pv * sn[j] : pv * sn[j] + v[i][j] * cs[j]) * sc; } }
            }
            if (kind == 7) {
                const float dtb_h = W.dtb[h];
#pragma unroll
                for (int i = 0; i < 8; ++i) { bf16* xp = (bf16*)B.xs + (m0 + tok0 + i) * 256 + h * 64 + 8 * cg; *(GAS v4u*)xp = (v4u){cvtpk(v[i][0], v[i][1]), cvtpk(v[i][2], v[i][3]), cvtpk(v[i][4], v[i][5]), cvtpk(v[i][6], v[i][7])};
                    const float dt = softplus_f(B.gates[(m0 + tok0 + i) * 16 + 12 + h] + dtb_h);
#pragma unroll
                    for (int j = 0; j < 8; ++j) v[i][j] *= dt; }
            }
            unsigned P[8][4];
#pragma unroll
            for (int i = 0; i < 8; ++i)
#pragma unroll
                for (int j = 0; j < 4; ++j) P[i][j] = cvtpk(v[i][2 * j], v[i][2 * j + 1]);
            bf16* rm = nullptr;
            if (kind == 3) rm = B.ql + (0 * (size_t)M + m0) * 256 + h * 64; else if (kind == 4) rm = B.kl + (0 * (size_t)M + m0) * 256 + h * 64;
            else if (kind == 5) rm = B.ql + (1 * (size_t)M + m0) * 256 + h * 64; else if (kind == 6) rm = B.kl + (1 * (size_t)M + m0) * 256 + h * 64;
            else if (kind == 8) rm = B.kl + (2 * (size_t)M + m0) * 256 + h * 64; else if (kind == 9) rm = B.ql + (2 * (size_t)M + m0) * 256 + h * 64;
            if (rm) {
#pragma unroll
                for (int i = 0; i < 8; ++i) *(GAS v4u*)(rm + (size_t)(tok0 + i) * 256 + 8 * cg) = (v4u){P[i][0], P[i][1], P[i][2], P[i][3]};
            }
            bf16* tr = nullptr;
            if (kind == 0) tr = B.vtf + ((size_t)(b * 4 + h) * 64) * SEQ;
            else if (kind == 1) tr = B.vtl + (((size_t)(0 * BATCH + b) * 4 + h) * 96) * SEQ;
            else if (kind == 2) tr = B.vtl + (((size_t)(1 * BATCH + b) * 4 + h) * 96) * SEQ;
            else if (kind == 7) tr = B.vtl + (((size_t)(2 * BATCH + b) * 4 + h) * 96) * SEQ;
            else if (kind == 4) tr = B.kt + (((size_t)(0 * BATCH + b) * 4 + h) * 64) * SEQ;
            else if (kind == 6) tr = B.kt + (((size_t)(1 * BATCH + b) * 4 + h) * 64) * SEQ;
            else if (kind == 8) tr = B.kt + (((size_t)(2 * BATCH + b) * 4 + h) * 64) * SEQ;
            if (tr) {
                tr += s0 + tok0;
#pragma unroll
                for (int j = 0; j < 8; ++j) { v4u o;
#pragma unroll
                    for (int ip = 0; ip < 4; ++ip) o[ip] = (j & 1) ? ((P[2 * ip][j >> 1] >> 16) | (P[2 * ip + 1][j >> 1] & 0xffff0000u)) : ((P[2 * ip][j >> 1] & 0xffffu) | (P[2 * ip + 1][j >> 1] << 16));
                    *(GAS v4u*)(tr + (size_t)(8 * cg + j) * SEQ) = o; }
                if (kind == 1 && cg < 4) {
#pragma unroll
                    for (int j = 0; j < 8; ++j) { const unsigned w = (cg == 0 && j == 0) ? 0x3f803f80u : 0u; *(GAS v4u*)(tr + (size_t)(64 + 8 * cg + j) * SEQ) = (v4u){w, w, w, w}; }
                }
            }
        } else {
            const int gj = job - 36, mixer = gj >> 2, h = gj & 3;
            const size_t m = m0 + lane;
            if (mixer == 0) {
                const float cum = wave_scan_add(log_sigmoid_f(B.gates[m * 16 + h] + W.fox_fb[h]), lane);
                B.lcum[(size_t)(b * 4 + h) * SEQ + s0 + lane] = cum; if (lane == 63) B.ctot[(b * 4 + h) * 32 + c] = cum;
            } else {
                const int mx = mixer - 1; const size_t ci = ((size_t)(mx * BATCH + b) * 4 + h) * SEQ + s0 + lane; const int si = ((mx * BATCH + b) * 4 + h) * 32 + c;
                if (mx == 0) {
                    const float bb = wave_scan_add(log_sigmoid_f(B.gates[m * 16 + 8 + h] + W.mfb[h]), lane), ic = B.gates[m * 16 + 4 + h] + W.mib[h], be = bb - ic, pm = wave_scan_max(-be, lane);
                    B.a1[ci] = bb; B.a2[ci] = bb + pm; B.beta[ci] = be; if (lane == 63) { B.s1[si] = bb; B.s2[si] = bb + pm; }
                } else if (mx == 1) {
                    const float lg = log1pf(-exp2f(-5.0f - (float)h)), v = (float)(lane + 1) * lg;
                    B.a1[ci] = v; B.a2[ci] = 0.f; B.beta[ci] = v; if (lane == 63) { B.s1[si] = v; B.s2[si] = 0.f; }
                } else {
                    const float dt = softplus_f(B.gates[m * 16 + 12 + h] + W.dtb[h]), cum = wave_scan_add(dt * (-__expf(W.alog[h])), lane);
                    B.a1[ci] = cum; B.a2[ci] = 0.f; B.beta[ci] = cum; if (lane == 63) { B.s1[si] = cum; B.s2[si] = 0.f; }
                }
            }
        }
    }
}

__device__ __forceinline__ int sig32(int i) { return (i & ~0xC) | ((i & 4) << 1) | ((i & 8) >> 1); }
#define GLDS16(gp, lp) __builtin_amdgcn_global_load_lds((const unsigned*)(gp), (LAS unsigned*)(lp), 16, 0, 0)
#define VMWAIT(n) asm volatile("s_waitcnt vmcnt(" #n ")" ::: "memory")
#define WGBAR() do { asm volatile("" ::: "memory"); __builtin_amdgcn_s_barrier(); asm volatile("" ::: "memory"); } while (0)
constexpr int FOX_SLOT = 16384, FOX_LC = 3 * FOX_SLOT;
__device__ __forceinline__ void fox_wg_unit(const MixBufs& B, bf16* ybf, LAS unsigned char* lds, int b, int h, int qb8, int wave, int lane) {
    const int col = lane & 31, hi = lane >> 5, t0 = 256 * qb8 + 32 * wave;
    const size_t rowq = (size_t)b * SEQ + t0 + col;
    bf16x8 qf[4];
#pragma unroll
    for (int ks = 0; ks < 4; ++ks) qf[ks] = *(const bf16x8*)(B.proj + rowq * PROJ_LD + PC_FQ + h * 64 + 16 * ks + 8 * hi);
    float offv; { const float cv = (lane < 32) ? B.ctot[(b * 4 + h) * 32 + lane] : 0.f; offv = wave_scan_add(cv, lane) - cv; }
    if (wave <= qb8) GLDS16(B.lcum + (size_t)(b * 4 + h) * SEQ + 256 * wave + 4 * lane, lds + FOX_LC + 1024 * wave);
    const bf16* ksrc = B.proj + ((size_t)b * SEQ + 32 * (wave >> 2) + sig32(col)) * PROJ_LD + PC_FK + h * 64 + 16 * (wave & 3) + 8 * hi;
    const bf16* vsrc = B.vtf + ((size_t)(b * 4 + h) * 64 + 32 * (wave >> 2) + col) * SEQ + 16 * (wave & 3) + 8 * hi;
    const int nkt = 4 * (qb8 + 1), tdiag = 4 * qb8 + (wave >> 1);
#define FOX_ISSUE(t, slot) do { GLDS16(ksrc + (size_t)(64 * (t)) * PROJ_LD, lds + (slot) * FOX_SLOT + 1024 * wave); GLDS16(vsrc + 64 * (t), lds + (slot) * FOX_SLOT + 8192 + 1024 * wave); } while (0)
    VMWAIT(0); WGBAR();
    if (wave <= qb8) {
        LAS f32x4* lp = (LAS f32x4*)(lds + FOX_LC + 1024 * wave) + lane; const f32x4 cv = *lp;
        const float o = __shfl(offv, 4 * wave + (lane >> 4));
        *lp = (cv + o) * (-LOG2E);
    }
    asm volatile("s_waitcnt lgkmcnt(0)" ::: "memory"); WGBAR();
    FOX_ISSUE(0, 0); FOX_ISSUE(1, 1);
    float mrun = -INFINITY, lsum = 0.f; f32x16 O0, O1;
#pragma unroll
    for (int r = 0; r < 16; ++r) { O0[r] = 0.f; O1[r] = 0.f; }
    int slot = 0;
    for (int kt = 0; kt < nkt; ++kt) {
        VMWAIT(2); WGBAR();
        { const int tn = (kt + 2 < nkt) ? kt + 2 : nkt - 1; const int sn = (slot == 0) ? 2 : slot - 1; FOX_ISSUE(tn, sn); }
        if (kt <= tdiag) {
            const int s0 = 64 * kt;
            const LAS unsigned char* sp = lds + slot * FOX_SLOT + 16 * lane;
            const LAS float* lc = (const LAS float*)(lds + FOX_LC) + s0 + 8 * hi;
            f32x16 S0, S1;
#pragma unroll
            for (int j = 0; j < 4; ++j) { const f32x4 c0 = *(const LAS f32x4*)(lc + 16 * j), c1 = *(const LAS f32x4*)(lc + 16 * j + 4);
#pragma unroll
                for (int i = 0; i < 4; ++i) { if (j < 2) { S0[8 * j + i] = c0[i]; S0[8 * j + 4 + i] = c1[i]; } else { S1[8 * (j - 2) + i] = c0[i]; S1[8 * (j - 2) + 4 + i] = c1[i]; } } }
#pragma unroll
            for (int ks = 0; ks < 4; ++ks) { S0 = MFMA32(*(const LAS bf16x8*)(sp + ks * 1024), qf[ks], S0); S1 = MFMA32(*(const LAS bf16x8*)(sp + (4 + ks) * 1024), qf[ks], S1); }
            if (kt == tdiag) {
                const int tq = t0 + col - s0;
#pragma unroll
                for (int r = 0; r < 16; ++r) { const int sl = 16 * (r >> 3) + 8 * hi + (r & 7); if (sl > tq) S0[r] = -INFINITY; if (sl + 32 > tq) S1[r] = -INFINITY; }
            }
            float mloc = fmaxf(fmax16(S0), fmax16(S1)); mloc = fmaxf(mloc, __shfl_xor(mloc, 32));
            const float mnew = fmaxf(mrun, mloc), alpha = __builtin_amdgcn_exp2f(mrun - mnew); mrun = mnew;
            float psum = 0.f;
#pragma unroll
            for (int r = 0; r < 16; ++r) { S0[r] = __builtin_amdgcn_exp2f(S0[r] - mnew); S1[r] = __builtin_amdgcn_exp2f(S1[r] - mnew); psum += S0[r] + S1[r]; }
            lsum = lsum * alpha + psum;
#pragma unroll
            for (int r = 0; r < 16; ++r) { O0[r] *= alpha; O1[r] *= alpha; }
            { const bf16x8 p00 = pack8<0>(S0), p01 = pack8<1>(S0), p10 = pack8<0>(S1), p11 = pack8<1>(S1);
              const LAS unsigned char* vp = sp + 8192;
              O0 = MFMA32(*(const LAS bf16x8*)(vp), p00, O0); O0 = MFMA32(*(const LAS bf16x8*)(vp + 1024), p01, O0); O0 = MFMA32(*(const LAS bf16x8*)(vp + 2048), p10, O0); O0 = MFMA32(*(const LAS bf16x8*)(vp + 3072), p11, O0);
              O1 = MFMA32(*(const LAS bf16x8*)(vp + 4096), p00, O1); O1 = MFMA32(*(const LAS bf16x8*)(vp + 5120), p01, O1); O1 = MFMA32(*(const LAS bf16x8*)(vp + 6144), p10, O1); O1 = MFMA32(*(const LAS bf16x8*)(vp + 7168), p11, O1); }
        }
        asm volatile("" ::: "memory");
        slot = (slot == 2) ? 0 : slot + 1;
    }
#undef FOX_ISSUE
    const float rl = 1.0f / (lsum + __shfl_xor(lsum, 32));
    bf16* yp = ybf + rowq * DM + h * 64 + 4 * hi;
#pragma unroll
    for (int g = 0; g < 4; ++g) { *(unsigned long long*)(yp + 8 * g) = (unsigned long long)cvtpk(O0[4 * g] * rl, O0[4 * g + 1] * rl) | ((unsigned long long)cvtpk(O0[4 * g + 2] * rl, O0[4 * g + 3] * rl) << 32);
                                  *(unsigned long long*)(yp + 32 + 8 * g) = (unsigned long long)cvtpk(O1[4 * g] * rl, O1[4 * g + 1] * rl) | ((unsigned long long)cvtpk(O1[4 * g + 2] * rl, O1[4 * g + 3] * rl) << 32); }
    VMWAIT(0); WGBAR();
}

constexpr int LIN_BUF = 30720, LIN_STF = 3 * LIN_BUF;
__device__ __forceinline__ void lin_wg_unit(const MixBufs& B, LAS unsigned char* lbuf, int mx, int b, int h, int es, int wave, int lane) {
    const int col = lane & 31, hi = lane >> 5, hk = (mx == 2) ? (h >> 1) : h; const bool ml = (mx == 0);
    const size_t cbase = (((size_t)mx * BATCH + b) * 4 + h) * SEQ; const int sbase = ((mx * BATCH + b) * 4 + h) * 32;
    if (wave >= 1 && wave <= 4) {
        const bf16* src; size_t step_c, step_hi, step_lo; int np, f0;
        if (wave == 1)      { src = B.ql + ((size_t)mx * M + (size_t)b * SEQ + col) * 256 + hk * 64 + 8 * hi;            step_c = 64 * 256; step_hi = 32 * 256; step_lo = 16; np = 8; f0 = 0; }
        else if (wave == 2) { src = B.kl + ((size_t)mx * M + (size_t)b * SEQ + sig32(col)) * 256 + hk * 64 + 8 * hi;     step_c = 64 * 256; step_hi = 32 * 256; step_lo = 16; np = 8; f0 = 8; }
        else if (wave == 3) { src = B.kt + ((((size_t)mx * BATCH + b) * 4 + hk) * 64 + sig32(col)) * SEQ + 8 * hi;      step_c = 64; step_hi = (size_t)32 * SEQ; step_lo = 16; np = 8; f0 = 16; }
        else                { src = B.vtl + ((((size_t)mx * BATCH + b) * 4 + h) * 96 + 32 * es + col) * SEQ + 8 * hi;   step_c = 64; step_hi = 0; step_lo = 16; np = 4; f0 = 24; }
        const int cl = lane & 15; const bool sc_lane = (lane == 48 || lane == 49);
        const float* cfp = (lane < 16) ? B.a1 + cbase + 4 * cl : (lane < 32) ? B.a2 + cbase + 4 * cl : (lane < 48) ? B.beta + cbase + 4 * cl : (lane == 48) ? B.s1 + sbase : (lane == 49) ? B.s2 + sbase : B.a1 + cbase;
#define LIN_ISSUE(c, bi) do { LAS unsigned char* bb_ = lbuf + (bi) * LIN_BUF + f0 * 1024; const bf16* sc_ = src + (size_t)(c) * step_c; \
            _Pragma("unroll") for (int f = 0; f < 8; ++f) if (f < np) GLDS16(sc_ + (size_t)(f >> 2) * step_hi + (size_t)(f & 3) * step_lo, bb_ + f * 1024); \
            if (wave == 4) GLDS16(cfp + (sc_lane ? 4 * ((c) >> 2) : 64 * (c)), lbuf + (bi) * LIN_BUF + 28 * 1024); } while (0)
        LIN_ISSUE(0, 0); LIN_ISSUE(1, 1);
        if (wave == 4) VMWAIT(5); else VMWAIT(8);
        WGBAR();
        int bi = 2;
        for (int c = 0; c < 32; ++c) {
            const int cc = (c + 2 < 32) ? c + 2 : 31;
            LIN_ISSUE(cc, bi);
            if (wave == 4) VMWAIT(5); else VMWAIT(8);
            WGBAR();
            bi = (bi == 2) ? 0 : bi + 1;
        }
#undef LIN_ISSUE
        VMWAIT(0);
    } else if (wave == 0 || wave == 5) {
        const int tt = (wave == 5) ? 1 : 0;
        float mst = 0.f; int bi = 0;
        WGBAR();
        for (int c = 0; c < 32; ++c) {
            const int s0 = 64 * c;
            const LAS unsigned char* bp = lbuf + bi * LIN_BUF + 16 * lane;
            const LAS unsigned char* sf = lbuf + LIN_STF + (c & 1) * 4096 + 16 * lane;
            const LAS float* cf = (const LAS float*)(lbuf + bi * LIN_BUF + 28 * 1024);
#define LFR(f) (*(const LAS bf16x8*)(bp + (f) * 1024))
            const float S1v = cf[192 + (c & 3)], S2v = cf[196 + (c & 3)];
            float mnew = 0.f;
            if (ml) mnew = fmaxf(S1v + mst, S2v);
            const float a1 = cf[32 * tt + col]; float al = a1, rho = a1, mt = 0.f;
            if (ml) { mt = fmaxf(a1 + mst, cf[64 + 32 * tt + col]); al = a1 - mt; rho = a1 + mst - mt; }
            f32x16 y;
#pragma unroll
            for (int r = 0; r < 16; ++r) y[r] = 0.f;
#pragma unroll
            for (int j = 0; j < 4; ++j) y = MFMA32(*(const LAS bf16x8*)(sf + j * 1024), LFR(tt * 4 + j), y);
            const float er = __expf(rho);
#pragma unroll
            for (int r = 0; r < 16; ++r) y[r] *= er;
            for (int st = 0; st <= tt; ++st) {
                f32x4 bD[2][2];
#pragma unroll
                for (int k = 0; k < 2; ++k) { bD[k][0] = *(const LAS f32x4*)(cf + 128 + 16 * (2 * st + k) + 8 * hi); bD[k][1] = *(const LAS f32x4*)(cf + 128 + 16 * (2 * st + k) + 8 * hi + 4); }
                f32x16 p;
#pragma unroll
                for (int r = 0; r < 16; ++r) p[r] = 0.f;
#pragma unroll
                for (int ks = 0; ks < 4; ++ks) p = MFMA32(LFR(8 + st * 4 + ks), LFR(tt * 4 + ks), p);
#pragma unroll
                for (int r = 0; r < 16; ++r) { float v = p[r] * __expf(al - bD[r >> 3][(r >> 2) & 1][r & 3]); if (st == tt && (16 * (r >> 3) + 8 * hi + (r & 7)) > col) v = 0.f; p[r] = v; }
                y = MFMA32(LFR(24 + 2 * st), pack8<0>(p), y); y = MFMA32(LFR(24 + 2 * st + 1), pack8<1>(p), y);
            }
            { const size_t row = (size_t)b * SEQ + s0 + 32 * tt + col;
              if (es < 2) { bf16* yp = (bf16*)B.yraw + row * 1024 + 256 * (mx + 1) + h * 64 + 32 * es + 4 * hi;
#pragma unroll
                  for (int g = 0; g < 4; ++g) *(unsigned long long*)(yp + 8 * g) = (unsigned long long)cvtpk(y[4 * g], y[4 * g + 1]) | ((unsigned long long)cvtpk(y[4 * g + 2], y[4 * g + 3]) << 32); }
              else if (hi == 0) { B.den[row * 8 + h * 2] = y[0]; B.den[row * 8 + h * 2 + 1] = mt; } }
#undef LFR
            if (ml) mst = mnew;
            asm volatile("s_waitcnt lgkmcnt(0)" ::: "memory");
            WGBAR();
            bi = (bi == 2) ? 0 : bi + 1;
        }
    } else if (wave == 6) {
        f32x16 st0, st1;
#pragma unroll
        for (int r = 0; r < 16; ++r) { st0[r] = 0.f; st1[r] = 0.f; }
        { LAS unsigned char* sf = lbuf + LIN_STF + 16 * lane;
#pragma unroll
          for (int j = 0; j < 4; ++j) *(LAS v4u*)(sf + j * 1024) = (v4u){0u, 0u, 0u, 0u}; }
        float mst = 0.f; int bi = 0;
        asm volatile("s_waitcnt lgkmcnt(0)" ::: "memory");
        WGBAR();
        for (int c = 0; c < 32; ++c) {
            const LAS unsigned char* bp = lbuf + bi * LIN_BUF + 16 * lane;
            const LAS float* cf = (const LAS float*)(lbuf + bi * LIN_BUF + 28 * 1024);
#define LFR(f) (*(const LAS bf16x8*)(bp + (f) * 1024))
            const float S1v = cf[192 + (c & 3)], S2v = cf[196 + (c & 3)];
            float gam = S1v, dlt = S1v, mnew = 0.f;
            if (ml) { mnew = fmaxf(S1v + mst, S2v); gam = S1v - mnew; dlt = S1v + mst - mnew; }
            const float ed = __expf(dlt);
#pragma unroll
            for (int r = 0; r < 16; ++r) { st0[r] *= ed; st1[r] *= ed; }
#pragma unroll
            for (int k4 = 0; k4 < 4; ++k4) {
                const bf16x8 vr = LFR(24 + k4); const f32x4 b0 = *(const LAS f32x4*)(cf + 128 + 16 * k4 + 8 * hi), b1 = *(const LAS f32x4*)(cf + 128 + 16 * k4 + 8 * hi + 4);
                v4u wv; wv.x = cvtpk(bf2f((unsigned short)vr[0]) * __expf(gam - b0[0]), bf2f((unsigned short)vr[1]) * __expf(gam - b0[1])); wv.y = cvtpk(bf2f((unsigned short)vr[2]) * __expf(gam - b0[2]), bf2f((unsigned short)vr[3]) * __expf(gam - b0[3]));
                wv.z = cvtpk(bf2f((unsigned short)vr[4]) * __expf(gam - b1[0]), bf2f((unsigned short)vr[5]) * __expf(gam - b1[1])); wv.w = cvtpk(bf2f((unsigned short)vr[6]) * __expf(gam - b1[2]), bf2f((unsigned short)vr[7]) * __expf(gam - b1[3]));
                const bf16x8 wvf = __builtin_bit_cast(bf16x8, wv);
                st0 = MFMA32(LFR(16 + k4), wvf, st0); st1 = MFMA32(LFR(20 + k4), wvf, st1);
            }
#undef LFR
            { LAS unsigned char* sf = lbuf + LIN_STF + ((c + 1) & 1) * 4096 + 16 * lane;
              *(LAS bf16x8*)(sf) = pack8<0>(st0); *(LAS bf16x8*)(sf + 1024) = pack8<1>(st0); *(LAS bf16x8*)(sf + 2048) = pack8<0>(st1); *(LAS bf16x8*)(sf + 3072) = pack8<1>(st1); }
            if (ml) mst = mnew;
            asm volatile("s_waitcnt lgkmcnt(0)" ::: "memory");
            WGBAR();
            bi = (bi == 2) ? 0 : bi + 1;
        }
    } else {
        for (int c = 0; c < 33; ++c) WGBAR();
    }
    VMWAIT(0); WGBAR();
}
constexpr int MX_LC = 3 * 16384, MX_LIN = MX_LC + 8192, MX_STF = MX_LIN + 3 * LIN_BUF;
static_assert(MX_STF + 8192 <= LDSCTL_OFF, "mixer LDS map");
__device__ __forceinline__ void mixer_phase(const MixBufs& B, bf16* ybf, LAS unsigned char* lds, int vcu, int wave, int lane) {
    const int G = gridDim.x;
    const int col = lane & 31, hi = lane >> 5;
    for (int v = vcu; v < 256; v += G) {
        const int bh = v >> 3, i8 = v & 7, fb = bh >> 2, fh = bh & 3;
        const int nktA = 2 * i8 + 2, NF = 34;
        const bool has_lin = i8 < 7; const int lj = (bh & 3) * 7 + i8;
        int mx, lh, es; const int lb = fb; if (lj < 12) { mx = 0; lh = lj / 3; es = lj % 3; } else { const int w2 = lj - 12; mx = 1 + (w2 >> 3); lh = (w2 >> 1) & 3; es = w2 & 1; }
        const int hk = (mx == 2) ? (lh >> 1) : lh; const bool ml = (mx == 0);
        const size_t cbase = (((size_t)mx * BATCH + lb) * 4 + lh) * SEQ; const int sbase = ((mx * BATCH + lb) * 4 + lh) * 32;
        if (wave < 4) {
            int qb16 = i8, t0 = 128 * qb16 + 32 * wave, tdiag = 2 * qb16 + (wave >> 1);
            size_t rowq = (size_t)fb * SEQ + t0 + col;
            bf16x8 qf[4];
#pragma unroll
            for (int ks = 0; ks < 4; ++ks) qf[ks] = *(const bf16x8*)(B.proj + rowq * PROJ_LD + PC_FQ + fh * 64 + 16 * ks + 8 * hi);
            float offv; { const float cv = (lane < 32) ? B.ctot[(fb * 4 + fh) * 32 + lane] : 0.f; offv = wave_scan_add(cv, lane) - cv; }
            GLDS16(B.lcum + (size_t)(fb * 4 + fh) * SEQ + 256 * wave + 4 * lane, lds + MX_LC + 1024 * wave);
            GLDS16(B.lcum + (size_t)(fb * 4 + fh) * SEQ + 256 * (wave + 4) + 4 * lane, lds + MX_LC + 1024 * (wave + 4));
            const bf16* ksrc = B.proj + ((size_t)fb * SEQ + sig32(col)) * PROJ_LD + PC_FK + fh * 64 + 16 * wave + 8 * hi;
            const bf16* vsrc = B.vtf + ((size_t)(fb * 4 + fh) * 64 + col) * SEQ + 16 * wave + 8 * hi;
#define FOX_ISSUE(kt, slot) do { LAS unsigned char* d_ = lds + (slot) * FOX_SLOT + 1024 * wave; const bf16* k_ = ksrc + (size_t)(64 * (kt)) * PROJ_LD; const bf16* v_ = vsrc + 64 * (kt); \
                GLDS16(k_, d_); GLDS16(k_ + (size_t)32 * PROJ_LD, d_ + 4096); GLDS16(v_, d_ + 8192); GLDS16(v_ + (size_t)32 * SEQ, d_ + 12288); } while (0)
            FOX_ISSUE(0, 0); FOX_ISSUE(1, 1);
            VMWAIT(8); WGBAR();
#pragma unroll
            for (int pz = 0; pz < 2; ++pz) { const int pc_ = wave + 4 * pz;
                LAS f32x4* lp = (LAS f32x4*)(lds + MX_LC + 1024 * pc_) + lane; const f32x4 cv = *lp; const float o = __shfl(offv, 4 * pc_ + (lane >> 4)); *lp = (cv + o) * (-LOG2E); }
            asm volatile("s_waitcnt lgkmcnt(0)" ::: "memory"); WGBAR();
            float mrun = -INFINITY, lsum = 0.f; f32x16 O0, O1;
#pragma unroll
            for (int r = 0; r < 16; ++r) { O0[r] = 0.f; O1[r] = 0.f; }
            int sl = 0;
            for (int f = 0; f < NF; ++f) {
                if (f + 1 < NF) VMWAIT(4); else VMWAIT(0);
                WGBAR();
                if (f + 2 < NF) { const int kn = (f + 2 < nktA) ? f + 2 : f + 2 - nktA; FOX_ISSUE(kn, (sl == 0) ? 2 : sl - 1); }
                if (f == nktA) {
                    const float rl = 1.0f / (lsum + __shfl_xor(lsum, 32));
                    bf16* yp = ybf + rowq * DM + fh * 64 + 4 * hi;
#pragma unroll
                    for (int g = 0; g < 4; ++g) { *(unsigned long long*)(yp + 8 * g) = (unsigned long long)cvtpk(O0[4 * g] * rl, O0[4 * g + 1] * rl) | ((unsigned long long)cvtpk(O0[4 * g + 2] * rl, O0[4 * g + 3] * rl) << 32);
                                                  *(unsigned long long*)(yp + 32 + 8 * g) = (unsigned long long)cvtpk(O1[4 * g] * rl, O1[4 * g + 1] * rl) | ((unsigned long long)cvtpk(O1[4 * g + 2] * rl, O1[4 * g + 3] * rl) << 32); }
                    qb16 = 15 - i8; t0 = 128 * qb16 + 32 * wave; tdiag = 2 * qb16 + (wave >> 1); rowq = (size_t)fb * SEQ + t0 + col;
#pragma unroll
                    for (int ks = 0; ks < 4; ++ks) qf[ks] = *(const bf16x8*)(B.proj + rowq * PROJ_LD + PC_FQ + fh * 64 + 16 * ks + 8 * hi);
                    mrun = -INFINITY; lsum = 0.f;
#pragma unroll
                    for (int r = 0; r < 16; ++r) { O0[r] = 0.f; O1[r] = 0.f; }
                }
                const int kt = (f < nktA) ? f : f - nktA;
                if (kt <= tdiag) {
                    const int s0 = 64 * kt;
                    const LAS unsigned char* sp = lds + sl * FOX_SLOT + 16 * lane;
                    const LAS float* lc = (const LAS float*)(lds + MX_LC) + s0 + 8 * hi;
                    f32x16 S0, S1;
#pragma unroll
                    for (int j = 0; j < 4; ++j) { const f32x4 c0 = *(const LAS f32x4*)(lc + 16 * j), c1 = *(const LAS f32x4*)(lc + 16 * j + 4);
#pragma unroll
                        for (int i = 0; i < 4; ++i) { if (j < 2) { S0[8 * j + i] = c0[i]; S0[8 * j + 4 + i] = c1[i]; } else { S1[8 * (j - 2) + i] = c0[i]; S1[8 * (j - 2) + 4 + i] = c1[i]; } } }
#pragma unroll
                    for (int ks = 0; ks < 4; ++ks) { S0 = MFMA32(*(const LAS bf16x8*)(sp + ks * 1024), qf[ks], S0); S1 = MFMA32(*(const LAS bf16x8*)(sp + (4 + ks) * 1024), qf[ks], S1); }
                    if (kt == tdiag) {
                        const int tq = t0 + col - s0;
#pragma unroll
                        for (int r = 0; r < 16; ++r) { const int sl = 16 * (r >> 3) + 8 * hi + (r & 7); if (sl > tq) S0[r] = -INFINITY; if (sl + 32 > tq) S1[r] = -INFINITY; }
                    }
                    float mloc = fmaxf(fmax16(S0), fmax16(S1)); mloc = fmaxf(mloc, __shfl_xor(mloc, 32));
                    const float mnew = fmaxf(mrun, mloc), alpha = __builtin_amdgcn_exp2f(mrun - mnew); mrun = mnew;
                    float psum = 0.f;
#pragma unroll
                    for (int r = 0; r < 16; ++r) { S0[r] = __builtin_amdgcn_exp2f(S0[r] - mnew); S1[r] = __builtin_amdgcn_exp2f(S1[r] - mnew); psum += S0[r] + S1[r]; }
                    lsum = lsum * alpha + psum;
#pragma unroll
                    for (int r = 0; r < 16; ++r) { O0[r] *= alpha; O1[r] *= alpha; }
                    { const bf16x8 p00 = pack8<0>(S0), p01 = pack8<1>(S0), p10 = pack8<0>(S1), p11 = pack8<1>(S1);
                      const LAS unsigned char* vp = sp + 8192;
                      O0 = MFMA32(*(const LAS bf16x8*)(vp), p00, O0); O0 = MFMA32(*(const LAS bf16x8*)(vp + 1024), p01, O0); O0 = MFMA32(*(const LAS bf16x8*)(vp + 2048), p10, O0); O0 = MFMA32(*(const LAS bf16x8*)(vp + 3072), p11, O0);
                      O1 = MFMA32(*(const LAS bf16x8*)(vp + 4096), p00, O1); O1 = MFMA32(*(const LAS bf16x8*)(vp + 5120), p01, O1); O1 = MFMA32(*(const LAS bf16x8*)(vp + 6144), p10, O1); O1 = MFMA32(*(const LAS bf16x8*)(vp + 7168), p11, O1); }
                }
                asm volatile("s_waitcnt lgkmcnt(0)" ::: "memory");
                sl = (sl == 2) ? 0 : sl + 1;
            }
#undef FOX_ISSUE
            { const float rl = 1.0f / (lsum + __shfl_xor(lsum, 32));
              bf16* yp = ybf + rowq * DM + fh * 64 + 4 * hi;
#pragma unroll
              for (int g = 0; g < 4; ++g) { *(unsigned long long*)(yp + 8 * g) = (unsigned long long)cvtpk(O0[4 * g] * rl, O0[4 * g + 1] * rl) | ((unsigned long long)cvtpk(O0[4 * g + 2] * rl, O0[4 * g + 3] * rl) << 32);
                                            *(unsigned long long*)(yp + 32 + 8 * g) = (unsigned long long)cvtpk(O1[4 * g] * rl, O1[4 * g + 1] * rl) | ((unsigned long long)cvtpk(O1[4 * g + 2] * rl, O1[4 * g + 3] * rl) << 32); } }
        } else {
            const bf16* src; size_t step_c, step_hi; int np, f0;
            if (wave == 4)      { src = B.ql + ((size_t)mx * M + (size_t)lb * SEQ + col) * 256 + hk * 64 + 8 * hi;            step_c = 64 * 256; step_hi = 32 * 256; np = 8; f0 = 0; }
            else if (wave == 6) { src = B.kt + ((((size_t)mx * BATCH + lb) * 4 + hk) * 64 + sig32(col)) * SEQ + 8 * hi;      step_c = 64; step_hi = (size_t)32 * SEQ; np = 8; f0 = 16; }
            else if (wave == 7) { src = B.vtl + ((((size_t)mx * BATCH + lb) * 4 + lh) * 96 + 32 * es + col) * SEQ + 8 * hi;  step_c = 64; step_hi = 0; np = 4; f0 = 24; }
            else                { src = B.ql; step_c = 0; step_hi = 0; np = 0; f0 = 0; }
            const bf16* srck = B.kl + ((size_t)mx * M + (size_t)lb * SEQ + sig32(col)) * 256 + hk * 64 + 8 * hi;
            const int cl = lane & 15; const bool sc_lane = (lane == 48 || lane == 49);
            const float* cfp = (lane < 16) ? B.a1 + cbase + 4 * cl : (lane < 32) ? B.a2 + cbase + 4 * cl : (lane < 48) ? B.beta + cbase + 4 * cl : (lane == 48) ? B.s1 + sbase : (lane == 49) ? B.s2 + sbase : B.a1 + cbase;
            LAS unsigned char* lbuf = lds + MX_LIN;
#define LIN_ISSUE(c, bi) do { LAS unsigned char* bb_ = lbuf + (bi) * LIN_BUF + f0 * 1024; const bf16* sc_ = src + (size_t)(c) * step_c; \
                _Pragma("unroll") for (int f = 0; f < 8; ++f) if (f < np) GLDS16(sc_ + (size_t)(f >> 2) * step_hi + (size_t)(f & 3) * 16, bb_ + f * 1024); \
                if (wave == 7) { const bf16* sk_ = srck + (size_t)(c) * (64 * 256); LAS unsigned char* bk_ = lbuf + (bi) * LIN_BUF + 8 * 1024; \
                    _Pragma("unroll") for (int f = 0; f < 8; ++f) GLDS16(sk_ + (size_t)(f >> 2) * (32 * 256) + (size_t)(f & 3) * 16, bk_ + f * 1024); \
                    GLDS16(cfp + (sc_lane ? 4 * ((c) >> 2) : 64 * (c)), lbuf + (bi) * LIN_BUF + 28 * 1024); } } while (0)
            if (has_lin) { LIN_ISSUE(0, 0); LIN_ISSUE(1, 1); }
            f32x16 st0, st1;
#pragma unroll
            for (int r = 0; r < 16; ++r) { st0[r] = 0.f; st1[r] = 0.f; }
            if (wave == 6) { LAS unsigned char* sf = lds + MX_STF + 16 * lane;
#pragma unroll
                for (int j = 0; j < 4; ++j) *(LAS v4u*)(sf + j * 1024) = (v4u){0u, 0u, 0u, 0u}; }
            asm volatile("s_waitcnt lgkmcnt(0)" ::: "memory"); WGBAR();
            WGBAR();
            float mst = 0.f; int bi = 0;
            for (int c = 0; c < NF; ++c) {
                if (c + 1 < 32) { if (wave == 7) VMWAIT(13); else if (wave == 5) VMWAIT(0); else VMWAIT(8); } else VMWAIT(0);
                WGBAR();
                if (has_lin && c < 32) {
                    if (c + 2 < 32) LIN_ISSUE(c + 2, (bi == 0) ? 2 : bi - 1);
                    const LAS unsigned char* bp = lbuf + bi * LIN_BUF + 16 * lane;
                    const LAS float* cf = (const LAS float*)(lbuf + bi * LIN_BUF + 28 * 1024);
#define LFR(f) (*(const LAS bf16x8*)(bp + (f) * 1024))
                    if (wave == 4 || wave == 5) {
                        const int tt = wave - 4, s0 = 64 * c;
                        const LAS unsigned char* sf = lds + MX_STF + (c & 1) * 4096 + 16 * lane;
                        const float S1v = cf[192 + (c & 3)], S2v = cf[196 + (c & 3)];
                        float mnew = 0.f;
                        if (ml) mnew = fmaxf(S1v + mst, S2v);
                        const float a1 = cf[32 * tt + col]; float al = a1, rho = a1, mt = 0.f;
                        if (ml) { mt = fmaxf(a1 + mst, cf[64 + 32 * tt + col]); al = a1 - mt; rho = a1 + mst - mt; }
                        f32x16 y;
#pragma unroll
                        for (int r = 0; r < 16; ++r) y[r] = 0.f;
#pragma unroll
                        for (int j = 0; j < 4; ++j) y = MFMA32(*(const LAS bf16x8*)(sf + j * 1024), LFR(tt * 4 + j), y);
                        const float er = __expf(rho);
#pragma unroll
                        for (int r = 0; r < 16; ++r) y[r] *= er;
                        for (int st = 0; st <= tt; ++st) {
                            f32x4 bD[2][2];
#pragma unroll
                            for (int k = 0; k < 2; ++k) { bD[k][0] = *(const LAS f32x4*)(cf + 128 + 16 * (2 * st + k) + 8 * hi); bD[k][1] = *(const LAS f32x4*)(cf + 128 + 16 * (2 * st + k) + 8 * hi + 4); }
                            f32x16 p;
#pragma unroll
                            for (int r = 0; r < 16; ++r) p[r] = 0.f;
#pragma unroll
                            for (int ks = 0; ks < 4; ++ks) p = MFMA32(LFR(8 + st * 4 + ks), LFR(tt * 4 + ks), p);
#pragma unroll
                            for (int r = 0; r < 16; ++r) { float vv = p[r] * __expf(al - bD[r >> 3][(r >> 2) & 1][r & 3]); if (st == tt && (16 * (r >> 3) + 8 * hi + (r & 7)) > col) vv = 0.f; p[r] = vv; }
                            y = MFMA32(LFR(24 + 2 * st), pack8<0>(p), y); y = MFMA32(LFR(24 + 2 * st + 1), pack8<1>(p), y);
                        }
                        { const size_t row = (size_t)lb * SEQ + s0 + 32 * tt + col;
                          if (es < 2) { bf16* yp = (bf16*)B.yraw + row * 1024 + 256 * (mx + 1) + lh * 64 + 32 * es + 4 * hi;
#pragma unroll
                              for (int g = 0; g < 4; ++g) *(unsigned long long*)(yp + 8 * g) = (unsigned long long)cvtpk(y[4 * g], y[4 * g + 1]) | ((unsigned long long)cvtpk(y[4 * g + 2], y[4 * g + 3]) << 32); }
                          else if (hi == 0) { B.den[row * 8 + lh * 2] = y[0]; B.den[row * 8 + lh * 2 + 1] = mt; } }
                        if (ml) mst = mnew;
                    } else if (wave == 6) {
                        const float S1v = cf[192 + (c & 3)], S2v = cf[196 + (c & 3)];
                        float gam = S1v, dlt = S1v, mnew = 0.f;
                        if (ml) { mnew = fmaxf(S1v + mst, S2v); gam = S1v - mnew; dlt = S1v + mst - mnew; }
                        const float ed = __expf(dlt);
#pragma unroll
                        for (int r = 0; r < 16; ++r) { st0[r] *= ed; st1[r] *= ed; }
#pragma unroll
                        for (int k4 = 0; k4 < 4; ++k4) {
                            const bf16x8 vr = LFR(24 + k4); const f32x4 b0 = *(const LAS f32x4*)(cf + 128 + 16 * k4 + 8 * hi), b1 = *(const LAS f32x4*)(cf + 128 + 16 * k4 + 8 * hi + 4);
                            v4u wv; wv.x = cvtpk(bf2f((unsigned short)vr[0]) * __expf(gam - b0[0]), bf2f((unsigned short)vr[1]) * __expf(gam - b0[1])); wv.y = cvtpk(bf2f((unsigned short)vr[2]) * __expf(gam - b0[2]), bf2f((unsigned short)vr[3]) * __expf(gam - b0[3]));
                            wv.z = cvtpk(bf2f((unsigned short)vr[4]) * __expf(gam - b1[0]), bf2f((unsigned short)vr[5]) * __expf(gam - b1[1])); wv.w = cvtpk(bf2f((unsigned short)vr[6]) * __expf(gam - b1[2]), bf2f((unsigned short)vr[7]) * __expf(gam - b1[3]));
                            const bf16x8 wvf = __builtin_bit_cast(bf16x8, wv);
                            st0 = MFMA32(LFR(16 + k4), wvf, st0); st1 = MFMA32(LFR(20 + k4), wvf, st1);
                        }
                        { LAS unsigned char* sf = lds + MX_STF + ((c + 1) & 1) * 4096 + 16 * lane;
                          *(LAS bf16x8*)(sf) = pack8<0>(st0); *(LAS bf16x8*)(sf + 1024) = pack8<1>(st0); *(LAS bf16x8*)(sf + 2048) = pack8<0>(st1); *(LAS bf16x8*)(sf + 3072) = pack8<1>(st1); }
                        if (ml) mst = mnew;
                    }
#undef LFR
                }
                asm volatile("s_waitcnt lgkmcnt(0)" ::: "memory");
                bi = (bi == 2) ? 0 : bi + 1;
            }
#undef LIN_ISSUE
        }
        VMWAIT(0); WGBAR();
    }
}
__device__ __forceinline__ f32x4 unpack4bf(unsigned long long q) { return (f32x4){__uint_as_float((unsigned)q << 16), __uint_as_float((unsigned)q & 0xffff0000u), __uint_as_float((unsigned)(q >> 32) << 16), __uint_as_float((unsigned)(q >> 32) & 0xffff0000u)}; }
__device__ __forceinline__ void post_new(const MixBufs& B, bf16* ybf, const float* mng, const float* rng, const float* sng, const float* sD, int gw, int NGW, int lane) {
    constexpr int R = 4;
    const int c4 = 4 * lane, hd = lane >> 4;
    const f32x4 gnm = *(const f32x4*)(mng + c4), gnr = *(const f32x4*)(rng + c4), gns = *(const f32x4*)(sng + c4); const float Dh = sD[hd];
    for (int k0 = 0; k0 < M / NGW; k0 += R) {
        unsigned long long yq[R][3], gq[R][3]; f32x4 xx[R]; float dn[R], mt[R];
#pragma unroll
        for (int j = 0; j < R; ++j) { const int m = (NGW == 2048) ? ((gw >> 8) * SEQ + (gw & 255) + 256 * (k0 + j)) : (gw + (k0 + j) * NGW); const size_t r = (size_t)m;
#pragma unroll
            for (int mx = 0; mx < 3; ++mx) yq[j][mx] = *(const unsigned long long*)((const bf16*)B.yraw + r * 1024 + 256 * (mx + 1) + c4);
            gq[j][0] = *(const unsigned long long*)(B.proj + r * PROJ_LD + PC_MO + c4); gq[j][1] = *(const unsigned long long*)(B.proj + r * PROJ_LD + PC_RG + c4); gq[j][2] = *(const unsigned long long*)(B.proj + r * PROJ_LD + PC_SZ + c4);
            xx[j] = unpack4bf(*(const unsigned long long*)((const bf16*)B.xs + r * 256 + c4)); dn[j] = B.den[r * 8 + hd * 2]; mt[j] = B.den[r * 8 + hd * 2 + 1]; }
#pragma unroll
        for (int j = 0; j < R; ++j) { const int m = (NGW == 2048) ? ((gw >> 8) * SEQ + (gw & 255) + 256 * (k0 + j)) : (gw + (k0 + j) * NGW); const size_t r = (size_t)m;
            GAS unsigned long long* o8 = (GAS unsigned long long*)(ybf + r * DM) + lane;
#pragma unroll
            for (int mx = 0; mx < 2; ++mx) {
                f32x4 v = unpack4bf(yq[j][mx]);
                if (mx == 0) v = v * (1.0f / fmaxf(fabsf(dn[j]), __expf(-mt[j])));
                float ss = (v.x * v.x + v.y * v.y) + (v.z * v.z + v.w * v.w);
                ss += __shfl_xor(ss, 1); ss += __shfl_xor(ss, 2); ss += __shfl_xor(ss, 4); ss += __shfl_xor(ss, 8);
                const float rstd = 1.0f / sqrtf(ss * (1.0f / 64.0f) + RMS_EPS);
                const f32x4 gr = unpack4bf(gq[j][mx]); f32x4 gt;
#pragma unroll
                for (int i = 0; i < 4; ++i) gt[i] = mx == 0 ? sigmoid_f(gr[i]) : silu_acc(gr[i]);
                const f32x4 o = gt * (v * rstd * (mx == 0 ? gnm : gnr));
                o8[64 * (mx + 1)] = (unsigned long long)pk2(o.x, o.y) | ((unsigned long long)pk2(o.z, o.w) << 32);
            }
            { const f32x4 hs = unpack4bf(yq[j][2]), zr = unpack4bf(gq[j][2]); f32x4 v;
#pragma unroll
              for (int i = 0; i < 4; ++i) v[i] = (hs[i] + Dh * xx[j][i]) * silu_acc(zr[i]);
              const float ss = wave_sum((v.x * v.x + v.y * v.y) + (v.z * v.z + v.w * v.w));
              const float rstd = 1.0f / sqrtf(ss * (1.0f / 256.0f) + RMS_EPS);
              const f32x4 o = v * rstd * gns;
              o8[192] = (unsigned long long)pk2(o.x, o.y) | ((unsigned long long)pk2(o.z, o.w) << 32); }
        }
    }
}
__device__ __forceinline__ void final_norm(float* x, const float* g, int gw, int NGW, int lane) {
    constexpr int R = 4;
    f32x4 gv[4];
#pragma unroll
    for (int j = 0; j < 4; ++j) gv[j] = ((const f32x4*)g)[lane + 64 * j];
    for (int k0 = 0; k0 < M / NGW; k0 += R) {
        f32x4 v[R][4];
#pragma unroll
        for (int q = 0; q < R; ++q) { const int m = (NGW == 2048) ? ((gw >> 8) * SEQ + (gw & 255) + 256 * (k0 + q)) : (gw + (k0 + q) * NGW);
            const GAS f32x4* xr = (const GAS f32x4*)(x + (size_t)m * DM) + lane;
#pragma unroll
            for (int j = 0; j < 4; ++j) v[q][j] = xr[64 * j]; }
#pragma unroll
        for (int q = 0; q < R; ++q) { const int m = (NGW == 2048) ? ((gw >> 8) * SEQ + (gw & 255) + 256 * (k0 + q)) : (gw + (k0 + q) * NGW);
            GAS f32x4* xr = (GAS f32x4*)(x + (size_t)m * DM) + lane; float s = 0.f;
#pragma unroll
            for (int j = 0; j < 4; ++j) s += (v[q][j].x * v[q][j].x + v[q][j].y * v[q][j].y) + (v[q][j].z * v[q][j].z + v[q][j].w * v[q][j].w);
            const float rstd = 1.0f / sqrtf(wave_sum(s) * (1.0f / DM) + RMS_EPS);
#pragma unroll
            for (int j = 0; j < 4; ++j) xr[64 * j] = v[q][j] * rstd * gv[j]; }
    }
}

__global__ void __launch_bounds__(NTHR, 2) fwd(Args a) {
    extern __shared__ __attribute__((aligned(16))) unsigned char lds_raw[];
    LAS unsigned char* lds = (LAS unsigned char*)lds_raw;
    const int tid = threadIdx.x, lane = tid & 63, wave = __builtin_amdgcn_readfirstlane(tid >> 6), G = gridDim.x;
    const int gw = blockIdx.x * NWAVES + wave, NGW = G * NWAVES;
    unsigned char* ws = a.ws;
    for (int u = tid; u < (LDS_BYTES - LDSCTL_OFF) / 4; u += NTHR) ((LAS unsigned*)(lds + LDSCTL_OFF))[u] = 0u;
    __syncthreads();
    const int lo = a.ph_lo, hi = a.ph_hi;
    XcdBarrier bar; bar.bar = (unsigned*)(ws + WS_CTL) + CW_BAR; bar.x = 0; bar.st = nullptr;
    if (hi - lo > 1) bar = xcd_barrier_post((unsigned*)(ws + WS_CTL) + CW_BAR, (volatile LAS unsigned*)(lds + MISC_OFF) + 8);
    volatile LAS unsigned* MISCW = (volatile LAS unsigned*)(lds + MISC_OFF);
    if (hi - lo > 1 && tid == 0) MISCW[16] = xb_add(&bar.bar[XB_RANK(bar.x)], 1u);
    int bid = (int)blockIdx.x; bool loc = false;
#define IN(k) (lo <= (k) && (k) < hi)
#define PH_IDS int t_ = threadIdx.x; asm volatile("" : "+v"(t_)); const int lane_ = t_ & 63, wave_ = __builtin_amdgcn_readfirstlane(t_ >> 6), gw_ = blockIdx.x * NWAVES + wave_; (void)lane_; (void)gw_; (void)wave_;
#define SEAM(k) do { if ((k) + 1 < hi) { if (loc) xcd_local_barrier(bar.bar, bar.x, 32u); else xcd_barrier(bar); } } while (0)
    float* xres = a.out;
    float* cond = (float*)(ws + WS_COND); const float2* rope = (const float2*)(ws + WS_ROPE);
    bf16* HB = (bf16*)(ws + WS_HB); bf16* ACT = (bf16*)(ws + WS_ACT); bf16* PROJ = (bf16*)(ws + WS_PROJ); float* GATES = (float*)(ws + WS_GATES);
    bf16* YBF = (bf16*)(ws + WS_YBF);
#define MK_MB unsigned char* ws_ = a.ws; asm volatile("" : "+s"(ws_)); MixBufs MB; MB.proj = (const bf16*)(ws_ + WS_PROJ); MB.gates = (const float*)(ws_ + WS_GATES); MB.vtf = (bf16*)(ws_ + WS_VTF); MB.lcum = (float*)(ws_ + WS_COEF + COEF_LCUM); MB.ctot = (float*)(ws_ + WS_COEF + COEF_CTOT); \
    MB.ql = (bf16*)(ws_ + WS_QL); MB.kl = (bf16*)(ws_ + WS_KL); MB.kt = (bf16*)(ws_ + WS_KT); MB.vtl = (bf16*)(ws_ + WS_VTL); MB.xs = (float*)(ws_ + WS_XS); \
    MB.a1 = (float*)(ws_ + WS_COEF + COEF_A1); MB.a2 = (float*)(ws_ + WS_COEF + COEF_A2); MB.beta = (float*)(ws_ + WS_COEF + COEF_BETA); MB.s1 = (float*)(ws_ + WS_COEF + COEF_S1); MB.s2 = (float*)(ws_ + WS_COEF + COEF_S2); \
    MB.den = (float*)(ws_ + WS_DEN); MB.yraw = (float*)(ws_ + WS_YRAW); bf16* YBF_ = (bf16*)(ws_ + WS_YBF); (void)YBF_;
    long long* SS = (long long*)(ws + WS_SS);
    if (IN(0)) { PH_IDS prologue0(a, lds, t_, lane_, wave_, G); SEAM(0); }
    if (IN(1)) { PH_IDS prologue1(a, lds, lane_, wave_, G); thin_xg(a.in[0], HB, (bf16*)(ws + WS_XB), a.in[4], cond, 1 * DM, SS, gw_, NGW, lane_); SEAM(1);
        { const long long* q = (const long long*)(ws + WS_BIASQ); float* bf = (float*)(ws + WS_BIAS);
          for (int i = blockIdx.x * NTHR + t_; i < (int)(BIAS_BYTES / 4); i += G * NTHR) bf[i] = (float)((double)q[i] * (1.0 / 4294967296.0)); }
        SEAM(1); }
    if (lo == 0 && hi == PH_END && G == 256) {
        if (tid == 0) { bool ok = true;
#pragma unroll
            for (unsigned j = 0; j < 16; ++j) { const unsigned cnt = xb_ld(&bar.bar[XB_RANK(j)]); ok = ok && (cnt == (j < 8 ? 32u : 0u)); }
            MISCW[17] = ok ? 1u : 0u; }
        __syncthreads();
        if (MISCW[17]) { loc = true; bid = __builtin_amdgcn_readfirstlane((int)(MISCW[16] * 8u + bar.x)); }
    }
    const int vcu = (G % 8 == 0) ? (bid % 8) * (G / 8) + bid / 8 : bid;
    for (int l = 0; l < DEPTH; ++l) {
        const int pb = PH_LAYER0 + PH_PER_LAYER * l;
        if (hi <= pb || lo >= pb + PH_PER_LAYER) continue;
        const float* cond_l = cond + (size_t)l * BATCH * NCOND;
        unsigned char* wl = ws + WS_W + (size_t)l * LAYER_W;
        const float* xin = (l == 0) ? a.in[0] : xres;
        const float* bias_l = (const float*)(ws + WS_BIAS + (size_t)l * 3 * BIAS_USE);
        long long* ss0 = SS + (size_t)(3 * l) * M;
        const float* ng = a.in[4] + (size_t)(l * 3) * DM;
        if (IN(pb + 0)) { pg8::Gemm g{HB, (const bf16*)(wl + OFF_UP1), M, NUP, DM}; pg8::StaticOrder S; S.init(M, NUP, G, bid); pg8::EpiSwigluN E{ACT, PROJ_LD, ss0, bias_l, NUP};
            pg8::gemm_phase<pg8::EpiSwigluN, pg8::StaticOrder, true, true>(lds, g, S, E); if (REP_UP > 1) { __syncthreads(); pg8::gemm_phase<pg8::EpiSwigluN, pg8::StaticOrder, true, true>(lds, g, S, E); } SEAM(pb + 0); }
        if (IN(pb + 1)) { pg8::Gemm g{ACT, (const bf16*)(wl + OFF_DN1), M, DM, DFF, PROJ_LD}; pg8::StaticOrder S; S.init(M, DM, G, bid);
            pg8::EpiResidNorm E{cond_l, ng + DM, ws, 2 * DM, 4 * DM, (int)(WS_HB / MiB), (int)(WS_XB / MiB), (int)(WS_SS / 8) + (3 * l + 1) * M, 0.5f};
            pg8::gemm_phase<pg8::EpiResidNorm, pg8::StaticOrder, true, true>(lds, g, S, E); SEAM(pb + 1); }
        if (IN(pb + 2)) { pg8::Gemm g{HB, (const bf16*)(wl + OFF_IN), M, NPROJ, DM}; pg8::StaticOrder S; S.init(M, NPROJ, G, bid); pg8::EpiProjN E{PROJ, PROJ_LD, GATES, PROJ_LD / 256, 0.125f * LOG2E, ss0 + M, bias_l + 8 * NUP, NPROJ};
            pg8::gemm_phase<pg8::EpiProjN, pg8::StaticOrder, true, true>(lds, g, S, E); SEAM(pb + 2); }
        if (IN(pb + 3)) { PH_IDS MK_MB PrepW PW{a.in[12] + (size_t)l * 4 * 512, a.in[13] + (size_t)l * 512, a.in[18] + (size_t)l * 4 * 512, a.in[19] + (size_t)l * 512, a.in[11] + l * 4, a.in[14] + l * 4, a.in[15] + l * 4, a.in[20] + l * 4, a.in[21] + l * 4, (const float2*)(ws_ + WS_ROPE)};
            for (int rep = 0; rep < REP_PREP; ++rep) for (int u = vcu; u < BATCH * 32; u += G) prep_unit(MB, PW, u, wave_, lane_); SEAM(pb + 3); }
        if (IN(pb + 4)) { PH_IDS MK_MB mixer_phase(MB, YBF_, lds, vcu, wave_, lane_); if (REP_MIX > 1) { asm volatile("" ::: "memory"); mixer_phase(MB, YBF_, lds, vcu, wave_, lane_); } SEAM(pb + 4); }
        if (IN(pb + 5)) { PH_IDS MK_MB for (int rep = 0; rep < REP_POST; ++rep) post_new(MB, YBF_, a.in[16] + (size_t)l * 256, a.in[17] + (size_t)l * 256, a.in[23] + (size_t)l * 256, a.in[22] + l * 4, vcu * NWAVES + wave_, NGW, lane_); SEAM(pb + 5); }
        if (IN(pb + 6)) { pg8::Gemm g{YBF, (const bf16*)(wl + OFF_OUT), M, DM, DM}; pg8::StaticOrder S; S.init(M, DM, G, bid);
            pg8::EpiResidNorm E{cond_l, ng + 2 * DM, ws, 5 * DM, 7 * DM, (int)(WS_HB / MiB), (int)(WS_XB / MiB), (int)(WS_SS / 8) + (3 * l + 2) * M, 1.0f};
            pg8::gemm_phase<pg8::EpiResidNorm, pg8::StaticOrder, true, true>(lds, g, S, E); SEAM(pb + 6); }
        if (IN(pb + 7)) { pg8::Gemm g{HB, (const bf16*)(wl + OFF_UP2), M, NUP, DM}; pg8::StaticOrder S; S.init(M, NUP, G, bid); pg8::EpiSwigluN E{ACT, PROJ_LD, ss0 + 2 * M, bias_l + 2 * 8 * NUP, NUP};
            pg8::gemm_phase<pg8::EpiSwigluN, pg8::StaticOrder, true, true>(lds, g, S, E); SEAM(pb + 7); }
        if (IN(pb + 8)) { pg8::Gemm g{ACT, (const bf16*)(wl + OFF_DN2), M, DM, DFF, PROJ_LD}; pg8::StaticOrder S; S.init(M, DM, G, bid);
            if (l + 1 < DEPTH) { pg8::EpiResidNorm E{cond_l, ng + 3 * DM, ws, 8 * DM, BATCH * NCOND + 1 * DM, (int)(WS_HB / MiB), (int)(WS_XB / MiB), (int)(WS_SS / 8) + (3 * l + 3) * M, 0.5f};
                pg8::gemm_phase<pg8::EpiResidNorm, pg8::StaticOrder, true, true>(lds, g, S, E); }
            else { pg8::EpiResid E{(const bf16*)(ws + WS_XB), xres, DM, cond_l + 8 * DM, NCOND, SEQ, 0.5f}; pg8::gemm_phase<pg8::EpiResid, pg8::StaticOrder, true, true>(lds, g, S, E); }
            SEAM(pb + 8); }
    }
    if (IN(PH_FINAL)) { PH_IDS final_norm(xres, a.in[24], vcu * NWAVES + wave_, NGW, lane_); }
#undef IN
#undef SEAM
}

#ifndef N_SPLIT
#define N_SPLIT 0
#endif
extern "C" void kernel_launch(void* const* d_in, const int* in_sizes, int n_in, void* d_out, int out_size, void* d_ws, size_t ws_size, hipStream_t stream) {
    static int grid = 0;
    if (grid == 0) {
        if (n_in != 25 || in_sizes[0] != M * DM || out_size != M * DM || ws_size < WS_END) { fprintf(stderr, "kernel_launch: unexpected problem (n_in %d, in0 %d, out %d, ws %zu)\n", n_in, n_in > 0 ? in_sizes[0] : -1, out_size, ws_size); grid = -1; return; }
        int dev = 0, cus = 0, per_cu = 0;
        if (hipGetDevice(&dev) != hipSuccess || hipDeviceGetAttribute(&cus, hipDeviceAttributeMultiprocessorCount, dev) != hipSuccess) { grid = -1; return; }
        if (hipFuncSetAttribute((const void*)fwd, hipFuncAttributeMaxDynamicSharedMemorySize, LDS_BYTES) != hipSuccess) { fprintf(stderr, "kernel_launch: hipFuncSetAttribute failed\n"); grid = -1; return; }
        if (hipOccupancyMaxActiveBlocksPerMultiprocessor(&per_cu, (const void*)fwd, NTHR, LDS_BYTES) != hipSuccess || per_cu < 1) fprintf(stderr, "kernel_launch: occupancy query says %d\n", per_cu);
        (void)hipGetLastError();
        grid = cus;
    }
    if (grid < 0) return;
    if (hipMemsetAsync((char*)d_ws + WS_CTL, 0, CTL_ZERO_BYTES, stream) != hipSuccess) return;
    Args a{};
    for (int i = 0; i < 25; ++i) a.in[i] = (const float*)d_in[i];
    a.out = (float*)d_out; a.ws = (unsigned char*)d_ws;
#if N_SPLIT
    for (int p = 0; p < PH_END; ++p) { a.ph_lo = p; a.ph_hi = p + 1; hipLaunchKernelGGL(fwd, dim3(grid), dim3(NTHR), LDS_BYTES, stream, a); }
#else
    a.ph_lo = 0; a.ph_hi = PH_END; hipLaunchKernelGGL(fwd, dim3(grid), dim3(NTHR), LDS_BYTES, stream, a);
#endif
}
```

```cpp
#include <hip/hip_runtime.h>
#include <cstdio>
#include <cstdint>
#ifndef REP_FOX
#define REP_FOX 1
#endif
#ifndef REP_LIN
#define REP_LIN 1
#endif
#ifndef REP_MIX
#define REP_MIX 1
#endif
#ifndef REP_PREP
#define REP_PREP 1
#endif
#ifndef REP_POST
#define REP_POST 1
#endif
#ifndef REP_THIN
#define REP_THIN 1
#endif
#ifndef REP_UP
#define REP_UP 1
#endif
#ifndef REP_IN
#define REP_IN 1
#endif
namespace pg8 {
#define PG8_LAS __attribute__((address_space(3)))
typedef unsigned short bf16_t;
typedef short bf16x8 __attribute__((ext_vector_type(8)));
typedef float f32x4 __attribute__((ext_vector_type(4)));
typedef unsigned u32x4 __attribute__((ext_vector_type(4)));
constexpr int BM = 256, BK = 64, HALF = 128, HTB = HALF * BK * 2  , STAGE_BYTES = 8 * HTB, NXCD = 8, WGM = 4;

__host__ __device__ __forceinline__ int lds_byte(int r, int c) { const int st = (r >> 4) * 2 + (c >> 5), rr = r & 15, cc = c & 31, ob = rr * 64 + cc * 2; return st * 1024 + (ob ^ (((ob >> 9) & 1) << 5)); }
__host__ __device__ __forceinline__ void stage_rc(int b, int& R, int& C) { const int st = b / 1024, sb = b % 1024, swz = sb ^ (((sb >> 9) & 1) << 5); R = (st >> 1) * 16 + swz / 64; C = (st & 1) * 32 + (swz % 64) / 2; }
__host__ __device__ __forceinline__ int perm32(int rho) { const int n = rho >> 4, i = rho & 15; return 8 * (i >> 2) + 4 * n + (i & 3); }

struct Unit { int pm, pn; };
struct Gemm { const bf16_t* A; const bf16_t* Bt; int M, N, K; int lda; };

struct StaticOrder {
    int nM, nN, nwg, G, c;
    __host__ __device__ void init(int M, int N, int G_, int c_) { nM = M / BM; nN = N / BM; nwg = nM * nN; G = G_; c = c_; }
    __host__ __device__ bool next(int i, Unit& u) const {
        const long L = (long)i * G + c; if (L >= nwg) return false;
        int wgid = (int)L; { const int q = nwg / NXCD, r = nwg % NXCD, xcd = wgid % NXCD, off = wgid / NXCD; wgid = (xcd < r ? xcd * (q + 1) : r * (q + 1) + (xcd - r) * q) + off; }
        const int nig = WGM * nN, gid = wgid / nig, fm = gid * WGM, gsz = (nM - fm) < WGM ? (nM - fm) : WGM;
        u.pm = fm + ((wgid % nig) % gsz); u.pn = (wgid % nig) / gsz; return true;
    }
    __device__ __forceinline__ void a_ready(const Unit&) const {}
    __device__ __forceinline__ void done(const Unit&) const {}
};

__device__ __forceinline__ unsigned cvt_pk_bf16(float lo, float hi) { unsigned r; asm volatile("v_cvt_pk_bf16_f32 %0, %1, %2" : "=v"(r) : "v"(lo), "v"(hi)); return r; }

__device__ __forceinline__ float silu_f(float v) { return v * __builtin_amdgcn_rcpf(1.0f + __expf(-v)); }
__device__ __forceinline__ f32x4 swiglu4(const f32x4 a, const f32x4 g) {
    const f32x4 t = g * (-1.44269504088896341f); f32x4 e;
#pragma unroll
    for (int i = 0; i < 4; ++i) e[i] = __builtin_amdgcn_exp2f(t[i]);
    const f32x4 d = e + 1.0f; f32x4 r;
#pragma unroll
    for (int i = 0; i < 4; ++i) r[i] = __builtin_amdgcn_rcpf(d[i]);
    return (a * g) * r;
}
struct EpiSwiglu {
    static constexpr bool PERM = true, AFTER_DRAIN = false;
    bf16_t* O; int ldo;
    __device__ __forceinline__ void operator()(const f32x4 (&acc)[2][2][4][2], const Unit& u, int wr, int wc, int fr, int fq) const {
        const int row0 = u.pm * BM + wr * 64 + fr, col0 = u.pn * HALF + wc * 32 + 8 * fq;
#pragma unroll
        for (int ai = 0; ai < 2; ++ai)
#pragma unroll
            for (int m = 0; m < 4; ++m) { bf16_t* rowp = O + (size_t)(row0 + ai * HALF + m * 16) * ldo + col0;
                const f32x4 a0 = acc[ai][0][m][0], a1 = acc[ai][0][m][1], g0 = acc[ai][1][m][0], g1 = acc[ai][1][m][1];
                u32x4 w; w.x = cvt_pk_bf16(silu_f(g0[0]) * a0[0], silu_f(g0[1]) * a0[1]); w.y = cvt_pk_bf16(silu_f(g0[2]) * a0[2], silu_f(g0[3]) * a0[3]);
                w.z = cvt_pk_bf16(silu_f(g1[0]) * a1[0], silu_f(g1[1]) * a1[1]); w.w = cvt_pk_bf16(silu_f(g1[2]) * a1[2], silu_f(g1[3]) * a1[3]);
                *(u32x4*)rowp = w; }
    }
};
struct EpiResid {
    static constexpr bool PERM = false, AFTER_DRAIN = false;
    const bf16_t* base; float* out; int ldc; const float* gate; int gstride; int rows_per_b; float coef;
    __device__ __forceinline__ void operator()(const f32x4 (&acc)[2][2][4][2], const Unit& u, int wr, int wc, int fr, int fq) const {
        const int col0 = u.pn * BM + wc * 32 + 4 * fq; const int b = (u.pm * BM) / rows_per_b;
        f32x4 gv[2][2];
#pragma unroll
        for (int bj = 0; bj < 2; ++bj)
#pragma unroll
            for (int n = 0; n < 2; ++n) gv[bj][n] = *(const f32x4*)(gate + (size_t)b * gstride + col0 + bj * HALF + n * 16) * coef;
#pragma unroll
        for (int ai = 0; ai < 2; ++ai)
#pragma unroll
            for (int m = 0; m < 4; ++m) { const size_t off = (size_t)(u.pm * BM + ai * HALF + wr * 64 + m * 16 + fr) * ldc + col0;
#pragma unroll
                for (int bj = 0; bj < 2; ++bj)
#pragma unroll
                    for (int n = 0; n < 2; ++n) { typedef unsigned u32x2r __attribute__((ext_vector_type(2))); const u32x2r rb = *(const u32x2r*)(base + off + bj * HALF + n * 16);
                        const f32x4 bs = (f32x4){__builtin_bit_cast(float, rb.x << 16), __builtin_bit_cast(float, rb.x & 0xffff0000u), __builtin_bit_cast(float, rb.y << 16), __builtin_bit_cast(float, rb.y & 0xffff0000u)};
                        *(f32x4*)(out + off + bj * HALF + n * 16) = bs + gv[bj][n] * acc[ai][bj][m][n]; }
                if (m & 1) asm volatile("" ::: "memory"); }
    }
};
struct EpiProj {
    static constexpr bool PERM = true, AFTER_DRAIN = false;
    bf16_t* P; int ldp; float* G; int ntile_bf; float scale0;
    __device__ __forceinline__ void operator()(const f32x4 (&acc)[2][2][4][2], const Unit& u, int wr, int wc, int fr, int fq) const {
        const int row0 = u.pm * BM + wr * 64 + fr;
        if (u.pn < ntile_bf) {
            const int col0 = u.pn * BM + wc * 32 + 8 * fq; const float sc = (u.pn == 0) ? scale0 : 1.0f;
#pragma unroll
            for (int ai = 0; ai < 2; ++ai)
#pragma unroll
                for (int m = 0; m < 4; ++m) { bf16_t* rowp = P + (size_t)(row0 + ai * HALF + m * 16) * ldp + col0;
#pragma unroll
                    for (int bj = 0; bj < 2; ++bj) { const f32x4 v0 = acc[ai][bj][m][0] * sc, v1 = acc[ai][bj][m][1] * sc;
                        u32x4 w; w.x = cvt_pk_bf16(v0[0], v0[1]); w.y = cvt_pk_bf16(v0[2], v0[3]); w.z = cvt_pk_bf16(v1[0], v1[1]); w.w = cvt_pk_bf16(v1[2], v1[3]);
                        *(u32x4*)(rowp + bj * HALF) = w; } }
        } else if (wc == 0 && fq < 2) {
#pragma unroll
            for (int ai = 0; ai < 2; ++ai)
#pragma unroll
                for (int m = 0; m < 4; ++m) { float* gp = G + (size_t)(row0 + ai * HALF + m * 16) * 16 + 8 * fq;
                    *(f32x4*)gp = acc[ai][0][m][0]; *(f32x4*)(gp + 4) = acc[ai][0][m][1]; }
        }
    }
};

__device__ __forceinline__ float rstd_q(long long q) { const unsigned long long u = (unsigned long long)q; const float f = (float)(unsigned)(u >> 32) * 4294967296.0f + (float)(unsigned)u;
    return __builtin_amdgcn_rsqf(f * (1.0f / (16777216.0f * 1024.0f)) + 1e-6f); }
struct EpiSwigluN {
    static constexpr bool PERM = true, AFTER_DRAIN = false;
    bf16_t* O; int ldo; const long long* ss; const float* bias; int nb;
    __device__ __forceinline__ void operator()(const f32x4 (&acc)[2][2][4][2], const Unit& u, int wr, int wc, int fr, int fq) const {
        const int row0 = u.pm * BM + wr * 64 + fr, col0 = u.pn * HALF + wc * 32 + 8 * fq; const int b = u.pm >> 3;
        const float* bp = bias + (size_t)b * nb + u.pn * BM + wc * 32 + 8 * fq;
        const f32x4 ba0 = *(const f32x4*)bp, ba1 = *(const f32x4*)(bp + 4), bg0 = *(const f32x4*)(bp + HALF), bg1 = *(const f32x4*)(bp + HALF + 4);
        long long ssv[2][4];
#pragma unroll
        for (int ai = 0; ai < 2; ++ai)
#pragma unroll
            for (int m = 0; m < 4; ++m) ssv[ai][m] = ss[row0 + ai * HALF + m * 16];
#pragma unroll
        for (int ai = 0; ai < 2; ++ai)
#pragma unroll
            for (int m = 0; m < 4; ++m) { const int row = row0 + ai * HALF + m * 16; bf16_t* rowp = O + (size_t)row * ldo + col0;
                const float rs = rstd_q(ssv[ai][m]);
                const f32x4 a0 = acc[ai][0][m][0] * rs + ba0, a1 = acc[ai][0][m][1] * rs + ba1, g0 = acc[ai][1][m][0] * rs + bg0, g1 = acc[ai][1][m][1] * rs + bg1;
                const f32x4 o0 = swiglu4(a0, g0), o1 = swiglu4(a1, g1);
                u32x4 w; w.x = cvt_pk_bf16(o0[0], o0[1]); w.y = cvt_pk_bf16(o0[2], o0[3]); w.z = cvt_pk_bf16(o1[0], o1[1]); w.w = cvt_pk_bf16(o1[2], o1[3]);
                *(u32x4*)rowp = w; }
    }
};
struct EpiProjN {
    static constexpr bool PERM = true, AFTER_DRAIN = false;
    bf16_t* P; int ldp; float* G; int ntile_bf; float scale0; const long long* ss; const float* bias; int nb;
    __device__ __forceinline__ void operator()(const f32x4 (&acc)[2][2][4][2], const Unit& u, int wr, int wc, int fr, int fq) const {
        const int row0 = u.pm * BM + wr * 64 + fr; const int b = u.pm >> 3;
        const float* bp = bias + (size_t)b * nb + u.pn * BM + wc * 32 + 8 * fq;
        if (u.pn < ntile_bf) {
            const int col0 = u.pn * BM + wc * 32 + 8 * fq; const float sc = (u.pn == 0) ? scale0 : 1.0f;
            const f32x4 b00 = *(const f32x4*)bp, b01 = *(const f32x4*)(bp + 4), b10 = *(const f32x4*)(bp + HALF), b11 = *(const f32x4*)(bp + HALF + 4);
            long long ssv[2][4];
#pragma unroll
            for (int ai = 0; ai < 2; ++ai)
#pragma unroll
                for (int m = 0; m < 4; ++m) ssv[ai][m] = ss[row0 + ai * HALF + m * 16];
#pragma unroll
            for (int ai = 0; ai < 2; ++ai)
#pragma unroll
                for (int m = 0; m < 4; ++m) { const int row = row0 + ai * HALF + m * 16; bf16_t* rowp = P + (size_t)row * ldp + col0;
                    const float rs = rstd_q(ssv[ai][m]);
#pragma unroll
                    for (int bj = 0; bj < 2; ++bj) { const f32x4 v0 = (acc[ai][bj][m][0] * rs + (bj ? b10 : b00)) * sc, v1 = (acc[ai][bj][m][1] * rs + (bj ? b11 : b01)) * sc;
                        u32x4 w; w.x = cvt_pk_bf16(v0[0], v0[1]); w.y = cvt_pk_bf16(v0[2], v0[3]); w.z = cvt_pk_bf16(v1[0], v1[1]); w.w = cvt_pk_bf16(v1[2], v1[3]);
                        *(u32x4*)(rowp + bj * HALF) = w; } }
        } else if (wc == 0 && fq < 2) {
            const f32x4 b00 = *(const f32x4*)bp, b01 = *(const f32x4*)(bp + 4);
#pragma unroll
            for (int ai = 0; ai < 2; ++ai)
#pragma unroll
                for (int m = 0; m < 4; ++m) { const int row = row0 + ai * HALF + m * 16; float* gp = G + (size_t)row * 16 + 8 * fq;
                    const float rs = rstd_q(ss[row]);
                    *(f32x4*)gp = acc[ai][0][m][0] * rs + b00; *(f32x4*)(gp + 4) = acc[ai][0][m][1] * rs + b01; }
        }
    }
};
struct EpiResidNorm {
    static constexpr bool PERM = true, AFTER_DRAIN = false;
    const float* cnd; const float* ng; unsigned char* wsb; int goff, scoff, hb_off, xb_off, ss_off; float coef;
    __device__ __forceinline__ void operator()(const f32x4 (&acc)[2][2][4][2], const Unit& u, int wr, int wc, int fr, int fq) const {
        constexpr int ldc = 1024, gstride = 9 * 1024;
        const int col0 = u.pn * BM + wc * 32 + 8 * fq; const int b = u.pm >> 3;
        const float* gate = cnd + goff; const float* scn = cnd + scoff;
        __attribute__((address_space(1))) bf16_t* xg = (__attribute__((address_space(1))) bf16_t*)(wsb + (size_t)hb_off * 1048576);
        unsigned long long* ssn = (unsigned long long*)(wsb + (size_t)ss_off * 8);
        __attribute__((address_space(1))) bf16_t* xb = (__attribute__((address_space(1))) bf16_t*)(wsb + (size_t)xb_off * 1048576);
        float sq[2][4];
#pragma unroll
        for (int ai = 0; ai < 2; ++ai)
#pragma unroll
            for (int m = 0; m < 4; ++m) sq[ai][m] = 0.f;
#pragma unroll
        for (int bj = 0; bj < 2; ++bj) { const int c = col0 + bj * HALF;
            const f32x4 gv0 = *(const f32x4*)(gate + (size_t)b * gstride + c) * coef, gv1 = *(const f32x4*)(gate + (size_t)b * gstride + c + 4) * coef;
            const f32x4 gm0 = *(const f32x4*)(ng + c) * (*(const f32x4*)(scn + (size_t)b * gstride + c) + 1.0f), gm1 = *(const f32x4*)(ng + c + 4) * (*(const f32x4*)(scn + (size_t)b * gstride + c + 4) + 1.0f);
#pragma unroll
            for (int ai = 0; ai < 2; ++ai) { u32x4 rbv[4];
                const unsigned off0 = (unsigned)(u.pm * BM + ai * HALF + wr * 64 + fr) * (unsigned)ldc + (unsigned)c;
#pragma unroll
                for (int m = 0; m < 4; ++m) rbv[m] = *(const __attribute__((address_space(1))) u32x4*)(xb + (off0 + (unsigned)(m * 16 * ldc)));
#pragma unroll
                for (int m = 0; m < 4; ++m) { const unsigned off = off0 + (unsigned)(m * 16 * ldc); const u32x4 rb = rbv[m];
                    const f32x4 xn0 = (f32x4){__builtin_bit_cast(float, rb.x << 16), __builtin_bit_cast(float, rb.x & 0xffff0000u), __builtin_bit_cast(float, rb.y << 16), __builtin_bit_cast(float, rb.y & 0xffff0000u)} + gv0 * acc[ai][bj][m][0];
                    const f32x4 xn1 = (f32x4){__builtin_bit_cast(float, rb.z << 16), __builtin_bit_cast(float, rb.z & 0xffff0000u), __builtin_bit_cast(float, rb.w << 16), __builtin_bit_cast(float, rb.w & 0xffff0000u)} + gv1 * acc[ai][bj][m][1];
                    { u32x4 wx; wx.x = cvt_pk_bf16(xn0[0], xn0[1]); wx.y = cvt_pk_bf16(xn0[2], xn0[3]); wx.z = cvt_pk_bf16(xn1[0], xn1[1]); wx.w = cvt_pk_bf16(xn1[2], xn1[3]); *(__attribute__((address_space(1))) u32x4*)(xb + off) = wx; }
                    sq[ai][m] += ((xn0[0] * xn0[0] + xn0[1] * xn0[1]) + (xn0[2] * xn0[2] + xn0[3] * xn0[3])) + ((xn1[0] * xn1[0] + xn1[1] * xn1[1]) + (xn1[2] * xn1[2] + xn1[3] * xn1[3]));
                    const f32x4 h0 = xn0 * gm0, h1 = xn1 * gm1;
                    u32x4 w; w.x = cvt_pk_bf16(h0[0], h0[1]); w.y = cvt_pk_bf16(h0[2], h0[3]); w.z = cvt_pk_bf16(h1[0], h1[1]); w.w = cvt_pk_bf16(h1[2], h1[3]); *(__attribute__((address_space(1))) u32x4*)(xg + off) = w; }
                asm volatile("" ::: "memory"); } }
#pragma unroll
        for (int ai = 0; ai < 2; ++ai)
#pragma unroll
            for (int m = 0; m < 4; ++m) { float v = sq[ai][m]; v += __shfl_xor(v, 16); v += __shfl_xor(v, 32);
                if (fq == 0) atomicAdd(ssn + (u.pm * BM + ai * HALF + wr * 64 + m * 16 + fr), (unsigned long long)__float2ll_rn(v * 16777216.0f)); }
    }
};

struct EpiResidLast {
    static constexpr bool PERM = true, AFTER_DRAIN = false;
    const float* cnd; const float* ng; unsigned char* wsb; int goff, scoff, hb_off, xb_off, ss_off; float coef;
    __device__ __forceinline__ void operator()(const f32x4 (&acc)[2][2][4][2], const Unit& u, int wr, int wc, int fr, int fq) const {
        constexpr int ldc = 1024, gstride = 9 * 1024;
        const int col0 = u.pn * BM + wc * 32 + 8 * fq; const int b = u.pm >> 3;
        const float* gate = cnd + goff;
        unsigned long long* ssn = (unsigned long long*)(wsb + (size_t)ss_off * 8);
        __attribute__((address_space(1))) bf16_t* xb = (__attribute__((address_space(1))) bf16_t*)(wsb + (size_t)xb_off * 1048576);
        float sq[2][4];
#pragma unroll
        for (int ai = 0; ai < 2; ++ai)
#pragma unroll
            for (int m = 0; m < 4; ++m) sq[ai][m] = 0.f;
#pragma unroll
        for (int bj = 0; bj < 2; ++bj) { const int c = col0 + bj * HALF;
            const f32x4 gv0 = *(const f32x4*)(gate + (size_t)b * gstride + c) * coef, gv1 = *(const f32x4*)(gate + (size_t)b * gstride + c + 4) * coef;
#pragma unroll
            for (int ai = 0; ai < 2; ++ai) { u32x4 rbv[4];
                const unsigned off0 = (unsigned)(u.pm * BM + ai * HALF + wr * 64 + fr) * (unsigned)ldc + (unsigned)c;
#pragma unroll
                for (int m = 0; m < 4; ++m) rbv[m] = *(const __attribute__((address_space(1))) u32x4*)(xb + (off0 + (unsigned)(m * 16 * ldc)));
#pragma unroll
                for (int m = 0; m < 4; ++m) { const unsigned off = off0 + (unsigned)(m * 16 * ldc); const u32x4 rb = rbv[m];
                    const f32x4 xn0 = (f32x4){__builtin_bit_cast(float, rb.x << 16), __builtin_bit_cast(float, rb.x & 0xffff0000u), __builtin_bit_cast(float, rb.y << 16), __builtin_bit_cast(float, rb.y & 0xffff0000u)} + gv0 * acc[ai][bj][m][0];
                    const f32x4 xn1 = (f32x4){__builtin_bit_cast(float, rb.z << 16), __builtin_bit_cast(float, rb.z & 0xffff0000u), __builtin_bit_cast(float, rb.w << 16), __builtin_bit_cast(float, rb.w & 0xffff0000u)} + gv1 * acc[ai][bj][m][1];
                    { u32x4 wx; wx.x = cvt_pk_bf16(xn0[0], xn0[1]); wx.y = cvt_pk_bf16(xn0[2], xn0[3]); wx.z = cvt_pk_bf16(xn1[0], xn1[1]); wx.w = cvt_pk_bf16(xn1[2], xn1[3]); *(__attribute__((address_space(1))) u32x4*)(xb + off) = wx; }
                    sq[ai][m] += ((xn0[0] * xn0[0] + xn0[1] * xn0[1]) + (xn0[2] * xn0[2] + xn0[3] * xn0[3])) + ((xn1[0] * xn1[0] + xn1[1] * xn1[1]) + (xn1[2] * xn1[2] + xn1[3] * xn1[3]));
                    }
                asm volatile("" ::: "memory"); } }
#pragma unroll
        for (int ai = 0; ai < 2; ++ai)
#pragma unroll
            for (int m = 0; m < 4; ++m) { float v = sq[ai][m]; v += __shfl_xor(v, 16); v += __shfl_xor(v, 32);
                if (fq == 0) atomicAdd(ssn + (u.pm * BM + ai * HALF + wr * 64 + m * 16 + fr), (unsigned long long)__float2ll_rn(v * 16777216.0f)); }
    }
};

template <class Epi, class Sched, bool ALIGN_EPI = false, bool SP2 = false>
__device__ __forceinline__ void gemm_phase(PG8_LAS unsigned char* lds, const Gemm g, const Sched& S, const Epi& E) {
    int tid_ = threadIdx.x; asm volatile("" : "+v"(tid_));
    const int tid = tid_, wid = __builtin_amdgcn_readfirstlane(tid >> 6), lane = tid & 63, wr = wid >> 2, wc = wid & 3, fr = lane & 15, fq = lane >> 4;
    const int K = g.K, nt = K / BK, LDA = g.lda ? g.lda : g.K;
    unsigned voffA[2], voffB[2];
#pragma unroll
    for (int i = 0; i < 2; ++i) { int R, C; stage_rc(tid * 16 + i * 8192, R, C); const int Rb = Epi::PERM ? ((R & ~31) + perm32(R & 31)) : R;
        voffA[i] = (unsigned)(R * LDA + C) * 2u; voffB[i] = (unsigned)(Rb * K + C) * 2u; }
    const size_t kstep = (size_t)(BK * 2);
    const size_t hstep = (size_t)HALF * K * 2;
    const size_t tstep = 2 * hstep;
    const size_t hstepA = (size_t)HALF * LDA * 2, tstepA = 2 * hstepA;
    const unsigned ldsw = (unsigned)wid * 1024u;
    const int aoff = lds_byte(wr * 64 + fr, fq * 8), boff = lds_byte(wc * 32 + fr, fq * 8);
#define PG8_SA(b, h) (((b) * 2 + (h)) * HTB)
#define PG8_SB(b, h) ((4 + (b) * 2 + (h)) * HTB)
#define PG8_STAGE(bufoff, gbase, voff) do { _Pragma("unroll") for (int _i = 0; _i < 2; ++_i) \
        __builtin_amdgcn_global_load_lds((const unsigned*)((const char*)(gbase) + (voff)[_i]), (PG8_LAS unsigned*)(lds + (bufoff) + ldsw + _i * 8192), 16, 0, 0); } while (0)
#define PG8_LDA(dst, b, h) do { _Pragma("unroll") for (int m = 0; m < 4; ++m) _Pragma("unroll") for (int k = 0; k < 2; ++k) dst[m][k] = *(const PG8_LAS bf16x8*)(lds + PG8_SA(b, h) + aoff + m * 2048 + k * 1024); } while (0)
#define PG8_LDB(dst, b, h) do { _Pragma("unroll") for (int n = 0; n < 2; ++n) _Pragma("unroll") for (int k = 0; k < 2; ++k) dst[n][k] = *(const PG8_LAS bf16x8*)(lds + PG8_SB(b, h) + boff + n * 2048 + k * 1024); } while (0)
#define PG8_MMA(ai, bj, At, Bt) do { __builtin_amdgcn_s_setprio(1); _Pragma("unroll") for (int m = 0; m < 4; ++m) _Pragma("unroll") for (int n = 0; n < 2; ++n) _Pragma("unroll") for (int k = 0; k < 2; ++k) \
        acc[ai][bj][m][n] = __builtin_amdgcn_mfma_f32_16x16x32_bf16(Bt[n][k], At[m][k], acc[ai][bj][m][n], 0, 0, 0); __builtin_amdgcn_s_setprio(0); } while (0)
#define PG8_WAIT_V(n) asm volatile("s_waitcnt vmcnt(" #n ")" ::: "memory")
#define PG8_WAIT_L(n) asm volatile("s_waitcnt lgkmcnt(" #n ")" ::: "memory")
#define PG8_BAR __builtin_amdgcn_s_barrier()
#define PG8_SCHED __builtin_amdgcn_sched_barrier(0)
    Unit cur, nxt; int ui = 0;
    if (!S.next(0, cur)) return;
    f32x4 acc[2][2][4][2];
#pragma unroll
    for (int a = 0; a < 2; ++a)
#pragma unroll
        for (int b = 0; b < 2; ++b)
#pragma unroll
            for (int m = 0; m < 4; ++m)
#pragma unroll
                for (int n = 0; n < 2; ++n) acc[a][b][m][n] = (f32x4){0.f, 0.f, 0.f, 0.f};
    bf16x8 At[4][2], B0[2][2], B1[2][2];
    const char* cA = (const char*)g.A + (size_t)cur.pm * tstepA; const char* cB = (const char*)g.Bt + (size_t)cur.pn * tstep;
    S.a_ready(cur);
    if constexpr (SP2) {
        PG8_STAGE(PG8_SB(0, 0), cB, voffB); PG8_STAGE(PG8_SB(0, 1), cB + hstep, voffB); PG8_STAGE(PG8_SA(0, 0), cA, voffA); PG8_STAGE(PG8_SA(0, 1), cA + hstepA, voffA);
        if (wr == 1) PG8_BAR;
        PG8_WAIT_V(2); PG8_BAR;
        PG8_STAGE(PG8_SB(1, 0), cB + kstep, voffB); PG8_STAGE(PG8_SA(1, 0), cA + kstep, voffA); PG8_STAGE(PG8_SB(1, 1), cB + hstep + kstep, voffB);
        PG8_WAIT_V(6); PG8_BAR;
    } else {
        PG8_STAGE(PG8_SB(0, 0), cB, voffB); PG8_STAGE(PG8_SA(0, 0), cA, voffA); PG8_STAGE(PG8_SB(0, 1), cB + hstep, voffB); PG8_STAGE(PG8_SA(0, 1), cA + hstepA, voffA);
        if (wr == 1) PG8_BAR;
        PG8_WAIT_V(4); PG8_BAR;
        PG8_STAGE(PG8_SB(1, 0), cB + kstep, voffB); PG8_STAGE(PG8_SA(1, 0), cA + kstep, voffA); PG8_STAGE(PG8_SB(1, 1), cB + hstep + kstep, voffB);
        PG8_WAIT_V(6); PG8_BAR;
    }
    for (;;) {
        const bool has_next = S.next(ui + 1, nxt);
        const char* nA = has_next ? (const char*)g.A + (size_t)nxt.pm * tstepA : cA; const char* nB = has_next ? (const char*)g.Bt + (size_t)nxt.pn * tstep : cB;
        for (int t = 0; t < nt; t += 2) {
            const bool last = (t == nt - 2);
            const char* a1 = cA + (size_t)(t + 1) * kstep;
            const char* a2 = last ? nA : cA + (size_t)(t + 2) * kstep; const char* b2 = last ? nB : cB + (size_t)(t + 2) * kstep;
            const char* a3 = a2 + kstep; const char* b3 = b2 + kstep;
            if (last && has_next) S.a_ready(nxt);
            if constexpr (SP2) {
            PG8_LDB(B0, 0, 0); PG8_LDB(B1, 0, 1); PG8_SCHED; PG8_LDA(At, 0, 0); PG8_STAGE(PG8_SA(1, 1), a1 + hstepA, voffA);
            PG8_WAIT_V(8); PG8_WAIT_L(0); PG8_BAR; PG8_MMA(0, 0, At, B0); PG8_MMA(0, 1, At, B1); PG8_BAR; PG8_SCHED;
            PG8_LDA(At, 0, 1); PG8_STAGE(PG8_SB(0, 0), b2, voffB); PG8_STAGE(PG8_SB(0, 1), b2 + hstep, voffB); PG8_STAGE(PG8_SA(0, 0), a2, voffA);
            PG8_WAIT_V(8); PG8_WAIT_L(0); PG8_BAR; PG8_MMA(1, 0, At, B0); PG8_MMA(1, 1, At, B1); PG8_BAR; PG8_SCHED;
            PG8_LDB(B0, 1, 0); PG8_LDB(B1, 1, 1); PG8_SCHED; PG8_LDA(At, 1, 0); PG8_STAGE(PG8_SA(0, 1), a2 + hstepA, voffA);
            PG8_WAIT_V(8); PG8_WAIT_L(0); PG8_BAR; PG8_MMA(0, 0, At, B0); PG8_MMA(0, 1, At, B1); PG8_BAR; PG8_SCHED;
            PG8_LDA(At, 1, 1); PG8_STAGE(PG8_SB(1, 0), b3, voffB); PG8_STAGE(PG8_SB(1, 1), b3 + hstep, voffB); PG8_STAGE(PG8_SA(1, 0), a3, voffA);
            PG8_WAIT_V(8); PG8_WAIT_L(0); PG8_BAR; PG8_MMA(1, 0, At, B0); PG8_MMA(1, 1, At, B1); PG8_BAR; PG8_SCHED;
            } else {
            PG8_LDB(B0, 0, 0); PG8_SCHED; PG8_LDA(At, 0, 0); PG8_STAGE(PG8_SA(1, 1), a1 + hstepA, voffA);
            PG8_WAIT_L(8); PG8_BAR; PG8_WAIT_L(0); PG8_MMA(0, 0, At, B0); PG8_BAR; PG8_SCHED;
            PG8_LDB(B1, 0, 1); PG8_STAGE(PG8_SB(0, 0), b2, voffB);
            PG8_BAR; PG8_WAIT_L(0); PG8_MMA(0, 1, At, B1); PG8_BAR;
            PG8_LDA(At, 0, 1); PG8_STAGE(PG8_SA(0, 0), a2, voffA);
            PG8_BAR; PG8_WAIT_L(0); PG8_MMA(1, 0, At, B0); PG8_BAR; PG8_SCHED;
            PG8_STAGE(PG8_SB(0, 1), b2 + hstep, voffB);
            PG8_WAIT_V(6); PG8_BAR; PG8_MMA(1, 1, At, B1); PG8_BAR;
            PG8_LDB(B0, 1, 0); PG8_SCHED; PG8_LDA(At, 1, 0); PG8_STAGE(PG8_SA(0, 1), a2 + hstepA, voffA);
            PG8_WAIT_L(8); PG8_BAR; PG8_WAIT_L(0); PG8_MMA(0, 0, At, B0); PG8_BAR; PG8_SCHED;
            PG8_LDB(B1, 1, 1); PG8_STAGE(PG8_SB(1, 0), b3, voffB);
            PG8_BAR; PG8_WAIT_L(0); PG8_MMA(0, 1, At, B1); PG8_BAR;
            PG8_LDA(At, 1, 1); PG8_STAGE(PG8_SA(1, 0), a3, voffA);
            PG8_BAR; PG8_WAIT_L(0); PG8_MMA(1, 0, At, B0); PG8_BAR; PG8_SCHED;
            PG8_STAGE(PG8_SB(1, 1), b3 + hstep, voffB);
            PG8_WAIT_V(6); PG8_BAR; PG8_MMA(1, 1, At, B1); PG8_BAR;
            }
        }
        if constexpr (ALIGN_EPI) { if (wr == 0) PG8_BAR; }
        if constexpr (!Epi::AFTER_DRAIN) { E(acc, cur, wr, wc, fr, fq); S.done(cur); }
        if (!has_next) break;
#pragma unroll
        for (int a = 0; a < 2; ++a)
#pragma unroll
            for (int b = 0; b < 2; ++b)
#pragma unroll
                for (int m = 0; m < 4; ++m)
#pragma unroll
                    for (int n = 0; n < 2; ++n) acc[a][b][m][n] = (f32x4){0.f, 0.f, 0.f, 0.f};
        cur = nxt; cA = nA; cB = nB; ++ui;
        if constexpr (ALIGN_EPI) { if (wr == 1) PG8_BAR; }
    }
    PG8_WAIT_V(0);
    if constexpr (!ALIGN_EPI) { if (wr == 0) PG8_BAR; }
    PG8_BAR;
    if constexpr (Epi::AFTER_DRAIN) { E.fused(acc, cur, wr, wc, fr, fq, lds, wid, lane); S.done(cur); }
#undef PG8_SA
#undef PG8_SB
#undef PG8_STAGE
#undef PG8_LDA
#undef PG8_LDB
#undef PG8_MMA
#undef PG8_WAIT_V
#undef PG8_WAIT_L
#undef PG8_BAR
#undef PG8_SCHED
}
}
#define GAS __attribute__((address_space(1)))
#define LAS __attribute__((address_space(3)))
typedef unsigned short bf16;
typedef unsigned v4u __attribute__((ext_vector_type(4)));
typedef float f32x4 __attribute__((ext_vector_type(4)));
typedef short bf16x8 __attribute__((ext_vector_type(8)));
typedef GAS unsigned gu32;
typedef GAS unsigned long long gu64;
#define RLX_AGENT __ATOMIC_RELAXED, __HIP_MEMORY_SCOPE_AGENT
#define LDS_WAIT() asm volatile("s_waitcnt lgkmcnt(0)" ::: "memory")
#define VM_WAIT() asm volatile("s_waitcnt vmcnt(0)" ::: "memory")
__device__ __forceinline__ unsigned long long rt() { return __builtin_amdgcn_s_memrealtime(); }
__device__ __forceinline__ unsigned f2bf(float f) { unsigned u = __builtin_bit_cast(unsigned, f); return (u + 0x7fffu + ((u >> 16) & 1u)) >> 16; }
__device__ __forceinline__ unsigned pk2(float lo, float hi) { return f2bf(lo) | (f2bf(hi) << 16); }

#define XB_TMO      128
#define XB_XCNT(j)  (256  + 64 * (j))
#define XB_XSUB(j)  (1280 + 64 * (j))
#define XB_XGEN(j)  (2304 + 64 * (j))
#define XB_TOP      3328
#define XB_TOPGEN   3392
#define XCD_BAR_WORDS 3456
#define XB_SPIN_CAP (1u << 18)

__device__ __forceinline__ unsigned xb_ld(unsigned* p)              { return __hip_atomic_load(p, __ATOMIC_RELAXED, __HIP_MEMORY_SCOPE_AGENT); }
__device__ __forceinline__ unsigned xb_add(unsigned* p, unsigned v) { return __hip_atomic_fetch_add(p, v, __ATOMIC_RELAXED, __HIP_MEMORY_SCOPE_AGENT); }
__device__ __forceinline__ unsigned xb_xcc_id() { return (unsigned)__builtin_amdgcn_s_getreg((3 << 11) | 20) & 0xFu; }
#define XB_SPIN(cond, bar) do { unsigned _sp = 0; while (cond) { __builtin_amdgcn_s_sleep(1); \
    if ((++_sp & 255u) == 0u) { if (xb_ld(&(bar)[XB_TMO])) break; if (_sp > XB_SPIN_CAP) { atomicAdd(&(bar)[XB_TMO], 1u); break; } } } } while (0)

struct XcdBarrier {
    unsigned* bar; unsigned x;
    volatile LAS unsigned* st;
};

__device__ __forceinline__ XcdBarrier xcd_barrier_post(unsigned* bar, volatile LAS unsigned* st) {
    XcdBarrier b; b.bar = bar; b.x = xb_xcc_id(); b.st = st;
    if (threadIdx.x == 0) (void)xb_add(&bar[XB_XCNT(b.x)], 1u);
    return b;
}
__device__ __forceinline__ void xcd_barrier_complete(unsigned* bar, unsigned x, unsigned& nloc, unsigned& nx) {
    const unsigned G = gridDim.x * gridDim.y * gridDim.z;
    unsigned sum, cnt, mine, sp = 0u;
    for (;;) {
        sum = 0u; cnt = 0u; mine = 0u;
#pragma unroll
        for (unsigned j = 0; j < 16; ++j) { const unsigned c = xb_ld(&bar[XB_XCNT(j)]); sum += c; cnt += (c > 0u) ? 1u : 0u; mine = (j == x) ? c : mine; }
        if (sum == G) break;
        __builtin_amdgcn_s_sleep(1);
        if ((++sp & 255u) == 0u) { if (xb_ld(&bar[XB_TMO])) break; if (sp > XB_SPIN_CAP) { atomicAdd(&bar[XB_TMO], 1u); break; } }
    }
    nloc = mine > 0u ? mine : 1u; nx = cnt > 0u ? cnt : 1u;
}

__device__ __forceinline__ void xcd_barrier(const XcdBarrier& b) {
    asm volatile("s_waitcnt vmcnt(0)" ::: "memory");
    __syncthreads();
    if (threadIdx.x == 0) {
        unsigned* bar = b.bar;
        __builtin_amdgcn_s_waitcnt(0);
        unsigned nloc = b.st[0], nx = b.st[1];
        if (nloc == 0u) { xcd_barrier_complete(bar, b.x, nloc, nx); b.st[0] = nloc; b.st[1] = nx; }
        const unsigned old = xb_add(&bar[XB_XSUB(b.x)], 1u);
        const unsigned gen = old / nloc;
        if (old + 1u == (gen + 1u) * nloc) {
            __builtin_amdgcn_fence(__ATOMIC_RELEASE, "agent");
            asm volatile("s_waitcnt vmcnt(0)" ::: "memory");
            const unsigned og = xb_add(&bar[XB_TOP], 1u);
            const unsigned tg = og / nx;
            if (og + 1u == (tg + 1u) * nx) xb_add(&bar[XB_TOPGEN], 1u);
            else XB_SPIN(xb_ld(&bar[XB_TOPGEN]) == tg, bar);
            __builtin_amdgcn_fence(__ATOMIC_ACQUIRE, "agent");
            xb_add(&bar[XB_XGEN(b.x)], 1u);
            asm volatile("s_waitcnt vmcnt(0)" ::: "memory");
        } else {
            XB_SPIN(xb_ld(&bar[XB_XGEN(b.x)]) == gen, bar);
            __builtin_amdgcn_fence(__ATOMIC_ACQUIRE, "agent");
            asm volatile("s_waitcnt vmcnt(0)" ::: "memory");
        }
    }
    __syncthreads();
}

#define XB_LOC(j)   (3584 + 64 * (j))
#define XB_RANK(j)  (4608 + 64 * (j))
#define XB_LGEN(j)  (5632 + 64 * (j))
#define XB_ALL_WORDS 6656
__device__ __forceinline__ void xcd_local_barrier(unsigned* bar, unsigned x, unsigned nloc) {
    asm volatile("s_waitcnt vmcnt(0)" ::: "memory");
    __syncthreads();
    if (threadIdx.x == 0) {
        __builtin_amdgcn_s_waitcnt(0);
        const unsigned old = xb_add(&bar[XB_LOC(x)], 1u); const unsigned gen = old / nloc;
        if (old + 1u == (gen + 1u) * nloc) {
            __builtin_amdgcn_fence(__ATOMIC_RELEASE, "agent");
            asm volatile("s_waitcnt vmcnt(0)" ::: "memory");
            __builtin_amdgcn_fence(__ATOMIC_ACQUIRE, "agent");
            xb_add(&bar[XB_LGEN(x)], 1u);
            asm volatile("s_waitcnt vmcnt(0)" ::: "memory");
        } else {
            XB_SPIN(xb_ld(&bar[XB_LGEN(x)]) == gen, bar);
            __builtin_amdgcn_fence(__ATOMIC_ACQUIRE, "agent");
            asm volatile("s_waitcnt vmcnt(0)" ::: "memory");
        }
    }
    __syncthreads();
}

constexpr int NWAVES = 8, NTHR = 512;
constexpr int DM = 1024, BATCH = 8, SEQ = 2048, DEPTH = 4, M = BATCH * SEQ;
constexpr int DFF = 2816, NUP = 2 * DFF, NPROJ = 3840, PROJ_LD = 3584, NIN_SRC = 3600, NCOND = 9 * DM;
constexpr float RMS_EPS = 1e-6f;
constexpr int PC_FQ = 0, PC_FK = 256, PC_FV = 512, PC_MQ = 768, PC_MK = 1024, PC_MV = 1280, PC_MO = 1536, PC_RQ = 1792, PC_RK = 2048, PC_RV = 2304, PC_RG = 2560, PC_SZ = 2816, PC_SX = 3072;
constexpr int PH_LAYER0 = 2, PH_PER_LAYER = 9, PH_FINAL = PH_LAYER0 + PH_PER_LAYER * DEPTH, PH_END = PH_FINAL + 1;
constexpr size_t MiB = 1u << 20;
constexpr size_t WS_CTL = 0, CTL_ZERO_BYTES = 1 * MiB;
constexpr size_t WS_COND = 1 * MiB;
constexpr size_t WS_ROPE = 3 * MiB;
constexpr size_t WS_W = 4 * MiB;
constexpr size_t W_UP = (size_t)NUP * DM * 2, W_DN = (size_t)DM * DFF * 2, W_IN = (size_t)NPROJ * DM * 2, W_OUT = (size_t)DM * DM * 2;
constexpr size_t OFF_UP1 = 0, OFF_DN1 = W_UP, OFF_UP2 = W_UP + W_DN, OFF_DN2 = 2 * W_UP + W_DN, OFF_IN = 2 * W_UP + 2 * W_DN, OFF_OUT = OFF_IN + W_IN, LAYER_W = OFF_OUT + W_OUT;
static_assert(LAYER_W * DEPTH == 170 * MiB, "weights");
constexpr size_t WS_HB = 174 * MiB;
constexpr size_t WS_PROJ = 206 * MiB, WS_ACT = 206 * MiB;
constexpr size_t WS_GATES = 318 * MiB;
constexpr size_t WS_VTF = 319 * MiB;
constexpr size_t WS_VTL = 327 * MiB;
constexpr size_t WS_QL = 363 * MiB, WS_KL = 387 * MiB;
constexpr size_t WS_COEF = 411 * MiB;
constexpr size_t COEF_A1 = 0, COEF_A2 = 768 * 1024, COEF_BETA = 2 * 768 * 1024, COEF_LCUM = 3 * 768 * 1024, COEF_S1 = COEF_LCUM + 256 * 1024, COEF_S2 = COEF_S1 + 16 * 1024, COEF_CTOT = COEF_S2 + 16 * 1024;
constexpr size_t WS_YRAW = 415 * MiB;
constexpr size_t WS_XB = 447 * MiB;
constexpr size_t WS_YBF = 479 * MiB;
constexpr size_t WS_KT = 511 * MiB;
constexpr size_t WS_XS = 535 * MiB;
constexpr size_t WS_DEN = 551 * MiB;
constexpr size_t WS_BIAS = 552 * MiB;
constexpr size_t BIAS_USE = (size_t)8 * NUP * 4, BIAS_BYTES = (size_t)DEPTH * 3 * BIAS_USE;
constexpr size_t WS_SS = 556 * MiB, SS_BYTES = (size_t)(3 * DEPTH + 1) * M * 8;
constexpr size_t WS_BIASQ = 558 * MiB, BIASQ_BYTES = 2 * BIAS_BYTES, WS_END = 563 * MiB;
static_assert(WS_BIAS + BIAS_BYTES <= 555 * MiB && WS_SS + SS_BYTES <= WS_BIASQ && WS_BIASQ + BIASQ_BYTES <= WS_END, "ws map 2");
static_assert(WS_PROJ + (size_t)M * PROJ_LD * 2 <= WS_GATES && WS_ACT + (size_t)M * DFF * 2 <= WS_GATES && COEF_CTOT + 4096 <= 4 * MiB && WS_YRAW + (size_t)M * 1024 * 4 <= WS_YBF, "ws map");
constexpr int CW_BAR = 4096;
constexpr int RING_BYTES = 131072, LDS_BYTES = 163840, LDSCTL_OFF = LDS_BYTES - 1024, MISC_OFF = LDSCTL_OFF + 320;

__device__ const double INVREV[32] = {0.15915494309189535, 0.11934937021124886, 0.089499401608891013, 0.067115083005227255, 0.050329212104487035, 0.037741584717419778, 0.028302195830623395, 0.02122365276477766, 0.015915494309189534, 0.011934937021124886, 0.0089499401608891006, 0.0067115083005227253, 0.0050329212104487037, 0.0037741584717419768, 0.0028302195830623399, 0.0021223652764777662, 0.0015915494309189536, 0.0011934937021124887, 0.00089499401608891024, 0.0006711508300522726, 0.00050329212104487033, 0.00037741584717419769, 0.00028302195830623401, 0.00021223652764777661, 0.00015915494309189535, 0.00011934937021124885, 8.9499401608891018e-05, 6.7115083005227268e-05, 5.0329212104487035e-05, 3.7741584717419777e-05, 2.8302195830623396e-05, 2.1223652764777659e-05};

struct Args { const float* in[25]; float* out; unsigned char* ws; int ph_lo, ph_hi; };
static_assert(sizeof(Args) == 27 * 8 + 8, "Args has no padding");

__device__ __forceinline__ float wave_sum(float v) {
#pragma unroll
    for (int o = 1; o < 64; o <<= 1) v += __shfl_xor(v, o);
    return v;
}
__device__ __forceinline__ float bf2f(unsigned short u) { return __uint_as_float((unsigned)u << 16); }
__device__ __forceinline__ float sigmoid_f(float v) { return 1.0f / (1.0f + __expf(-v)); }
__device__ __forceinline__ float silu_acc(float v) { return v / (1.0f + __expf(-v)); }
__device__ __forceinline__ float log_sigmoid_f(float v) { return fminf(v, 0.f) - log1pf(__expf(-fabsf(v))); }
__device__ __forceinline__ float softplus_f(float v) { return fmaxf(v, 0.f) + log1pf(__expf(-fabsf(v))); }

__device__ __forceinline__ int map_up(int n) { const int t = n >> 8, r = n & 255; return (r < 128) ? (t * 128 + r) : (DFF + t * 128 + (r - 128)); }
__device__ __forceinline__ int map_in(int n) {
    if (n < 768) return n; if (n < 1536) return n + 4; if (n < 3584) return n + 12;
    const int j = n - 3584; if (j < 4) return 768 + j; if (j < 8) return 1540 + (j - 4); if (j < 12) return 1544 + (j - 8); if (j < 16) return 3596 + (j - 12); return -1; }
template <int MAP> __device__ __forceinline__ void tr_item(const float* W, int K, int Nsrc, bf16* WT, int kb, int nb, LAS float* scr, int lane, const float* shp, long long* biasp, int Ndst) {
    const int k0 = 64 * kb, n0 = 32 * nb; const int nd = n0 + (lane & 31); const int src = MAP == 1 ? map_up(nd) : (MAP == 2 ? map_in(nd) : nd);
    const bool regular = (MAP != 2) || (n0 < 3584);
    if (regular) {
        const int s0c = MAP == 1 ? map_up(n0) : (MAP == 2 ? map_in(n0) : n0); const int kq = lane >> 3, nq = lane & 7;
        f32x4 wv[8];
#pragma unroll
        for (int i = 0; i < 8; ++i) wv[i] = *(const f32x4*)(W + (size_t)(k0 + 8 * i + kq) * Nsrc + s0c + 4 * nq);
#pragma unroll
        for (int i = 0; i < 8; ++i) { LAS float* d = scr + (8 * i + kq) * 33 + 4 * nq; d[0] = wv[i][0]; d[1] = wv[i][1]; d[2] = wv[i][2]; d[3] = wv[i][3]; }
    } else {
#pragma unroll 8
        for (int i = 0; i < 32; ++i) { const int kk = 2 * i + (lane >> 5); scr[kk * 33 + (lane & 31)] = src >= 0 ? W[(size_t)(k0 + kk) * Nsrc + src] : 0.f; }
    }
    if (MAP != 0) {
        LAS float* shs = scr + 64 * 33;
#pragma unroll
        for (int bb = 0; bb < 8; ++bb) shs[lane * 8 + bb] = shp[(size_t)bb * NCOND + k0 + lane];
    }
    LDS_WAIT(); asm volatile("" ::: "memory");
    const int c = lane & 7;
#pragma unroll
    for (int j = 0; j < 4; ++j) { const int n = (lane >> 3) + 8 * j; const LAS float* s = scr + (8 * c) * 33 + n;
        v4u o; o.x = pk2(s[0 * 33], s[1 * 33]); o.y = pk2(s[2 * 33], s[3 * 33]); o.z = pk2(s[4 * 33], s[5 * 33]); o.w = pk2(s[6 * 33], s[7 * 33]);
        *(GAS v4u*)(WT + (size_t)(n0 + n) * K + k0 + 8 * c) = o; }
    if (MAP != 0) {
        const LAS float* shs = scr + 64 * 33; const int n = lane & 31, hf = lane >> 5;
        float acc[8];
#pragma unroll
        for (int bb = 0; bb < 8; ++bb) acc[bb] = 0.f;
#pragma unroll 8
        for (int i = 0; i < 32; ++i) { const int kk = 32 * hf + i; const float w = scr[kk * 33 + n]; const f32x4 s0 = *(const LAS f32x4*)(shs + kk * 8), s1 = *(const LAS f32x4*)(shs + kk * 8 + 4);
            acc[0] += w * s0[0]; acc[1] += w * s0[1]; acc[2] += w * s0[2]; acc[3] += w * s0[3]; acc[4] += w * s1[0]; acc[5] += w * s1[1]; acc[6] += w * s1[2]; acc[7] += w * s1[3]; }
#pragma unroll
        for (int bb = 0; bb < 8; ++bb) { acc[bb] += __shfl_xor(acc[bb], 32); if (hf == 0 && src >= 0) atomicAdd((unsigned long long*)(biasp + (size_t)bb * Ndst + n0 + n), (unsigned long long)__float2ll_rn(acc[bb] * 4294967296.0f)); }
    }
    LDS_WAIT(); asm volatile("" ::: "memory");
}
__device__ __forceinline__ void prologue0(const Args& a, LAS unsigned char* lds, int tid, int lane, int wave, int G) {
    unsigned char* ws = a.ws;
    LAS float* cact = (LAS float*)(lds + 69632);
    LAS float* red = (LAS float*)(lds + 102400);
    for (int i = tid; i < BATCH * DM; i += NTHR) { const float v = a.in[1][i]; cact[i] = silu_acc(v); }
    __syncthreads();
    float* cond = (float*)(ws + WS_COND);
    for (int item = blockIdx.x; item < DEPTH * (NCOND / 64); item += G) {
        const int l = item / (NCOND / 64), cb = item % (NCOND / 64), col = cb * 64 + lane, ks = wave;
        const float* W = a.in[2] + (size_t)l * DM * NCOND + col;
        float acc[8];
#pragma unroll
        for (int b = 0; b < 8; ++b) acc[b] = 0.f;
        for (int k = ks * 128; k < ks * 128 + 128; k += 16) { float w[16];
#pragma unroll
            for (int i = 0; i < 16; ++i) w[i] = W[(size_t)(k + i) * NCOND];
#pragma unroll
            for (int i = 0; i < 16; ++i)
#pragma unroll
                for (int b = 0; b < 8; ++b) acc[b] += cact[b * DM + k + i] * w[i]; }
#pragma unroll
        for (int b = 0; b < 8; ++b) red[(ks * 8 + b) * 64 + lane] = acc[b];
        __syncthreads();
        { const int b = wave; float s = 0.f;
#pragma unroll
          for (int k2 = 0; k2 < 8; ++k2) s += red[(k2 * 8 + b) * 64 + lane];
          cond[((size_t)l * BATCH + b) * NCOND + col] = s + a.in[3][(size_t)l * NCOND + col]; }
        __syncthreads();
    }
    float2* rope = (float2*)(ws + WS_ROPE);
    for (int e = blockIdx.x * NTHR + tid; e < SEQ * 32; e += G * NTHR) { const int s = e >> 5, i = e & 31; const double rev = (double)s * INVREV[i]; const float fr = (float)(rev - rint(rev));
        rope[e] = make_float2(__builtin_amdgcn_cosf(fr), __builtin_amdgcn_sinf(fr)); }
    { GAS f32x4* z = (GAS f32x4*)(ws + WS_BIASQ); for (size_t i = (size_t)blockIdx.x * NTHR + tid; i < BIASQ_BYTES / 16; i += (size_t)G * NTHR) z[i] = (f32x4){0.f, 0.f, 0.f, 0.f};
      GAS f32x4* z2 = (GAS f32x4*)(ws + WS_SS); for (size_t i = (size_t)blockIdx.x * NTHR + tid; i < SS_BYTES / 16; i += (size_t)G * NTHR) z2[i] = (f32x4){0.f, 0.f, 0.f, 0.f}; }
}
__device__ __forceinline__ void prologue1(const Args& a, LAS unsigned char* lds, int lane, int wave, int G) {
    unsigned char* ws = a.ws;
    LAS float* scr = (LAS float*)(lds + wave * 10496);
    const float* cond = (const float*)(ws + WS_COND);
    const int gw = blockIdx.x * NWAVES + wave, NGW = G * NWAVES;
    constexpr int I_UP = (DM / 64) * (NUP / 32), I_DN = (DFF / 64) * (DM / 32), I_IN = (DM / 64) * (NPROJ / 32), I_OUT = (DM / 64) * (DM / 32), I_LAYER = 2 * I_UP + 2 * I_DN + I_IN + I_OUT;
    for (int it = gw; it < DEPTH * I_LAYER; it += NGW) {
        const int l = it / I_LAYER; int r = it % I_LAYER;
        unsigned char* wl = ws + WS_W + (size_t)l * LAYER_W; const float* cl = cond + (size_t)l * BATCH * NCOND; long long* bl = (long long*)(ws + WS_BIASQ + (size_t)l * 3 * 2 * BIAS_USE);
        if (r < I_UP) { tr_item<1>(a.in[5] + (size_t)l * DM * NUP, DM, NUP, (bf16*)(wl + OFF_UP1), r / (NUP / 32), r % (NUP / 32), scr, lane, cl + 0 * DM, bl, NUP); continue; } r -= I_UP;
        if (r < I_DN) { tr_item<0>(a.in[6] + (size_t)l * DFF * DM, DFF, DM, (bf16*)(wl + OFF_DN1), r / (DM / 32), r % (DM / 32), scr, lane, nullptr, nullptr, 0); continue; } r -= I_DN;
        if (r < I_UP) { tr_item<1>(a.in[7] + (size_t)l * DM * NUP, DM, NUP, (bf16*)(wl + OFF_UP2), r / (NUP / 32), r % (NUP / 32), scr, lane, cl + 6 * DM, bl + 2 * 8 * NUP, NUP); continue; } r -= I_UP;
        if (r < I_DN) { tr_item<0>(a.in[8] + (size_t)l * DFF * DM, DFF, DM, (bf16*)(wl + OFF_DN2), r / (DM / 32), r % (DM / 32), scr, lane, nullptr, nullptr, 0); continue; } r -= I_DN;
        if (r < I_IN) { tr_item<2>(a.in[9] + (size_t)l * DM * NIN_SRC, DM, NIN_SRC, (bf16*)(wl + OFF_IN), r / (NPROJ / 32), r % (NPROJ / 32), scr, lane, cl + 3 * DM, bl + 1 * 8 * NUP, NPROJ); continue; } r -= I_IN;
        tr_item<0>(a.in[10] + (size_t)l * DM * DM, DM, DM, (bf16*)(wl + OFF_OUT), r / (DM / 32), r % (DM / 32), scr, lane, nullptr, nullptr, 0);
    }
}
__device__ __forceinline__ void thin_xg(const float* x, bf16* hb, bf16* xb, const float* g, const float* cond_l, int sc_off, long long* ss, int gw, int NGW, int lane) {
    for (int m = gw; m < M; m += NGW) {
        const int b = m >> 11;
        const GAS f32x4* xr = (const GAS f32x4*)(x + (size_t)m * DM) + lane;
        f32x4 v[4]; float s = 0.f;
#pragma unroll
        for (int j = 0; j < 4; ++j) { v[j] = xr[64 * j]; s += (v[j].x * v[j].x + v[j].y * v[j].y) + (v[j].z * v[j].z + v[j].w * v[j].w); }
        s = wave_sum(s); if (lane == 0) ss[m] = __float2ll_rn(s * 16777216.0f);
        const f32x4* g4 = (const f32x4*)g + lane; const f32x4* sc4 = (const f32x4*)(cond_l + (size_t)b * NCOND + sc_off) + lane;
        GAS unsigned long long* o8 = (GAS unsigned long long*)(hb + (size_t)m * DM) + lane;
#pragma unroll
        for (int j = 0; j < 4; ++j) { const f32x4 o = v[j] * g4[64 * j] * (sc4[64 * j] + 1.0f);
            o8[64 * j] = (unsigned long long)pk2(o.x, o.y) | ((unsigned long long)pk2(o.z, o.w) << 32); }
        GAS unsigned long long* x8 = (GAS unsigned long long*)(xb + (size_t)m * DM) + lane;
#pragma unroll
        for (int j = 0; j < 4; ++j) x8[64 * j] = (unsigned long long)pk2(v[j].x, v[j].y) | ((unsigned long long)pk2(v[j].z, v[j].w) << 32);
    }
}
__device__ __forceinline__ void thin_norm(const float* x, bf16* hb, const float* g, const float* cond_l, int sh_off, int sc_off, int gw, int NGW, int lane) {
    for (int m = gw; m < M; m += NGW) {
        const int b = m >> 11;
        const GAS f32x4* xr = (const GAS f32x4*)(x + (size_t)m * DM) + lane;
        f32x4 v[4]; float s = 0.f;
#pragma unroll
        for (int j = 0; j < 4; ++j) { v[j] = xr[64 * j]; s += (v[j].x * v[j].x + v[j].y * v[j].y) + (v[j].z * v[j].z + v[j].w * v[j].w); }
        const float rstd = 1.0f / sqrtf(wave_sum(s) * (1.0f / DM) + RMS_EPS);
        const f32x4* g4 = (const f32x4*)g + lane; const f32x4* sh4 = (const f32x4*)(cond_l + (size_t)b * NCOND + sh_off) + lane; const f32x4* sc4 = (const f32x4*)(cond_l + (size_t)b * NCOND + sc_off) + lane;
        GAS unsigned long long* o8 = (GAS unsigned long long*)(hb + (size_t)m * DM) + lane;
#pragma unroll
        for (int j = 0; j < 4; ++j) { const f32x4 gg = g4[64 * j], sh = sh4[64 * j], sc = sc4[64 * j]; const f32x4 o = v[j] * rstd * gg * (sc + 1.0f) + sh;
            o8[64 * j] = (unsigned long long)pk2(o.x, o.y) | ((unsigned long long)pk2(o.z, o.w) << 32); }
    }
}

typedef float f32x16 __attribute__((ext_vector_type(16)));
typedef short s16x4 __attribute__((ext_vector_type(4)));
typedef float f32x2_t __attribute__((ext_vector_type(2))); typedef __bf16 bf16x2_t __attribute__((ext_vector_type(2)));
#define MFMA32(a, b, c) __builtin_amdgcn_mfma_f32_32x32x16_bf16((a), (b), (c), 0, 0, 0)
constexpr float LOG2E = 1.4426950408889634f;
__device__ __forceinline__ unsigned cvtpk(float lo, float hi) { f32x2_t v = {lo, hi}; bf16x2_t b = __builtin_convertvector(v, bf16x2_t); return __builtin_bit_cast(unsigned, b); }
template <int KAP> __device__ __forceinline__ bf16x8 pack8(const f32x16& x) {
    v4u p; p.x = cvtpk(x[8 * KAP + 0], x[8 * KAP + 1]); p.y = cvtpk(x[8 * KAP + 2], x[8 * KAP + 3]); p.z = cvtpk(x[8 * KAP + 4], x[8 * KAP + 5]); p.w = cvtpk(x[8 * KAP + 6], x[8 * KAP + 7]);
    return __builtin_bit_cast(bf16x8, p); }
__device__ __forceinline__ bf16x8 ld_perm(const bf16* p) { const s16x4 lo = *(const s16x4*)p, hi = *(const s16x4*)(p + 8); return __builtin_shufflevector(lo, hi, 0, 1, 2, 3, 4, 5, 6, 7); }
__device__ __forceinline__ float fmax16(const f32x16& a) { float m0 = fmaxf(fmaxf(a[0], a[1]), fmaxf(a[2], a[3])), m1 = fmaxf(fmaxf(a[4], a[5]), fmaxf(a[6], a[7])), m2 = fmaxf(fmaxf(a[8], a[9]), fmaxf(a[10], a[11])), m3 = fmaxf(fmaxf(a[12], a[13]), fmaxf(a[14], a[15])); return fmaxf(fmaxf(m0, m1), fmaxf(m2, m3)); }

struct MixBufs {
    const bf16* proj; const float* gates;
    bf16* vtf;
    float* lcum;
    float* ctot;
    bf16* ql;
    bf16* kl;
    bf16* kt;
    bf16* vtl;
    float* xs;
    float* a1; float* a2; float* beta;
    float* s1; float* s2;
    float* den;
    float* yraw;
};
__device__ __forceinline__ float wave_scan_add(float v, int lane) {
#pragma unroll
    for (int o = 1; o < 64; o <<= 1) { const float u = __shfl_up(v, o); if (lane >= o) v += u; }
    return v; }
__device__ __forceinline__ float wave_scan_max(float v, int lane) {
#pragma unroll
    for (int o = 1; o < 64; o <<= 1) { const float u = __shfl_up(v, o); if (lane >= o) v = fmaxf(v, u); }
    return v; }

struct PrepW { const float* mcw; const float* mcb; const float* scw; const float* scb; const float* fox_fb; const float* mib; const float* mfb; const float* dtb; const float* alog; const float2* rope; };
__device__ __forceinline__ void prep_unit(const MixBufs& B, const PrepW& W, int u, int wave, int lane) {
    const int b = u >> 5, c = u & 31, s0 = 64 * c; const size_t m0 = (size_t)b * SEQ + s0;
    for (int job = wave; job < 52; job += NWAVES) {
        if (job < 36) {
            const int kind = job < 32 ? (job >> 2) : (job < 34 ? 8 : 9), h = job < 32 ? (job & 3) : (job & 1);
            const int cg = lane & 7, tb = lane >> 3, tok0 = 8 * tb;
            const int pc = (kind == 0 ? PC_FV + h * 64 : kind == 1 ? PC_MV + h * 64 : kind == 2 ? PC_RV + h * 64 : kind == 3 ? PC_MQ + h * 64 : kind == 4 ? PC_MK + h * 64 : kind == 5 ? PC_RQ + h * 64 : kind == 6 ? PC_RK + h * 64
                         : kind == 7 ? PC_SX + h * 64 : kind == 8 ? PC_SX + 256 + h * 64 : PC_SX + 384 + h * 64);
            const bf16* src = B.proj + (m0 + tok0) * PROJ_LD + pc + 8 * cg;
            const bool is_conv = (kind == 3 || kind == 4 || kind >= 7), is_rot = (kind == 5 || kind == 6);
            v4u raw[8];
#pragma unroll
            for (int i = 0; i < 8; ++i) raw[i] = *(const v4u*)(src + (size_t)i * PROJ_LD);
            float v[8][8];
#pragma unroll
            for (int i = 0; i < 8; ++i)
#pragma unroll
                for (int j = 0; j < 4; ++j) { v[i][2 * j] = __uint_as_float(raw[i][j] << 16); v[i][2 * j + 1] = __uint_as_float(raw[i][j] & 0xffff0000u); }
            if (is_conv) {
                const int cc = (kind == 3 ? h * 64 : kind == 4 ? 256 + h * 64 : kind == 7 ? h * 64 : kind == 8 ? 256 + h * 64 : 384 + h * 64) + 8 * cg; const float* cw = (kind <= 4) ? W.mcw : W.scw; const float* cbp = (kind <= 4) ? W.mcb : W.scb;
                float wt[4][8], cb[8], xh[3][8];
#pragma unroll
                for (int k = 0; k < 4; ++k) { const f32x4 a = *(const f32x4*)(cw + k * 512 + cc), d = *(const f32x4*)(cw + k * 512 + cc + 4);
#pragma unroll
                    for (int j = 0; j < 4; ++j) { wt[k][j] = a[j]; wt[k][4 + j] = d[j]; } }
                { const f32x4 a = *(const f32x4*)(cbp + cc), d = *(const f32x4*)(cbp + cc + 4);
#pragma unroll
                  for (int j = 0; j < 4; ++j) { cb[j] = a[j]; cb[4 + j] = d[j]; } }
                const bool has_halo = (c > 0) || (tb > 0);
#pragma unroll
                for (int k = 0; k < 3; ++k) { v4u hr = (v4u){0u, 0u, 0u, 0u}; if (has_halo) hr = *(const v4u*)(src - (size_t)(3 - k) * PROJ_LD);
#pragma unroll
                    for (int j = 0; j < 4; ++j) { xh[k][2 * j] = __uint_as_float(hr[j] << 16); xh[k][2 * j + 1] = __uint_as_float(hr[j] & 0xffff0000u); } }
#pragma unroll
                for (int j = 0; j < 8; ++j) { float x0 = xh[0][j], x1 = xh[1][j], x2 = xh[2][j];
#pragma unroll
                    for (int i = 0; i < 8; ++i) { const float x3 = v[i][j]; float o = pg8::silu_f(cb[j] + wt[0][j] * x0 + wt[1][j] * x1 + wt[2][j] * x2 + wt[3][j] * x3); if (kind == 3) o *= 0.125f; v[i][j] = o; x0 = x1; x1 = x2; x2 = x3; } }
            } else if (is_rot) {
                const bf16* src2 = B.proj + (m0 + tok0) * PROJ_LD + pc + 8 * (cg ^ 4);
                const bool lowh = cg < 4; const float sc = (kind == 6) ? 0.125f : 1.0f;
#pragma unroll
                for (int i = 0; i < 8; ++i) { const v4u pr = *(const v4u*)(src2 + (size_t)i * PROJ_LD); const float2* rp = W.rope + (size_t)(s0 + tok0 + i) * 32 + 8 * (cg & 3);
                    const f32x4 r0 = *(const f32x4*)rp, r1 = *(const f32x4*)(rp + 2), r2 = *(const f32x4*)(rp + 4), r3 = *(const f32x4*)(rp + 6);
                    const float cs[8] = {r0[0], r0[2], r1[0], r1[2], r2[0], r2[2], r3[0], r3[2]}, sn[8] = {r0[1], r0[3], r1[1], r1[3], r2[1], r2[3], r3[1], r3[3]};
#pragma unroll
                    for (int j = 0; j < 8; ++j) { const float pv = (j & 1) ? __uint_as_float(pr[j >> 1] & 0xffff0000u) : __uint_as_float(pr[j >> 1] << 16);
                        v[i][j] = (lowh ? v[i][j] * cs[j] - pv * sn[j] : pv * sn[j] + v[i][j] * cs[j]) * sc; } }
            }
            if (kind == 7) {
                const float dtb_h = W.dtb[h];
#pragma unroll
                for (int i = 0; i < 8; ++i) { bf16* xp = (bf16*)B.xs + (m0 + tok0 + i) * 256 + h * 64 + 8 * cg; *(GAS v4u*)xp = (v4u){cvtpk(v[i][0], v[i][1]), cvtpk(v[i][2], v[i][3]), cvtpk(v[i][4], v[i][5]), cvtpk(v[i][6], v[i][7])};
                    const float dt = softplus_f(B.gates[(m0 + tok0 + i) * 16 + 12 + h] + dtb_h);
#pragma unroll
                    for (int j = 0; j < 8; ++j) v[i][j] *= dt; }
            }
            unsigned P[8][4];
#pragma unroll
            for (int i = 0; i < 8; ++i)
#pragma unroll
                for (int j = 0; j < 4; ++j) P[i][j] = cvtpk(v[i][2 * j], v[i][2 * j + 1]);
            bf16* rm = nullptr;
            if (kind == 3) rm = B.ql + (0 * (size_t)M + m0) * 256 + h * 64; else if (kind == 4) rm = B.kl + (0 * (size_t)M + m0) * 256 + h * 64;
            else if (kind == 5) rm = B.ql + (1 * (size_t)M + m0) * 256 + h * 64; else if (kind == 6) rm = B.kl + (1 * (size_t)M + m0) * 256 + h * 64;
            else if (kind == 8) rm = B.kl + (2 * (size_t)M + m0) * 256 + h * 64; else if (kind == 9) rm = B.ql + (2 * (size_t)M + m0) * 256 + h * 64;
            if (rm) {
#pragma unroll
                for (int i = 0; i < 8; ++i) *(GAS v4u*)(rm + (size_t)(tok0 + i) * 256 + 8 * cg) = (v4u){P[i][0], P[i][1], P[i][2], P[i][3]};
            }
            bf16* tr = nullptr;
            if (kind == 0) tr = B.vtf + ((size_t)(b * 4 + h) * 64) * SEQ;
            else if (kind == 1) tr = B.vtl + (((size_t)(0 * BATCH + b) * 4 + h) * 96) * SEQ;
            else if (kind == 2) tr = B.vtl + (((size_t)(1 * BATCH + b) * 4 + h) * 96) * SEQ;
            else if (kind == 7) tr = B.vtl + (((size_t)(2 * BATCH + b) * 4 + h) * 96) * SEQ;
            else if (kind == 4) tr = B.kt + (((size_t)(0 * BATCH + b) * 4 + h) * 64) * SEQ;
            else if (kind == 6) tr = B.kt + (((size_t)(1 * BATCH + b) * 4 + h) * 64) * SEQ;
            else if (kind == 8) tr = B.kt + (((size_t)(2 * BATCH + b) * 4 + h) * 64) * SEQ;
            if (tr) {
                tr += s0 + tok0;
#pragma unroll
                for (int j = 0; j < 8; ++j) { v4u o;
#pragma unroll
                    for (int ip = 0; ip < 4; ++ip) o[ip] = (j & 1) ? ((P[2 * ip][j >> 1] >> 16) | (P[2 * ip + 1][j >> 1] & 0xffff0000u)) : ((P[2 * ip][j >> 1] & 0xffffu) | (P[2 * ip + 1][j >> 1] << 16));
                    *(GAS v4u*)(tr + (size_t)(8 * cg + j) * SEQ) = o; }
                if (kind == 1 && cg < 4) {
#pragma unroll
                    for (int j = 0; j < 8; ++j) { const unsigned w = (cg == 0 && j == 0) ? 0x3f803f80u : 0u; *(GAS v4u*)(tr + (size_t)(64 + 8 * cg + j) * SEQ) = (v4u){w, w, w, w}; }
                }
            }
        } else {
            const int gj = job - 36, mixer = gj >> 2, h = gj & 3;
            const size_t m = m0 + lane;
            if (mixer == 0) {
                const float cum = wave_scan_add(log_sigmoid_f(B.gates[m * 16 + h] + W.fox_fb[h]), lane);
                B.lcum[(size_t)(b * 4 + h) * SEQ + s0 + lane] = cum; if (lane == 63) B.ctot[(b * 4 + h) * 32 + c] = cum;
            } else {
                const int mx = mixer - 1; const size_t ci = ((size_t)(mx * BATCH + b) * 4 + h) * SEQ + s0 + lane; const int si = ((mx * BATCH + b) * 4 + h) * 32 + c;
                if (mx == 0) {
                    const float bb = wave_scan_add(log_sigmoid_f(B.gates[m * 16 + 8 + h] + W.mfb[h]), lane), ic = B.gates[m * 16 + 4 + h] + W.mib[h], be = bb - ic, pm = wave_scan_max(-be, lane);
                    B.a1[ci] = bb; B.a2[ci] = bb + pm; B.beta[ci] = be; if (lane == 63) { B.s1[si] = bb; B.s2[si] = bb + pm; }
                } else if (mx == 1) {
                    const float lg = log1pf(-exp2f(-5.0f - (float)h)), v = (float)(lane + 1) * lg;
                    B.a1[ci] = v; B.a2[ci] = 0.f; B.beta[ci] = v; if (lane == 63) { B.s1[si] = v; B.s2[si] = 0.f; }
                } else {
                    const float dt = softplus_f(B.gates[m * 16 + 12 + h] + W.dtb[h]), cum = wave_scan_add(dt * (-__expf(W.alog[h])), lane);
                    B.a1[ci] = cum; B.a2[ci] = 0.f; B.beta[ci] = cum; if (lane == 63) { B.s1[si] = cum; B.s2[si] = 0.f; }
                }
            }
        }
    }
}

__device__ __forceinline__ int sig32(int i) { return (i & ~0xC) | ((i & 4) << 1) | ((i & 8) >> 1); }
#define GLDS16(gp, lp) __builtin_amdgcn_global_load_lds((const unsigned*)(gp), (LAS unsigned*)(lp), 16, 0, 0)
#define VMWAIT(n) asm volatile("s_waitcnt vmcnt(" #n ")" ::: "memory")
#define WGBAR() do { asm volatile("" ::: "memory"); __builtin_amdgcn_s_barrier(); asm volatile("" ::: "memory"); } while (0)
constexpr int FOX_SLOT = 16384, FOX_LC = 3 * FOX_SLOT;
__device__ __forceinline__ void fox_wg_unit(const MixBufs& B, bf16* ybf, LAS unsigned char* lds, int b, int h, int qb8, int wave, int lane) {
    const int col = lane & 31, hi = lane >> 5, t0 = 256 * qb8 + 32 * wave;
    const size_t rowq = (size_t)b * SEQ + t0 + col;
    bf16x8 qf[4];
#pragma unroll
    for (int ks = 0; ks < 4; ++ks) qf[ks] = *(const bf16x8*)(B.proj + rowq * PROJ_LD + PC_FQ + h * 64 + 16 * ks + 8 * hi);
    float offv; { const float cv = (lane < 32) ? B.ctot[(b * 4 + h) * 32 + lane] : 0.f; offv = wave_scan_add(cv, lane) - cv; }
    if (wave <= qb8) GLDS16(B.lcum + (size_t)(b * 4 + h) * SEQ + 256 * wave + 4 * lane, lds + FOX_LC + 1024 * wave);
    const bf16* ksrc = B.proj + ((size_t)b * SEQ + 32 * (wave >> 2) + sig32(col)) * PROJ_LD + PC_FK + h * 64 + 16 * (wave & 3) + 8 * hi;
    const bf16* vsrc = B.vtf + ((size_t)(b * 4 + h) * 64 + 32 * (wave >> 2) + col) * SEQ + 16 * (wave & 3) + 8 * hi;
    const int nkt = 4 * (qb8 + 1), tdiag = 4 * qb8 + (wave >> 1);
#define FOX_ISSUE(t, slot) do { GLDS16(ksrc + (size_t)(64 * (t)) * PROJ_LD, lds + (slot) * FOX_SLOT + 1024 * wave); GLDS16(vsrc + 64 * (t), lds + (slot) * FOX_SLOT + 8192 + 1024 * wave); } while (0)
    VMWAIT(0); WGBAR();
    if (wave <= qb8) {
        LAS f32x4* lp = (LAS f32x4*)(lds + FOX_LC + 1024 * wave) + lane; const f32x4 cv = *lp;
        const float o = __shfl(offv, 4 * wave + (lane >> 4));
        *lp = (cv + o) * (-LOG2E);
    }
    asm volatile("s_waitcnt lgkmcnt(0)" ::: "memory"); WGBAR();
    FOX_ISSUE(0, 0); FOX_ISSUE(1, 1);
    float mrun = -INFINITY, lsum = 0.f; f32x16 O0, O1;
#pragma unroll
    for (int r = 0; r < 16; ++r) { O0[r] = 0.f; O1[r] = 0.f; }
    int slot = 0;
    for (int kt = 0; kt < nkt; ++kt) {
        VMWAIT(2); WGBAR();
        { const int tn = (kt + 2 < nkt) ? kt + 2 : nkt - 1; const int sn = (slot == 0) ? 2 : slot - 1; FOX_ISSUE(tn, sn); }
        if (kt <= tdiag) {
            const int s0 = 64 * kt;
            const LAS unsigned char* sp = lds + slot * FOX_SLOT + 16 * lane;
            const LAS float* lc = (const LAS float*)(lds + FOX_LC) + s0 + 8 * hi;
            f32x16 S0, S1;
#pragma unroll
            for (int j = 0; j < 4; ++j) { const f32x4 c0 = *(const LAS f32x4*)(lc + 16 * j), c1 = *(const LAS f32x4*)(lc + 16 * j + 4);
#pragma unroll
                for (int i = 0; i < 4; ++i) { if (j < 2) { S0[8 * j + i] = c0[i]; S0[8 * j + 4 + i] = c1[i]; } else { S1[8 * (j - 2) + i] = c0[i]; S1[8 * (j - 2) + 4 + i] = c1[i]; } } }
#pragma unroll
            for (int ks = 0; ks < 4; ++ks) { S0 = MFMA32(*(const LAS bf16x8*)(sp + ks * 1024), qf[ks], S0); S1 = MFMA32(*(const LAS bf16x8*)(sp + (4 + ks) * 1024), qf[ks], S1); }
            if (kt == tdiag) {
                const int tq = t0 + col - s0;
#pragma unroll
                for (int r = 0; r < 16; ++r) { const int sl = 16 * (r >> 3) + 8 * hi + (r & 7); if (sl > tq) S0[r] = -INFINITY; if (sl + 32 > tq) S1[r] = -INFINITY; }
            }
            float mloc = fmaxf(fmax16(S0), fmax16(S1)); mloc = fmaxf(mloc, __shfl_xor(mloc, 32));
            const float mnew = fmaxf(mrun, mloc), alpha = __builtin_amdgcn_exp2f(mrun - mnew); mrun = mnew;
            float psum = 0.f;
#pragma unroll
            for (int r = 0; r < 16; ++r) { S0[r] = __builtin_amdgcn_exp2f(S0[r] - mnew); S1[r] = __builtin_amdgcn_exp2f(S1[r] - mnew); psum += S0[r] + S1[r]; }
            lsum = lsum * alpha + psum;
#pragma unroll
            for (int r = 0; r < 16; ++r) { O0[r] *= alpha; O1[r] *= alpha; }
            { const bf16x8 p00 = pack8<0>(S0), p01 = pack8<1>(S0), p10 = pack8<0>(S1), p11 = pack8<1>(S1);
              const LAS unsigned char* vp = sp + 8192;
              O0 = MFMA32(*(const LAS bf16x8*)(vp), p00, O0); O0 = MFMA32(*(const LAS bf16x8*)(vp + 1024), p01, O0); O0 = MFMA32(*(const LAS bf16x8*)(vp + 2048), p10, O0); O0 = MFMA32(*(const LAS bf16x8*)(vp + 3072), p11, O0);
              O1 = MFMA32(*(const LAS bf16x8*)(vp + 4096), p00, O1); O1 = MFMA32(*(const LAS bf16x8*)(vp + 5120), p01, O1); O1 = MFMA32(*(const LAS bf16x8*)(vp + 6144), p10, O1); O1 = MFMA32(*(const LAS bf16x8*)(vp + 7168), p11, O1); }
        }
        asm volatile("" ::: "memory");
        slot = (slot == 2) ? 0 : slot + 1;
    }
#undef FOX_ISSUE
    const float rl = 1.0f / (lsum + __shfl_xor(lsum, 32));
    bf16* yp = ybf + rowq * DM + h * 64 + 4 * hi;
#pragma unroll
    for (int g = 0; g < 4; ++g) { *(unsigned long long*)(yp + 8 * g) = (unsigned long long)cvtpk(O0[4 * g] * rl, O0[4 * g + 1] * rl) | ((unsigned long long)cvtpk(O0[4 * g + 2] * rl, O0[4 * g + 3] * rl) << 32);
                                  *(unsigned long long*)(yp + 32 + 8 * g) = (unsigned long long)cvtpk(O1[4 * g] * rl, O1[4 * g + 1] * rl) | ((unsigned long long)cvtpk(O1[4 * g + 2] * rl, O1[4 * g + 3] * rl) << 32); }
    VMWAIT(0); WGBAR();
}

constexpr int LIN_BUF = 30720, LIN_STF = 3 * LIN_BUF;
__device__ __forceinline__ void lin_wg_unit(const MixBufs& B, LAS unsigned char* lbuf, int mx, int b, int h, int es, int wave, int lane) {
    const int col = lane & 31, hi = lane >> 5, hk = (mx == 2) ? (h >> 1) : h; const bool ml = (mx == 0);
    const size_t cbase = (((size_t)mx * BATCH + b) * 4 + h) * SEQ; const int sbase = ((mx * BATCH + b) * 4 + h) * 32;
    if (wave >= 1 && wave <= 4) {
        const bf16* src; size_t step_c, step_hi, step_lo; int np, f0;
        if (wave == 1)      { src = B.ql + ((size_t)mx * M + (size_t)b * SEQ + col) * 256 + hk * 64 + 8 * hi;            step_c = 64 * 256; step_hi = 32 * 256; step_lo = 16; np = 8; f0 = 0; }
        else if (wave == 2) { src = B.kl + ((size_t)mx * M + (size_t)b * SEQ + sig32(col)) * 256 + hk * 64 + 8 * hi;     step_c = 64 * 256; step_hi = 32 * 256; step_lo = 16; np = 8; f0 = 8; }
        else if (wave == 3) { src = B.kt + ((((size_t)mx * BATCH + b) * 4 + hk) * 64 + sig32(col)) * SEQ + 8 * hi;      step_c = 64; step_hi = (size_t)32 * SEQ; step_lo = 16; np = 8; f0 = 16; }
        else                { src = B.vtl + ((((size_t)mx * BATCH + b) * 4 + h) * 96 + 32 * es + col) * SEQ + 8 * hi;   step_c = 64; step_hi = 0; step_lo = 16; np = 4; f0 = 24; }
        const int cl = lane & 15; const bool sc_lane = (lane == 48 || lane == 49);
        const float* cfp = (lane < 16) ? B.a1 + cbase + 4 * cl : (lane < 32) ? B.a2 + cbase + 4 * cl : (lane < 48) ? B.beta + cbase + 4 * cl : (lane == 48) ? B.s1 + sbase : (lane == 49) ? B.s2 + sbase : B.a1 + cbase;
#define LIN_ISSUE(c, bi) do { LAS unsigned char* bb_ = lbuf + (bi) * LIN_BUF + f0 * 1024; const bf16* sc_ = src + (size_t)(c) * step_c; \
            _Pragma("unroll") for (int f = 0; f < 8; ++f) if (f < np) GLDS16(sc_ + (size_t)(f >> 2) * step_hi + (size_t)(f & 3) * step_lo, bb_ + f * 1024); \
            if (wave == 4) GLDS16(cfp + (sc_lane ? 4 * ((c) >> 2) : 64 * (c)), lbuf + (bi) * LIN_BUF + 28 * 1024); } while (0)
        LIN_ISSUE(0, 0); LIN_ISSUE(1, 1);
        if (wave == 4) VMWAIT(5); else VMWAIT(8);
        WGBAR();
        int bi = 2;
        for (int c = 0; c < 32; ++c) {
            const int cc = (c + 2 < 32) ? c + 2 : 31;
            LIN_ISSUE(cc, bi);
            if (wave == 4) VMWAIT(5); else VMWAIT(8);
            WGBAR();
            bi = (bi == 2) ? 0 : bi + 1;
        }
#undef LIN_ISSUE
        VMWAIT(0);
    } else if (wave == 0 || wave == 5) {
        const int tt = (wave == 5) ? 1 : 0;
        float mst = 0.f; int bi = 0;
        WGBAR();
        for (int c = 0; c < 32; ++c) {
            const int s0 = 64 * c;
            const LAS unsigned char* bp = lbuf + bi * LIN_BUF + 16 * lane;
            const LAS unsigned char* sf = lbuf + LIN_STF + (c & 1) * 4096 + 16 * lane;
            const LAS float* cf = (const LAS float*)(lbuf + bi * LIN_BUF + 28 * 1024);
#define LFR(f) (*(const LAS bf16x8*)(bp + (f) * 1024))
            const float S1v = cf[192 + (c & 3)], S2v = cf[196 + (c & 3)];
            float mnew = 0.f;
            if (ml) mnew = fmaxf(S1v + mst, S2v);
            const float a1 = cf[32 * tt + col]; float al = a1, rho = a1, mt = 0.f;
            if (ml) { mt = fmaxf(a1 + mst, cf[64 + 32 * tt + col]); al = a1 - mt; rho = a1 + mst - mt; }
            f32x16 y;
#pragma unroll
            for (int r = 0; r < 16; ++r) y[r] = 0.f;
#pragma unroll
            for (int j = 0; j < 4; ++j) y = MFMA32(*(const LAS bf16x8*)(sf + j * 1024), LFR(tt * 4 + j), y);
            const float er = __expf(rho);
#pragma unroll
            for (int r = 0; r < 16; ++r) y[r] *= er;
            for (int st = 0; st <= tt; ++st) {
                f32x4 bD[2][2];
#pragma unroll
                for (int k = 0; k < 2; ++k) { bD[k][0] = *(const LAS f32x4*)(cf + 128 + 16 * (2 * st + k) + 8 * hi); bD[k][1] = *(const LAS f32x4*)(cf + 128 + 16 * (2 * st + k) + 8 * hi + 4); }
                f32x16 p;
#pragma unroll
                for (int r = 0; r < 16; ++r) p[r] = 0.f;
#pragma unroll
                for (int ks = 0; ks < 4; ++ks) p = MFMA32(LFR(8 + st * 4 + ks), LFR(tt * 4 + ks), p);
#pragma unroll
                for (int r = 0; r < 16; ++r) { float v = p[r] * __expf(al - bD[r >> 3][(r >> 2) & 1][r & 3]); if (st == tt && (16 * (r >> 3) + 8 * hi + (r & 7)) > col) v = 0.f; p[r] = v; }
                y = MFMA32(LFR(24 + 2 * st), pack8<0>(p), y); y = MFMA32(LFR(24 + 2 * st + 1), pack8<1>(p), y);
            }
            { const size_t row = (size_t)b * SEQ + s0 + 32 * tt + col;
              if (es < 2) { bf16* yp = (bf16*)B.yraw + row * 1024 + 256 * (mx + 1) + h * 64 + 32 * es + 4 * hi;
#pragma unroll
                  for (int g = 0; g < 4; ++g) *(unsigned long long*)(yp + 8 * g) = (unsigned long long)cvtpk(y[4 * g], y[4 * g + 1]) | ((unsigned long long)cvtpk(y[4 * g + 2], y[4 * g + 3]) << 32); }
              else if (hi == 0) { B.den[row * 8 + h * 2] = y[0]; B.den[row * 8 + h * 2 + 1] = mt; } }
#undef LFR
            if (ml) mst = mnew;
            asm volatile("s_waitcnt lgkmcnt(0)" ::: "memory");
            WGBAR();
            bi = (bi == 2) ? 0 : bi + 1;
        }
    } else if (wave == 6) {
        f32x16 st0, st1;
#pragma unroll
        for (int r = 0; r < 16; ++r) { st0[r] = 0.f; st1[r] = 0.f; }
        { LAS unsigned char* sf = lbuf + LIN_STF + 16 * lane;
#pragma unroll
          for (int j = 0; j < 4; ++j) *(LAS v4u*)(sf + j * 1024) = (v4u){0u, 0u, 0u, 0u}; }
        float mst = 0.f; int bi = 0;
        asm volatile("s_waitcnt lgkmcnt(0)" ::: "memory");
        WGBAR();
        for (int c = 0; c < 32; ++c) {
            const LAS unsigned char* bp = lbuf + bi * LIN_BUF + 16 * lane;
            const LAS float* cf = (const LAS float*)(lbuf + bi * LIN_BUF + 28 * 1024);
#define LFR(f) (*(const LAS bf16x8*)(bp + (f) * 1024))
            const float S1v = cf[192 + (c & 3)], S2v = cf[196 + (c & 3)];
            float gam = S1v, dlt = S1v, mnew = 0.f;
            if (ml) { mnew = fmaxf(S1v + mst, S2v); gam = S1v - mnew; dlt = S1v + mst - mnew; }
            const float ed = __expf(dlt);
#pragma unroll
            for (int r = 0; r < 16; ++r) { st0[r] *= ed; st1[r] *= ed; }
#pragma unroll
            for (int k4 = 0; k4 < 4; ++k4) {
                const bf16x8 vr = LFR(24 + k4); const f32x4 b0 = *(const LAS f32x4*)(cf + 128 + 16 * k4 + 8 * hi), b1 = *(const LAS f32x4*)(cf + 128 + 16 * k4 + 8 * hi + 4);
                v4u wv; wv.x = cvtpk(bf2f((unsigned short)vr[0]) * __expf(gam - b0[0]), bf2f((unsigned short)vr[1]) * __expf(gam - b0[1])); wv.y = cvtpk(bf2f((unsigned short)vr[2]) * __expf(gam - b0[2]), bf2f((unsigned short)vr[3]) * __expf(gam - b0[3]));
                wv.z = cvtpk(bf2f((unsigned short)vr[4]) * __expf(gam - b1[0]), bf2f((unsigned short)vr[5]) * __expf(gam - b1[1])); wv.w = cvtpk(bf2f((unsigned short)vr[6]) * __expf(gam - b1[2]), bf2f((unsigned short)vr[7]) * __expf(gam - b1[3]));
                const bf16x8 wvf = __builtin_bit_cast(bf16x8, wv);
                st0 = MFMA32(LFR(16 + k4), wvf, st0); st1 = MFMA32(LFR(20 + k4), wvf, st1);
            }
#undef LFR
            { LAS unsigned char* sf = lbuf + LIN_STF + ((c + 1) & 1) * 4096 + 16 * lane;
              *(LAS bf16x8*)(sf) = pack8<0>(st0); *(LAS bf16x8*)(sf + 1024) = pack8<1>(st0); *(LAS bf16x8*)(sf + 2048) = pack8<0>(st1); *(LAS bf16x8*)(sf + 3072) = pack8<1>(st1); }
            if (ml) mst = mnew;
            asm volatile("s_waitcnt lgkmcnt(0)" ::: "memory");
            WGBAR();
            bi = (bi == 2) ? 0 : bi + 1;
        }
    } else {
        for (int c = 0; c < 33; ++c) WGBAR();
    }
    VMWAIT(0); WGBAR();
}
constexpr int MX_LC = 3 * 16384, MX_LIN = MX_LC + 8192, MX_STF = MX_LIN + 3 * LIN_BUF;
static_assert(MX_STF + 8192 <= LDSCTL_OFF, "mixer LDS map");
__device__ __forceinline__ void mixer_phase(const MixBufs& B, bf16* ybf, LAS unsigned char* lds, int vcu, int wave, int lane) {
    const int G = gridDim.x;
    const int col = lane & 31, hi = lane >> 5;
    for (int v = vcu; v < 256; v += G) {
        const int bh = v >> 3, i8 = v & 7, fb = bh >> 2, fh = bh & 3;
        const int nktA = 2 * i8 + 2, NF = 34;
        const bool has_lin = i8 < 7; const int lj = (bh & 3) * 7 + i8;
        int mx, lh, es; const int lb = fb; if (lj < 12) { mx = 0; lh = lj / 3; es = lj % 3; } else { const int w2 = lj - 12; mx = 1 + (w2 >> 3); lh = (w2 >> 1) & 3; es = w2 & 1; }
        const int hk = (mx == 2) ? (lh >> 1) : lh; const bool ml = (mx == 0);
        const size_t cbase = (((size_t)mx * BATCH + lb) * 4 + lh) * SEQ; const int sbase = ((mx * BATCH + lb) * 4 + lh) * 32;
        if (wave < 4) {
            int qb16 = i8, t0 = 128 * qb16 + 32 * wave, tdiag = 2 * qb16 + (wave >> 1);
            size_t rowq = (size_t)fb * SEQ + t0 + col;
            bf16x8 qf[4];
#pragma unroll
            for (int ks = 0; ks < 4; ++ks) qf[ks] = *(const bf16x8*)(B.proj + rowq * PROJ_LD + PC_FQ + fh * 64 + 16 * ks + 8 * hi);
            float offv; { const float cv = (lane < 32) ? B.ctot[(fb * 4 + fh) * 32 + lane] : 0.f; offv = wave_scan_add(cv, lane) - cv; }
            GLDS16(B.lcum + (size_t)(fb * 4 + fh) * SEQ + 256 * wave + 4 * lane, lds + MX_LC + 1024 * wave);
            GLDS16(B.lcum + (size_t)(fb * 4 + fh) * SEQ + 256 * (wave + 4) + 4 * lane, lds + MX_LC + 1024 * (wave + 4));
            const bf16* ksrc = B.proj + ((size_t)fb * SEQ + sig32(col)) * PROJ_LD + PC_FK + fh * 64 + 16 * wave + 8 * hi;
            const bf16* vsrc = B.vtf + ((size_t)(fb * 4 + fh) * 64 + col) * SEQ + 16 * wave + 8 * hi;
#define FOX_ISSUE(kt, slot) do { LAS unsigned char* d_ = lds + (slot) * FOX_SLOT + 1024 * wave; const bf16* k_ = ksrc + (size_t)(64 * (kt)) * PROJ_LD; const bf16* v_ = vsrc + 64 * (kt); \
                GLDS16(k_, d_); GLDS16(k_ + (size_t)32 * PROJ_LD, d_ + 4096); GLDS16(v_, d_ + 8192); GLDS16(v_ + (size_t)32 * SEQ, d_ + 12288); } while (0)
            FOX_ISSUE(0, 0); FOX_ISSUE(1, 1);
            VMWAIT(8); WGBAR();
#pragma unroll
            for (int pz = 0; pz < 2; ++pz) { const int pc_ = wave + 4 * pz;
                LAS f32x4* lp = (LAS f32x4*)(lds + MX_LC + 1024 * pc_) + lane; const f32x4 cv = *lp; const float o = __shfl(offv, 4 * pc_ + (lane >> 4)); *lp = (cv + o) * (-LOG2E); }
            asm volatile("s_waitcnt lgkmcnt(0)" ::: "memory"); WGBAR();
            float mrun = -INFINITY, lsum = 0.f; f32x16 O0, O1;
#pragma unroll
            for (int r = 0; r < 16; ++r) { O0[r] = 0.f; O1[r] = 0.f; }
            int sl = 0;
            for (int f = 0; f < NF; ++f) {
                if (f + 1 < NF) VMWAIT(4); else VMWAIT(0);
                WGBAR();
                if (f + 2 < NF) { const int kn = (f + 2 < nktA) ? f + 2 : f + 2 - nktA; FOX_ISSUE(kn, (sl == 0) ? 2 : sl - 1); }
                if (f == nktA) {
                    const float rl = 1.0f / (lsum + __shfl_xor(lsum, 32));
                    bf16* yp = ybf + rowq * DM + fh * 64 + 4 * hi;
#pragma unroll
                    for (int g = 0; g < 4; ++g) { *(unsigned long long*)(yp + 8 * g) = (unsigned long long)cvtpk(O0[4 * g] * rl, O0[4 * g + 1] * rl) | ((unsigned long long)cvtpk(O0[4 * g + 2] * rl, O0[4 * g + 3] * rl) << 32);
                                                  *(unsigned long long*)(yp + 32 + 8 * g) = (unsigned long long)cvtpk(O1[4 * g] * rl, O1[4 * g + 1] * rl) | ((unsigned long long)cvtpk(O1[4 * g + 2] * rl, O1[4 * g + 3] * rl) << 32); }
                    qb16 = 15 - i8; t0 = 128 * qb16 + 32 * wave; tdiag = 2 * qb16 + (wave >> 1); rowq = (size_t)fb * SEQ + t0 + col;
#pragma unroll
                    for (int ks = 0; ks < 4; ++ks) qf[ks] = *(const bf16x8*)(B.proj + rowq * PROJ_LD + PC_FQ + fh * 64 + 16 * ks + 8 * hi);
                    mrun = -INFINITY; lsum = 0.f;
#pragma unroll
                    for (int r = 0; r < 16; ++r) { O0[r] = 0.f; O1[r] = 0.f; }
                }
                const int kt = (f < nktA) ? f : f - nktA;
                if (kt <= tdiag) {
                    const int s0 = 64 * kt;
                    const LAS unsigned char* sp = lds + sl * FOX_SLOT + 16 * lane;
                    const LAS float* lc = (const LAS float*)(lds + MX_LC) + s0 + 8 * hi;
                    f32x16 S0, S1;
#pragma unroll
                    for (int j = 0; j < 4; ++j) { const f32x4 c0 = *(const LAS f32x4*)(lc + 16 * j), c1 = *(const LAS f32x4*)(lc + 16 * j + 4);
#pragma unroll
                        for (int i = 0; i < 4; ++i) { if (j < 2) { S0[8 * j + i] = c0[i]; S0[8 * j + 4 + i] = c1[i]; } else { S1[8 * (j - 2) + i] = c0[i]; S1[8 * (j - 2) + 4 + i] = c1[i]; } } }
#pragma unroll
                    for (int ks = 0; ks < 4; ++ks) { S0 = MFMA32(*(const LAS bf16x8*)(sp + ks * 1024), qf[ks], S0); S1 = MFMA32(*(const LAS bf16x8*)(sp + (4 + ks) * 1024), qf[ks], S1); }
                    if (kt == tdiag) {
                        const int tq = t0 + col - s0;
#pragma unroll
                        for (int r = 0; r < 16; ++r) { const int sl = 16 * (r >> 3) + 8 * hi + (r & 7); if (sl > tq) S0[r] = -INFINITY; if (sl + 32 > tq) S1[r] = -INFINITY; }
                    }
                    float mloc = fmaxf(fmax16(S0), fmax16(S1)); mloc = fmaxf(mloc, __shfl_xor(mloc, 32));
                    const float mnew = fmaxf(mrun, mloc), alpha = __builtin_amdgcn_exp2f(mrun - mnew); mrun = mnew;
                    float psum = 0.f;
#pragma unroll
                    for (int r = 0; r < 16; ++r) { S0[r] = __builtin_amdgcn_exp2f(S0[r] - mnew); S1[r] = __builtin_amdgcn_exp2f(S1[r] - mnew); psum += S0[r] + S1[r]; }
                    lsum = lsum * alpha + psum;
#pragma unroll
                    for (int r = 0; r < 16; ++r) { O0[r] *= alpha; O1[r] *= alpha; }
                    { const bf16x8 p00 = pack8<0>(S0), p01 = pack8<1>(S0), p10 = pack8<0>(S1), p11 = pack8<1>(S1);
                      const LAS unsigned char* vp = sp + 8192;
                      O0 = MFMA32(*(const LAS bf16x8*)(vp), p00, O0); O0 = MFMA32(*(const LAS bf16x8*)(vp + 1024), p01, O0); O0 = MFMA32(*(const LAS bf16x8*)(vp + 2048), p10, O0); O0 = MFMA32(*(const LAS bf16x8*)(vp + 3072), p11, O0);
                      O1 = MFMA32(*(const LAS bf16x8*)(vp + 4096), p00, O1); O1 = MFMA32(*(const LAS bf16x8*)(vp + 5120), p01, O1); O1 = MFMA32(*(const LAS bf16x8*)(vp + 6144), p10, O1); O1 = MFMA32(*(const LAS bf16x8*)(vp + 7168), p11, O1); }
                }
                asm volatile("s_waitcnt lgkmcnt(0)" ::: "memory");
                sl = (sl == 2) ? 0 : sl + 1;
            }
#undef FOX_ISSUE
            { const float rl = 1.0f / (lsum + __shfl_xor(lsum, 32));
              bf16* yp = ybf + rowq * DM + fh * 64 + 4 * hi;
#pragma unroll
              for (int g = 0; g < 4; ++g) { *(unsigned long long*)(yp + 8 * g) = (unsigned long long)cvtpk(O0[4 * g] * rl, O0[4 * g + 1] * rl) | ((unsigned long long)cvtpk(O0[4 * g + 2] * rl, O0[4 * g + 3] * rl) << 32);
                                            *(unsigned long long*)(yp + 32 + 8 * g) = (unsigned long long)cvtpk(O1[4 * g] * rl, O1[4 * g + 1] * rl) | ((unsigned long long)cvtpk(O1[4 * g + 2] * rl, O1[4 * g + 3] * rl) << 32); } }
        } else {
            const bf16* src; size_t step_c, step_hi; int np, f0;
            if (wave == 4)      { src = B.ql + ((size_t)mx * M + (size_t)lb * SEQ + col) * 256 + hk * 64 + 8 * hi;            step_c = 64 * 256; step_hi = 32 * 256; np = 8; f0 = 0; }
            else if (wave == 6) { src = B.kt + ((((size_t)mx * BATCH + lb) * 4 + hk) * 64 + sig32(col)) * SEQ + 8 * hi;      step_c = 64; step_hi = (size_t)32 * SEQ; np = 8; f0 = 16; }
            else if (wave == 7) { src = B.vtl + ((((size_t)mx * BATCH + lb) * 4 + lh) * 96 + 32 * es + col) * SEQ + 8 * hi;  step_c = 64; step_hi = 0; np = 4; f0 = 24; }
            else                { src = B.ql; step_c = 0; step_hi = 0; np = 0; f0 = 0; }
            const bf16* srck = B.kl + ((size_t)mx * M + (size_t)lb * SEQ + sig32(col)) * 256 + hk * 64 + 8 * hi;
            const int cl = lane & 15; const bool sc_lane = (lane == 48 || lane == 49);
            const float* cfp = (lane < 16) ? B.a1 + cbase + 4 * cl : (lane < 32) ? B.a2 + cbase + 4 * cl : (lane < 48) ? B.beta + cbase + 4 * cl : (lane == 48) ? B.s1 + sbase : (lane == 49) ? B.s2 + sbase : B.a1 + cbase;
            LAS unsigned char* lbuf = lds + MX_LIN;
#define LIN_ISSUE(c, bi) do { LAS unsigned char* bb_ = lbuf + (bi) * LIN_BUF + f0 * 1024; const bf16* sc_ = src + (size_t)(c) * step_c; \
                _Pragma("unroll") for (int f = 0; f < 8; ++f) if (f < np) GLDS16(sc_ + (size_t)(f >> 2) * step_hi + (size_t)(f & 3) * 16, bb_ + f * 1024); \
                if (wave == 7) { const bf16* sk_ = srck + (size_t)(c) * (64 * 256); LAS unsigned char* bk_ = lbuf + (bi) * LIN_BUF + 8 * 1024; \
                    _Pragma("unroll") for (int f = 0; f < 8; ++f) GLDS16(sk_ + (size_t)(f >> 2) * (32 * 256) + (size_t)(f & 3) * 16, bk_ + f * 1024); \
                    GLDS16(cfp + (sc_lane ? 4 * ((c) >> 2) : 64 * (c)), lbuf + (bi) * LIN_BUF + 28 * 1024); } } while (0)
            if (has_lin) { LIN_ISSUE(0, 0); LIN_ISSUE(1, 1); }
            f32x16 st0, st1;
#pragma unroll
            for (int r = 0; r < 16; ++r) { st0[r] = 0.f; st1[r] = 0.f; }
            if (wave == 6) { LAS unsigned char* sf = lds + MX_STF + 16 * lane;
#pragma unroll
                for (int j = 0; j < 4; ++j) *(LAS v4u*)(sf + j * 1024) = (v4u){0u, 0u, 0u, 0u}; }
            asm volatile("s_waitcnt lgkmcnt(0)" ::: "memory"); WGBAR();
            WGBAR();
            float mst = 0.f; int bi = 0;
            for (int c = 0; c < NF; ++c) {
                if (c + 1 < 32) { if (wave == 7) VMWAIT(13); else if (wave == 5) VMWAIT(0); else VMWAIT(8); } else VMWAIT(0);
                WGBAR();
                if (has_lin && c < 32) {
                    if (c + 2 < 32) LIN_ISSUE(c + 2, (bi == 0) ? 2 : bi - 1);
                    const LAS unsigned char* bp = lbuf + bi * LIN_BUF + 16 * lane;
                    const LAS float* cf = (const LAS float*)(lbuf + bi * LIN_BUF + 28 * 1024);
#define LFR(f) (*(const LAS bf16x8*)(bp + (f) * 1024))
                    if (wave == 4 || wave == 5) {
                        const int tt = wave - 4, s0 = 64 * c;
                        const LAS unsigned char* sf = lds + MX_STF + (c & 1) * 4096 + 16 * lane;
                        const float S1v = cf[192 + (c & 3)], S2v = cf[196 + (c & 3)];
                        float mnew = 0.f;
                        if (ml) mnew = fmaxf(S1v + mst, S2v);
                        const float a1 = cf[32 * tt + col]; float al = a1, rho = a1, mt = 0.f;
                        if (ml) { mt = fmaxf(a1 + mst, cf[64 + 32 * tt + col]); al = a1 - mt; rho = a1 + mst - mt; }
                        f32x16 y;
#pragma unroll
                        for (int r = 0; r < 16; ++r) y[r] = 0.f;
#pragma unroll
                        for (int j = 0; j < 4; ++j) y = MFMA32(*(const LAS bf16x8*)(sf + j * 1024), LFR(tt * 4 + j), y);
                        const float er = __expf(rho);
#pragma unroll
                        for (int r = 0; r < 16; ++r) y[r] *= er;
                        for (int st = 0; st <= tt; ++st) {
                            f32x4 bD[2][2];
#pragma unroll
                            for (int k = 0; k < 2; ++k) { bD[k][0] = *(const LAS f32x4*)(cf + 128 + 16 * (2 * st + k) + 8 * hi); bD[k][1] = *(const LAS f32x4*)(cf + 128 + 16 * (2 * st + k) + 8 * hi + 4); }
                            f32x16 p;
#pragma unroll
                            for (int r = 0; r < 16; ++r) p[r] = 0.f;
#pragma unroll
                            for (int ks = 0; ks < 4; ++ks) p = MFMA32(LFR(8 + st * 4 + ks), LFR(tt * 4 + ks), p);
#pragma unroll
                            for (int r = 0; r < 16; ++r) { float vv = p[r] * __expf(al - bD[r >> 3][(r >> 2) & 1][r & 3]); if (st == tt && (16 * (r >> 3) + 8 * hi + (r & 7)) > col) vv = 0.f; p[r] = vv; }
                            y = MFMA32(LFR(24 + 2 * st), pack8<0>(p), y); y = MFMA32(LFR(24 + 2 * st + 1), pack8<1>(p), y);
                        }
                        { const size_t row = (size_t)lb * SEQ + s0 + 32 * tt + col;
                          if (es < 2) { bf16* yp = (bf16*)B.yraw + row * 1024 + 256 * (mx + 1) + lh * 64 + 32 * es + 4 * hi;
#pragma unroll
                              for (int g = 0; g < 4; ++g) *(unsigned long long*)(yp + 8 * g) = (unsigned long long)cvtpk(y[4 * g], y[4 * g + 1]) | ((unsigned long long)cvtpk(y[4 * g + 2], y[4 * g + 3]) << 32); }
                          else if (hi == 0) { B.den[row * 8 + lh * 2] = y[0]; B.den[row * 8 + lh * 2 + 1] = mt; } }
                        if (ml) mst = mnew;
                    } else if (wave == 6) {
                        const float S1v = cf[192 + (c & 3)], S2v = cf[196 + (c & 3)];
                        float gam = S1v, dlt = S1v, mnew = 0.f;
                        if (ml) { mnew = fmaxf(S1v + mst, S2v); gam = S1v - mnew; dlt = S1v + mst - mnew; }
                        const float ed = __expf(dlt);
#pragma unroll
                        for (int r = 0; r < 16; ++r) { st0[r] *= ed; st1[r] *= ed; }
#pragma unroll
                        for (int k4 = 0; k4 < 4; ++k4) {
                            const bf16x8 vr = LFR(24 + k4); const f32x4 b0 = *(const LAS f32x4*)(cf + 128 + 16 * k4 + 8 * hi), b1 = *(const LAS f32x4*)(cf + 128 + 16 * k4 + 8 * hi + 4);
                            v4u wv; wv.x = cvtpk(bf2f((unsigned short)vr[0]) * __expf(gam - b0[0]), bf2f((unsigned short)vr[1]) * __expf(gam - b0[1])); wv.y = cvtpk(bf2f((unsigned short)vr[2]) * __expf(gam - b0[2]), bf2f((unsigned short)vr[3]) * __expf(gam - b0[3]));
                            wv.z = cvtpk(bf2f((unsigned short)vr[4]) * __expf(gam - b1[0]), bf2f((unsigned short)vr[5]) * __expf(gam - b1[1])); wv.w = cvtpk(bf2f((unsigned short)vr[6]) * __expf(gam - b1[2]), bf2f((unsigned short)vr[7]) * __expf(gam - b1[3]));
                            const bf16x8 wvf = __builtin_bit_cast(bf16x8, wv);
                            st0 = MFMA32(LFR(16 + k4), wvf, st0); st1 = MFMA32(LFR(20 + k4), wvf, st1);
                        }
                        { LAS unsigned char* sf = lds + MX_STF + ((c + 1) & 1) * 4096 + 16 * lane;
                          *(LAS bf16x8*)(sf) = pack8<0>(st0); *(LAS bf16x8*)(sf + 1024) = pack8<1>(st0); *(LAS bf16x8*)(sf + 2048) = pack8<0>(st1); *(LAS bf16x8*)(sf + 3072) = pack8<1>(st1); }
                        if (ml) mst = mnew;
                    }
#undef LFR
                }
                asm volatile("s_waitcnt lgkmcnt(0)" ::: "memory");
                bi = (bi == 2) ? 0 : bi + 1;
            }
#undef LIN_ISSUE
        }
        VMWAIT(0); WGBAR();
    }
}
__device__ __forceinline__ f32x4 unpack4bf(unsigned long long q) { return (f32x4){__uint_as_float((unsigned)q << 16), __uint_as_float((unsigned)q & 0xffff0000u), __uint_as_float((unsigned)(q >> 32) << 16), __uint_as_float((unsigned)(q >> 32) & 0xffff0000u)}; }
__device__ __forceinline__ void post_new(const MixBufs& B, bf16* ybf, const float* mng, const float* rng, const float* sng, const float* sD, int gw, int NGW, int lane) {
    constexpr int R = 4;
    const int c4 = 4 * lane, hd = lane >> 4;
    const f32x4 gnm = *(const f32x4*)(mng + c4), gnr = *(const f32x4*)(rng + c4), gns = *(const f32x4*)(sng + c4); const float Dh = sD[hd];
    for (int k0 = 0; k0 < M / NGW; k0 += R) {
        unsigned long long yq[R][3], gq[R][3]; f32x4 xx[R]; float dn[R], mt[R];
#pragma unroll
        for (int j = 0; j < R; ++j) { const int m = (NGW == 2048) ? ((gw >> 8) * SEQ + (gw & 255) + 256 * (k0 + j)) : (gw + (k0 + j) * NGW); const size_t r = (size_t)m;
#pragma unroll
            for (int mx = 0; mx < 3; ++mx) yq[j][mx] = *(const unsigned long long*)((const bf16*)B.yraw + r * 1024 + 256 * (mx + 1) + c4);
            gq[j][0] = *(const unsigned long long*)(B.proj + r * PROJ_LD + PC_MO + c4); gq[j][1] = *(const unsigned long long*)(B.proj + r * PROJ_LD + PC_RG + c4); gq[j][2] = *(const unsigned long long*)(B.proj + r * PROJ_LD + PC_SZ + c4);
            xx[j] = unpack4bf(*(const unsigned long long*)((const bf16*)B.xs + r * 256 + c4)); dn[j] = B.den[r * 8 + hd * 2]; mt[j] = B.den[r * 8 + hd * 2 + 1]; }
#pragma unroll
        for (int j = 0; j < R; ++j) { const int m = (NGW == 2048) ? ((gw >> 8) * SEQ + (gw & 255) + 256 * (k0 + j)) : (gw + (k0 + j) * NGW); const size_t r = (size_t)m;
            GAS unsigned long long* o8 = (GAS unsigned long long*)(ybf + r * DM) + lane;
#pragma unroll
            for (int mx = 0; mx < 2; ++mx) {
                f32x4 v = unpack4bf(yq[j][mx]);
                if (mx == 0) v = v * (1.0f / fmaxf(fabsf(dn[j]), __expf(-mt[j])));
                float ss = (v.x * v.x + v.y * v.y) + (v.z * v.z + v.w * v.w);
                ss += __shfl_xor(ss, 1); ss += __shfl_xor(ss, 2); ss += __shfl_xor(ss, 4); ss += __shfl_xor(ss, 8);
                const float rstd = 1.0f / sqrtf(ss * (1.0f / 64.0f) + RMS_EPS);
                const f32x4 gr = unpack4bf(gq[j][mx]); f32x4 gt;
#pragma unroll
                for (int i = 0; i < 4; ++i) gt[i] = mx == 0 ? sigmoid_f(gr[i]) : silu_acc(gr[i]);
                const f32x4 o = gt * (v * rstd * (mx == 0 ? gnm : gnr));
                o8[64 * (mx + 1)] = (unsigned long long)pk2(o.x, o.y) | ((unsigned long long)pk2(o.z, o.w) << 32);
            }
            { const f32x4 hs = unpack4bf(yq[j][2]), zr = unpack4bf(gq[j][2]); f32x4 v;
#pragma unroll
              for (int i = 0; i < 4; ++i) v[i] = (hs[i] + Dh * xx[j][i]) * silu_acc(zr[i]);
              const float ss = wave_sum((v.x * v.x + v.y * v.y) + (v.z * v.z + v.w * v.w));
              const float rstd = 1.0f / sqrtf(ss * (1.0f / 256.0f) + RMS_EPS);
              const f32x4 o = v * rstd * gns;
              o8[192] = (unsigned long long)pk2(o.x, o.y) | ((unsigned long long)pk2(o.z, o.w) << 32); }
        }
    }
}
__device__ __forceinline__ void final_norm(const bf16* xb, const long long* ss, float* out, const float* g, int gw, int NGW, int lane) {
    constexpr int R = 4;
    f32x4 gv[4];
#pragma unroll
    for (int j = 0; j < 4; ++j) gv[j] = ((const f32x4*)g)[lane + 64 * j];
    for (int k0 = 0; k0 < M / NGW; k0 += R) {
        unsigned long long v[R][4]; long long q[R];
#pragma unroll
        for (int r = 0; r < R; ++r) { const int m = (NGW == 2048) ? ((gw >> 8) * SEQ + (gw & 255) + 256 * (k0 + r)) : (gw + (k0 + r) * NGW);
            const GAS unsigned long long* xr = (const GAS unsigned long long*)(xb + (size_t)m * DM) + lane; q[r] = ss[m];
#pragma unroll
            for (int j = 0; j < 4; ++j) v[r][j] = xr[64 * j]; }
#pragma unroll
        for (int r = 0; r < R; ++r) { const int m = (NGW == 2048) ? ((gw >> 8) * SEQ + (gw & 255) + 256 * (k0 + r)) : (gw + (k0 + r) * NGW);
            GAS f32x4* orow = (GAS f32x4*)(out + (size_t)m * DM) + lane; const float rstd = pg8::rstd_q(q[r]);
#pragma unroll
            for (int j = 0; j < 4; ++j) orow[64 * j] = unpack4bf(v[r][j]) * rstd * gv[j]; }
    }
}

__global__ void __launch_bounds__(NTHR, 2) fwd(Args a) {
    extern __shared__ __attribute__((aligned(16))) unsigned char lds_raw[];
    LAS unsigned char* lds = (LAS unsigned char*)lds_raw;
    const int tid = threadIdx.x, lane = tid & 63, wave = __builtin_amdgcn_readfirstlane(tid >> 6), G = gridDim.x;
    const int gw = blockIdx.x * NWAVES + wave, NGW = G * NWAVES;
    unsigned char* ws = a.ws;
    for (int u = tid; u < (LDS_BYTES - LDSCTL_OFF) / 4; u += NTHR) ((LAS unsigned*)(lds + LDSCTL_OFF))[u] = 0u;
    __syncthreads();
    const int lo = a.ph_lo, hi = a.ph_hi;
    XcdBarrier bar; bar.bar = (unsigned*)(ws + WS_CTL) + CW_BAR; bar.x = 0; bar.st = nullptr;
    if (hi - lo > 1) bar = xcd_barrier_post((unsigned*)(ws + WS_CTL) + CW_BAR, (volatile LAS unsigned*)(lds + MISC_OFF) + 8);
    volatile LAS unsigned* MISCW = (volatile LAS unsigned*)(lds + MISC_OFF);
    if (hi - lo > 1 && tid == 0) MISCW[16] = xb_add(&bar.bar[XB_RANK(bar.x)], 1u);
    int bid = (int)blockIdx.x; bool loc = false;
#define IN(k) (lo <= (k) && (k) < hi)
#define PH_IDS int t_ = threadIdx.x; asm volatile("" : "+v"(t_)); const int lane_ = t_ & 63, wave_ = __builtin_amdgcn_readfirstlane(t_ >> 6), gw_ = blockIdx.x * NWAVES + wave_; (void)lane_; (void)gw_; (void)wave_;
#define SEAM(k) do { if ((k) + 1 < hi) { if (loc) xcd_local_barrier(bar.bar, bar.x, 32u); else xcd_barrier(bar); } } while (0)
    float* xres = a.out;
    float* cond = (float*)(ws + WS_COND); const float2* rope = (const float2*)(ws + WS_ROPE);
    bf16* HB = (bf16*)(ws + WS_HB); bf16* ACT = (bf16*)(ws + WS_ACT); bf16* PROJ = (bf16*)(ws + WS_PROJ); float* GATES = (float*)(ws + WS_GATES);
    bf16* YBF = (bf16*)(ws + WS_YBF);
#define MK_MB unsigned char* ws_ = a.ws; asm volatile("" : "+s"(ws_)); MixBufs MB; MB.proj = (const bf16*)(ws_ + WS_PROJ); MB.gates = (const float*)(ws_ + WS_GATES); MB.vtf = (bf16*)(ws_ + WS_VTF); MB.lcum = (float*)(ws_ + WS_COEF + COEF_LCUM); MB.ctot = (float*)(ws_ + WS_COEF + COEF_CTOT); \
    MB.ql = (bf16*)(ws_ + WS_QL); MB.kl = (bf16*)(ws_ + WS_KL); MB.kt = (bf16*)(ws_ + WS_KT); MB.vtl = (bf16*)(ws_ + WS_VTL); MB.xs = (float*)(ws_ + WS_XS); \
    MB.a1 = (float*)(ws_ + WS_COEF + COEF_A1); MB.a2 = (float*)(ws_ + WS_COEF + COEF_A2); MB.beta = (float*)(ws_ + WS_COEF + COEF_BETA); MB.s1 = (float*)(ws_ + WS_COEF + COEF_S1); MB.s2 = (float*)(ws_ + WS_COEF + COEF_S2); \
    MB.den = (float*)(ws_ + WS_DEN); MB.yraw = (float*)(ws_ + WS_YRAW); bf16* YBF_ = (bf16*)(ws_ + WS_YBF); (void)YBF_;
    long long* SS = (long long*)(ws + WS_SS);
    if (IN(0)) { PH_IDS prologue0(a, lds, t_, lane_, wave_, G); SEAM(0); }
    if (IN(1)) { PH_IDS prologue1(a, lds, lane_, wave_, G); thin_xg(a.in[0], HB, (bf16*)(ws + WS_XB), a.in[4], cond, 1 * DM, SS, gw_, NGW, lane_); SEAM(1);
        { const long long* q = (const long long*)(ws + WS_BIASQ); float* bf = (float*)(ws + WS_BIAS);
          for (int i = blockIdx.x * NTHR + t_; i < (int)(BIAS_BYTES / 4); i += G * NTHR) bf[i] = (float)((double)q[i] * (1.0 / 4294967296.0)); }
        SEAM(1); }
    if (lo == 0 && hi == PH_END && G == 256) {
        if (tid == 0) { bool ok = true;
#pragma unroll
            for (unsigned j = 0; j < 16; ++j) { const unsigned cnt = xb_ld(&bar.bar[XB_RANK(j)]); ok = ok && (cnt == (j < 8 ? 32u : 0u)); }
            MISCW[17] = ok ? 1u : 0u; }
        __syncthreads();
        if (MISCW[17]) { loc = true; bid = __builtin_amdgcn_readfirstlane((int)(MISCW[16] * 8u + bar.x)); }
    }
    const int vcu = (G % 8 == 0) ? (bid % 8) * (G / 8) + bid / 8 : bid;
    for (int l = 0; l < DEPTH; ++l) {
        const int pb = PH_LAYER0 + PH_PER_LAYER * l;
        if (hi <= pb || lo >= pb + PH_PER_LAYER) continue;
        const float* cond_l = cond + (size_t)l * BATCH * NCOND;
        unsigned char* wl = ws + WS_W + (size_t)l * LAYER_W;
        const float* xin = (l == 0) ? a.in[0] : xres;
        const float* bias_l = (const float*)(ws + WS_BIAS + (size_t)l * 3 * BIAS_USE);
        long long* ss0 = SS + (size_t)(3 * l) * M;
        const float* ng = a.in[4] + (size_t)(l * 3) * DM;
        if (IN(pb + 0)) { pg8::Gemm g{HB, (const bf16*)(wl + OFF_UP1), M, NUP, DM}; pg8::StaticOrder S; S.init(M, NUP, G, bid); pg8::EpiSwigluN E{ACT, PROJ_LD, ss0, bias_l, NUP};
            pg8::gemm_phase<pg8::EpiSwigluN, pg8::StaticOrder, true, true>(lds, g, S, E); if (REP_UP > 1) { __syncthreads(); pg8::gemm_phase<pg8::EpiSwigluN, pg8::StaticOrder, true, true>(lds, g, S, E); } SEAM(pb + 0); }
        if (IN(pb + 1)) { pg8::Gemm g{ACT, (const bf16*)(wl + OFF_DN1), M, DM, DFF, PROJ_LD}; pg8::StaticOrder S; S.init(M, DM, G, bid);
            pg8::EpiResidNorm E{cond_l, ng + DM, ws, 2 * DM, 4 * DM, (int)(WS_HB / MiB), (int)(WS_XB / MiB), (int)(WS_SS / 8) + (3 * l + 1) * M, 0.5f};
            pg8::gemm_phase<pg8::EpiResidNorm, pg8::StaticOrder, true, true>(lds, g, S, E); SEAM(pb + 1); }
        if (IN(pb + 2)) { pg8::Gemm g{HB, (const bf16*)(wl + OFF_IN), M, NPROJ, DM}; pg8::StaticOrder S; S.init(M, NPROJ, G, bid); pg8::EpiProjN E{PROJ, PROJ_LD, GATES, PROJ_LD / 256, 0.125f * LOG2E, ss0 + M, bias_l + 8 * NUP, NPROJ};
            pg8::gemm_phase<pg8::EpiProjN, pg8::StaticOrder, true, true>(lds, g, S, E); SEAM(pb + 2); }
        if (IN(pb + 3)) { PH_IDS MK_MB PrepW PW{a.in[12] + (size_t)l * 4 * 512, a.in[13] + (size_t)l * 512, a.in[18] + (size_t)l * 4 * 512, a.in[19] + (size_t)l * 512, a.in[11] + l * 4, a.in[14] + l * 4, a.in[15] + l * 4, a.in[20] + l * 4, a.in[21] + l * 4, (const float2*)(ws_ + WS_ROPE)};
            for (int rep = 0; rep < REP_PREP; ++rep) for (int u = vcu; u < BATCH * 32; u += G) prep_unit(MB, PW, u, wave_, lane_); SEAM(pb + 3); }
        if (IN(pb + 4)) { PH_IDS MK_MB mixer_phase(MB, YBF_, lds, vcu, wave_, lane_); if (REP_MIX > 1) { asm volatile("" ::: "memory"); mixer_phase(MB, YBF_, lds, vcu, wave_, lane_); } SEAM(pb + 4); }
        if (IN(pb + 5)) { PH_IDS MK_MB for (int rep = 0; rep < REP_POST; ++rep) post_new(MB, YBF_, a.in[16] + (size_t)l * 256, a.in[17] + (size_t)l * 256, a.in[23] + (size_t)l * 256, a.in[22] + l * 4, vcu * NWAVES + wave_, NGW, lane_); SEAM(pb + 5); }
        if (IN(pb + 6)) { pg8::Gemm g{YBF, (const bf16*)(wl + OFF_OUT), M, DM, DM}; pg8::StaticOrder S; S.init(M, DM, G, bid);
            pg8::EpiResidNorm E{cond_l, ng + 2 * DM, ws, 5 * DM, 7 * DM, (int)(WS_HB / MiB), (int)(WS_XB / MiB), (int)(WS_SS / 8) + (3 * l + 2) * M, 1.0f};
            pg8::gemm_phase<pg8::EpiResidNorm, pg8::StaticOrder, true, true>(lds, g, S, E); SEAM(pb + 6); }
        if (IN(pb + 7)) { pg8::Gemm g{HB, (const bf16*)(wl + OFF_UP2), M, NUP, DM}; pg8::StaticOrder S; S.init(M, NUP, G, bid); pg8::EpiSwigluN E{ACT, PROJ_LD, ss0 + 2 * M, bias_l + 2 * 8 * NUP, NUP};
            pg8::gemm_phase<pg8::EpiSwigluN, pg8::StaticOrder, true, true>(lds, g, S, E); SEAM(pb + 7); }
        if (IN(pb + 8)) { pg8::Gemm g{ACT, (const bf16*)(wl + OFF_DN2), M, DM, DFF, PROJ_LD}; pg8::StaticOrder S; S.init(M, DM, G, bid);
            if (l + 1 < DEPTH) { pg8::EpiResidNorm E{cond_l, ng + 3 * DM, ws, 8 * DM, BATCH * NCOND + 1 * DM, (int)(WS_HB / MiB), (int)(WS_XB / MiB), (int)(WS_SS / 8) + (3 * l + 3) * M, 0.5f};
                pg8::gemm_phase<pg8::EpiResidNorm, pg8::StaticOrder, true, true>(lds, g, S, E); }
            else { pg8::EpiResidLast E{cond_l, ng, ws, 8 * DM, 0, 0, (int)(WS_XB / MiB), (int)(WS_SS / 8) + (3 * l + 3) * M, 0.5f}; pg8::gemm_phase<pg8::EpiResidLast, pg8::StaticOrder, true, true>(lds, g, S, E); }
            SEAM(pb + 8); }
    }
    if (IN(PH_FINAL)) { PH_IDS final_norm((const bf16*)(ws + WS_XB), SS + (size_t)(3 * DEPTH) * M, xres, a.in[24], vcu * NWAVES + wave_, NGW, lane_); }
#undef IN
#undef SEAM
}

#ifndef N_SPLIT
#define N_SPLIT 0
#endif
extern "C" void kernel_launch(void* const* d_in, const int* in_sizes, int n_in, void* d_out, int out_size, void* d_ws, size_t ws_size, hipStream_t stream) {
    static int grid = 0;
    if (grid == 0) {
        if (n_in != 25 || in_sizes[0] != M * DM || out_size != M * DM || ws_size < WS_END) { fprintf(stderr, "kernel_launch: unexpected problem (n_in %d, in0 %d, out %d, ws %zu)\n", n_in, n_in > 0 ? in_sizes[0] : -1, out_size, ws_size); grid = -1; return; }
        int dev = 0, cus = 0, per_cu = 0;
        if (hipGetDevice(&dev) != hipSuccess || hipDeviceGetAttribute(&cus, hipDeviceAttributeMultiprocessorCount, dev) != hipSuccess) { grid = -1; return; }
        if (hipFuncSetAttribute((const void*)fwd, hipFuncAttributeMaxDynamicSharedMemorySize, LDS_BYTES) != hipSuccess) { fprintf(stderr, "kernel_launch: hipFuncSetAttribute failed\n"); grid = -1; return; }
        if (hipOccupancyMaxActiveBlocksPerMultiprocessor(&per_cu, (const void*)fwd, NTHR, LDS_BYTES) != hipSuccess || per_cu < 1) fprintf(stderr, "kernel_launch: occupancy query says %d\n", per_cu);
        (void)hipGetLastError();
        grid = cus;
    }
    if (grid < 0) return;
    if (hipMemsetAsync((char*)d_ws + WS_CTL, 0, CTL_ZERO_BYTES, stream) != hipSuccess) return;
    Args a{};
    for (int i = 0; i < 25; ++i) a.in[i] = (const float*)d_in[i];
    a.out = (float*)d_out; a.ws = (unsigned char*)d_ws;
#if N_SPLIT
    for (int p = 0; p < PH_END; ++p) { a.ph_lo = p; a.ph_hi = p + 1; hipLaunchKernelGGL(fwd, dim3(grid), dim3(NTHR), LDS_BYTES, stream, a); }
#else
    a.ph_lo = 0; a.ph_hi = PH_END; hipLaunchKernelGGL(fwd, dim3(grid), dim3(NTHR), LDS_BYTES, stream, a);
#endif
}
```

```cpp
#include <hip/hip_runtime.h>
#include <cstdio>
#include <cstdint>
#ifndef REP_FOX
#define REP_FOX 1
#endif
#ifndef REP_LIN
#define REP_LIN 1
#endif
#ifndef REP_MIX
#define REP_MIX 1
#endif
#ifndef REP_PREP
#define REP_PREP 1
#endif
#ifndef REP_POST
#define REP_POST 1
#endif
#ifndef REP_THIN
#define REP_THIN 1
#endif
#ifndef REP_UP
#define REP_UP 1
#endif
#ifndef REP_IN
#define REP_IN 1
#endif
namespace pg8 {
#define PG8_LAS __attribute__((address_space(3)))
typedef unsigned short bf16_t;
typedef short bf16x8 __attribute__((ext_vector_type(8)));
typedef float f32x4 __attribute__((ext_vector_type(4)));
typedef unsigned u32x4 __attribute__((ext_vector_type(4)));
constexpr int BM = 256, BK = 64, HALF = 128, HTB = HALF * BK * 2  , STAGE_BYTES = 8 * HTB, NXCD = 8, WGM = 4;

__host__ __device__ __forceinline__ int lds_byte(int r, int c) { const int st = (r >> 4) * 2 + (c >> 5), rr = r & 15, cc = c & 31, ob = rr * 64 + cc * 2; return st * 1024 + (ob ^ (((ob >> 9) & 1) << 5)); }
__host__ __device__ __forceinline__ void stage_rc(int b, int& R, int& C) { const int st = b / 1024, sb = b % 1024, swz = sb ^ (((sb >> 9) & 1) << 5); R = (st >> 1) * 16 + swz / 64; C = (st & 1) * 32 + (swz % 64) / 2; }
__host__ __device__ __forceinline__ int perm32(int rho) { const int n = rho >> 4, i = rho & 15; return 8 * (i >> 2) + 4 * n + (i & 3); }

struct Unit { int pm, pn; };
struct Gemm { const bf16_t* A; const bf16_t* Bt; int M, N, K; int lda; };

struct StaticOrder {
    int nM, nN, nwg, G, c;
    __host__ __device__ void init(int M, int N, int G_, int c_) { nM = M / BM; nN = N / BM; nwg = nM * nN; G = G_; c = c_; }
    __host__ __device__ bool next(int i, Unit& u) const {
        const long L = (long)i * G + c; if (L >= nwg) return false;
        int wgid = (int)L; { const int q = nwg / NXCD, r = nwg % NXCD, xcd = wgid % NXCD, off = wgid / NXCD; wgid = (xcd < r ? xcd * (q + 1) : r * (q + 1) + (xcd - r) * q) + off; }
        const int nig = WGM * nN, gid = wgid / nig, fm = gid * WGM, gsz = (nM - fm) < WGM ? (nM - fm) : WGM;
        u.pm = fm + ((wgid % nig) % gsz); u.pn = (wgid % nig) / gsz; return true;
    }
    __device__ __forceinline__ void a_ready(const Unit&) const {}
    __device__ __forceinline__ void done(const Unit&) const {}
};

__device__ __forceinline__ unsigned cvt_pk_bf16(float lo, float hi) { unsigned r; asm volatile("v_cvt_pk_bf16_f32 %0, %1, %2" : "=v"(r) : "v"(lo), "v"(hi)); return r; }

__device__ __forceinline__ float silu_f(float v) { return v * __builtin_amdgcn_rcpf(1.0f + __expf(-v)); }
__device__ __forceinline__ f32x4 swiglu4(const f32x4 a, const f32x4 g) {
    const f32x4 t = g * (-1.44269504088896341f); f32x4 e;
#pragma unroll
    for (int i = 0; i < 4; ++i) e[i] = __builtin_amdgcn_exp2f(t[i]);
    const f32x4 d = e + 1.0f; f32x4 r;
#pragma unroll
    for (int i = 0; i < 4; ++i) r[i] = __builtin_amdgcn_rcpf(d[i]);
    return (a * g) * r;
}
struct EpiSwiglu {
    static constexpr bool PERM = true, AFTER_DRAIN = false;
    bf16_t* O; int ldo;
    __device__ __forceinline__ void operator()(const f32x4 (&acc)[2][2][4][2], const Unit& u, int wr, int wc, int fr, int fq) const {
        const int row0 = u.pm * BM + wr * 64 + fr, col0 = u.pn * HALF + wc * 32 + 8 * fq;
#pragma unroll
        for (int ai = 0; ai < 2; ++ai)
#pragma unroll
            for (int m = 0; m < 4; ++m) { bf16_t* rowp = O + (size_t)(row0 + ai * HALF + m * 16) * ldo + col0;
                const f32x4 a0 = acc[ai][0][m][0], a1 = acc[ai][0][m][1], g0 = acc[ai][1][m][0], g1 = acc[ai][1][m][1];
                u32x4 w; w.x = cvt_pk_bf16(silu_f(g0[0]) * a0[0], silu_f(g0[1]) * a0[1]); w.y = cvt_pk_bf16(silu_f(g0[2]) * a0[2], silu_f(g0[3]) * a0[3]);
                w.z = cvt_pk_bf16(silu_f(g1[0]) * a1[0], silu_f(g1[1]) * a1[1]); w.w = cvt_pk_bf16(silu_f(g1[2]) * a1[2], silu_f(g1[3]) * a1[3]);
                *(u32x4*)rowp = w; }
    }
};
struct EpiResid {
    static constexpr bool PERM = false, AFTER_DRAIN = false;
    const bf16_t* base; float* out; int ldc; const float* gate; int gstride; int rows_per_b; float coef;
    __device__ __forceinline__ void operator()(const f32x4 (&acc)[2][2][4][2], const Unit& u, int wr, int wc, int fr, int fq) const {
        const int col0 = u.pn * BM + wc * 32 + 4 * fq; const int b = (u.pm * BM) / rows_per_b;
        f32x4 gv[2][2];
#pragma unroll
        for (int bj = 0; bj < 2; ++bj)
#pragma unroll
            for (int n = 0; n < 2; ++n) gv[bj][n] = *(const f32x4*)(gate + (size_t)b * gstride + col0 + bj * HALF + n * 16) * coef;
#pragma unroll
        for (int ai = 0; ai < 2; ++ai)
#pragma unroll
            for (int m = 0; m < 4; ++m) { const size_t off = (size_t)(u.pm * BM + ai * HALF + wr * 64 + m * 16 + fr) * ldc + col0;
#pragma unroll
                for (int bj = 0; bj < 2; ++bj)
#pragma unroll
                    for (int n = 0; n < 2; ++n) { typedef unsigned u32x2r __attribute__((ext_vector_type(2))); const u32x2r rb = *(const u32x2r*)(base + off + bj * HALF + n * 16);
                        const f32x4 bs = (f32x4){__builtin_bit_cast(float, rb.x << 16), __builtin_bit_cast(float, rb.x & 0xffff0000u), __builtin_bit_cast(float, rb.y << 16), __builtin_bit_cast(float, rb.y & 0xffff0000u)};
                        *(f32x4*)(out + off + bj * HALF + n * 16) = bs + gv[bj][n] * acc[ai][bj][m][n]; }
                if (m & 1) asm volatile("" ::: "memory"); }
    }
};
struct EpiProj {
    static constexpr bool PERM = true, AFTER_DRAIN = false;
    bf16_t* P; int ldp; float* G; int ntile_bf; float scale0;
    __device__ __forceinline__ void operator()(const f32x4 (&acc)[2][2][4][2], const Unit& u, int wr, int wc, int fr, int fq) const {
        const int row0 = u.pm * BM + wr * 64 + fr;
        if (u.pn < ntile_bf) {
            const int col0 = u.pn * BM + wc * 32 + 8 * fq; const float sc = (u.pn == 0) ? scale0 : 1.0f;
#pragma unroll
            for (int ai = 0; ai < 2; ++ai)
#pragma unroll
                for (int m = 0; m < 4; ++m) { bf16_t* rowp = P + (size_t)(row0 + ai * HALF + m * 16) * ldp + col0;
#pragma unroll
                    for (int bj = 0; bj < 2; ++bj) { const f32x4 v0 = acc[ai][bj][m][0] * sc, v1 = acc[ai][bj][m][1] * sc;
                        u32x4 w; w.x = cvt_pk_bf16(v0[0], v0[1]); w.y = cvt_pk_bf16(v0[2], v0[3]); w.z = cvt_pk_bf16(v1[0], v1[1]); w.w = cvt_pk_bf16(v1[2], v1[3]);
                        *(u32x4*)(rowp + bj * HALF) = w; } }
        } else if (wc == 0 && fq < 2) {
#pragma unroll
            for (int ai = 0; ai < 2; ++ai)
#pragma unroll
                for (int m = 0; m < 4; ++m) { float* gp = G + (size_t)(row0 + ai * HALF + m * 16) * 16 + 8 * fq;
                    *(f32x4*)gp = acc[ai][0][m][0]; *(f32x4*)(gp + 4) = acc[ai][0][m][1]; }
        }
    }
};

__device__ __forceinline__ float rstd_q(long long q) { const unsigned long long u = (unsigned long long)q; const float f = (float)(unsigned)(u >> 32) * 4294967296.0f + (float)(unsigned)u;
    return __builtin_amdgcn_rsqf(f * (1.0f / (16777216.0f * 1024.0f)) + 1e-6f); }
struct EpiSwigluN {
    static constexpr bool PERM = true, AFTER_DRAIN = false;
    bf16_t* O; int ldo; const long long* ss; const float* bias; int nb;
    __device__ __forceinline__ void operator()(const f32x4 (&acc)[2][2][4][2], const Unit& u, int wr, int wc, int fr, int fq) const {
        const int row0 = u.pm * BM + wr * 64 + fr, col0 = u.pn * HALF + wc * 32 + 8 * fq; const int b = u.pm >> 3;
        const float* bp = bias + (size_t)b * nb + u.pn * BM + wc * 32 + 8 * fq;
        const f32x4 ba0 = *(const f32x4*)bp, ba1 = *(const f32x4*)(bp + 4), bg0 = *(const f32x4*)(bp + HALF), bg1 = *(const f32x4*)(bp + HALF + 4);
        long long ssv[2][4];
#pragma unroll
        for (int ai = 0; ai < 2; ++ai)
#pragma unroll
            for (int m = 0; m < 4; ++m) ssv[ai][m] = ss[row0 + ai * HALF + m * 16];
#pragma unroll
        for (int ai = 0; ai < 2; ++ai)
#pragma unroll
            for (int m = 0; m < 4; ++m) { const int row = row0 + ai * HALF + m * 16; bf16_t* rowp = O + (size_t)row * ldo + col0;
                const float rs = rstd_q(ssv[ai][m]);
                const f32x4 a0 = acc[ai][0][m][0] * rs + ba0, a1 = acc[ai][0][m][1] * rs + ba1, g0 = acc[ai][1][m][0] * rs + bg0, g1 = acc[ai][1][m][1] * rs + bg1;
                const f32x4 o0 = swiglu4(a0, g0), o1 = swiglu4(a1, g1);
                u32x4 w; w.x = cvt_pk_bf16(o0[0], o0[1]); w.y = cvt_pk_bf16(o0[2], o0[3]); w.z = cvt_pk_bf16(o1[0], o1[1]); w.w = cvt_pk_bf16(o1[2], o1[3]);
                *(u32x4*)rowp = w; }
    }
};
struct EpiProjN {
    static constexpr bool PERM = true, AFTER_DRAIN = false;
    bf16_t* P; int ldp; float* G; int ntile_bf; float scale0; const long long* ss; const float* bias; int nb;
    __device__ __forceinline__ void operator()(const f32x4 (&acc)[2][2][4][2], const Unit& u, int wr, int wc, int fr, int fq) const {
        const int row0 = u.pm * BM + wr * 64 + fr; const int b = u.pm >> 3;
        const float* bp = bias + (size_t)b * nb + u.pn * BM + wc * 32 + 8 * fq;
        if (u.pn < ntile_bf) {
            const int col0 = u.pn * BM + wc * 32 + 8 * fq; const float sc = (u.pn == 0) ? scale0 : 1.0f;
            const f32x4 b00 = *(const f32x4*)bp, b01 = *(const f32x4*)(bp + 4), b10 = *(const f32x4*)(bp + HALF), b11 = *(const f32x4*)(bp + HALF + 4);
            long long ssv[2][4];
#pragma unroll
            for (int ai = 0; ai < 2; ++ai)
#pragma unroll
                for (int m = 0; m < 4; ++m) ssv[ai][m] = ss[row0 + ai * HALF + m * 16];
#pragma unroll
            for (int ai = 0; ai < 2; ++ai)
#pragma unroll
                for (int m = 0; m < 4; ++m) { const int row = row0 + ai * HALF + m * 16; bf16_t* rowp = P + (size_t)row * ldp + col0;
                    const float rs = rstd_q(ssv[ai][m]);
#pragma unroll
                    for (int bj = 0; bj < 2; ++bj) { const f32x4 v0 = (acc[ai][bj][m][0] * rs + (bj ? b10 : b00)) * sc, v1 = (acc[ai][bj][m][1] * rs + (bj ? b11 : b01)) * sc;
                        u32x4 w; w.x = cvt_pk_bf16(v0[0], v0[1]); w.y = cvt_pk_bf16(v0[2], v0[3]); w.z = cvt_pk_bf16(v1[0], v1[1]); w.w = cvt_pk_bf16(v1[2], v1[3]);
                        *(u32x4*)(rowp + bj * HALF) = w; } }
        } else if (wc == 0 && fq < 2) {
            const f32x4 b00 = *(const f32x4*)bp, b01 = *(const f32x4*)(bp + 4);
#pragma unroll
            for (int ai = 0; ai < 2; ++ai)
#pragma unroll
                for (int m = 0; m < 4; ++m) { const int row = row0 + ai * HALF + m * 16; float* gp = G + (size_t)row * 16 + 8 * fq;
                    const float rs = rstd_q(ss[row]);
                    *(f32x4*)gp = acc[ai][0][m][0] * rs + b00; *(f32x4*)(gp + 4) = acc[ai][0][m][1] * rs + b01; }
        }
    }
};
struct EpiResidNorm {
    static constexpr bool PERM = true, AFTER_DRAIN = false;
    const float* cnd; const float* ng; unsigned char* wsb; int goff, scoff, hb_off, xb_off, ss_off; float coef;
    __device__ __forceinline__ void operator()(const f32x4 (&acc)[2][2][4][2], const Unit& u, int wr, int wc, int fr, int fq) const {
        constexpr int ldc = 1024, gstride = 9 * 1024;
        const int col0 = u.pn * BM + wc * 32 + 8 * fq; const int b = u.pm >> 3;
        const float* gate = cnd + goff; const float* scn = cnd + scoff;
        __attribute__((address_space(1))) bf16_t* xg = (__attribute__((address_space(1))) bf16_t*)(wsb + (size_t)hb_off * 1048576);
        unsigned long long* ssn = (unsigned long long*)(wsb + (size_t)ss_off * 8);
        __attribute__((address_space(1))) bf16_t* xb = (__attribute__((address_space(1))) bf16_t*)(wsb + (size_t)xb_off * 1048576);
        float sq[2][4];
#pragma unroll
        for (int ai = 0; ai < 2; ++ai)
#pragma unroll
            for (int m = 0; m < 4; ++m) sq[ai][m] = 0.f;
#pragma unroll
        for (int bj = 0; bj < 2; ++bj) { const int c = col0 + bj * HALF;
            const f32x4 gv0 = *(const f32x4*)(gate + (size_t)b * gstride + c) * coef, gv1 = *(const f32x4*)(gate + (size_t)b * gstride + c + 4) * coef;
            const f32x4 gm0 = *(const f32x4*)(ng + c) * (*(const f32x4*)(scn + (size_t)b * gstride + c) + 1.0f), gm1 = *(const f32x4*)(ng + c + 4) * (*(const f32x4*)(scn + (size_t)b * gstride + c + 4) + 1.0f);
#pragma unroll
            for (int ai = 0; ai < 2; ++ai) { u32x4 rbv[4];
                const unsigned off0 = (unsigned)(u.pm * BM + ai * HALF + wr * 64 + fr) * (unsigned)ldc + (unsigned)c;
#pragma unroll
                for (int m = 0; m < 4; ++m) rbv[m] = *(const __attribute__((address_space(1))) u32x4*)(xb + (off0 + (unsigned)(m * 16 * ldc)));
#pragma unroll
                for (int m = 0; m < 4; ++m) { const unsigned off = off0 + (unsigned)(m * 16 * ldc); const u32x4 rb = rbv[m];
                    const f32x4 xn0 = (f32x4){__builtin_bit_cast(float, rb.x << 16), __builtin_bit_cast(float, rb.x & 0xffff0000u), __builtin_bit_cast(float, rb.y << 16), __builtin_bit_cast(float, rb.y & 0xffff0000u)} + gv0 * acc[ai][bj][m][0];
                    const f32x4 xn1 = (f32x4){__builtin_bit_cast(float, rb.z << 16), __builtin_bit_cast(float, rb.z & 0xffff0000u), __builtin_bit_cast(float, rb.w << 16), __builtin_bit_cast(float, rb.w & 0xffff0000u)} + gv1 * acc[ai][bj][m][1];
                    { u32x4 wx; wx.x = cvt_pk_bf16(xn0[0], xn0[1]); wx.y = cvt_pk_bf16(xn0[2], xn0[3]); wx.z = cvt_pk_bf16(xn1[0], xn1[1]); wx.w = cvt_pk_bf16(xn1[2], xn1[3]); *(__attribute__((address_space(1))) u32x4*)(xb + off) = wx; }
                    sq[ai][m] += ((xn0[0] * xn0[0] + xn0[1] * xn0[1]) + (xn0[2] * xn0[2] + xn0[3] * xn0[3])) + ((xn1[0] * xn1[0] + xn1[1] * xn1[1]) + (xn1[2] * xn1[2] + xn1[3] * xn1[3]));
                    const f32x4 h0 = xn0 * gm0, h1 = xn1 * gm1;
                    u32x4 w; w.x = cvt_pk_bf16(h0[0], h0[1]); w.y = cvt_pk_bf16(h0[2], h0[3]); w.z = cvt_pk_bf16(h1[0], h1[1]); w.w = cvt_pk_bf16(h1[2], h1[3]); *(__attribute__((address_space(1))) u32x4*)(xg + off) = w; }
                asm volatile("" ::: "memory"); } }
#pragma unroll
        for (int ai = 0; ai < 2; ++ai)
#pragma unroll
            for (int m = 0; m < 4; ++m) { float v = sq[ai][m]; v += __shfl_xor(v, 16); v += __shfl_xor(v, 32);
                if (fq == 0) atomicAdd(ssn + (u.pm * BM + ai * HALF + wr * 64 + m * 16 + fr), (unsigned long long)__float2ll_rn(v * 16777216.0f)); }
    }
};

template <class Epi, class Sched, bool ALIGN_EPI = false, bool SP2 = false>
__device__ __forceinline__ void gemm_phase(PG8_LAS unsigned char* lds, const Gemm g, const Sched& S, const Epi& E) {
    int tid_ = threadIdx.x; asm volatile("" : "+v"(tid_));
    const int tid = tid_, wid = __builtin_amdgcn_readfirstlane(tid >> 6), lane = tid & 63, wr = wid >> 2, wc = wid & 3, fr = lane & 15, fq = lane >> 4;
    const int K = g.K, nt = K / BK, LDA = g.lda ? g.lda : g.K;
    unsigned voffA[2], voffB[2];
#pragma unroll
    for (int i = 0; i < 2; ++i) { int R, C; stage_rc(tid * 16 + i * 8192, R, C); const int Rb = Epi::PERM ? ((R & ~31) + perm32(R & 31)) : R;
        voffA[i] = (unsigned)(R * LDA + C) * 2u; voffB[i] = (unsigned)(Rb * K + C) * 2u; }
    const size_t kstep = (size_t)(BK * 2);
    const size_t hstep = (size_t)HALF * K * 2;
    const size_t tstep = 2 * hstep;
    const size_t hstepA = (size_t)HALF * LDA * 2, tstepA = 2 * hstepA;
    const unsigned ldsw = (unsigned)wid * 1024u;
    const int aoff = lds_byte(wr * 64 + fr, fq * 8), boff = lds_byte(wc * 32 + fr, fq * 8);
#define PG8_SA(b, h) (((b) * 2 + (h)) * HTB)
#define PG8_SB(b, h) ((4 + (b) * 2 + (h)) * HTB)
#define PG8_STAGE(bufoff, gbase, voff) do { _Pragma("unroll") for (int _i = 0; _i < 2; ++_i) \
        __builtin_amdgcn_global_load_lds((const unsigned*)((const char*)(gbase) + (voff)[_i]), (PG8_LAS unsigned*)(lds + (bufoff) + ldsw + _i * 8192), 16, 0, 0); } while (0)
#define PG8_LDA(dst, b, h) do { _Pragma("unroll") for (int m = 0; m < 4; ++m) _Pragma("unroll") for (int k = 0; k < 2; ++k) dst[m][k] = *(const PG8_LAS bf16x8*)(lds + PG8_SA(b, h) + aoff + m * 2048 + k * 1024); } while (0)
#define PG8_LDB(dst, b, h) do { _Pragma("unroll") for (int n = 0; n < 2; ++n) _Pragma("unroll") for (int k = 0; k < 2; ++k) dst[n][k] = *(const PG8_LAS bf16x8*)(lds + PG8_SB(b, h) + boff + n * 2048 + k * 1024); } while (0)
#define PG8_MMA(ai, bj, At, Bt) do { __builtin_amdgcn_s_setprio(1); _Pragma("unroll") for (int m = 0; m < 4; ++m) _Pragma("unroll") for (int n = 0; n < 2; ++n) _Pragma("unroll") for (int k = 0; k < 2; ++k) \
        acc[ai][bj][m][n] = __builtin_amdgcn_mfma_f32_16x16x32_bf16(Bt[n][k], At[m][k], acc[ai][bj][m][n], 0, 0, 0); __builtin_amdgcn_s_setprio(0); } while (0)
#define PG8_WAIT_V(n) asm volatile("s_waitcnt vmcnt(" #n ")" ::: "memory")
#define PG8_WAIT_L(n) asm volatile("s_waitcnt lgkmcnt(" #n ")" ::: "memory")
#define PG8_BAR __builtin_amdgcn_s_barrier()
#define PG8_SCHED __builtin_amdgcn_sched_barrier(0)
    Unit cur, nxt; int ui = 0;
    if (!S.next(0, cur)) return;
    f32x4 acc[2][2][4][2];
#pragma unroll
    for (int a = 0; a < 2; ++a)
#pragma unroll
        for (int b = 0; b < 2; ++b)
#pragma unroll
            for (int m = 0; m < 4; ++m)
#pragma unroll
                for (int n = 0; n < 2; ++n) acc[a][b][m][n] = (f32x4){0.f, 0.f, 0.f, 0.f};
    bf16x8 At[4][2], B0[2][2], B1[2][2];
    const char* cA = (const char*)g.A + (size_t)cur.pm * tstepA; const char* cB = (const char*)g.Bt + (size_t)cur.pn * tstep;
    S.a_ready(cur);
    if constexpr (SP2) {
        PG8_STAGE(PG8_SB(0, 0), cB, voffB); PG8_STAGE(PG8_SB(0, 1), cB + hstep, voffB); PG8_STAGE(PG8_SA(0, 0), cA, voffA); PG8_STAGE(PG8_SA(0, 1), cA + hstepA, voffA);
        if (wr == 1) PG8_BAR;
        PG8_WAIT_V(2); PG8_BAR;
        PG8_STAGE(PG8_SB(1, 0), cB + kstep, voffB); PG8_STAGE(PG8_SA(1, 0), cA + kstep, voffA); PG8_STAGE(PG8_SB(1, 1), cB + hstep + kstep, voffB);
        PG8_WAIT_V(6); PG8_BAR;
    } else {
        PG8_STAGE(PG8_SB(0, 0), cB, voffB); PG8_STAGE(PG8_SA(0, 0), cA, voffA); PG8_STAGE(PG8_SB(0, 1), cB + hstep, voffB); PG8_STAGE(PG8_SA(0, 1), cA + hstepA, voffA);
        if (wr == 1) PG8_BAR;
        PG8_WAIT_V(4); PG8_BAR;
        PG8_STAGE(PG8_SB(1, 0), cB + kstep, voffB); PG8_STAGE(PG8_SA(1, 0), cA + kstep, voffA); PG8_STAGE(PG8_SB(1, 1), cB + hstep + kstep, voffB);
        PG8_WAIT_V(6); PG8_BAR;
    }
    for (;;) {
        const bool has_next = S.next(ui + 1, nxt);
        const char* nA = has_next ? (const char*)g.A + (size_t)nxt.pm * tstepA : cA; const char* nB = has_next ? (const char*)g.Bt + (size_t)nxt.pn * tstep : cB;
        for (int t = 0; t < nt; t += 2) {
            const bool last = (t == nt - 2);
            const char* a1 = cA + (size_t)(t + 1) * kstep;
            const char* a2 = last ? nA : cA + (size_t)(t + 2) * kstep; const char* b2 = last ? nB : cB + (size_t)(t + 2) * kstep;
            const char* a3 = a2 + kstep; const char* b3 = b2 + kstep;
            if (last && has_next) S.a_ready(nxt);
            if constexpr (SP2) {
            PG8_LDB(B0, 0, 0); PG8_LDB(B1, 0, 1); PG8_SCHED; PG8_LDA(At, 0, 0); PG8_STAGE(PG8_SA(1, 1), a1 + hstepA, voffA);
            PG8_WAIT_V(8); PG8_WAIT_L(0); PG8_BAR; PG8_MMA(0, 0, At, B0); PG8_MMA(0, 1, At, B1); PG8_BAR; PG8_SCHED;
            PG8_LDA(At, 0, 1); PG8_STAGE(PG8_SB(0, 0), b2, voffB); PG8_STAGE(PG8_SB(0, 1), b2 + hstep, voffB); PG8_STAGE(PG8_SA(0, 0), a2, voffA);
            PG8_WAIT_V(8); PG8_WAIT_L(0); PG8_BAR; PG8_MMA(1, 0, At, B0); PG8_MMA(1, 1, At, B1); PG8_BAR; PG8_SCHED;
            PG8_LDB(B0, 1, 0); PG8_LDB(B1, 1, 1); PG8_SCHED; PG8_LDA(At, 1, 0); PG8_STAGE(PG8_SA(0, 1), a2 + hstepA, voffA);
            PG8_WAIT_V(8); PG8_WAIT_L(0); PG8_BAR; PG8_MMA(0, 0, At, B0); PG8_MMA(0, 1, At, B1); PG8_BAR; PG8_SCHED;
            PG8_LDA(At, 1, 1); PG8_STAGE(PG8_SB(1, 0), b3, voffB); PG8_STAGE(PG8_SB(1, 1), b3 + hstep, voffB); PG8_STAGE(PG8_SA(1, 0), a3, voffA);
            PG8_WAIT_V(8); PG8_WAIT_L(0); PG8_BAR; PG8_MMA(1, 0, At, B0); PG8_MMA(1, 1, At, B1); PG8_BAR; PG8_SCHED;
            } else {
            PG8_LDB(B0, 0, 0); PG8_SCHED; PG8_LDA(At, 0, 0); PG8_STAGE(PG8_SA(1, 1), a1 + hstepA, voffA);
            PG8_WAIT_L(8); PG8_BAR; PG8_WAIT_L(0); PG8_MMA(0, 0, At, B0); PG8_BAR; PG8_SCHED;
            PG8_LDB(B1, 0, 1); PG8_STAGE(PG8_SB(0, 0), b2, voffB);
            PG8_BAR; PG8_WAIT_L(0); PG8_MMA(0, 1, At, B1); PG8_BAR;
            PG8_LDA(At, 0, 1); PG8_STAGE(PG8_SA(0, 0), a2, voffA);
            PG8_BAR; PG8_WAIT_L(0); PG8_MMA(1, 0, At, B0); PG8_BAR; PG8_SCHED;
            PG8_STAGE(PG8_SB(0, 1), b2 + hstep, voffB);
            PG8_WAIT_V(6); PG8_BAR; PG8_MMA(1, 1, At, B1); PG8_BAR;
            PG8_LDB(B0, 1, 0); PG8_SCHED; PG8_LDA(At, 1, 0); PG8_STAGE(PG8_SA(0, 1), a2 + hstepA, voffA);
            PG8_WAIT_L(8); PG8_BAR; PG8_WAIT_L(0); PG8_MMA(0, 0, At, B0); PG8_BAR; PG8_SCHED;
            PG8_LDB(B1, 1, 1); PG8_STAGE(PG8_SB(1, 0), b3, voffB);
            PG8_BAR; PG8_WAIT_L(0); PG8_MMA(0, 1, At, B1); PG8_BAR;
            PG8_LDA(At, 1, 1); PG8_STAGE(PG8_SA(1, 0), a3, voffA);
            PG8_BAR; PG8_WAIT_L(0); PG8_MMA(1, 0, At, B0); PG8_BAR; PG8_SCHED;
            PG8_STAGE(PG8_SB(1, 1), b3 + hstep, voffB);
            PG8_WAIT_V(6); PG8_BAR; PG8_MMA(1, 1, At, B1); PG8_BAR;
            }
        }
        if constexpr (ALIGN_EPI) { if (wr == 0) PG8_BAR; }
        if constexpr (!Epi::AFTER_DRAIN) { E(acc, cur, wr, wc, fr, fq); S.done(cur); }
        if (!has_next) break;
#pragma unroll
        for (int a = 0; a < 2; ++a)
#pragma unroll
            for (int b = 0; b < 2; ++b)
#pragma unroll
                for (int m = 0; m < 4; ++m)
#pragma unroll
                    for (int n = 0; n < 2; ++n) acc[a][b][m][n] = (f32x4){0.f, 0.f, 0.f, 0.f};
        cur = nxt; cA = nA; cB = nB; ++ui;
        if constexpr (ALIGN_EPI) { if (wr == 1) PG8_BAR; }
    }
    PG8_WAIT_V(0);
    if constexpr (!ALIGN_EPI) { if (wr == 0) PG8_BAR; }
    PG8_BAR;
    if constexpr (Epi::AFTER_DRAIN) { E.fused(acc, cur, wr, wc, fr, fq, lds, wid, lane); S.done(cur); }
#undef PG8_SA
#undef PG8_SB
#undef PG8_STAGE
#undef PG8_LDA
#undef PG8_LDB
#undef PG8_MMA
#undef PG8_WAIT_V
#undef PG8_WAIT_L
#undef PG8_BAR
#undef PG8_SCHED
}
}
#define GAS __attribute__((address_space(1)))
#define LAS __attribute__((address_space(3)))
typedef unsigned short bf16;
typedef unsigned v4u __attribute__((ext_vector_type(4)));
typedef float f32x4 __attribute__((ext_vector_type(4)));
typedef short bf16x8 __attribute__((ext_vector_type(8)));
typedef GAS unsigned gu32;
typedef GAS unsigned long long gu64;
#define RLX_AGENT __ATOMIC_RELAXED, __HIP_MEMORY_SCOPE_AGENT
#define LDS_WAIT() asm volatile("s_waitcnt lgkmcnt(0)" ::: "memory")
#define VM_WAIT() asm volatile("s_waitcnt vmcnt(0)" ::: "memory")
__device__ __forceinline__ unsigned long long rt() { return __builtin_amdgcn_s_memrealtime(); }
__device__ __forceinline__ unsigned f2bf(float f) { unsigned u = __builtin_bit_cast(unsigned, f); return (u + 0x7fffu + ((u >> 16) & 1u)) >> 16; }
__device__ __forceinline__ unsigned pk2(float lo, float hi) { return f2bf(lo) | (f2bf(hi) << 16); }

#define XB_TMO      128
#define XB_XCNT(j)  (256  + 64 * (j))
#define XB_XSUB(j)  (1280 + 64 * (j))
#define XB_XGEN(j)  (2304 + 64 * (j))
#define XB_TOP      3328
#define XB_TOPGEN   3392
#define XCD_BAR_WORDS 3456
#define XB_SPIN_CAP (1u << 18)

__device__ __forceinline__ unsigned xb_ld(unsigned* p)              { return __hip_atomic_load(p, __ATOMIC_RELAXED, __HIP_MEMORY_SCOPE_AGENT); }
__device__ __forceinline__ unsigned xb_add(unsigned* p, unsigned v) { return __hip_atomic_fetch_add(p, v, __ATOMIC_RELAXED, __HIP_MEMORY_SCOPE_AGENT); }
__device__ __forceinline__ unsigned xb_xcc_id() { return (unsigned)__builtin_amdgcn_s_getreg((3 << 11) | 20) & 0xFu; }
#define XB_SPIN(cond, bar) do { unsigned _sp = 0; while (cond) { __builtin_amdgcn_s_sleep(1); \
    if ((++_sp & 255u) == 0u) { if (xb_ld(&(bar)[XB_TMO])) break; if (_sp > XB_SPIN_CAP) { atomicAdd(&(bar)[XB_TMO], 1u); break; } } } } while (0)

struct XcdBarrier {
    unsigned* bar; unsigned x;
    volatile LAS unsigned* st;
};

__device__ __forceinline__ XcdBarrier xcd_barrier_post(unsigned* bar, volatile LAS unsigned* st) {
    XcdBarrier b; b.bar = bar; b.x = xb_xcc_id(); b.st = st;
    if (threadIdx.x == 0) (void)xb_add(&bar[XB_XCNT(b.x)], 1u);
    return b;
}
__device__ __forceinline__ void xcd_barrier_complete(unsigned* bar, unsigned x, unsigned& nloc, unsigned& nx) {
    const unsigned G = gridDim.x * gridDim.y * gridDim.z;
    unsigned sum, cnt, mine, sp = 0u;
    for (;;) {
        sum = 0u; cnt = 0u; mine = 0u;
#pragma unroll
        for (unsigned j = 0; j < 16; ++j) { const unsigned c = xb_ld(&bar[XB_XCNT(j)]); sum += c; cnt += (c > 0u) ? 1u : 0u; mine = (j == x) ? c : mine; }
        if (sum == G) break;
        __builtin_amdgcn_s_sleep(1);
        if ((++sp & 255u) == 0u) { if (xb_ld(&bar[XB_TMO])) break; if (sp > XB_SPIN_CAP) { atomicAdd(&bar[XB_TMO], 1u); break; } }
    }
    nloc = mine > 0u ? mine : 1u; nx = cnt > 0u ? cnt : 1u;
}

__device__ __forceinline__ void xcd_barrier(const XcdBarrier& b) {
    asm volatile("s_waitcnt vmcnt(0)" ::: "memory");
    __syncthreads();
    if (threadIdx.x == 0) {
        unsigned* bar = b.bar;
        __builtin_amdgcn_s_waitcnt(0);
        unsigned nloc = b.st[0], nx = b.st[1];
        if (nloc == 0u) { xcd_barrier_complete(bar, b.x, nloc, nx); b.st[0] = nloc; b.st[1] = nx; }
        const unsigned old = xb_add(&bar[XB_XSUB(b.x)], 1u);
        const unsigned gen = old / nloc;
        if (old + 1u == (gen + 1u) * nloc) {
            __builtin_amdgcn_fence(__ATOMIC_RELEASE, "agent");
            asm volatile("s_waitcnt vmcnt(0)" ::: "memory");
            const unsigned og = xb_add(&bar[XB_TOP], 1u);
            const unsigned tg = og / nx;
            if (og + 1u == (tg + 1u) * nx) xb_add(&bar[XB_TOPGEN], 1u);
            else XB_SPIN(xb_ld(&bar[XB_TOPGEN]) == tg, bar);
            __builtin_amdgcn_fence(__ATOMIC_ACQUIRE, "agent");
            xb_add(&bar[XB_XGEN(b.x)], 1u);
            asm volatile("s_waitcnt vmcnt(0)" ::: "memory");
        } else {
            XB_SPIN(xb_ld(&bar[XB_XGEN(b.x)]) == gen, bar);
            __builtin_amdgcn_fence(__ATOMIC_ACQUIRE, "agent");
            asm volatile("s_waitcnt vmcnt(0)" ::: "memory");
        }
    }
    __syncthreads();
}

#define XB_LOC(j)   (3584 + 64 * (j))
#define XB_RANK(j)  (4608 + 64 * (j))
#define XB_LGEN(j)  (5632 + 64 * (j))
#define XB_ALL_WORDS 6656
__device__ __forceinline__ void xcd_local_barrier(unsigned* bar, unsigned x, unsigned nloc) {
    asm volatile("s_waitcnt vmcnt(0)" ::: "memory");
    __syncthreads();
    if (threadIdx.x == 0) {
        __builtin_amdgcn_s_waitcnt(0);
        const unsigned old = xb_add(&bar[XB_LOC(x)], 1u); const unsigned gen = old / nloc;
        if (old + 1u == (gen + 1u) * nloc) {
            __builtin_amdgcn_fence(__ATOMIC_RELEASE, "agent");
            asm volatile("s_waitcnt vmcnt(0)" ::: "memory");
            __builtin_amdgcn_fence(__ATOMIC_ACQUIRE, "agent");
            xb_add(&bar[XB_LGEN(x)], 1u);
            asm volatile("s_waitcnt vmcnt(0)" ::: "memory");
        } else {
            XB_SPIN(xb_ld(&bar[XB_LGEN(x)]) == gen, bar);
            __builtin_amdgcn_fence(__ATOMIC_ACQUIRE, "agent");
            asm volatile("s_waitcnt vmcnt(0)" ::: "memory");
        }
    }
    __syncthreads();
}

constexpr int NWAVES = 8, NTHR = 512;
constexpr int DM = 1024, BATCH = 8, SEQ = 2048, DEPTH = 4, M = BATCH * SEQ;
constexpr int DFF = 2816, NUP = 2 * DFF, NPROJ = 3840, PROJ_LD = 3584, NIN_SRC = 3600, NCOND = 9 * DM;
constexpr float RMS_EPS = 1e-6f;
constexpr int PC_FQ = 0, PC_FK = 256, PC_FV = 512, PC_MQ = 768, PC_MK = 1024, PC_MV = 1280, PC_MO = 1536, PC_RQ = 1792, PC_RK = 2048, PC_RV = 2304, PC_RG = 2560, PC_SZ = 2816, PC_SX = 3072;
constexpr int PH_LAYER0 = 2, PH_PER_LAYER = 9, PH_FINAL = PH_LAYER0 + PH_PER_LAYER * DEPTH, PH_END = PH_FINAL + 1;
constexpr size_t MiB = 1u << 20;
constexpr size_t WS_CTL = 0, CTL_ZERO_BYTES = 1 * MiB;
constexpr size_t WS_COND = 1 * MiB;
constexpr size_t WS_ROPE = 3 * MiB;
constexpr size_t WS_W = 4 * MiB;
constexpr size_t W_UP = (size_t)NUP * DM * 2, W_DN = (size_t)DM * DFF * 2, W_IN = (size_t)NPROJ * DM * 2, W_OUT = (size_t)DM * DM * 2;
constexpr size_t OFF_UP1 = 0, OFF_DN1 = W_UP, OFF_UP2 = W_UP + W_DN, OFF_DN2 = 2 * W_UP + W_DN, OFF_IN = 2 * W_UP + 2 * W_DN, OFF_OUT = OFF_IN + W_IN, LAYER_W = OFF_OUT + W_OUT;
static_assert(LAYER_W * DEPTH == 170 * MiB, "weights");
constexpr size_t WS_HB = 174 * MiB;
constexpr size_t WS_PROJ = 206 * MiB, WS_ACT = 206 * MiB;
constexpr size_t WS_GATES = 318 * MiB;
constexpr size_t WS_VTF = 319 * MiB;
constexpr size_t WS_VTL = 327 * MiB;
constexpr size_t WS_QL = 363 * MiB, WS_KL = 387 * MiB;
constexpr size_t WS_COEF = 411 * MiB;
constexpr size_t COEF_A1 = 0, COEF_A2 = 768 * 1024, COEF_BETA = 2 * 768 * 1024, COEF_LCUM = 3 * 768 * 1024, COEF_S1 = COEF_LCUM + 256 * 1024, COEF_S2 = COEF_S1 + 16 * 1024, COEF_CTOT = COEF_S2 + 16 * 1024;
constexpr size_t WS_YRAW = 415 * MiB;
constexpr size_t WS_XB = 447 * MiB;
constexpr size_t WS_YBF = 479 * MiB;
constexpr size_t WS_KT = 511 * MiB;
constexpr size_t WS_XS = 535 * MiB;
constexpr size_t WS_DEN = 551 * MiB;
constexpr size_t WS_BIAS = 552 * MiB;
constexpr size_t BIAS_USE = (size_t)8 * NUP * 4, BIAS_BYTES = (size_t)DEPTH * 3 * BIAS_USE;
constexpr size_t WS_SS = 556 * MiB, SS_BYTES = (size_t)3 * DEPTH * M * 8;
constexpr size_t WS_BIASQ = 558 * MiB, BIASQ_BYTES = 2 * BIAS_BYTES, WS_END = 563 * MiB;
static_assert(WS_BIAS + BIAS_BYTES <= 555 * MiB && WS_SS + SS_BYTES <= WS_BIASQ && WS_BIASQ + BIASQ_BYTES <= WS_END, "ws map 2");
static_assert(WS_PROJ + (size_t)M * PROJ_LD * 2 <= WS_GATES && WS_ACT + (size_t)M * DFF * 2 <= WS_GATES && COEF_CTOT + 4096 <= 4 * MiB && WS_YRAW + (size_t)M * 1024 * 4 <= WS_YBF, "ws map");
constexpr int CW_BAR = 4096;
constexpr int RING_BYTES = 131072, LDS_BYTES = 163840, LDSCTL_OFF = LDS_BYTES - 1024, MISC_OFF = LDSCTL_OFF + 320;

__device__ const double INVREV[32] = {0.15915494309189535, 0.11934937021124886, 0.089499401608891013, 0.067115083005227255, 0.050329212104487035, 0.037741584717419778, 0.028302195830623395, 0.02122365276477766, 0.015915494309189534, 0.011934937021124886, 0.0089499401608891006, 0.0067115083005227253, 0.0050329212104487037, 0.0037741584717419768, 0.0028302195830623399, 0.0021223652764777662, 0.0015915494309189536, 0.0011934937021124887, 0.00089499401608891024, 0.0006711508300522726, 0.00050329212104487033, 0.00037741584717419769, 0.00028302195830623401, 0.00021223652764777661, 0.00015915494309189535, 0.00011934937021124885, 8.9499401608891018e-05, 6.7115083005227268e-05, 5.0329212104487035e-05, 3.7741584717419777e-05, 2.8302195830623396e-05, 2.1223652764777659e-05};

struct Args { const float* in[25]; float* out; unsigned char* ws; int ph_lo, ph_hi; };
static_assert(sizeof(Args) == 27 * 8 + 8, "Args has no padding");

__device__ __forceinline__ float wave_sum(float v) {
#pragma unroll
    for (int o = 1; o < 64; o <<= 1) v += __shfl_xor(v, o);
    return v;
}
__device__ __forceinline__ float bf2f(unsigned short u) { return __uint_as_float((unsigned)u << 16); }
__device__ __forceinline__ float sigmoid_f(float v) { return 1.0f / (1.0f + __expf(-v)); }
__device__ __forceinline__ float silu_acc(float v) { return v / (1.0f + __expf(-v)); }
__device__ __forceinline__ float log_sigmoid_f(float v) { return fminf(v, 0.f) - log1pf(__expf(-fabsf(v))); }
__device__ __forceinline__ float softplus_f(float v) { return fmaxf(v, 0.f) + log1pf(__expf(-fabsf(v))); }

__device__ __forceinline__ int map_up(int n) { const int t = n >> 8, r = n & 255; return (r < 128) ? (t * 128 + r) : (DFF + t * 128 + (r - 128)); }
__device__ __forceinline__ int map_in(int n) {
    if (n < 768) return n; if (n < 1536) return n + 4; if (n < 3584) return n + 12;
    const int j = n - 3584; if (j < 4) return 768 + j; if (j < 8) return 1540 + (j - 4); if (j < 12) return 1544 + (j - 8); if (j < 16) return 3596 + (j - 12); return -1; }
template <int MAP> __device__ __forceinline__ void tr_item(const float* W, int K, int Nsrc, bf16* WT, int kb, int nb, LAS float* scr, int lane, const float* shp, long long* biasp, int Ndst) {
    const int k0 = 64 * kb, n0 = 32 * nb; const int nd = n0 + (lane & 31); const int src = MAP == 1 ? map_up(nd) : (MAP == 2 ? map_in(nd) : nd);
    const bool regular = (MAP != 2) || (n0 < 3584);
    if (regular) {
        const int s0c = MAP == 1 ? map_up(n0) : (MAP == 2 ? map_in(n0) : n0); const int kq = lane >> 3, nq = lane & 7;
        f32x4 wv[8];
#pragma unroll
        for (int i = 0; i < 8; ++i) wv[i] = *(const f32x4*)(W + (size_t)(k0 + 8 * i + kq) * Nsrc + s0c + 4 * nq);
#pragma unroll
        for (int i = 0; i < 8; ++i) { LAS float* d = scr + (8 * i + kq) * 33 + 4 * nq; d[0] = wv[i][0]; d[1] = wv[i][1]; d[2] = wv[i][2]; d[3] = wv[i][3]; }
    } else {
#pragma unroll 8
        for (int i = 0; i < 32; ++i) { const int kk = 2 * i + (lane >> 5); scr[kk * 33 + (lane & 31)] = src >= 0 ? W[(size_t)(k0 + kk) * Nsrc + src] : 0.f; }
    }
    if (MAP != 0) {
        LAS float* shs = scr + 64 * 33;
#pragma unroll
        for (int bb = 0; bb < 8; ++bb) shs[lane * 8 + bb] = shp[(size_t)bb * NCOND + k0 + lane];
    }
    LDS_WAIT(); asm volatile("" ::: "memory");
    const int c = lane & 7;
#pragma unroll
    for (int j = 0; j < 4; ++j) { const int n = (lane >> 3) + 8 * j; const LAS float* s = scr + (8 * c) * 33 + n;
        v4u o; o.x = pk2(s[0 * 33], s[1 * 33]); o.y = pk2(s[2 * 33], s[3 * 33]); o.z = pk2(s[4 * 33], s[5 * 33]); o.w = pk2(s[6 * 33], s[7 * 33]);
        *(GAS v4u*)(WT + (size_t)(n0 + n) * K + k0 + 8 * c) = o; }
    if (MAP != 0) {
        const LAS float* shs = scr + 64 * 33; const int n = lane & 31, hf = lane >> 5;
        float acc[8];
#pragma unroll
        for (int bb = 0; bb < 8; ++bb) acc[bb] = 0.f;
#pragma unroll 8
        for (int i = 0; i < 32; ++i) { const int kk = 32 * hf + i; const float w = scr[kk * 33 + n]; const f32x4 s0 = *(const LAS f32x4*)(shs + kk * 8), s1 = *(const LAS f32x4*)(shs + kk * 8 + 4);
            acc[0] += w * s0[0]; acc[1] += w * s0[1]; acc[2] += w * s0[2]; acc[3] += w * s0[3]; acc[4] += w * s1[0]; acc[5] += w * s1[1]; acc[6] += w * s1[2]; acc[7] += w * s1[3]; }
#pragma unroll
        for (int bb = 0; bb < 8; ++bb) { acc[bb] += __shfl_xor(acc[bb], 32); if (hf == 0 && src >= 0) atomicAdd((unsigned long long*)(biasp + (size_t)bb * Ndst + n0 + n), (unsigned long long)__float2ll_rn(acc[bb] * 4294967296.0f)); }
    }
    LDS_WAIT(); asm volatile("" ::: "memory");
}
__device__ __forceinline__ void prologue0(const Args& a, LAS unsigned char* lds, int tid, int lane, int wave, int G) {
    unsigned char* ws = a.ws;
    LAS float* cact = (LAS float*)(lds + 69632);
    LAS float* red = (LAS float*)(lds + 102400);
    for (int i = tid; i < BATCH * DM; i += NTHR) { const float v = a.in[1][i]; cact[i] = silu_acc(v); }
    __syncthreads();
    float* cond = (float*)(ws + WS_COND);
    for (int item = blockIdx.x; item < DEPTH * (NCOND / 64); item += G) {
        const int l = item / (NCOND / 64), cb = item % (NCOND / 64), col = cb * 64 + lane, ks = wave;
        const float* W = a.in[2] + (size_t)l * DM * NCOND + col;
        float acc[8];
#pragma unroll
        for (int b = 0; b < 8; ++b) acc[b] = 0.f;
        for (int k = ks * 128; k < ks * 128 + 128; k += 16) { float w[16];
#pragma unroll
            for (int i = 0; i < 16; ++i) w[i] = W[(size_t)(k + i) * NCOND];
#pragma unroll
            for (int i = 0; i < 16; ++i)
#pragma unroll
                for (int b = 0; b < 8; ++b) acc[b] += cact[b * DM + k + i] * w[i]; }
#pragma unroll
        for (int b = 0; b < 8; ++b) red[(ks * 8 + b) * 64 + lane] = acc[b];
        __syncthreads();
        { const int b = wave; float s = 0.f;
#pragma unroll
          for (int k2 = 0; k2 < 8; ++k2) s += red[(k2 * 8 + b) * 64 + lane];
          cond[((size_t)l * BATCH + b) * NCOND + col] = s + a.in[3][(size_t)l * NCOND + col]; }
        __syncthreads();
    }
    float2* rope = (float2*)(ws + WS_ROPE);
    for (int e = blockIdx.x * NTHR + tid; e < SEQ * 32; e += G * NTHR) { const int s = e >> 5, i = e & 31; const double rev = (double)s * INVREV[i]; const float fr = (float)(rev - rint(rev));
        rope[e] = make_float2(__builtin_amdgcn_cosf(fr), __builtin_amdgcn_sinf(fr)); }
    { GAS f32x4* z = (GAS f32x4*)(ws + WS_BIASQ); for (size_t i = (size_t)blockIdx.x * NTHR + tid; i < BIASQ_BYTES / 16; i += (size_t)G * NTHR) z[i] = (f32x4){0.f, 0.f, 0.f, 0.f};
      GAS f32x4* z2 = (GAS f32x4*)(ws + WS_SS); for (size_t i = (size_t)blockIdx.x * NTHR + tid; i < SS_BYTES / 16; i += (size_t)G * NTHR) z2[i] = (f32x4){0.f, 0.f, 0.f, 0.f}; }
}
__device__ __forceinline__ void prologue1(const Args& a, LAS unsigned char* lds, int lane, int wave, int G) {
    unsigned char* ws = a.ws;
    LAS float* scr = (LAS float*)(lds + wave * 10496);
    const float* cond = (const float*)(ws + WS_COND);
    const int gw = blockIdx.x * NWAVES + wave, NGW = G * NWAVES;
    constexpr int I_UP = (DM / 64) * (NUP / 32), I_DN = (DFF / 64) * (DM / 32), I_IN = (DM / 64) * (NPROJ / 32), I_OUT = (DM / 64) * (DM / 32), I_LAYER = 2 * I_UP + 2 * I_DN + I_IN + I_OUT;
    for (int it = gw; it < DEPTH * I_LAYER; it += NGW) {
        const int l = it / I_LAYER; int r = it % I_LAYER;
        unsigned char* wl = ws + WS_W + (size_t)l * LAYER_W; const float* cl = cond + (size_t)l * BATCH * NCOND; long long* bl = (long long*)(ws + WS_BIASQ + (size_t)l * 3 * 2 * BIAS_USE);
        if (r < I_UP) { tr_item<1>(a.in[5] + (size_t)l * DM * NUP, DM, NUP, (bf16*)(wl + OFF_UP1), r / (NUP / 32), r % (NUP / 32), scr, lane, cl + 0 * DM, bl, NUP); continue; } r -= I_UP;
        if (r < I_DN) { tr_item<0>(a.in[6] + (size_t)l * DFF * DM, DFF, DM, (bf16*)(wl + OFF_DN1), r / (DM / 32), r % (DM / 32), scr, lane, nullptr, nullptr, 0); continue; } r -= I_DN;
        if (r < I_UP) { tr_item<1>(a.in[7] + (size_t)l * DM * NUP, DM, NUP, (bf16*)(wl + OFF_UP2), r / (NUP / 32), r % (NUP / 32), scr, lane, cl + 6 * DM, bl + 2 * 8 * NUP, NUP); continue; } r -= I_UP;
        if (r < I_DN) { tr_item<0>(a.in[8] + (size_t)l * DFF * DM, DFF, DM, (bf16*)(wl + OFF_DN2), r / (DM / 32), r % (DM / 32), scr, lane, nullptr, nullptr, 0); continue; } r -= I_DN;
        if (r < I_IN) { tr_item<2>(a.in[9] + (size_t)l * DM * NIN_SRC, DM, NIN_SRC, (bf16*)(wl + OFF_IN), r / (NPROJ / 32), r % (NPROJ / 32), scr, lane, cl + 3 * DM, bl + 1 * 8 * NUP, NPROJ); continue; } r -= I_IN;
        tr_item<0>(a.in[10] + (size_t)l * DM * DM, DM, DM, (bf16*)(wl + OFF_OUT), r / (DM / 32), r % (DM / 32), scr, lane, nullptr, nullptr, 0);
    }
}
__device__ __forceinline__ void thin_xg(const float* x, bf16* hb, bf16* xb, const float* g, const float* cond_l, int sc_off, long long* ss, int gw, int NGW, int lane) {
    for (int m = gw; m < M; m += NGW) {
        const int b = m >> 11;
        const GAS f32x4* xr = (const GAS f32x4*)(x + (size_t)m * DM) + lane;
        f32x4 v[4]; float s = 0.f;
#pragma unroll
        for (int j = 0; j < 4; ++j) { v[j] = xr[64 * j]; s += (v[j].x * v[j].x + v[j].y * v[j].y) + (v[j].z * v[j].z + v[j].w * v[j].w); }
        s = wave_sum(s); if (lane == 0) ss[m] = __float2ll_rn(s * 16777216.0f);
        const f32x4* g4 = (const f32x4*)g + lane; const f32x4* sc4 = (const f32x4*)(cond_l + (size_t)b * NCOND + sc_off) + lane;
        GAS unsigned long long* o8 = (GAS unsigned long long*)(hb + (size_t)m * DM) + lane;
#pragma unroll
        for (int j = 0; j < 4; ++j) { const f32x4 o = v[j] * g4[64 * j] * (sc4[64 * j] + 1.0f);
            o8[64 * j] = (unsigned long long)pk2(o.x, o.y) | ((unsigned long long)pk2(o.z, o.w) << 32); }
        GAS unsigned long long* x8 = (GAS unsigned long long*)(xb + (size_t)m * DM) + lane;
#pragma unroll
        for (int j = 0; j < 4; ++j) x8[64 * j] = (unsigned long long)pk2(v[j].x, v[j].y) | ((unsigned long long)pk2(v[j].z, v[j].w) << 32);
    }
}
__device__ __forceinline__ void thin_norm(const float* x, bf16* hb, const float* g, const float* cond_l, int sh_off, int sc_off, int gw, int NGW, int lane) {
    for (int m = gw; m < M; m += NGW) {
        const int b = m >> 11;
        const GAS f32x4* xr = (const GAS f32x4*)(x + (size_t)m * DM) + lane;
        f32x4 v[4]; float s = 0.f;
#pragma unroll
        for (int j = 0; j < 4; ++j) { v[j] = xr[64 * j]; s += (v[j].x * v[j].x + v[j].y * v[j].y) + (v[j].z * v[j].z + v[j].w * v[j].w); }
        const float rstd = 1.0f / sqrtf(wave_sum(s) * (1.0f / DM) + RMS_EPS);
        const f32x4* g4 = (const f32x4*)g + lane; const f32x4* sh4 = (const f32x4*)(cond_l + (size_t)b * NCOND + sh_off) + lane; const f32x4* sc4 = (const f32x4*)(cond_l + (size_t)b * NCOND + sc_off) + lane;
        GAS unsigned long long* o8 = (GAS unsigned long long*)(hb + (size_t)m * DM) + lane;
#pragma unroll
        for (int j = 0; j < 4; ++j) { const f32x4 gg = g4[64 * j], sh = sh4[64 * j], sc = sc4[64 * j]; const f32x4 o = v[j] * rstd * gg * (sc + 1.0f) + sh;
            o8[64 * j] = (unsigned long long)pk2(o.x, o.y) | ((unsigned long long)pk2(o.z, o.w) << 32); }
    }
}

typedef float f32x16 __attribute__((ext_vector_type(16)));
typedef short s16x4 __attribute__((ext_vector_type(4)));
typedef float f32x2_t __attribute__((ext_vector_type(2))); typedef __bf16 bf16x2_t __attribute__((ext_vector_type(2)));
#define MFMA32(a, b, c) __builtin_amdgcn_mfma_f32_32x32x16_bf16((a), (b), (c), 0, 0, 0)
constexpr float LOG2E = 1.4426950408889634f;
__device__ __forceinline__ unsigned cvtpk(float lo, float hi) { f32x2_t v = {lo, hi}; bf16x2_t b = __builtin_convertvector(v, bf16x2_t); return __builtin_bit_cast(unsigned, b); }
template <int KAP> __device__ __forceinline__ bf16x8 pack8(const f32x16& x) {
    v4u p; p.x = cvtpk(x[8 * KAP + 0], x[8 * KAP + 1]); p.y = cvtpk(x[8 * KAP + 2], x[8 * KAP + 3]); p.z = cvtpk(x[8 * KAP + 4], x[8 * KAP + 5]); p.w = cvtpk(x[8 * KAP + 6], x[8 * KAP + 7]);
    return __builtin_bit_cast(bf16x8, p); }
__device__ __forceinline__ bf16x8 ld_perm(const bf16* p) { const s16x4 lo = *(const s16x4*)p, hi = *(const s16x4*)(p + 8); return __builtin_shufflevector(lo, hi, 0, 1, 2, 3, 4, 5, 6, 7); }
__device__ __forceinline__ float fmax16(const f32x16& a) { float m0 = fmaxf(fmaxf(a[0], a[1]), fmaxf(a[2], a[3])), m1 = fmaxf(fmaxf(a[4], a[5]), fmaxf(a[6], a[7])), m2 = fmaxf(fmaxf(a[8], a[9]), fmaxf(a[10], a[11])), m3 = fmaxf(fmaxf(a[12], a[13]), fmaxf(a[14], a[15])); return fmaxf(fmaxf(m0, m1), fmaxf(m2, m3)); }

struct MixBufs {
    const bf16* proj; const float* gates;
    bf16* vtf;
    float* lcum;
    float* ctot;
    bf16* ql;
    bf16* kl;
    bf16* kt;
    bf16* vtl;
    float* xs;
    float* a1; float* a2; float* beta;
    float* s1; float* s2;
    float* den;
    float* yraw;
};
__device__ __forceinline__ float wave_scan_add(float v, int lane) {
#pragma unroll
    for (int o = 1; o < 64; o <<= 1) { const float u = __shfl_up(v, o); if (lane >= o) v += u; }
    return v; }
__device__ __forceinline__ float wave_scan_max(float v, int lane) {
#pragma unroll
    for (int o = 1; o < 64; o <<= 1) { const float u = __shfl_up(v, o); if (lane >= o) v = fmaxf(v, u); }
    return v; }

struct PrepW { const float* mcw; const float* mcb; const float* scw; const float* scb; const float* fox_fb; const float* mib; const float* mfb; const float* dtb; const float* alog; const float2* rope; };
__device__ __forceinline__ void prep_unit(const MixBufs& B, const PrepW& W, int u, int wave, int lane) {
    const int b = u >> 5, c = u & 31, s0 = 64 * c; const size_t m0 = (size_t)b * SEQ + s0;
    for (int job = wave; job < 52; job += NWAVES) {
        if (job < 36) {
            const int kind = job < 32 ? (job >> 2) : (job < 34 ? 8 : 9), h = job < 32 ? (job & 3) : (job & 1);
            const int cg = lane & 7, tb = lane >> 3, tok0 = 8 * tb;
            const int pc = (kind == 0 ? PC_FV + h * 64 : kind == 1 ? PC_MV + h * 64 : kind == 2 ? PC_RV + h * 64 : kind == 3 ? PC_MQ + h * 64 : kind == 4 ? PC_MK + h * 64 : kind == 5 ? PC_RQ + h * 64 : kind == 6 ? PC_RK + h * 64
                         : kind == 7 ? PC_SX + h * 64 : kind == 8 ? PC_SX + 256 + h * 64 : PC_SX + 384 + h * 64);
            const bf16* src = B.proj + (m0 + tok0) * PROJ_LD + pc + 8 * cg;
            const bool is_conv = (kind == 3 || kind == 4 || kind >= 7), is_rot = (kind == 5 || kind == 6);
            v4u raw[8];
#pragma unroll
            for (int i = 0; i < 8; ++i) raw[i] = *(const v4u*)(src + (size_t)i * PROJ_LD);
            float v[8][8];
#pragma unroll
            for (int i = 0; i < 8; ++i)
#pragma unroll
                for (int j = 0; j < 4; ++j) { v[i][2 * j] = __uint_as_float(raw[i][j] << 16); v[i][2 * j + 1] = __uint_as_float(raw[i][j] & 0xffff0000u); }
            if (is_conv) {
                const int cc = (kind == 3 ? h * 64 : kind == 4 ? 256 + h * 64 : kind == 7 ? h * 64 : kind == 8 ? 256 + h * 64 : 384 + h * 64) + 8 * cg; const float* cw = (kind <= 4) ? W.mcw : W.scw; const float* cbp = (kind <= 4) ? W.mcb : W.scb;
                float wt[4][8], cb[8], xh[3][8];
#pragma unroll
                for (int k = 0; k < 4; ++k) { const f32x4 a = *(const f32x4*)(cw + k * 512 + cc), d = *(const f32x4*)(cw + k * 512 + cc + 4);
#pragma unroll
                    for (int j = 0; j < 4; ++j) { wt[k][j] = a[j]; wt[k][4 + j] = d[j]; } }
                { const f32x4 a = *(const f32x4*)(cbp + cc), d = *(const f32x4*)(cbp + cc + 4);
#pragma unroll
                  for (int j = 0; j < 4; ++j) { cb[j] = a[j]; cb[4 + j] = d[j]; } }
                const bool has_halo = (c > 0) || (tb > 0);
#pragma unroll
                for (int k = 0; k < 3; ++k) { v4u hr = (v4u){0u, 0u, 0u, 0u}; if (has_halo) hr = *(const v4u*)(src - (size_t)(3 - k) * PROJ_LD);
#pragma unroll
                    for (int j = 0; j < 4; ++j) { xh[k][2 * j] = __uint_as_float(hr[j] << 16); xh[k][2 * j + 1] = __uint_as_float(hr[j] & 0xffff0000u); } }
#pragma unroll
                for (int j = 0; j < 8; ++j) { float x0 = xh[0][j], x1 = xh[1][j], x2 = xh[2][j];
#pragma unroll
                    for (int i = 0; i < 8; ++i) { const float x3 = v[i][j]; float o = pg8::silu_f(cb[j] + wt[0][j] * x0 + wt[1][j] * x1 + wt[2][j] * x2 + wt[3][j] * x3); if (kind == 3) o *= 0.125f; v[i][j] = o; x0 = x1; x1 = x2; x2 = x3; } }
            } else if (is_rot) {
                const bf16* src2 = B.proj + (m0 + tok0) * PROJ_LD + pc + 8 * (cg ^ 4);
                const bool lowh = cg < 4; const float sc = (kind == 6) ? 0.125f : 1.0f;
#pragma unroll
                for (int i = 0; i < 8; ++i) { const v4u pr = *(const v4u*)(src2 + (size_t)i * PROJ_LD); const float2* rp = W.rope + (size_t)(s0 + tok0 + i) * 32 + 8 * (cg & 3);
                    const f32x4 r0 = *(const f32x4*)rp, r1 = *(const f32x4*)(rp + 2), r2 = *(const f32x4*)(rp + 4), r3 = *(const f32x4*)(rp + 6);
                    const float cs[8] = {r0[0], r0[2], r1[0], r1[2], r2[0], r2[2], r3[0], r3[2]}, sn[8] = {r0[1], r0[3], r1[1], r1[3], r2[1], r2[3], r3[1], r3[3]};
#pragma unroll
                    for (int j = 0; j < 8; ++j) { const float pv = (j & 1) ? __uint_as_float(pr[j >> 1] & 0xffff0000u) : __uint_as_float(pr[j >> 1] << 16);
                        v[i][j] = (lowh ? v[i][j] * cs[j] - pv * sn[j] : pv * sn[j] + v[i][j] * cs[j]) * sc; } }
            }
            if (kind == 7) {
                const float dtb_h = W.dtb[h];
#pragma unroll
                for (int i = 0; i < 8; ++i) { bf16* xp = (bf16*)B.xs + (m0 + tok0 + i) * 256 + h * 64 + 8 * cg; *(GAS v4u*)xp = (v4u){cvtpk(v[i][0], v[i][1]), cvtpk(v[i][2], v[i][3]), cvtpk(v[i][4], v[i][5]), cvtpk(v[i][6], v[i][7])};
                    const float dt = softplus_f(B.gates[(m0 + tok0 + i) * 16 + 12 + h] + dtb_h);
#pragma unroll
                    for (int j = 0; j < 8; ++j) v[i][j] *= dt; }
            }
            unsigned P[8][4];
#pragma unroll
            for (int i = 0; i < 8; ++i)
#pragma unroll
                for (int j = 0; j < 4; ++j) P[i][j] = cvtpk(v[i][2 * j], v[i][2 * j + 1]);
            bf16* rm = nullptr;
            if (kind == 3) rm = B.ql + (0 * (size_t)M + m0) * 256 + h * 64; else if (kind == 4) rm = B.kl + (0 * (size_t)M + m0) * 256 + h * 64;
            else if (kind == 5) rm = B.ql + (1 * (size_t)M + m0) * 256 + h * 64; else if (kind == 6) rm = B.kl + (1 * (size_t)M + m0) * 256 + h * 64;
            else if (kind == 8) rm = B.kl + (2 * (size_t)M + m0) * 256 + h * 64; else if (kind == 9) rm = B.ql + (2 * (size_t)M + m0) * 256 + h * 64;
            if (rm) {
#pragma unroll
                for (int i = 0; i < 8; ++i) *(GAS v4u*)(rm + (size_t)(tok0 + i) * 256 + 8 * cg) = (v4u){P[i][0], P[i][1], P[i][2], P[i][3]};
            }
            bf16* tr = nullptr;
            if (kind == 0) tr = B.vtf + ((size_t)(b * 4 + h) * 64) * SEQ;
            else if (kind == 1) tr = B.vtl + (((size_t)(0 * BATCH + b) * 4 + h) * 96) * SEQ;
            else if (kind == 2) tr = B.vtl + (((size_t)(1 * BATCH + b) * 4 + h) * 96) * SEQ;
            else if (kind == 7) tr = B.vtl + (((size_t)(2 * BATCH + b) * 4 + h) * 96) * SEQ;
            else if (kind == 4) tr = B.kt + (((size_t)(0 * BATCH + b) * 4 + h) * 64) * SEQ;
            else if (kind == 6) tr = B.kt + (((size_t)(1 * BATCH + b) * 4 + h) * 64) * SEQ;
            else if (kind == 8) tr = B.kt + (((size_t)(2 * BATCH + b) * 4 + h) * 64) * SEQ;
            if (tr) {
                tr += s0 + tok0;
#pragma unroll
                for (int j = 0; j < 8; ++j) { v4u o;
#pragma unroll
                    for (int ip = 0; ip < 4; ++ip) o[ip] = (j & 1) ? ((P[2 * ip][j >> 1] >> 16) | (P[2 * ip + 1][j >> 1] & 0xffff0000u)) : ((P[2 * ip][j >> 1] & 0xffffu) | (P[2 * ip + 1][j >> 1] << 16));
                    *(GAS v4u*)(tr + (size_t)(8 * cg + j) * SEQ) = o; }
                if (kind == 1 && cg < 4) {
#pragma unroll
                    for (int j = 0; j < 8; ++j) { const unsigned w = (cg == 0 && j == 0) ? 0x3f803f80u : 0u; *(GAS v4u*)(tr + (size_t)(64 + 8 * cg + j) * SEQ) = (v4u){w, w, w, w}; }
                }
            }
        } else {
            const int gj = job - 36, mixer = gj >> 2, h = gj & 3;
            const size_t m = m0 + lane;
            if (mixer == 0) {
                const float cum = wave_scan_add(log_sigmoid_f(B.gates[m * 16 + h] + W.fox_fb[h]), lane);
                B.lcum[(size_t)(b * 4 + h) * SEQ + s0 + lane] = cum; if (lane == 63) B.ctot[(b * 4 + h) * 32 + c] = cum;
            } else {
                const int mx = mixer - 1; const size_t ci = ((size_t)(mx * BATCH + b) * 4 + h) * SEQ + s0 + lane; const int si = ((mx * BATCH + b) * 4 + h) * 32 + c;
                if (mx == 0) {
                    const float bb = wave_scan_add(log_sigmoid_f(B.gates[m * 16 + 8 + h] + W.mfb[h]), lane), ic = B.gates[m * 16 + 4 + h] + W.mib[h], be = bb - ic, pm = wave_scan_max(-be, lane);
                    B.a1[ci] = bb; B.a2[ci] = bb + pm; B.beta[ci] = be; if (lane == 63) { B.s1[si] = bb; B.s2[si] = bb + pm; }
                } else if (mx == 1) {
                    const float lg = log1pf(-exp2f(-5.0f - (float)h)), v = (float)(lane + 1) * lg;
                    B.a1[ci] = v; B.a2[ci] = 0.f; B.beta[ci] = v; if (lane == 63) { B.s1[si] = v; B.s2[si] = 0.f; }
                } else {
                    const float dt = softplus_f(B.gates[m * 16 + 12 + h] + W.dtb[h]), cum = wave_scan_add(dt * (-__expf(W.alog[h])), lane);
                    B.a1[ci] = cum; B.a2[ci] = 0.f; B.beta[ci] = cum; if (lane == 63) { B.s1[si] = cum; B.s2[si] = 0.f; }
                }
            }
        }
    }
}

__device__ __forceinline__ int sig32(int i) { return (i & ~0xC) | ((i & 4) << 1) | ((i & 8) >> 1); }
#define GLDS16(gp, lp) __builtin_amdgcn_global_load_lds((const unsigned*)(gp), (LAS unsigned*)(lp), 16, 0, 0)
#define VMWAIT(n) asm volatile("s_waitcnt vmcnt(" #n ")" ::: "memory")
#define WGBAR() do { asm volatile("" ::: "memory"); __builtin_amdgcn_s_barrier(); asm volatile("" ::: "memory"); } while (0)
constexpr int FOX_SLOT = 16384, FOX_LC = 3 * FOX_SLOT;
__device__ __forceinline__ void fox_wg_unit(const MixBufs& B, bf16* ybf, LAS unsigned char* lds, int b, int h, int qb8, int wave, int lane) {
    const int col = lane & 31, hi = lane >> 5, t0 = 256 * qb8 + 32 * wave;
    const size_t rowq = (size_t)b * SEQ + t0 + col;
    bf16x8 qf[4];
#pragma unroll
    for (int ks = 0; ks < 4; ++ks) qf[ks] = *(const bf16x8*)(B.proj + rowq * PROJ_LD + PC_FQ + h * 64 + 16 * ks + 8 * hi);
    float offv; { const float cv = (lane < 32) ? B.ctot[(b * 4 + h) * 32 + lane] : 0.f; offv = wave_scan_add(cv, lane) - cv; }
    if (wave <= qb8) GLDS16(B.lcum + (size_t)(b * 4 + h) * SEQ + 256 * wave + 4 * lane, lds + FOX_LC + 1024 * wave);
    const bf16* ksrc = B.proj + ((size_t)b * SEQ + 32 * (wave >> 2) + sig32(col)) * PROJ_LD + PC_FK + h * 64 + 16 * (wave & 3) + 8 * hi;
    const bf16* vsrc = B.vtf + ((size_t)(b * 4 + h) * 64 + 32 * (wave >> 2) + col) * SEQ + 16 * (wave & 3) + 8 * hi;
    const int nkt = 4 * (qb8 + 1), tdiag = 4 * qb8 + (wave >> 1);
#define FOX_ISSUE(t, slot) do { GLDS16(ksrc + (size_t)(64 * (t)) * PROJ_LD, lds + (slot) * FOX_SLOT + 1024 * wave); GLDS16(vsrc + 64 * (t), lds + (slot) * FOX_SLOT + 8192 + 1024 * wave); } while (0)
    VMWAIT(0); WGBAR();
    if (wave <= qb8) {
        LAS f32x4* lp = (LAS f32x4*)(lds + FOX_LC + 1024 * wave) + lane; const f32x4 cv = *lp;
        const float o = __shfl(offv, 4 * wave + (lane >> 4));
        *lp = (cv + o) * (-LOG2E);
    }
    asm volatile("s_waitcnt lgkmcnt(0)" ::: "memory"); WGBAR();
    FOX_ISSUE(0, 0); FOX_ISSUE(1, 1);
    float mrun = -INFINITY, lsum = 0.f; f32x16 O0, O1;
#pragma unroll
    for (int r = 0; r < 16; ++r) { O0[r] = 0.f; O1[r] = 0.f; }
    int slot = 0;
    for (int kt = 0; kt < nkt; ++kt) {
        VMWAIT(2); WGBAR();
        { const int tn = (kt + 2 < nkt) ? kt + 2 : nkt - 1; const int sn = (slot == 0) ? 2 : slot - 1; FOX_ISSUE(tn, sn); }
        if (kt <= tdiag) {
            const int s0 = 64 * kt;
            const LAS unsigned char* sp = lds + slot * FOX_SLOT + 16 * lane;
            const LAS float* lc = (const LAS float*)(lds + FOX_LC) + s0 + 8 * hi;
            f32x16 S0, S1;
#pragma unroll
            for (int j = 0; j < 4; ++j) { const f32x4 c0 = *(const LAS f32x4*)(lc + 16 * j), c1 = *(const LAS f32x4*)(lc + 16 * j + 4);
#pragma unroll
                for (int i = 0; i < 4; ++i) { if (j < 2) { S0[8 * j + i] = c0[i]; S0[8 * j + 4 + i] = c1[i]; } else { S1[8 * (j - 2) + i] = c0[i]; S1[8 * (j - 2) + 4 + i] = c1[i]; } } }
#pragma unroll
            for (int ks = 0; ks < 4; ++ks) { S0 = MFMA32(*(const LAS bf16x8*)(sp + ks * 1024), qf[ks], S0); S1 = MFMA32(*(const LAS bf16x8*)(sp + (4 + ks) * 1024), qf[ks], S1); }
            if (kt == tdiag) {
                const int tq = t0 + col - s0;
#pragma unroll
                for (int r = 0; r < 16; ++r) { const int sl = 16 * (r >> 3) + 8 * hi + (r & 7); if (sl > tq) S0[r] = -INFINITY; if (sl + 32 > tq) S1[r] = -INFINITY; }
            }
            float mloc = fmaxf(fmax16(S0), fmax16(S1)); mloc = fmaxf(mloc, __shfl_xor(mloc, 32));
            const float mnew = fmaxf(mrun, mloc), alpha = __builtin_amdgcn_exp2f(mrun - mnew); mrun = mnew;
            float psum = 0.f;
#pragma unroll
            for (int r = 0; r < 16; ++r) { S0[r] = __builtin_amdgcn_exp2f(S0[r] - mnew); S1[r] = __builtin_amdgcn_exp2f(S1[r] - mnew); psum += S0[r] + S1[r]; }
            lsum = lsum * alpha + psum;
#pragma unroll
            for (int r = 0; r < 16; ++r) { O0[r] *= alpha; O1[r] *= alpha; }
            { const bf16x8 p00 = pack8<0>(S0), p01 = pack8<1>(S0), p10 = pack8<0>(S1), p11 = pack8<1>(S1);
              const LAS unsigned char* vp = sp + 8192;
              O0 = MFMA32(*(const LAS bf16x8*)(vp), p00, O0); O0 = MFMA32(*(const LAS bf16x8*)(vp + 1024), p01, O0); O0 = MFMA32(*(const LAS bf16x8*)(vp + 2048), p10, O0); O0 = MFMA32(*(const LAS bf16x8*)(vp + 3072), p11, O0);
              O1 = MFMA32(*(const LAS bf16x8*)(vp + 4096), p00, O1); O1 = MFMA32(*(const LAS bf16x8*)(vp + 5120), p01, O1); O1 = MFMA32(*(const LAS bf16x8*)(vp + 6144), p10, O1); O1 = MFMA32(*(const LAS bf16x8*)(vp + 7168), p11, O1); }
        }
        asm volatile("" ::: "memory");
        slot = (slot == 2) ? 0 : slot + 1;
    }
#undef FOX_ISSUE
    const float rl = 1.0f / (lsum + __shfl_xor(lsum, 32));
    bf16* yp = ybf + rowq * DM + h * 64 + 4 * hi;
#pragma unroll
    for (int g = 0; g < 4; ++g) { *(unsigned long long*)(yp + 8 * g) = (unsigned long long)cvtpk(O0[4 * g] * rl, O0[4 * g + 1] * rl) | ((unsigned long long)cvtpk(O0[4 * g + 2] * rl, O0[4 * g + 3] * rl) << 32);
                                  *(unsigned long long*)(yp + 32 + 8 * g) = (unsigned long long)cvtpk(O1[4 * g] * rl, O1[4 * g + 1] * rl) | ((unsigned long long)cvtpk(O1[4 * g + 2] * rl, O1[4 * g + 3] * rl) << 32); }
    VMWAIT(0); WGBAR();
}

constexpr int LIN_BUF = 30720, LIN_STF = 3 * LIN_BUF;
__device__ __forceinline__ void lin_wg_unit(const MixBufs& B, LAS unsigned char* lbuf, int mx, int b, int h, int es, int wave, int lane) {
    const int col = lane & 31, hi = lane >> 5, hk = (mx == 2) ? (h >> 1) : h; const bool ml = (mx == 0);
    const size_t cbase = (((size_t)mx * BATCH + b) * 4 + h) * SEQ; const int sbase = ((mx * BATCH + b) * 4 + h) * 32;
    if (wave >= 1 && wave <= 4) {
        const bf16* src; size_t step_c, step_hi, step_lo; int np, f0;
        if (wave == 1)      { src = B.ql + ((size_t)mx * M + (size_t)b * SEQ + col) * 256 + hk * 64 + 8 * hi;            step_c = 64 * 256; step_hi = 32 * 256; step_lo = 16; np = 8; f0 = 0; }
        else if (wave == 2) { src = B.kl + ((size_t)mx * M + (size_t)b * SEQ + sig32(col)) * 256 + hk * 64 + 8 * hi;     step_c = 64 * 256; step_hi = 32 * 256; step_lo = 16; np = 8; f0 = 8; }
        else if (wave == 3) { src = B.kt + ((((size_t)mx * BATCH + b) * 4 + hk) * 64 + sig32(col)) * SEQ + 8 * hi;      step_c = 64; step_hi = (size_t)32 * SEQ; step_lo = 16; np = 8; f0 = 16; }
        else                { src = B.vtl + ((((size_t)mx * BATCH + b) * 4 + h) * 96 + 32 * es + col) * SEQ + 8 * hi;   step_c = 64; step_hi = 0; step_lo = 16; np = 4; f0 = 24; }
        const int cl = lane & 15; const bool sc_lane = (lane == 48 || lane == 49);
        const float* cfp = (lane < 16) ? B.a1 + cbase + 4 * cl : (lane < 32) ? B.a2 + cbase + 4 * cl : (lane < 48) ? B.beta + cbase + 4 * cl : (lane == 48) ? B.s1 + sbase : (lane == 49) ? B.s2 + sbase : B.a1 + cbase;
#define LIN_ISSUE(c, bi) do { LAS unsigned char* bb_ = lbuf + (bi) * LIN_BUF + f0 * 1024; const bf16* sc_ = src + (size_t)(c) * step_c; \
            _Pragma("unroll") for (int f = 0; f < 8; ++f) if (f < np) GLDS16(sc_ + (size_t)(f >> 2) * step_hi + (size_t)(f & 3) * step_lo, bb_ + f * 1024); \
            if (wave == 4) GLDS16(cfp + (sc_lane ? 4 * ((c) >> 2) : 64 * (c)), lbuf + (bi) * LIN_BUF + 28 * 1024); } while (0)
        LIN_ISSUE(0, 0); LIN_ISSUE(1, 1);
        if (wave == 4) VMWAIT(5); else VMWAIT(8);
        WGBAR();
        int bi = 2;
        for (int c = 0; c < 32; ++c) {
            const int cc = (c + 2 < 32) ? c + 2 : 31;
            LIN_ISSUE(cc, bi);
            if (wave == 4) VMWAIT(5); else VMWAIT(8);
            WGBAR();
            bi = (bi == 2) ? 0 : bi + 1;
        }
#undef LIN_ISSUE
        VMWAIT(0);
    } else if (wave == 0 || wave == 5) {
        const int tt = (wave == 5) ? 1 : 0;
        float mst = 0.f; int bi = 0;
        WGBAR();
        for (int c = 0; c < 32; ++c) {
            const int s0 = 64 * c;
            const LAS unsigned char* bp = lbuf + bi * LIN_BUF + 16 * lane;
            const LAS unsigned char* sf = lbuf + LIN_STF + (c & 1) * 4096 + 16 * lane;
            const LAS float* cf = (const LAS float*)(lbuf + bi * LIN_BUF + 28 * 1024);
#define LFR(f) (*(const LAS bf16x8*)(bp + (f) * 1024))
            const float S1v = cf[192 + (c & 3)], S2v = cf[196 + (c & 3)];
            float mnew = 0.f;
            if (ml) mnew = fmaxf(S1v + mst, S2v);
            const float a1 = cf[32 * tt + col]; float al = a1, rho = a1, mt = 0.f;
            if (ml) { mt = fmaxf(a1 + mst, cf[64 + 32 * tt + col]); al = a1 - mt; rho = a1 + mst - mt; }
            f32x16 y;
#pragma unroll
            for (int r = 0; r < 16; ++r) y[r] = 0.f;
#pragma unroll
            for (int j = 0; j < 4; ++j) y = MFMA32(*(const LAS bf16x8*)(sf + j * 1024), LFR(tt * 4 + j), y);
            const float er = __expf(rho);
#pragma unroll
            for (int r = 0; r < 16; ++r) y[r] *= er;
            for (int st = 0; st <= tt; ++st) {
                f32x4 bD[2][2];
#pragma unroll
                for (int k = 0; k < 2; ++k) { bD[k][0] = *(const LAS f32x4*)(cf + 128 + 16 * (2 * st + k) + 8 * hi); bD[k][1] = *(const LAS f32x4*)(cf + 128 + 16 * (2 * st + k) + 8 * hi + 4); }
                f32x16 p;
#pragma unroll
                for (int r = 0; r < 16; ++r) p[r] = 0.f;
#pragma unroll
                for (int ks = 0; ks < 4; ++ks) p = MFMA32(LFR(8 + st * 4 + ks), LFR(tt * 4 + ks), p);
#pragma unroll
                for (int r = 0; r < 16; ++r) { float v = p[r] * __expf(al - bD[r >> 3][(r >> 2) & 1][r & 3]); if (st == tt && (16 * (r >> 3) + 8 * hi + (r & 7)) > col) v = 0.f; p[r] = v; }
                y = MFMA32(LFR(24 + 2 * st), pack8<0>(p), y); y = MFMA32(LFR(24 + 2 * st + 1), pack8<1>(p), y);
            }
            { const size_t row = (size_t)b * SEQ + s0 + 32 * tt + col;
              if (es < 2) { bf16* yp = (bf16*)B.yraw + row * 1024 + 256 * (mx + 1) + h * 64 + 32 * es + 4 * hi;
#pragma unroll
                  for (int g = 0; g < 4; ++g) *(unsigned long long*)(yp + 8 * g) = (unsigned long long)cvtpk(y[4 * g], y[4 * g + 1]) | ((unsigned long long)cvtpk(y[4 * g + 2], y[4 * g + 3]) << 32); }
              else if (hi == 0) { B.den[row * 8 + h * 2] = y[0]; B.den[row * 8 + h * 2 + 1] = mt; } }
#undef LFR
            if (ml) mst = mnew;
            asm volatile("s_waitcnt lgkmcnt(0)" ::: "memory");
            WGBAR();
            bi = (bi == 2) ? 0 : bi + 1;
        }
    } else if (wave == 6) {
        f32x16 st0, st1;
#pragma unroll
        for (int r = 0; r < 16; ++r) { st0[r] = 0.f; st1[r] = 0.f; }
        { LAS unsigned char* sf = lbuf + LIN_STF + 16 * lane;
#pragma unroll
          for (int j = 0; j < 4; ++j) *(LAS v4u*)(sf + j * 1024) = (v4u){0u, 0u, 0u, 0u}; }
        float mst = 0.f; int bi = 0;
        asm volatile("s_waitcnt lgkmcnt(0)" ::: "memory");
        WGBAR();
        for (int c = 0; c < 32; ++c) {
            const LAS unsigned char* bp = lbuf + bi * LIN_BUF + 16 * lane;
            const LAS float* cf = (const LAS float*)(lbuf + bi * LIN_BUF + 28 * 1024);
#define LFR(f) (*(const LAS bf16x8*)(bp + (f) * 1024))
            const float S1v = cf[192 + (c & 3)], S2v = cf[196 + (c & 3)];
            float gam = S1v, dlt = S1v, mnew = 0.f;
            if (ml) { mnew = fmaxf(S1v + mst, S2v); gam = S1v - mnew; dlt = S1v + mst - mnew; }
            const float ed = __expf(dlt);
#pragma unroll
            for (int r = 0; r < 16; ++r) { st0[r] *= ed; st1[r] *= ed; }
#pragma unroll
            for (int k4 = 0; k4 < 4; ++k4) {
                const bf16x8 vr = LFR(24 + k4); const f32x4 b0 = *(const LAS f32x4*)(cf + 128 + 16 * k4 + 8 * hi), b1 = *(const LAS f32x4*)(cf + 128 + 16 * k4 + 8 * hi + 4);
                v4u wv; wv.x = cvtpk(bf2f((unsigned short)vr[0]) * __expf(gam - b0[0]), bf2f((unsigned short)vr[1]) * __expf(gam - b0[1])); wv.y = cvtpk(bf2f((unsigned short)vr[2]) * __expf(gam - b0[2]), bf2f((unsigned short)vr[3]) * __expf(gam - b0[3]));
                wv.z = cvtpk(bf2f((unsigned short)vr[4]) * __expf(gam - b1[0]), bf2f((unsigned short)vr[5]) * __expf(gam - b1[1])); wv.w = cvtpk(bf2f((unsigned short)vr[6]) * __expf(gam - b1[2]), bf2f((unsigned short)vr[7]) * __expf(gam - b1[3]));
                const bf16x8 wvf = __builtin_bit_cast(bf16x8, wv);
                st0 = MFMA32(LFR(16 + k4), wvf, st0); st1 = MFMA32(LFR(20 + k4), wvf, st1);
            }
#undef LFR
            { LAS unsigned char* sf = lbuf + LIN_STF + ((c + 1) & 1) * 4096 + 16 * lane;
              *(LAS bf16x8*)(sf) = pack8<0>(st0); *(LAS bf16x8*)(sf + 1024) = pack8<1>(st0); *(LAS bf16x8*)(sf + 2048) = pack8<0>(st1); *(LAS bf16x8*)(sf + 3072) = pack8<1>(st1); }
            if (ml) mst = mnew;
            asm volatile("s_waitcnt lgkmcnt(0)" ::: "memory");
            WGBAR();
            bi = (bi == 2) ? 0 : bi + 1;
        }
    } else {
        for (int c = 0; c < 33; ++c) WGBAR();
    }
    VMWAIT(0); WGBAR();
}
constexpr int MX_LC = 3 * 16384, MX_LIN = MX_LC + 8192, MX_STF = MX_LIN + 3 * LIN_BUF;
static_assert(MX_STF + 8192 <= LDSCTL_OFF, "mixer LDS map");
__device__ __forceinline__ void mixer_phase(const MixBufs& B, bf16* ybf, LAS unsigned char* lds, int vcu, int wave, int lane) {
    const int G = gridDim.x;
    const int col = lane & 31, hi = lane >> 5;
    for (int v = vcu; v < 256; v += G) {
        const int bh = v >> 3, i8 = v & 7, fb = bh >> 2, fh = bh & 3;
        const int nktA = 2 * i8 + 2, NF = 34;
        const bool has_lin = i8 < 7; const int lj = (bh & 3) * 7 + i8;
        int mx, lh, es; const int lb = fb; if (lj < 12) { mx = 0; lh = lj / 3; es = lj % 3; } else { const int w2 = lj - 12; mx = 1 + (w2 >> 3); lh = (w2 >> 1) & 3; es = w2 & 1; }
        const int hk = (mx == 2) ? (lh >> 1) : lh; const bool ml = (mx == 0);
        const size_t cbase = (((size_t)mx * BATCH + lb) * 4 + lh) * SEQ; const int sbase = ((mx * BATCH + lb) * 4 + lh) * 32;
        if (wave < 4) {
            int qb16 = i8, t0 = 128 * qb16 + 32 * wave, tdiag = 2 * qb16 + (wave >> 1);
            size_t rowq = (size_t)fb * SEQ + t0 + col;
            bf16x8 qf[4];
#pragma unroll
            for (int ks = 0; ks < 4; ++ks) qf[ks] = *(const bf16x8*)(B.proj + rowq * PROJ_LD + PC_FQ + fh * 64 + 16 * ks + 8 * hi);
            float offv; { const float cv = (lane < 32) ? B.ctot[(fb * 4 + fh) * 32 + lane] : 0.f; offv = wave_scan_add(cv, lane) - cv; }
            GLDS16(B.lcum + (size_t)(fb * 4 + fh) * SEQ + 256 * wave + 4 * lane, lds + MX_LC + 1024 * wave);
            GLDS16(B.lcum + (size_t)(fb * 4 + fh) * SEQ + 256 * (wave + 4) + 4 * lane, lds + MX_LC + 1024 * (wave + 4));
            const bf16* ksrc = B.proj + ((size_t)fb * SEQ + sig32(col)) * PROJ_LD + PC_FK + fh * 64 + 16 * wave + 8 * hi;
            const bf16* vsrc = B.vtf + ((size_t)(fb * 4 + fh) * 64 + col) * SEQ + 16 * wave + 8 * hi;
#define FOX_ISSUE(kt, slot) do { LAS unsigned char* d_ = lds + (slot) * FOX_SLOT + 1024 * wave; const bf16* k_ = ksrc + (size_t)(64 * (kt)) * PROJ_LD; const bf16* v_ = vsrc + 64 * (kt); \
                GLDS16(k_, d_); GLDS16(k_ + (size_t)32 * PROJ_LD, d_ + 4096); GLDS16(v_, d_ + 8192); GLDS16(v_ + (size_t)32 * SEQ, d_ + 12288); } while (0)
            FOX_ISSUE(0, 0); FOX_ISSUE(1, 1);
            VMWAIT(8); WGBAR();
#pragma unroll
            for (int pz = 0; pz < 2; ++pz) { const int pc_ = wave + 4 * pz;
                LAS f32x4* lp = (LAS f32x4*)(lds + MX_LC + 1024 * pc_) + lane; const f32x4 cv = *lp; const float o = __shfl(offv, 4 * pc_ + (lane >> 4)); *lp = (cv + o) * (-LOG2E); }
            asm volatile("s_waitcnt lgkmcnt(0)" ::: "memory"); WGBAR();
            float mrun = -INFINITY, lsum = 0.f; f32x16 O0, O1;
#pragma unroll
            for (int r = 0; r < 16; ++r) { O0[r] = 0.f; O1[r] = 0.f; }
            int sl = 0;
            for (int f = 0; f < NF; ++f) {
                if (f + 1 < NF) VMWAIT(4); else VMWAIT(0);
                WGBAR();
                if (f + 2 < NF) { const int kn = (f + 2 < nktA) ? f + 2 : f + 2 - nktA; FOX_ISSUE(kn, (sl == 0) ? 2 : sl - 1); }
                if (f == nktA) {
                    const float rl = 1.0f / (lsum + __shfl_xor(lsum, 32));
                    bf16* yp = ybf + rowq * DM + fh * 64 + 4 * hi;
#pragma unroll
                    for (int g = 0; g < 4; ++g) { *(unsigned long long*)(yp + 8 * g) = (unsigned long long)cvtpk(O0[4 * g] * rl, O0[4 * g + 1] * rl) | ((unsigned long long)cvtpk(O0[4 * g + 2] * rl, O0[4 * g + 3] * rl) << 32);
                                                  *(unsigned long long*)(yp + 32 + 8 * g) = (unsigned long long)cvtpk(O1[4 * g] * rl, O1[4 * g + 1] * rl) | ((unsigned long long)cvtpk(O1[4 * g + 2] * rl, O1[4 * g + 3] * rl) << 32); }
                    qb16 = 15 - i8; t0 = 128 * qb16 + 32 * wave; tdiag = 2 * qb16 + (wave >> 1); rowq = (size_t)fb * SEQ + t0 + col;
#pragma unroll
                    for (int ks = 0; ks < 4; ++ks) qf[ks] = *(const bf16x8*)(B.proj + rowq * PROJ_LD + PC_FQ + fh * 64 + 16 * ks + 8 * hi);
                    mrun = -INFINITY; lsum = 0.f;
#pragma unroll
                    for (int r = 0; r < 16; ++r) { O0[r] = 0.f; O1[r] = 0.f; }
                }
                const int kt = (f < nktA) ? f : f - nktA;
                if (kt <= tdiag) {
                    const int s0 = 64 * kt;
                    const LAS unsigned char* sp = lds + sl * FOX_SLOT + 16 * lane;
                    const LAS float* lc = (const LAS float*)(lds + MX_LC) + s0 + 8 * hi;
                    f32x16 S0, S1;
#pragma unroll
                    for (int j = 0; j < 4; ++j) { const f32x4 c0 = *(const LAS f32x4*)(lc + 16 * j), c1 = *(const LAS f32x4*)(lc + 16 * j + 4);
#pragma unroll
                        for (int i = 0; i < 4; ++i) { if (j < 2) { S0[8 * j + i] = c0[i]; S0[8 * j + 4 + i] = c1[i]; } else { S1[8 * (j - 2) + i] = c0[i]; S1[8 * (j - 2) + 4 + i] = c1[i]; } } }
#pragma unroll
                    for (int ks = 0; ks < 4; ++ks) { S0 = MFMA32(*(const LAS bf16x8*)(sp + ks * 1024), qf[ks], S0); S1 = MFMA32(*(const LAS bf16x8*)(sp + (4 + ks) * 1024), qf[ks], S1); }
                    if (kt == tdiag) {
                        const int tq = t0 + col - s0;
#pragma unroll
                        for (int r = 0; r < 16; ++r) { const int sl = 16 * (r >> 3) + 8 * hi + (r & 7); if (sl > tq) S0[r] = -INFINITY; if (sl + 32 > tq) S1[r] = -INFINITY; }
                    }
                    float mloc = fmaxf(fmax16(S0), fmax16(S1)); mloc = fmaxf(mloc, __shfl_xor(mloc, 32));
                    const float mnew = fmaxf(mrun, mloc), alpha = __builtin_amdgcn_exp2f(mrun - mnew); mrun = mnew;
                    float psum = 0.f;
#pragma unroll
                    for (int r = 0; r < 16; ++r) { S0[r] = __builtin_amdgcn_exp2f(S0[r] - mnew); S1[r] = __builtin_amdgcn_exp2f(S1[r] - mnew); psum += S0[r] + S1[r]; }
                    lsum = lsum * alpha + psum;
#pragma unroll
                    for (int r = 0; r < 16; ++r) { O0[r] *= alpha; O1[r] *= alpha; }
                    { const bf16x8 p00 = pack8<0>(S0), p01 = pack8<1>(S0), p10 = pack8<0>(S1), p11 = pack8<1>(S1);
                      const LAS unsigned char* vp = sp + 8192;
                      O0 = MFMA32(*(const LAS bf16x8*)(vp), p00, O0); O0 = MFMA32(*(const LAS bf16x8*)(vp + 1024), p01, O0); O0 = MFMA32(*(const LAS bf16x8*)(vp + 2048), p10, O0); O0 = MFMA32(*(const LAS bf16x8*)(vp + 3072), p11, O0);
                      O1 = MFMA32(*(const LAS bf16x8*)(vp + 4096), p00, O1); O1 = MFMA32(*(const LAS bf16x8*)(vp + 5120), p01, O1); O1 = MFMA32(*(const LAS bf16x8*)(vp + 6144), p10, O1); O1 = MFMA32(*(const LAS bf16x8*)(vp + 7168), p11, O1); }
                }
                asm volatile("s_waitcnt lgkmcnt(0)" ::: "memory");
                sl = (sl == 2) ? 0 : sl + 1;
            }
#undef FOX_ISSUE
            { const float rl = 1.0f / (lsum + __shfl_xor(lsum, 32));
              bf16* yp = ybf + rowq * DM + fh * 64 + 4 * hi;
#pragma unroll
              for (int g = 0; g < 4; ++g) { *(unsigned long long*)(yp + 8 * g) = (unsigned long long)cvtpk(O0[4 * g] * rl, O0[4 * g + 1] * rl) | ((unsigned long long)cvtpk(O0[4 * g + 2] * rl, O0[4 * g + 3] * rl) << 32);
                                            *(unsigned long long*)(yp + 32 + 8 * g) = (unsigned long long)cvtpk(O1[4 * g] * rl, O1[4 * g + 1] * rl) | ((unsigned long long)cvtpk(O1[4 * g + 2] * rl, O1[4 * g + 3] * rl) << 32); } }
        } else {
            const bf16* src; size_t step_c, step_hi; int np, f0;
            if (wave == 4)      { src = B.ql + ((size_t)mx * M + (size_t)lb * SEQ + col) * 256 + hk * 64 + 8 * hi;            step_c = 64 * 256; step_hi = 32 * 256; np = 8; f0 = 0; }
            else if (wave == 6) { src = B.kt + ((((size_t)mx * BATCH + lb) * 4 + hk) * 64 + sig32(col)) * SEQ + 8 * hi;      step_c = 64; step_hi = (size_t)32 * SEQ; np = 8; f0 = 16; }
            else if (wave == 7) { src = B.vtl + ((((size_t)mx * BATCH + lb) * 4 + lh) * 96 + 32 * es + col) * SEQ + 8 * hi;  step_c = 64; step_hi = 0; np = 4; f0 = 24; }
            else                { src = B.ql; step_c = 0; step_hi = 0; np = 0; f0 = 0; }
            const bf16* srck = B.kl + ((size_t)mx * M + (size_t)lb * SEQ + sig32(col)) * 256 + hk * 64 + 8 * hi;
            const int cl = lane & 15; const bool sc_lane = (lane == 48 || lane == 49);
            const float* cfp = (lane < 16) ? B.a1 + cbase + 4 * cl : (lane < 32) ? B.a2 + cbase + 4 * cl : (lane < 48) ? B.beta + cbase + 4 * cl : (lane == 48) ? B.s1 + sbase : (lane == 49) ? B.s2 + sbase : B.a1 + cbase;
            LAS unsigned char* lbuf = lds + MX_LIN;
#define LIN_ISSUE(c, bi) do { LAS unsigned char* bb_ = lbuf + (bi) * LIN_BUF + f0 * 1024; const bf16* sc_ = src + (size_t)(c) * step_c; \
                _Pragma("unroll") for (int f = 0; f < 8; ++f) if (f < np) GLDS16(sc_ + (size_t)(f >> 2) * step_hi + (size_t)(f & 3) * 16, bb_ + f * 1024); \
                if (wave == 7) { const bf16* sk_ = srck + (size_t)(c) * (64 * 256); LAS unsigned char* bk_ = lbuf + (bi) * LIN_BUF + 8 * 1024; \
                    _Pragma("unroll") for (int f = 0; f < 8; ++f) GLDS16(sk_ + (size_t)(f >> 2) * (32 * 256) + (size_t)(f & 3) * 16, bk_ + f * 1024); \
                    GLDS16(cfp + (sc_lane ? 4 * ((c) >> 2) : 64 * (c)), lbuf + (bi) * LIN_BUF + 28 * 1024); } } while (0)
            if (has_lin) { LIN_ISSUE(0, 0); LIN_ISSUE(1, 1); }
            f32x16 st0, st1;
#pragma unroll
            for (int r = 0; r < 16; ++r) { st0[r] = 0.f; st1[r] = 0.f; }
            if (wave == 6) { LAS unsigned char* sf = lds + MX_STF + 16 * lane;
#pragma unroll
                for (int j = 0; j < 4; ++j) *(LAS v4u*)(sf + j * 1024) = (v4u){0u, 0u, 0u, 0u}; }
            asm volatile("s_waitcnt lgkmcnt(0)" ::: "memory"); WGBAR();
            WGBAR();
            float mst = 0.f; int bi = 0;
            for (int c = 0; c < NF; ++c) {
                if (c + 1 < 32) { if (wave == 7) VMWAIT(13); else if (wave == 5) VMWAIT(0); else VMWAIT(8); } else VMWAIT(0);
                WGBAR();
                if (has_lin && c < 32) {
                    if (c + 2 < 32) LIN_ISSUE(c + 2, (bi == 0) ? 2 : bi - 1);
                    const LAS unsigned char* bp = lbuf + bi * LIN_BUF + 16 * lane;
                    const LAS float* cf = (const LAS float*)(lbuf + bi * LIN_BUF + 28 * 1024);
#define LFR(f) (*(const LAS bf16x8*)(bp + (f) * 1024))
                    if (wave == 4 || wave == 5) {
                        const int tt = wave - 4, s0 = 64 * c;
                        const LAS unsigned char* sf = lds + MX_STF + (c & 1) * 4096 + 16 * lane;
                        const float S1v = cf[192 + (c & 3)], S2v = cf[196 + (c & 3)];
                        float mnew = 0.f;
                        if (ml) mnew = fmaxf(S1v + mst, S2v);
                        const float a1 = cf[32 * tt + col]; float al = a1, rho = a1, mt = 0.f;
                        if (ml) { mt = fmaxf(a1 + mst, cf[64 + 32 * tt + col]); al = a1 - mt; rho = a1 + mst - mt; }
                        f32x16 y;
#pragma unroll
                        for (int r = 0; r < 16; ++r) y[r] = 0.f;
#pragma unroll
                        for (int j = 0; j < 4; ++j) y = MFMA32(*(const LAS bf16x8*)(sf + j * 1024), LFR(tt * 4 + j), y);
                        const float er = __expf(rho);
#pragma unroll
                        for (int r = 0; r < 16; ++r) y[r] *= er;
                        for (int st = 0; st <= tt; ++st) {
                            f32x4 bD[2][2];
#pragma unroll
                            for (int k = 0; k < 2; ++k) { bD[k][0] = *(const LAS f32x4*)(cf + 128 + 16 * (2 * st + k) + 8 * hi); bD[k][1] = *(const LAS f32x4*)(cf + 128 + 16 * (2 * st + k) + 8 * hi + 4); }
                            f32x16 p;
#pragma unroll
                            for (int r = 0; r < 16; ++r) p[r] = 0.f;
#pragma unroll
                            for (int ks = 0; ks < 4; ++ks) p = MFMA32(LFR(8 + st * 4 + ks), LFR(tt * 4 + ks), p);
#pragma unroll
                            for (int r = 0; r < 16; ++r) { float vv = p[r] * __expf(al - bD[r >> 3][(r >> 2) & 1][r & 3]); if (st == tt && (16 * (r >> 3) + 8 * hi + (r & 7)) > col) vv = 0.f; p[r] = vv; }
                            y = MFMA32(LFR(24 + 2 * st), pack8<0>(p), y); y = MFMA32(LFR(24 + 2 * st + 1), pack8<1>(p), y);
                        }
                        { const size_t row = (size_t)lb * SEQ + s0 + 32 * tt + col;
                          if (es < 2) { bf16* yp = (bf16*)B.yraw + row * 1024 + 256 * (mx + 1) + lh * 64 + 32 * es + 4 * hi;
#pragma unroll
                              for (int g = 0; g < 4; ++g) *(unsigned long long*)(yp + 8 * g) = (unsigned long long)cvtpk(y[4 * g], y[4 * g + 1]) | ((unsigned long long)cvtpk(y[4 * g + 2], y[4 * g + 3]) << 32); }
                          else if (hi == 0) { B.den[row * 8 + lh * 2] = y[0]; B.den[row * 8 + lh * 2 + 1] = mt; } }
                        if (ml) mst = mnew;
                    } else if (wave == 6) {
                        const float S1v = cf[192 + (c & 3)], S2v = cf[196 + (c & 3)];
                        float gam = S1v, dlt = S1v, mnew = 0.f;
                        if (ml) { mnew = fmaxf(S1v + mst, S2v); gam = S1v - mnew; dlt = S1v + mst - mnew; }
                        const float ed = __expf(dlt);
#pragma unroll
                        for (int r = 0; r < 16; ++r) { st0[r] *= ed; st1[r] *= ed; }
#pragma unroll
                        for (int k4 = 0; k4 < 4; ++k4) {
                            const bf16x8 vr = LFR(24 + k4); const f32x4 b0 = *(const LAS f32x4*)(cf + 128 + 16 * k4 + 8 * hi), b1 = *(const LAS f32x4*)(cf + 128 + 16 * k4 + 8 * hi + 4);
                            v4u wv; wv.x = cvtpk(bf2f((unsigned short)vr[0]) * __expf(gam - b0[0]), bf2f((unsigned short)vr[1]) * __expf(gam - b0[1])); wv.y = cvtpk(bf2f((unsigned short)vr[2]) * __expf(gam - b0[2]), bf2f((unsigned short)vr[3]) * __expf(gam - b0[3]));
                            wv.z = cvtpk(bf2f((unsigned short)vr[4]) * __expf(gam - b1[0]), bf2f((unsigned short)vr[5]) * __expf(gam - b1[1])); wv.w = cvtpk(bf2f((unsigned short)vr[6]) * __expf(gam - b1[2]), bf2f((unsigned short)vr[7]) * __expf(gam - b1[3]));
                            const bf16x8 wvf = __builtin_bit_cast(bf16x8, wv);
                            st0 = MFMA32(LFR(16 + k4), wvf, st0); st1 = MFMA32(LFR(20 + k4), wvf, st1);
                        }
                        { LAS unsigned char* sf = lds + MX_STF + ((c + 1) & 1) * 4096 + 16 * lane;
                          *(LAS bf16x8*)(sf) = pack8<0>(st0); *(LAS bf16x8*)(sf + 1024) = pack8<1>(st0); *(LAS bf16x8*)(sf + 2048) = pack8<0>(st1); *(LAS bf16x8*)(sf + 3072) = pack8<1>(st1); }
                        if (ml) mst = mnew;
                    }
#undef LFR
                }
                asm volatile("s_waitcnt lgkmcnt(0)" ::: "memory");
                bi = (bi == 2) ? 0 : bi + 1;
            }
#undef LIN_ISSUE
        }
        VMWAIT(0); WGBAR();
    }
}
__device__ __forceinline__ f32x4 unpack4bf(unsigned long long q) { return (f32x4){__uint_as_float((unsigned)q << 16), __uint_as_float((unsigned)q & 0xffff0000u), __uint_as_float((unsigned)(q >> 32) << 16), __uint_as_float((unsigned)(q >> 32) & 0xffff0000u)}; }
__device__ __forceinline__ void unpack8bf(const v4u q, f32x4& lo, f32x4& hi) {
    lo = (f32x4){__uint_as_float(q.x << 16), __uint_as_float(q.x & 0xffff0000u), __uint_as_float(q.y << 16), __uint_as_float(q.y & 0xffff0000u)};
    hi = (f32x4){__uint_as_float(q.z << 16), __uint_as_float(q.z & 0xffff0000u), __uint_as_float(q.w << 16), __uint_as_float(q.w & 0xffff0000u)}; }
__device__ __forceinline__ void post_new(const MixBufs& B, bf16* ybf, const float* mng, const float* rng, const float* sng, const float* sD, int gw, int NGW, int lane) {
    constexpr int P = 4;
    const int hl = lane >> 5, l5 = lane & 31, c8 = 8 * l5, hd = l5 >> 3;
    f32x4 gn[3][2];
#pragma unroll
    for (int h2 = 0; h2 < 2; ++h2) { gn[0][h2] = *(const f32x4*)(mng + c8 + 4 * h2); gn[1][h2] = *(const f32x4*)(rng + c8 + 4 * h2); gn[2][h2] = *(const f32x4*)(sng + c8 + 4 * h2); }
    const float Dh = sD[hd];
    for (int k0 = 0; k0 < M / NGW; k0 += 2 * P) {
        v4u yq[P][3], gq[P][3], xq[P]; float dn[P], mt[P];
#pragma unroll
        for (int j = 0; j < P; ++j) { const int kk = k0 + 2 * j + hl; const int m = (NGW == 2048) ? ((gw >> 8) * SEQ + (gw & 255) + 256 * kk) : (gw + kk * NGW); const size_t r = (size_t)m;
#pragma unroll
            for (int mx = 0; mx < 3; ++mx) yq[j][mx] = *(const v4u*)((const bf16*)B.yraw + r * 1024 + 256 * (mx + 1) + c8);
            gq[j][0] = *(const v4u*)(B.proj + r * PROJ_LD + PC_MO + c8); gq[j][1] = *(const v4u*)(B.proj + r * PROJ_LD + PC_RG + c8); gq[j][2] = *(const v4u*)(B.proj + r * PROJ_LD + PC_SZ + c8);
            xq[j] = *(const v4u*)((const bf16*)B.xs + r * 256 + c8); dn[j] = B.den[r * 8 + hd * 2]; mt[j] = B.den[r * 8 + hd * 2 + 1]; }
#pragma unroll
        for (int j = 0; j < P; ++j) { const int kk = k0 + 2 * j + hl; const int m = (NGW == 2048) ? ((gw >> 8) * SEQ + (gw & 255) + 256 * kk) : (gw + kk * NGW); const size_t r = (size_t)m;
            bf16* orow = ybf + r * DM + c8;
#pragma unroll
            for (int mx = 0; mx < 2; ++mx) {
                f32x4 v0, v1; unpack8bf(yq[j][mx], v0, v1);
                if (mx == 0) { const float sc = 1.0f / fmaxf(fabsf(dn[j]), __expf(-mt[j])); v0 = v0 * sc; v1 = v1 * sc; }
                float ss = ((v0.x * v0.x + v0.y * v0.y) + (v0.z * v0.z + v0.w * v0.w)) + ((v1.x * v1.x + v1.y * v1.y) + (v1.z * v1.z + v1.w * v1.w));
                ss += __shfl_xor(ss, 1); ss += __shfl_xor(ss, 2); ss += __shfl_xor(ss, 4);
                const float rstd = 1.0f / sqrtf(ss * (1.0f / 64.0f) + RMS_EPS);
                f32x4 g0, g1; unpack8bf(gq[j][mx], g0, g1);
#pragma unroll
                for (int i = 0; i < 4; ++i) { g0[i] = mx == 0 ? sigmoid_f(g0[i]) : silu_acc(g0[i]); g1[i] = mx == 0 ? sigmoid_f(g1[i]) : silu_acc(g1[i]); }
                const f32x4 o0 = g0 * (v0 * rstd * gn[mx][0]), o1 = g1 * (v1 * rstd * gn[mx][1]);
                *(GAS v4u*)(orow + 256 * (mx + 1)) = (v4u){pk2(o0.x, o0.y), pk2(o0.z, o0.w), pk2(o1.x, o1.y), pk2(o1.z, o1.w)};
            }
            { f32x4 h0, h1, z0, z1, x0, x1; unpack8bf(yq[j][2], h0, h1); unpack8bf(gq[j][2], z0, z1); unpack8bf(xq[j], x0, x1); f32x4 v0, v1;
#pragma unroll
              for (int i = 0; i < 4; ++i) { v0[i] = (h0[i] + Dh * x0[i]) * silu_acc(z0[i]); v1[i] = (h1[i] + Dh * x1[i]) * silu_acc(z1[i]); }
              float ss = ((v0.x * v0.x + v0.y * v0.y) + (v0.z * v0.z + v0.w * v0.w)) + ((v1.x * v1.x + v1.y * v1.y) + (v1.z * v1.z + v1.w * v1.w));
              ss += __shfl_xor(ss, 1); ss += __shfl_xor(ss, 2); ss += __shfl_xor(ss, 4); ss += __shfl_xor(ss, 8); ss += __shfl_xor(ss, 16);
              const float rstd = 1.0f / sqrtf(ss * (1.0f / 256.0f) + RMS_EPS);
              const f32x4 o0 = v0 * rstd * gn[2][0], o1 = v1 * rstd * gn[2][1];
              *(GAS v4u*)(orow + 768) = (v4u){pk2(o0.x, o0.y), pk2(o0.z, o0.w), pk2(o1.x, o1.y), pk2(o1.z, o1.w)}; }
        }
    }
}
__device__ __forceinline__ void final_norm(float* x, const float* g, int gw, int NGW, int lane) {
    constexpr int R = 4;
    f32x4 gv[4];
#pragma unroll
    for (int j = 0; j < 4; ++j) gv[j] = ((const f32x4*)g)[lane + 64 * j];
    for (int k0 = 0; k0 < M / NGW; k0 += R) {
        f32x4 v[R][4];
#pragma unroll
        for (int q = 0; q < R; ++q) { const int m = (NGW == 2048) ? ((gw >> 8) * SEQ + (gw & 255) + 256 * (k0 + q)) : (gw + (k0 + q) * NGW);
            const GAS f32x4* xr = (const GAS f32x4*)(x + (size_t)m * DM) + lane;
#pragma unroll
            for (int j = 0; j < 4; ++j) v[q][j] = xr[64 * j]; }
#pragma unroll
        for (int q = 0; q < R; ++q) { const int m = (NGW == 2048) ? ((gw >> 8) * SEQ + (gw & 255) + 256 * (k0 + q)) : (gw + (k0 + q) * NGW);
            GAS f32x4* xr = (GAS f32x4*)(x + (size_t)m * DM) + lane; float s = 0.f;
#pragma unroll
            for (int j = 0; j < 4; ++j) s += (v[q][j].x * v[q][j].x + v[q][j].y * v[q][j].y) + (v[q][j].z * v[q][j].z + v[q][j].w * v[q][j].w);
            const float rstd = 1.0f / sqrtf(wave_sum(s) * (1.0f / DM) + RMS_EPS);
#pragma unroll
            for (int j = 0; j < 4; ++j) xr[64 * j] = v[q][j] * rstd * gv[j]; }
    }
}

__global__ void __launch_bounds__(NTHR, 2) fwd(Args a) {
    extern __shared__ __attribute__((aligned(16))) unsigned char lds_raw[];
    LAS unsigned char* lds = (LAS unsigned char*)lds_raw;
    const int tid = threadIdx.x, lane = tid & 63, wave = __builtin_amdgcn_readfirstlane(tid >> 6), G = gridDim.x;
    const int gw = blockIdx.x * NWAVES + wave, NGW = G * NWAVES;
    unsigned char* ws = a.ws;
    for (int u = tid; u < (LDS_BYTES - LDSCTL_OFF) / 4; u += NTHR) ((LAS unsigned*)(lds + LDSCTL_OFF))[u] = 0u;
    __syncthreads();
    const int lo = a.ph_lo, hi = a.ph_hi;
    XcdBarrier bar; bar.bar = (unsigned*)(ws + WS_CTL) + CW_BAR; bar.x = 0; bar.st = nullptr;
    if (hi - lo > 1) bar = xcd_barrier_post((unsigned*)(ws + WS_CTL) + CW_BAR, (volatile LAS unsigned*)(lds + MISC_OFF) + 8);
    volatile LAS unsigned* MISCW = (volatile LAS unsigned*)(lds + MISC_OFF);
    if (hi - lo > 1 && tid == 0) MISCW[16] = xb_add(&bar.bar[XB_RANK(bar.x)], 1u);
    int bid = (int)blockIdx.x; bool loc = false;
#define IN(k) (lo <= (k) && (k) < hi)
#define PH_IDS int t_ = threadIdx.x; asm volatile("" : "+v"(t_)); const int lane_ = t_ & 63, wave_ = __builtin_amdgcn_readfirstlane(t_ >> 6), gw_ = blockIdx.x * NWAVES + wave_; (void)lane_; (void)gw_; (void)wave_;
#define SEAM(k) do { if ((k) + 1 < hi) { if (loc) xcd_local_barrier(bar.bar, bar.x, 32u); else xcd_barrier(bar); } } while (0)
    float* xres = a.out;
    float* cond = (float*)(ws + WS_COND); const float2* rope = (const float2*)(ws + WS_ROPE);
    bf16* HB = (bf16*)(ws + WS_HB); bf16* ACT = (bf16*)(ws + WS_ACT); bf16* PROJ = (bf16*)(ws + WS_PROJ); float* GATES = (float*)(ws + WS_GATES);
    bf16* YBF = (bf16*)(ws + WS_YBF);
#define MK_MB unsigned char* ws_ = a.ws; asm volatile("" : "+s"(ws_)); MixBufs MB; MB.proj = (const bf16*)(ws_ + WS_PROJ); MB.gates = (const float*)(ws_ + WS_GATES); MB.vtf = (bf16*)(ws_ + WS_VTF); MB.lcum = (float*)(ws_ + WS_COEF + COEF_LCUM); MB.ctot = (float*)(ws_ + WS_COEF + COEF_CTOT); \
    MB.ql = (bf16*)(ws_ + WS_QL); MB.kl = (bf16*)(ws_ + WS_KL); MB.kt = (bf16*)(ws_ + WS_KT); MB.vtl = (bf16*)(ws_ + WS_VTL); MB.xs = (float*)(ws_ + WS_XS); \
    MB.a1 = (float*)(ws_ + WS_COEF + COEF_A1); MB.a2 = (float*)(ws_ + WS_COEF + COEF_A2); MB.beta = (float*)(ws_ + WS_COEF + COEF_BETA); MB.s1 = (float*)(ws_ + WS_COEF + COEF_S1); MB.s2 = (float*)(ws_ + WS_COEF + COEF_S2); \
    MB.den = (float*)(ws_ + WS_DEN); MB.yraw = (float*)(ws_ + WS_YRAW); bf16* YBF_ = (bf16*)(ws_ + WS_YBF); (void)YBF_;
    long long* SS = (long long*)(ws + WS_SS);
    if (IN(0)) { PH_IDS prologue0(a, lds, t_, lane_, wave_, G); SEAM(0); }
    if (IN(1)) { PH_IDS prologue1(a, lds, lane_, wave_, G); thin_xg(a.in[0], HB, (bf16*)(ws + WS_XB), a.in[4], cond, 1 * DM, SS, gw_, NGW, lane_); SEAM(1);
        { const long long* q = (const long long*)(ws + WS_BIASQ); float* bf = (float*)(ws + WS_BIAS);
          for (int i = blockIdx.x * NTHR + t_; i < (int)(BIAS_BYTES / 4); i += G * NTHR) bf[i] = (float)((double)q[i] * (1.0 / 4294967296.0)); }
        SEAM(1); }
    if (lo == 0 && hi == PH_END && G == 256) {
        if (tid == 0) { bool ok = true;
#pragma unroll
            for (unsigned j = 0; j < 16; ++j) { const unsigned cnt = xb_ld(&bar.bar[XB_RANK(j)]); ok = ok && (cnt == (j < 8 ? 32u : 0u)); }
            MISCW[17] = ok ? 1u : 0u; }
        __syncthreads();
        if (MISCW[17]) { loc = true; bid = __builtin_amdgcn_readfirstlane((int)(MISCW[16] * 8u + bar.x)); }
    }
    const int vcu = (G % 8 == 0) ? (bid % 8) * (G / 8) + bid / 8 : bid;
    for (int l = 0; l < DEPTH; ++l) {
        const int pb = PH_LAYER0 + PH_PER_LAYER * l;
        if (hi <= pb || lo >= pb + PH_PER_LAYER) continue;
        const float* cond_l = cond + (size_t)l * BATCH * NCOND;
        unsigned char* wl = ws + WS_W + (size_t)l * LAYER_W;
        const float* xin = (l == 0) ? a.in[0] : xres;
        const float* bias_l = (const float*)(ws + WS_BIAS + (size_t)l * 3 * BIAS_USE);
        long long* ss0 = SS + (size_t)(3 * l) * M;
        const float* ng = a.in[4] + (size_t)(l * 3) * DM;
        if (IN(pb + 0)) { pg8::Gemm g{HB, (const bf16*)(wl + OFF_UP1), M, NUP, DM}; pg8::StaticOrder S; S.init(M, NUP, G, bid); pg8::EpiSwigluN E{ACT, PROJ_LD, ss0, bias_l, NUP};
            pg8::gemm_phase<pg8::EpiSwigluN, pg8::StaticOrder, true, true>(lds, g, S, E); if (REP_UP > 1) { __syncthreads(); pg8::gemm_phase<pg8::EpiSwigluN, pg8::StaticOrder, true, true>(lds, g, S, E); } SEAM(pb + 0); }
        if (IN(pb + 1)) { pg8::Gemm g{ACT, (const bf16*)(wl + OFF_DN1), M, DM, DFF, PROJ_LD}; pg8::StaticOrder S; S.init(M, DM, G, bid);
            pg8::EpiResidNorm E{cond_l, ng + DM, ws, 2 * DM, 4 * DM, (int)(WS_HB / MiB), (int)(WS_XB / MiB), (int)(WS_SS / 8) + (3 * l + 1) * M, 0.5f};
            pg8::gemm_phase<pg8::EpiResidNorm, pg8::StaticOrder, true, true>(lds, g, S, E); SEAM(pb + 1); }
        if (IN(pb + 2)) { pg8::Gemm g{HB, (const bf16*)(wl + OFF_IN), M, NPROJ, DM}; pg8::StaticOrder S; S.init(M, NPROJ, G, bid); pg8::EpiProjN E{PROJ, PROJ_LD, GATES, PROJ_LD / 256, 0.125f * LOG2E, ss0 + M, bias_l + 8 * NUP, NPROJ};
            pg8::gemm_phase<pg8::EpiProjN, pg8::StaticOrder, true, true>(lds, g, S, E); SEAM(pb + 2); }
        if (IN(pb + 3)) { PH_IDS MK_MB PrepW PW{a.in[12] + (size_t)l * 4 * 512, a.in[13] + (size_t)l * 512, a.in[18] + (size_t)l * 4 * 512, a.in[19] + (size_t)l * 512, a.in[11] + l * 4, a.in[14] + l * 4, a.in[15] + l * 4, a.in[20] + l * 4, a.in[21] + l * 4, (const float2*)(ws_ + WS_ROPE)};
            for (int rep = 0; rep < REP_PREP; ++rep) for (int u = vcu; u < BATCH * 32; u += G) prep_unit(MB, PW, u, wave_, lane_); SEAM(pb + 3); }
        if (IN(pb + 4)) { PH_IDS MK_MB mixer_phase(MB, YBF_, lds, vcu, wave_, lane_); if (REP_MIX > 1) { asm volatile("" ::: "memory"); mixer_phase(MB, YBF_, lds, vcu, wave_, lane_); } SEAM(pb + 4); }
        if (IN(pb + 5)) { PH_IDS MK_MB for (int rep = 0; rep < REP_POST; ++rep) post_new(MB, YBF_, a.in[16] + (size_t)l * 256, a.in[17] + (size_t)l * 256, a.in[23] + (size_t)l * 256, a.in[22] + l * 4, vcu * NWAVES + wave_, NGW, lane_); SEAM(pb + 5); }
        if (IN(pb + 6)) { pg8::Gemm g{YBF, (const bf16*)(wl + OFF_OUT), M, DM, DM}; pg8::StaticOrder S; S.init(M, DM, G, bid);
            pg8::EpiResidNorm E{cond_l, ng + 2 * DM, ws, 5 * DM, 7 * DM, (int)(WS_HB / MiB), (int)(WS_XB / MiB), (int)(WS_SS / 8) + (3 * l + 2) * M, 1.0f};
            pg8::gemm_phase<pg8::EpiResidNorm, pg8::StaticOrder, true, true>(lds, g, S, E); SEAM(pb + 6); }
        if (IN(pb + 7)) { pg8::Gemm g{HB, (const bf16*)(wl + OFF_UP2), M, NUP, DM}; pg8::StaticOrder S; S.init(M, NUP, G, bid); pg8::EpiSwigluN E{ACT, PROJ_LD, ss0 + 2 * M, bias_l + 2 * 8 * NUP, NUP};
            pg8::gemm_phase<pg8::EpiSwigluN, pg8::StaticOrder, true, true>(lds, g, S, E); SEAM(pb + 7); }
        if (IN(pb + 8)) { pg8::Gemm g{ACT, (const bf16*)(wl + OFF_DN2), M, DM, DFF, PROJ_LD}; pg8::StaticOrder S; S.init(M, DM, G, bid);
            if (l + 1 < DEPTH) { pg8::EpiResidNorm E{cond_l, ng + 3 * DM, ws, 8 * DM, BATCH * NCOND + 1 * DM, (int)(WS_HB / MiB), (int)(WS_XB / MiB), (int)(WS_SS / 8) + (3 * l + 3) * M, 0.5f};
                pg8::gemm_phase<pg8::EpiResidNorm, pg8::StaticOrder, true, true>(lds, g, S, E); }
            else { pg8::EpiResid E{(const bf16*)(ws + WS_XB), xres, DM, cond_l + 8 * DM, NCOND, SEQ, 0.5f}; pg8::gemm_phase<pg8::EpiResid, pg8::StaticOrder, true, true>(lds, g, S, E); }
            SEAM(pb + 8); }
    }
    if (IN(PH_FINAL)) { PH_IDS final_norm(xres, a.in[24], vcu * NWAVES + wave_, NGW, lane_); }
#undef IN
#undef SEAM
}

#ifndef N_SPLIT
#define N_SPLIT 0
#endif
extern "C" void kernel_launch(void* const* d_in, const int* in_sizes, int n_in, void* d_out, int out_size, void* d_ws, size_t ws_size, hipStream_t stream) {
    static int grid = 0;
    if (grid == 0) {
        if (n_in != 25 || in_sizes[0] != M * DM || out_size != M * DM || ws_size < WS_END) { fprintf(stderr, "kernel_launch: unexpected problem (n_in %d, in0 %d, out %d, ws %zu)\n", n_in, n_in > 0 ? in_sizes[0] : -1, out_size, ws_size); grid = -1; return; }
        int dev = 0, cus = 0, per_cu = 0;
        if (hipGetDevice(&dev) != hipSuccess || hipDeviceGetAttribute(&cus, hipDeviceAttributeMultiprocessorCount, dev) != hipSuccess) { grid = -1; return; }
        if (hipFuncSetAttribute((const void*)fwd, hipFuncAttributeMaxDynamicSharedMemorySize, LDS_BYTES) != hipSuccess) { fprintf(stderr, "kernel_launch: hipFuncSetAttribute failed\n"); grid = -1; return; }
        if (hipOccupancyMaxActiveBlocksPerMultiprocessor(&per_cu, (const void*)fwd, NTHR, LDS_BYTES) != hipSuccess || per_cu < 1) fprintf(stderr, "kernel_launch: occupancy query says %d\n", per_cu);
        (void)hipGetLastError();
        grid = cus;
    }
    if (grid < 0) return;
    if (hipMemsetAsync((char*)d_ws + WS_CTL, 0, CTL_ZERO_BYTES, stream) != hipSuccess) return;
    Args a{};
    for (int i = 0; i < 25; ++i) a.in[i] = (const float*)d_in[i];
    a.out = (float*)d_out; a.ws = (unsigned char*)d_ws;
#if N_SPLIT
    for (int p = 0; p < PH_END; ++p) { a.ph_lo = p; a.ph_hi = p + 1; hipLaunchKernelGGL(fwd, dim3(grid), dim3(NTHR), LDS_BYTES, stream, a); }
#else
    a.ph_lo = 0; a.ph_hi = PH_END; hipLaunchKernelGGL(fwd, dim3(grid), dim3(NTHR), LDS_BYTES, stream, a);
#endif
}
```

```cpp
#include <hip/hip_runtime.h>
#include <cstdio>
#include <cstdint>
#ifndef REP_FOX
#define REP_FOX 1
#endif
#ifndef REP_LIN
#define REP_LIN 1
#endif
#ifndef REP_MIX
#define REP_MIX 1
#endif
#ifndef REP_PREP
#define REP_PREP 1
#endif
#ifndef REP_POST
#define REP_POST 1
#endif
#ifndef REP_THIN
#define REP_THIN 1
#endif
#ifndef REP_UP
#define REP_UP 1
#endif
#ifndef REP_IN
#define REP_IN 1
#endif
namespace pg8 {
#define PG8_LAS __attribute__((address_space(3)))
typedef unsigned short bf16_t;
typedef short bf16x8 __attribute__((ext_vector_type(8)));
typedef float f32x4 __attribute__((ext_vector_type(4)));
typedef unsigned u32x4 __attribute__((ext_vector_type(4)));
constexpr int BM = 256, BK = 64, HALF = 128, HTB = HALF * BK * 2  , STAGE_BYTES = 8 * HTB, NXCD = 8, WGM = 4;

__host__ __device__ __forceinline__ int lds_byte(int r, int c) { const int st = (r >> 4) * 2 + (c >> 5), rr = r & 15, cc = c & 31, ob = rr * 64 + cc * 2; return st * 1024 + (ob ^ (((ob >> 9) & 1) << 5)); }
__host__ __device__ __forceinline__ void stage_rc(int b, int& R, int& C) { const int st = b / 1024, sb = b % 1024, swz = sb ^ (((sb >> 9) & 1) << 5); R = (st >> 1) * 16 + swz / 64; C = (st & 1) * 32 + (swz % 64) / 2; }
__host__ __device__ __forceinline__ int perm32(int rho) { const int n = rho >> 4, i = rho & 15; return 8 * (i >> 2) + 4 * n + (i & 3); }

struct Unit { int pm, pn; };
struct Gemm { const bf16_t* A; const bf16_t* Bt; int M, N, K; int lda; };

struct StaticOrder {
    int nM, nN, nwg, G, c;
    __host__ __device__ void init(int M, int N, int G_, int c_) { nM = M / BM; nN = N / BM; nwg = nM * nN; G = G_; c = c_; }
    __host__ __device__ bool next(int i, Unit& u) const {
        const long L = (long)i * G + c; if (L >= nwg) return false;
        int wgid = (int)L; { const int q = nwg / NXCD, r = nwg % NXCD, xcd = wgid % NXCD, off = wgid / NXCD; wgid = (xcd < r ? xcd * (q + 1) : r * (q + 1) + (xcd - r) * q) + off; }
        const int nig = WGM * nN, gid = wgid / nig, fm = gid * WGM, gsz = (nM - fm) < WGM ? (nM - fm) : WGM;
        u.pm = fm + ((wgid % nig) % gsz); u.pn = (wgid % nig) / gsz; return true;
    }
    __device__ __forceinline__ void a_ready(const Unit&) const {}
    __device__ __forceinline__ void done(const Unit&) const {}
};

__device__ __forceinline__ unsigned cvt_pk_bf16(float lo, float hi) { unsigned r; asm volatile("v_cvt_pk_bf16_f32 %0, %1, %2" : "=v"(r) : "v"(lo), "v"(hi)); return r; }

__device__ __forceinline__ float silu_f(float v) { return v * __builtin_amdgcn_rcpf(1.0f + __expf(-v)); }
__device__ __forceinline__ f32x4 swiglu4(const f32x4 a, const f32x4 g) {
    const f32x4 t = g * (-1.44269504088896341f); f32x4 e;
#pragma unroll
    for (int i = 0; i < 4; ++i) e[i] = __builtin_amdgcn_exp2f(t[i]);
    const f32x4 d = e + 1.0f; f32x4 r;
#pragma unroll
    for (int i = 0; i < 4; ++i) r[i] = __builtin_amdgcn_rcpf(d[i]);
    return (a * g) * r;
}
struct EpiSwiglu {
    static constexpr bool PERM = true, AFTER_DRAIN = false;
    bf16_t* O; int ldo;
    __device__ __forceinline__ void operator()(const f32x4 (&acc)[2][2][4][2], const Unit& u, int wr, int wc, int fr, int fq) const {
        const int row0 = u.pm * BM + wr * 64 + fr, col0 = u.pn * HALF + wc * 32 + 8 * fq;
#pragma unroll
        for (int ai = 0; ai < 2; ++ai)
#pragma unroll
            for (int m = 0; m < 4; ++m) { bf16_t* rowp = O + (size_t)(row0 + ai * HALF + m * 16) * ldo + col0;
                const f32x4 a0 = acc[ai][0][m][0], a1 = acc[ai][0][m][1], g0 = acc[ai][1][m][0], g1 = acc[ai][1][m][1];
                u32x4 w; w.x = cvt_pk_bf16(silu_f(g0[0]) * a0[0], silu_f(g0[1]) * a0[1]); w.y = cvt_pk_bf16(silu_f(g0[2]) * a0[2], silu_f(g0[3]) * a0[3]);
                w.z = cvt_pk_bf16(silu_f(g1[0]) * a1[0], silu_f(g1[1]) * a1[1]); w.w = cvt_pk_bf16(silu_f(g1[2]) * a1[2], silu_f(g1[3]) * a1[3]);
                *(u32x4*)rowp = w; }
    }
};
struct EpiResid {
    static constexpr bool PERM = false, AFTER_DRAIN = false;
    const bf16_t* base; float* out; int ldc; const float* gate; int gstride; int rows_per_b; float coef;
    __device__ __forceinline__ void operator()(const f32x4 (&acc)[2][2][4][2], const Unit& u, int wr, int wc, int fr, int fq) const {
        const int col0 = u.pn * BM + wc * 32 + 4 * fq; const int b = (u.pm * BM) / rows_per_b;
        f32x4 gv[2][2];
#pragma unroll
        for (int bj = 0; bj < 2; ++bj)
#pragma unroll
            for (int n = 0; n < 2; ++n) gv[bj][n] = *(const f32x4*)(gate + (size_t)b * gstride + col0 + bj * HALF + n * 16) * coef;
#pragma unroll
        for (int ai = 0; ai < 2; ++ai)
#pragma unroll
            for (int m = 0; m < 4; ++m) { const size_t off = (size_t)(u.pm * BM + ai * HALF + wr * 64 + m * 16 + fr) * ldc + col0;
#pragma unroll
                for (int bj = 0; bj < 2; ++bj)
#pragma unroll
                    for (int n = 0; n < 2; ++n) { typedef unsigned u32x2r __attribute__((ext_vector_type(2))); const u32x2r rb = *(const u32x2r*)(base + off + bj * HALF + n * 16);
                        const f32x4 bs = (f32x4){__builtin_bit_cast(float, rb.x << 16), __builtin_bit_cast(float, rb.x & 0xffff0000u), __builtin_bit_cast(float, rb.y << 16), __builtin_bit_cast(float, rb.y & 0xffff0000u)};
                        *(f32x4*)(out + off + bj * HALF + n * 16) = bs + gv[bj][n] * acc[ai][bj][m][n]; }
                if (m & 1) asm volatile("" ::: "memory"); }
    }
};
struct EpiProj {
    static constexpr bool PERM = true, AFTER_DRAIN = false;
    bf16_t* P; int ldp; float* G; int ntile_bf; float scale0;
    __device__ __forceinline__ void operator()(const f32x4 (&acc)[2][2][4][2], const Unit& u, int wr, int wc, int fr, int fq) const {
        const int row0 = u.pm * BM + wr * 64 + fr;
        if (u.pn < ntile_bf) {
            const int col0 = u.pn * BM + wc * 32 + 8 * fq; const float sc = (u.pn == 0) ? scale0 : 1.0f;
#pragma unroll
            for (int ai = 0; ai < 2; ++ai)
#pragma unroll
                for (int m = 0; m < 4; ++m) { bf16_t* rowp = P + (size_t)(row0 + ai * HALF + m * 16) * ldp + col0;
#pragma unroll
                    for (int bj = 0; bj < 2; ++bj) { const f32x4 v0 = acc[ai][bj][m][0] * sc, v1 = acc[ai][bj][m][1] * sc;
                        u32x4 w; w.x = cvt_pk_bf16(v0[0], v0[1]); w.y = cvt_pk_bf16(v0[2], v0[3]); w.z = cvt_pk_bf16(v1[0], v1[1]); w.w = cvt_pk_bf16(v1[2], v1[3]);
                        *(u32x4*)(rowp + bj * HALF) = w; } }
        } else if (wc == 0 && fq < 2) {
#pragma unroll
            for (int ai = 0; ai < 2; ++ai)
#pragma unroll
                for (int m = 0; m < 4; ++m) { float* gp = G + (size_t)(row0 + ai * HALF + m * 16) * 16 + 8 * fq;
                    *(f32x4*)gp = acc[ai][0][m][0]; *(f32x4*)(gp + 4) = acc[ai][0][m][1]; }
        }
    }
};

__device__ __forceinline__ float rstd_q(long long q) { const unsigned long long u = (unsigned long long)q; const float f = (float)(unsigned)(u >> 32) * 4294967296.0f + (float)(unsigned)u;
    return __builtin_amdgcn_rsqf(f * (1.0f / (16777216.0f * 1024.0f)) + 1e-6f); }
struct EpiSwigluN {
    static constexpr bool PERM = true, AFTER_DRAIN = false;
    bf16_t* O; int ldo; const long long* ss; const float* bias; int nb;
    __device__ __forceinline__ void operator()(const f32x4 (&acc)[2][2][4][2], const Unit& u, int wr, int wc, int fr, int fq) const {
        const int row0 = u.pm * BM + wr * 64 + fr, col0 = u.pn * HALF + wc * 32 + 8 * fq; const int b = u.pm >> 3;
        const float* bp = bias + (size_t)b * nb + u.pn * BM + wc * 32 + 8 * fq;
        const f32x4 ba0 = *(const f32x4*)bp, ba1 = *(const f32x4*)(bp + 4), bg0 = *(const f32x4*)(bp + HALF), bg1 = *(const f32x4*)(bp + HALF + 4);
        long long ssv[2][4];
#pragma unroll
        for (int ai = 0; ai < 2; ++ai)
#pragma unroll
            for (int m = 0; m < 4; ++m) ssv[ai][m] = ss[row0 + ai * HALF + m * 16];
#pragma unroll
        for (int ai = 0; ai < 2; ++ai)
#pragma unroll
            for (int m = 0; m < 4; ++m) { const int row = row0 + ai * HALF + m * 16; bf16_t* rowp = O + (size_t)row * ldo + col0;
                const float rs = rstd_q(ssv[ai][m]);
                const f32x4 a0 = acc[ai][0][m][0] * rs + ba0, a1 = acc[ai][0][m][1] * rs + ba1, g0 = acc[ai][1][m][0] * rs + bg0, g1 = acc[ai][1][m][1] * rs + bg1;
                const f32x4 o0 = swiglu4(a0, g0), o1 = swiglu4(a1, g1);
                u32x4 w; w.x = cvt_pk_bf16(o0[0], o0[1]); w.y = cvt_pk_bf16(o0[2], o0[3]); w.z = cvt_pk_bf16(o1[0], o1[1]); w.w = cvt_pk_bf16(o1[2], o1[3]);
                *(u32x4*)rowp = w; }
    }
};
struct EpiProjN {
    static constexpr bool PERM = true, AFTER_DRAIN = false;
    bf16_t* P; int ldp; float* G; int ntile_bf; float scale0; const long long* ss; const float* bias; int nb;
    __device__ __forceinline__ void operator()(const f32x4 (&acc)[2][2][4][2], const Unit& u, int wr, int wc, int fr, int fq) const {
        const int row0 = u.pm * BM + wr * 64 + fr; const int b = u.pm >> 3;
        const float* bp = bias + (size_t)b * nb + u.pn * BM + wc * 32 + 8 * fq;
        if (u.pn < ntile_bf) {
            const int col0 = u.pn * BM + wc * 32 + 8 * fq; const float sc = (u.pn == 0) ? scale0 : 1.0f;
            const f32x4 b00 = *(const f32x4*)bp, b01 = *(const f32x4*)(bp + 4), b10 = *(const f32x4*)(bp + HALF), b11 = *(const f32x4*)(bp + HALF + 4);
            long long ssv[2][4];
#pragma unroll
            for (int ai = 0; ai < 2; ++ai)
#pragma unroll
                for (int m = 0; m < 4; ++m) ssv[ai][m] = ss[row0 + ai * HALF + m * 16];
#pragma unroll
            for (int ai = 0; ai < 2; ++ai)
#pragma unroll
                for (int m = 0; m < 4; ++m) { const int row = row0 + ai * HALF + m * 16; bf16_t* rowp = P + (size_t)row * ldp + col0;
                    const float rs = rstd_q(ssv[ai][m]);
#pragma unroll
                    for (int bj = 0; bj < 2; ++bj) { const f32x4 v0 = (acc[ai][bj][m][0] * rs + (bj ? b10 : b00)) * sc, v1 = (acc[ai][bj][m][1] * rs + (bj ? b11 : b01)) * sc;
                        u32x4 w; w.x = cvt_pk_bf16(v0[0], v0[1]); w.y = cvt_pk_bf16(v0[2], v0[3]); w.z = cvt_pk_bf16(v1[0], v1[1]); w.w = cvt_pk_bf16(v1[2], v1[3]);
                        *(u32x4*)(rowp + bj * HALF) = w; } }
        } else if (wc == 0 && fq < 2) {
            const f32x4 b00 = *(const f32x4*)bp, b01 = *(const f32x4*)(bp + 4);
#pragma unroll
            for (int ai = 0; ai < 2; ++ai)
#pragma unroll
                for (int m = 0; m < 4; ++m) { const int row = row0 + ai * HALF + m * 16; float* gp = G + (size_t)row * 16 + 8 * fq;
                    const float rs = rstd_q(ss[row]);
                    *(f32x4*)gp = acc[ai][0][m][0] * rs + b00; *(f32x4*)(gp + 4) = acc[ai][0][m][1] * rs + b01; }
        }
    }
};
struct EpiResidNorm {
    static constexpr bool PERM = true, AFTER_DRAIN = false;
    const float* cnd; const float* ng; unsigned char* wsb; int goff, scoff, hb_off, xb_off, ss_off; float coef;
    __device__ __forceinline__ void operator()(const f32x4 (&acc)[2][2][4][2], const Unit& u, int wr, int wc, int fr, int fq) const {
        constexpr int ldc = 1024, gstride = 9 * 1024;
        const int col0 = u.pn * BM + wc * 32 + 8 * fq; const int b = u.pm >> 3;
        const float* gate = cnd + goff; const float* scn = cnd + scoff;
        __attribute__((address_space(1))) bf16_t* xg = (__attribute__((address_space(1))) bf16_t*)(wsb + (size_t)hb_off * 1048576);
        unsigned long long* ssn = (unsigned long long*)(wsb + (size_t)ss_off * 8);
        __attribute__((address_space(1))) bf16_t* xb = (__attribute__((address_space(1))) bf16_t*)(wsb + (size_t)xb_off * 1048576);
        float sq[2][4];
#pragma unroll
        for (int ai = 0; ai < 2; ++ai)
#pragma unroll
            for (int m = 0; m < 4; ++m) sq[ai][m] = 0.f;
#pragma unroll
        for (int bj = 0; bj < 2; ++bj) { const int c = col0 + bj * HALF;
            const f32x4 gv0 = *(const f32x4*)(gate + (size_t)b * gstride + c) * coef, gv1 = *(const f32x4*)(gate + (size_t)b * gstride + c + 4) * coef;
            const f32x4 gm0 = *(const f32x4*)(ng + c) * (*(const f32x4*)(scn + (size_t)b * gstride + c) + 1.0f), gm1 = *(const f32x4*)(ng + c + 4) * (*(const f32x4*)(scn + (size_t)b * gstride + c + 4) + 1.0f);
#pragma unroll
            for (int ai = 0; ai < 2; ++ai) { u32x4 rbv[4];
                const unsigned off0 = (unsigned)(u.pm * BM + ai * HALF + wr * 64 + fr) * (unsigned)ldc + (unsigned)c;
#pragma unroll
                for (int m = 0; m < 4; ++m) rbv[m] = *(const __attribute__((address_space(1))) u32x4*)(xb + (off0 + (unsigned)(m * 16 * ldc)));
#pragma unroll
                for (int m = 0; m < 4; ++m) { const unsigned off = off0 + (unsigned)(m * 16 * ldc); const u32x4 rb = rbv[m];
                    const f32x4 xn0 = (f32x4){__builtin_bit_cast(float, rb.x << 16), __builtin_bit_cast(float, rb.x & 0xffff0000u), __builtin_bit_cast(float, rb.y << 16), __builtin_bit_cast(float, rb.y & 0xffff0000u)} + gv0 * acc[ai][bj][m][0];
                    const f32x4 xn1 = (f32x4){__builtin_bit_cast(float, rb.z << 16), __builtin_bit_cast(float, rb.z & 0xffff0000u), __builtin_bit_cast(float, rb.w << 16), __builtin_bit_cast(float, rb.w & 0xffff0000u)} + gv1 * acc[ai][bj][m][1];
                    { u32x4 wx; wx.x = cvt_pk_bf16(xn0[0], xn0[1]); wx.y = cvt_pk_bf16(xn0[2], xn0[3]); wx.z = cvt_pk_bf16(xn1[0], xn1[1]); wx.w = cvt_pk_bf16(xn1[2], xn1[3]); *(__attribute__((address_space(1))) u32x4*)(xb + off) = wx; }
                    sq[ai][m] += ((xn0[0] * xn0[0] + xn0[1] * xn0[1]) + (xn0[2] * xn0[2] + xn0[3] * xn0[3])) + ((xn1[0] * xn1[0] + xn1[1] * xn1[1]) + (xn1[2] * xn1[2] + xn1[3] * xn1[3]));
                    const f32x4 h0 = xn0 * gm0, h1 = xn1 * gm1;
                    u32x4 w; w.x = cvt_pk_bf16(h0[0], h0[1]); w.y = cvt_pk_bf16(h0[2], h0[3]); w.z = cvt_pk_bf16(h1[0], h1[1]); w.w = cvt_pk_bf16(h1[2], h1[3]); *(__attribute__((address_space(1))) u32x4*)(xg + off) = w; }
                asm volatile("" ::: "memory"); } }
#pragma unroll
        for (int ai = 0; ai < 2; ++ai)
#pragma unroll
            for (int m = 0; m < 4; ++m) { float v = sq[ai][m]; v += __shfl_xor(v, 16); v += __shfl_xor(v, 32);
                if (fq == 0) atomicAdd(ssn + (u.pm * BM + ai * HALF + wr * 64 + m * 16 + fr), (unsigned long long)__float2ll_rn(v * 16777216.0f)); }
    }
};

template <class Epi, class Sched, bool ALIGN_EPI = false, bool SP2 = false>
__device__ __forceinline__ void gemm_phase(PG8_LAS unsigned char* lds, const Gemm g, const Sched& S, const Epi& E) {
    int tid_ = threadIdx.x; asm volatile("" : "+v"(tid_));
    const int tid = tid_, wid = __builtin_amdgcn_readfirstlane(tid >> 6), lane = tid & 63, wr = wid >> 2, wc = wid & 3, fr = lane & 15, fq = lane >> 4;
    const int K = g.K, nt = K / BK, LDA = g.lda ? g.lda : g.K;
    unsigned voffA[2], voffB[2];
#pragma unroll
    for (int i = 0; i < 2; ++i) { int R, C; stage_rc(tid * 16 + i * 8192, R, C); const int Rb = Epi::PERM ? ((R & ~31) + perm32(R & 31)) : R;
        voffA[i] = (unsigned)(R * LDA + C) * 2u; voffB[i] = (unsigned)(Rb * K + C) * 2u; }
    const size_t kstep = (size_t)(BK * 2);
    const size_t hstep = (size_t)HALF * K * 2;
    const size_t tstep = 2 * hstep;
    const size_t hstepA = (size_t)HALF * LDA * 2, tstepA = 2 * hstepA;
    const unsigned ldsw = (unsigned)wid * 1024u;
    const int aoff = lds_byte(wr * 64 + fr, fq * 8), boff = lds_byte(wc * 32 + fr, fq * 8);
#define PG8_SA(b, h) (((b) * 2 + (h)) * HTB)
#define PG8_SB(b, h) ((4 + (b) * 2 + (h)) * HTB)
#define PG8_STAGE(bufoff, gbase, voff) do { _Pragma("unroll") for (int _i = 0; _i < 2; ++_i) \
        __builtin_amdgcn_global_load_lds((const unsigned*)((const char*)(gbase) + (voff)[_i]), (PG8_LAS unsigned*)(lds + (bufoff) + ldsw + _i * 8192), 16, 0, 0); } while (0)
#define PG8_LDA(dst, b, h) do { _Pragma("unroll") for (int m = 0; m < 4; ++m) _Pragma("unroll") for (int k = 0; k < 2; ++k) dst[m][k] = *(const PG8_LAS bf16x8*)(lds + PG8_SA(b, h) + aoff + m * 2048 + k * 1024); } while (0)
#define PG8_LDB(dst, b, h) do { _Pragma("unroll") for (int n = 0; n < 2; ++n) _Pragma("unroll") for (int k = 0; k < 2; ++k) dst[n][k] = *(const PG8_LAS bf16x8*)(lds + PG8_SB(b, h) + boff + n * 2048 + k * 1024); } while (0)
#define PG8_MMA(ai, bj, At, Bt) do { __builtin_amdgcn_s_setprio(1); _Pragma("unroll") for (int m = 0; m < 4; ++m) _Pragma("unroll") for (int n = 0; n < 2; ++n) _Pragma("unroll") for (int k = 0; k < 2; ++k) \
        acc[ai][bj][m][n] = __builtin_amdgcn_mfma_f32_16x16x32_bf16(Bt[n][k], At[m][k], acc[ai][bj][m][n], 0, 0, 0); __builtin_amdgcn_s_setprio(0); } while (0)
#define PG8_WAIT_V(n) asm volatile("s_waitcnt vmcnt(" #n ")" ::: "memory")
#define PG8_WAIT_L(n) asm volatile("s_waitcnt lgkmcnt(" #n ")" ::: "memory")
#define PG8_BAR __builtin_amdgcn_s_barrier()
#define PG8_SCHED __builtin_amdgcn_sched_barrier(0)
    Unit cur, nxt; int ui = 0;
    if (!S.next(0, cur)) return;
    f32x4 acc[2][2][4][2];
#pragma unroll
    for (int a = 0; a < 2; ++a)
#pragma unroll
        for (int b = 0; b < 2; ++b)
#pragma unroll
            for (int m = 0; m < 4; ++m)
#pragma unroll
                for (int n = 0; n < 2; ++n) acc[a][b][m][n] = (f32x4){0.f, 0.f, 0.f, 0.f};
    bf16x8 At[4][2], B0[2][2], B1[2][2];
    const char* cA = (const char*)g.A + (size_t)cur.pm * tstepA; const char* cB = (const char*)g.Bt + (size_t)cur.pn * tstep;
    S.a_ready(cur);
    if constexpr (SP2) {
        PG8_STAGE(PG8_SB(0, 0), cB, voffB); PG8_STAGE(PG8_SB(0, 1), cB + hstep, voffB); PG8_STAGE(PG8_SA(0, 0), cA, voffA); PG8_STAGE(PG8_SA(0, 1), cA + hstepA, voffA);
        if (wr == 1) PG8_BAR;
        PG8_WAIT_V(2); PG8_BAR;
        PG8_STAGE(PG8_SB(1, 0), cB + kstep, voffB); PG8_STAGE(PG8_SA(1, 0), cA + kstep, voffA); PG8_STAGE(PG8_SB(1, 1), cB + hstep + kstep, voffB);
        PG8_WAIT_V(6); PG8_BAR;
    } else {
        PG8_STAGE(PG8_SB(0, 0), cB, voffB); PG8_STAGE(PG8_SA(0, 0), cA, voffA); PG8_STAGE(PG8_SB(0, 1), cB + hstep, voffB); PG8_STAGE(PG8_SA(0, 1), cA + hstepA, voffA);
        if (wr == 1) PG8_BAR;
        PG8_WAIT_V(4); PG8_BAR;
        PG8_STAGE(PG8_SB(1, 0), cB + kstep, voffB); PG8_STAGE(PG8_SA(1, 0), cA + kstep, voffA); PG8_STAGE(PG8_SB(1, 1), cB + hstep + kstep, voffB);
        PG8_WAIT_V(6); PG8_BAR;
    }
    for (;;) {
        const bool has_next = S.next(ui + 1, nxt);
        const char* nA = has_next ? (const char*)g.A + (size_t)nxt.pm * tstepA : cA; const char* nB = has_next ? (const char*)g.Bt + (size_t)nxt.pn * tstep : cB;
        for (int t = 0; t < nt; t += 2) {
            const bool last = (t == nt - 2);
            const char* a1 = cA + (size_t)(t + 1) * kstep;
            const char* a2 = last ? nA : cA + (size_t)(t + 2) * kstep; const char* b2 = last ? nB : cB + (size_t)(t + 2) * kstep;
            const char* a3 = a2 + kstep; const char* b3 = b2 + kstep;
            if (last && has_next) S.a_ready(nxt);
            if constexpr (SP2) {
            PG8_LDB(B0, 0, 0); PG8_LDB(B1, 0, 1); PG8_SCHED; PG8_LDA(At, 0, 0); PG8_STAGE(PG8_SA(1, 1), a1 + hstepA, voffA);
            PG8_WAIT_V(8); PG8_WAIT_L(0); PG8_BAR; PG8_MMA(0, 0, At, B0); PG8_MMA(0, 1, At, B1); PG8_BAR; PG8_SCHED;
            PG8_LDA(At, 0, 1); PG8_STAGE(PG8_SB(0, 0), b2, voffB); PG8_STAGE(PG8_SB(0, 1), b2 + hstep, voffB); PG8_STAGE(PG8_SA(0, 0), a2, voffA);
            PG8_WAIT_V(8); PG8_WAIT_L(0); PG8_BAR; PG8_MMA(1, 0, At, B0); PG8_MMA(1, 1, At, B1); PG8_BAR; PG8_SCHED;
            PG8_LDB(B0, 1, 0); PG8_LDB(B1, 1, 1); PG8_SCHED; PG8_LDA(At, 1, 0); PG8_STAGE(PG8_SA(0, 1), a2 + hstepA, voffA);
            PG8_WAIT_V(8); PG8_WAIT_L(0); PG8_BAR; PG8_MMA(0, 0, At, B0); PG8_MMA(0, 1, At, B1); PG8_BAR; PG8_SCHED;
            PG8_LDA(At, 1, 1); PG8_STAGE(PG8_SB(1, 0), b3, voffB); PG8_STAGE(PG8_SB(1, 1), b3 + hstep, voffB); PG8_STAGE(PG8_SA(1, 0), a3, voffA);
            PG8_WAIT_V(8); PG8_WAIT_L(0); PG8_BAR; PG8_MMA(1, 0, At, B0); PG8_MMA(1, 1, At, B1); PG8_BAR; PG8_SCHED;
            } else {
            PG8_LDB(B0, 0, 0); PG8_SCHED; PG8_LDA(At, 0, 0); PG8_STAGE(PG8_SA(1, 1), a1 + hstepA, voffA);
            PG8_WAIT_L(8); PG8_BAR; PG8_WAIT_L(0); PG8_MMA(0, 0, At, B0); PG8_BAR; PG8_SCHED;
            PG8_LDB(B1, 0, 1); PG8_STAGE(PG8_SB(0, 0), b2, voffB);
            PG8_BAR; PG8_WAIT_L(0); PG8_MMA(0, 1, At, B1); PG8_BAR;
            PG8_LDA(At, 0, 1); PG8_STAGE(PG8_SA(0, 0), a2, voffA);
            PG8_BAR; PG8_WAIT_L(0); PG8_MMA(1, 0, At, B0); PG8_BAR; PG8_SCHED;
            PG8_STAGE(PG8_SB(0, 1), b2 + hstep, voffB);
            PG8_WAIT_V(6); PG8_BAR; PG8_MMA(1, 1, At, B1); PG8_BAR;
            PG8_LDB(B0, 1, 0); PG8_SCHED; PG8_LDA(At, 1, 0); PG8_STAGE(PG8_SA(0, 1), a2 + hstepA, voffA);
            PG8_WAIT_L(8); PG8_BAR; PG8_WAIT_L(0); PG8_MMA(0, 0, At, B0); PG8_BAR; PG8_SCHED;
            PG8_LDB(B1, 1, 1); PG8_STAGE(PG8_SB(1, 0), b3, voffB);
            PG8_BAR; PG8_WAIT_L(0); PG8_MMA(0, 1, At, B1); PG8_BAR;
            PG8_LDA(At, 1, 1); PG8_STAGE(PG8_SA(1, 0), a3, voffA);
            PG8_BAR; PG8_WAIT_L(0); PG8_MMA(1, 0, At, B0); PG8_BAR; PG8_SCHED;
            PG8_STAGE(PG8_SB(1, 1), b3 + hstep, voffB);
            PG8_WAIT_V(6); PG8_BAR; PG8_MMA(1, 1, At, B1); PG8_BAR;
            }
        }
        if constexpr (ALIGN_EPI) { if (wr == 0) PG8_BAR; }
        if constexpr (!Epi::AFTER_DRAIN) { E(acc, cur, wr, wc, fr, fq); S.done(cur); }
        if (!has_next) break;
#pragma unroll
        for (int a = 0; a < 2; ++a)
#pragma unroll
            for (int b = 0; b < 2; ++b)
#pragma unroll
                for (int m = 0; m < 4; ++m)
#pragma unroll
                    for (int n = 0; n < 2; ++n) acc[a][b][m][n] = (f32x4){0.f, 0.f, 0.f, 0.f};
        cur = nxt; cA = nA; cB = nB; ++ui;
        if constexpr (ALIGN_EPI) { if (wr == 1) PG8_BAR; }
    }
    PG8_WAIT_V(0);
    if constexpr (!ALIGN_EPI) { if (wr == 0) PG8_BAR; }
    PG8_BAR;
    if constexpr (Epi::AFTER_DRAIN) { E.fused(acc, cur, wr, wc, fr, fq, lds, wid, lane); S.done(cur); }
#undef PG8_SA
#undef PG8_SB
#undef PG8_STAGE
#undef PG8_LDA
#undef PG8_LDB
#undef PG8_MMA
#undef PG8_WAIT_V
#undef PG8_WAIT_L
#undef PG8_BAR
#undef PG8_SCHED
}
}
#define GAS __attribute__((address_space(1)))
#define LAS __attribute__((address_space(3)))
typedef unsigned short bf16;
typedef unsigned v4u __attribute__((ext_vector_type(4)));
typedef float f32x4 __attribute__((ext_vector_type(4)));
typedef short bf16x8 __attribute__((ext_vector_type(8)));
typedef GAS unsigned gu32;
typedef GAS unsigned long long gu64;
#define RLX_AGENT __ATOMIC_RELAXED, __HIP_MEMORY_SCOPE_AGENT
#define LDS_WAIT() asm volatile("s_waitcnt lgkmcnt(0)" ::: "memory")
#define VM_WAIT() asm volatile("s_waitcnt vmcnt(0)" ::: "memory")
__device__ __forceinline__ unsigned long long rt() { return __builtin_amdgcn_s_memrealtime(); }
__device__ __forceinline__ unsigned f2bf(float f) { unsigned u = __builtin_bit_cast(unsigned, f); return (u + 0x7fffu + ((u >> 16) & 1u)) >> 16; }
__device__ __forceinline__ unsigned pk2(float lo, float hi) { return f2bf(lo) | (f2bf(hi) << 16); }

#define XB_TMO      128
#define XB_XCNT(j)  (256  + 64 * (j))
#define XB_XSUB(j)  (1280 + 64 * (j))
#define XB_XGEN(j)  (2304 + 64 * (j))
#define XB_TOP      3328
#define XB_TOPGEN   3392
#define XCD_BAR_WORDS 3456
#define XB_SPIN_CAP (1u << 18)

__device__ __forceinline__ unsigned xb_ld(unsigned* p)              { return __hip_atomic_load(p, __ATOMIC_RELAXED, __HIP_MEMORY_SCOPE_AGENT); }
__device__ __forceinline__ unsigned xb_add(unsigned* p, unsigned v) { return __hip_atomic_fetch_add(p, v, __ATOMIC_RELAXED, __HIP_MEMORY_SCOPE_AGENT); }
__device__ __forceinline__ unsigned xb_xcc_id() { return (unsigned)__builtin_amdgcn_s_getreg((3 << 11) | 20) & 0xFu; }
#define XB_SPIN(cond, bar) do { unsigned _sp = 0; while (cond) { __builtin_amdgcn_s_sleep(1); \
    if ((++_sp & 255u) == 0u) { if (xb_ld(&(bar)[XB_TMO])) break; if (_sp > XB_SPIN_CAP) { atomicAdd(&(bar)[XB_TMO], 1u); break; } } } } while (0)

struct XcdBarrier {
    unsigned* bar; unsigned x;
    volatile LAS unsigned* st;
};

__device__ __forceinline__ XcdBarrier xcd_barrier_post(unsigned* bar, volatile LAS unsigned* st) {
    XcdBarrier b; b.bar = bar; b.x = xb_xcc_id(); b.st = st;
    if (threadIdx.x == 0) (void)xb_add(&bar[XB_XCNT(b.x)], 1u);
    return b;
}
__device__ __forceinline__ void xcd_barrier_complete(unsigned* bar, unsigned x, unsigned& nloc, unsigned& nx) {
    const unsigned G = gridDim.x * gridDim.y * gridDim.z;
    unsigned sum, cnt, mine, sp = 0u;
    for (;;) {
        sum = 0u; cnt = 0u; mine = 0u;
#pragma unroll
        for (unsigned j = 0; j < 16; ++j) { const unsigned c = xb_ld(&bar[XB_XCNT(j)]); sum += c; cnt += (c > 0u) ? 1u : 0u; mine = (j == x) ? c : mine; }
        if (sum == G) break;
        __builtin_amdgcn_s_sleep(1);
        if ((++sp & 255u) == 0u) { if (xb_ld(&bar[XB_TMO])) break; if (sp > XB_SPIN_CAP) { atomicAdd(&bar[XB_TMO], 1u); break; } }
    }
    nloc = mine > 0u ? mine : 1u; nx = cnt > 0u ? cnt : 1u;
}

__device__ __forceinline__ void xcd_barrier(const XcdBarrier& b) {
    asm volatile("s_waitcnt vmcnt(0)" ::: "memory");
    __syncthreads();
    if (threadIdx.x == 0) {
        unsigned* bar = b.bar;
        __builtin_amdgcn_s_waitcnt(0);
        unsigned nloc = b.st[0], nx = b.st[1];
        if (nloc == 0u) { xcd_barrier_complete(bar, b.x, nloc, nx); b.st[0] = nloc; b.st[1] = nx; }
        const unsigned old = xb_add(&bar[XB_XSUB(b.x)], 1u);
        const unsigned gen = old / nloc;
        if (old + 1u == (gen + 1u) * nloc) {
            __builtin_amdgcn_fence(__ATOMIC_RELEASE, "agent");
            asm volatile("s_waitcnt vmcnt(0)" ::: "memory");
            const unsigned og = xb_add(&bar[XB_TOP], 1u);
            const unsigned tg = og / nx;
            if (og + 1u == (tg + 1u) * nx) xb_add(&bar[XB_TOPGEN], 1u);
            else XB_SPIN(xb_ld(&bar[XB_TOPGEN]) == tg, bar);
            __builtin_amdgcn_fence(__ATOMIC_ACQUIRE, "agent");
            xb_add(&bar[XB_XGEN(b.x)], 1u);
            asm volatile("s_waitcnt vmcnt(0)" ::: "memory");
        } else {
            XB_SPIN(xb_ld(&bar[XB_XGEN(b.x)]) == gen, bar);
            __builtin_amdgcn_fence(__ATOMIC_ACQUIRE, "agent");
            asm volatile("s_waitcnt vmcnt(0)" ::: "memory");
        }
    }
    __syncthreads();
}

#define XB_LOC(j)   (3584 + 64 * (j))
#define XB_RANK(j)  (4608 + 64 * (j))
#define XB_LGEN(j)  (5632 + 64 * (j))
#define XB_ALL_WORDS 6656
__device__ __forceinline__ void xcd_local_barrier(unsigned* bar, unsigned x, unsigned nloc) {
    asm volatile("s_waitcnt vmcnt(0)" ::: "memory");
    __syncthreads();
    if (threadIdx.x == 0) {
        __builtin_amdgcn_s_waitcnt(0);
        const unsigned old = xb_add(&bar[XB_LOC(x)], 1u); const unsigned gen = old / nloc;
        if (old + 1u == (gen + 1u) * nloc) {
            __builtin_amdgcn_fence(__ATOMIC_RELEASE, "agent");
            asm volatile("s_waitcnt vmcnt(0)" ::: "memory");
            __builtin_amdgcn_fence(__ATOMIC_ACQUIRE, "agent");
            xb_add(&bar[XB_LGEN(x)], 1u);
            asm volatile("s_waitcnt vmcnt(0)" ::: "memory");
        } else {
            XB_SPIN(xb_ld(&bar[XB_LGEN(x)]) == gen, bar);
            __builtin_amdgcn_fence(__ATOMIC_ACQUIRE, "agent");
            asm volatile("s_waitcnt vmcnt(0)" ::: "memory");
        }
    }
    __syncthreads();
}

constexpr int NWAVES = 8, NTHR = 512;
constexpr int DM = 1024, BATCH = 8, SEQ = 2048, DEPTH = 4, M = BATCH * SEQ;
constexpr int DFF = 2816, NUP = 2 * DFF, NPROJ = 3840, PROJ_LD = 3584, NIN_SRC = 3600, NCOND = 9 * DM;
constexpr float RMS_EPS = 1e-6f;
constexpr int PC_FQ = 0, PC_FK = 256, PC_FV = 512, PC_MQ = 768, PC_MK = 1024, PC_MV = 1280, PC_MO = 1536, PC_RQ = 1792, PC_RK = 2048, PC_RV = 2304, PC_RG = 2560, PC_SZ = 2816, PC_SX = 3072;
constexpr int PH_LAYER0 = 2, PH_PER_LAYER = 9, PH_FINAL = PH_LAYER0 + PH_PER_LAYER * DEPTH, PH_END = PH_FINAL + 1;
constexpr size_t MiB = 1u << 20;
constexpr size_t WS_CTL = 0, CTL_ZERO_BYTES = 1 * MiB;
constexpr size_t WS_COND = 1 * MiB;
constexpr size_t WS_ROPE = 3 * MiB;
constexpr size_t WS_W = 4 * MiB;
constexpr size_t W_UP = (size_t)NUP * DM * 2, W_DN = (size_t)DM * DFF * 2, W_IN = (size_t)NPROJ * DM * 2, W_OUT = (size_t)DM * DM * 2;
constexpr size_t OFF_UP1 = 0, OFF_DN1 = W_UP, OFF_UP2 = W_UP + W_DN, OFF_DN2 = 2 * W_UP + W_DN, OFF_IN = 2 * W_UP + 2 * W_DN, OFF_OUT = OFF_IN + W_IN, LAYER_W = OFF_OUT + W_OUT;
static_assert(LAYER_W * DEPTH == 170 * MiB, "weights");
constexpr size_t WS_HB = 174 * MiB;
constexpr size_t WS_PROJ = 206 * MiB, WS_ACT = 206 * MiB;
constexpr size_t WS_GATES = 318 * MiB;
constexpr size_t WS_VTF = 319 * MiB;
constexpr size_t WS_VTL = 327 * MiB;
constexpr size_t WS_QL = 363 * MiB, WS_KL = 387 * MiB;
constexpr size_t WS_COEF = 411 * MiB;
constexpr size_t COEF_A1 = 0, COEF_A2 = 768 * 1024, COEF_BETA = 2 * 768 * 1024, COEF_LCUM = 3 * 768 * 1024, COEF_S1 = COEF_LCUM + 256 * 1024, COEF_S2 = COEF_S1 + 16 * 1024, COEF_CTOT = COEF_S2 + 16 * 1024;
constexpr size_t WS_YRAW = 415 * MiB;
constexpr size_t WS_XB = 447 * MiB;
constexpr size_t WS_YBF = 479 * MiB;
constexpr size_t WS_KT = 511 * MiB;
constexpr size_t WS_XS = 535 * MiB;
constexpr size_t WS_DEN = 551 * MiB;
constexpr size_t WS_BIAS = 552 * MiB;
constexpr size_t BIAS_USE = (size_t)8 * NUP * 4, BIAS_BYTES = (size_t)DEPTH * 3 * BIAS_USE;
constexpr size_t WS_SS = 556 * MiB, SS_BYTES = (size_t)3 * DEPTH * M * 8;
constexpr size_t WS_BIASQ = 558 * MiB, BIASQ_BYTES = 2 * BIAS_BYTES, WS_END = 563 * MiB;
static_assert(WS_BIAS + BIAS_BYTES <= 555 * MiB && WS_SS + SS_BYTES <= WS_BIASQ && WS_BIASQ + BIASQ_BYTES <= WS_END, "ws map 2");
static_assert(WS_PROJ + (size_t)M * PROJ_LD * 2 <= WS_GATES && WS_ACT + (size_t)M * DFF * 2 <= WS_GATES && COEF_CTOT + 4096 <= 4 * MiB && WS_YRAW + (size_t)M * 1024 * 4 <= WS_YBF, "ws map");
constexpr int CW_BAR = 4096;
constexpr int RING_BYTES = 131072, LDS_BYTES = 163840, LDSCTL_OFF = LDS_BYTES - 1024, MISC_OFF = LDSCTL_OFF + 320;

__device__ const double INVREV[32] = {0.15915494309189535, 0.11934937021124886, 0.089499401608891013, 0.067115083005227255, 0.050329212104487035, 0.037741584717419778, 0.028302195830623395, 0.02122365276477766, 0.015915494309189534, 0.011934937021124886, 0.0089499401608891006, 0.0067115083005227253, 0.0050329212104487037, 0.0037741584717419768, 0.0028302195830623399, 0.0021223652764777662, 0.0015915494309189536, 0.0011934937021124887, 0.00089499401608891024, 0.0006711508300522726, 0.00050329212104487033, 0.00037741584717419769, 0.00028302195830623401, 0.00021223652764777661, 0.00015915494309189535, 0.00011934937021124885, 8.9499401608891018e-05, 6.7115083005227268e-05, 5.0329212104487035e-05, 3.7741584717419777e-05, 2.8302195830623396e-05, 2.1223652764777659e-05};

struct Args { const float* in[25]; float* out; unsigned char* ws; int ph_lo, ph_hi; };
static_assert(sizeof(Args) == 27 * 8 + 8, "Args has no padding");

__device__ __forceinline__ float wave_sum(float v) {
#pragma unroll
    for (int o = 1; o < 64; o <<= 1) v += __shfl_xor(v, o);
    return v;
}
__device__ __forceinline__ float bf2f(unsigned short u) { return __uint_as_float((unsigned)u << 16); }
__device__ __forceinline__ float sigmoid_f(float v) { return 1.0f / (1.0f + __expf(-v)); }
__device__ __forceinline__ float silu_acc(float v) { return v / (1.0f + __expf(-v)); }
__device__ __forceinline__ float log_sigmoid_f(float v) { return fminf(v, 0.f) - log1pf(__expf(-fabsf(v))); }
__device__ __forceinline__ float softplus_f(float v) { return fmaxf(v, 0.f) + log1pf(__expf(-fabsf(v))); }

__device__ __forceinline__ int map_up(int n) { const int t = n >> 8, r = n & 255; return (r < 128) ? (t * 128 + r) : (DFF + t * 128 + (r - 128)); }
__device__ __forceinline__ int map_in(int n) {
    if (n < 768) return n; if (n < 1536) return n + 4; if (n < 3584) return n + 12;
    const int j = n - 3584; if (j < 4) return 768 + j; if (j < 8) return 1540 + (j - 4); if (j < 12) return 1544 + (j - 8); if (j < 16) return 3596 + (j - 12); return -1; }
template <int MAP> __device__ __forceinline__ void tr_item(const float* W, int K, int Nsrc, bf16* WT, int kb, int nb, LAS float* scr, int lane, const float* shp, long long* biasp, int Ndst) {
    const int k0 = 64 * kb, n0 = 32 * nb; const int nd = n0 + (lane & 31); const int src = MAP == 1 ? map_up(nd) : (MAP == 2 ? map_in(nd) : nd);
    const bool regular = (MAP != 2) || (n0 < 3584);
    if (regular) {
        const int s0c = MAP == 1 ? map_up(n0) : (MAP == 2 ? map_in(n0) : n0); const int kq = lane >> 3, nq = lane & 7;
        f32x4 wv[8];
#pragma unroll
        for (int i = 0; i < 8; ++i) wv[i] = *(const f32x4*)(W + (size_t)(k0 + 8 * i + kq) * Nsrc + s0c + 4 * nq);
#pragma unroll
        for (int i = 0; i < 8; ++i) { LAS float* d = scr + (8 * i + kq) * 33 + 4 * nq; d[0] = wv[i][0]; d[1] = wv[i][1]; d[2] = wv[i][2]; d[3] = wv[i][3]; }
    } else {
#pragma unroll 8
        for (int i = 0; i < 32; ++i) { const int kk = 2 * i + (lane >> 5); scr[kk * 33 + (lane & 31)] = src >= 0 ? W[(size_t)(k0 + kk) * Nsrc + src] : 0.f; }
    }
    if (MAP != 0) {
        LAS float* shs = scr + 64 * 33;
#pragma unroll
        for (int bb = 0; bb < 8; ++bb) shs[lane * 8 + bb] = shp[(size_t)bb * NCOND + k0 + lane];
    }
    LDS_WAIT(); asm volatile("" ::: "memory");
    const int c = lane & 7;
#pragma unroll
    for (int j = 0; j < 4; ++j) { const int n = (lane >> 3) + 8 * j; const LAS float* s = scr + (8 * c) * 33 + n;
        v4u o; o.x = pk2(s[0 * 33], s[1 * 33]); o.y = pk2(s[2 * 33], s[3 * 33]); o.z = pk2(s[4 * 33], s[5 * 33]); o.w = pk2(s[6 * 33], s[7 * 33]);
        *(GAS v4u*)(WT + (size_t)(n0 + n) * K + k0 + 8 * c) = o; }
    if (MAP != 0) {
        const LAS float* shs = scr + 64 * 33; const int n = lane & 31, hf = lane >> 5;
        float acc[8];
#pragma unroll
        for (int bb = 0; bb < 8; ++bb) acc[bb] = 0.f;
#pragma unroll 8
        for (int i = 0; i < 32; ++i) { const int kk = 32 * hf + i; const float w = scr[kk * 33 + n]; const f32x4 s0 = *(const LAS f32x4*)(shs + kk * 8), s1 = *(const LAS f32x4*)(shs + kk * 8 + 4);
            acc[0] += w * s0[0]; acc[1] += w * s0[1]; acc[2] += w * s0[2]; acc[3] += w * s0[3]; acc[4] += w * s1[0]; acc[5] += w * s1[1]; acc[6] += w * s1[2]; acc[7] += w * s1[3]; }
#pragma unroll
        for (int bb = 0; bb < 8; ++bb) { acc[bb] += __shfl_xor(acc[bb], 32); if (hf == 0 && src >= 0) atomicAdd((unsigned long long*)(biasp + (size_t)bb * Ndst + n0 + n), (unsigned long long)__float2ll_rn(acc[bb] * 4294967296.0f)); }
    }
    LDS_WAIT(); asm volatile("" ::: "memory");
}
__device__ __forceinline__ void prologue0(const Args& a, LAS unsigned char* lds, int tid, int lane, int wave, int G) {
    unsigned char* ws = a.ws;
    LAS float* cact = (LAS float*)(lds + 69632);
    LAS float* red = (LAS float*)(lds + 102400);
    for (int i = tid; i < BATCH * DM; i += NTHR) { const float v = a.in[1][i]; cact[i] = silu_acc(v); }
    __syncthreads();
    float* cond = (float*)(ws + WS_COND);
    for (int item = blockIdx.x; item < DEPTH * (NCOND / 64); item += G) {
        const int l = item / (NCOND / 64), cb = item % (NCOND / 64), col = cb * 64 + lane, ks = wave;
        const float* W = a.in[2] + (size_t)l * DM * NCOND + col;
        float acc[8];
#pragma unroll
        for (int b = 0; b < 8; ++b) acc[b] = 0.f;
        for (int k = ks * 128; k < ks * 128 + 128; k += 16) { float w[16];
#pragma unroll
            for (int i = 0; i < 16; ++i) w[i] = W[(size_t)(k + i) * NCOND];
#pragma unroll
            for (int i = 0; i < 16; ++i)
#pragma unroll
                for (int b = 0; b < 8; ++b) acc[b] += cact[b * DM + k + i] * w[i]; }
#pragma unroll
        for (int b = 0; b < 8; ++b) red[(ks * 8 + b) * 64 + lane] = acc[b];
        __syncthreads();
        { const int b = wave; float s = 0.f;
#pragma unroll
          for (int k2 = 0; k2 < 8; ++k2) s += red[(k2 * 8 + b) * 64 + lane];
          cond[((size_t)l * BATCH + b) * NCOND + col] = s + a.in[3][(size_t)l * NCOND + col]; }
        __syncthreads();
    }
    float2* rope = (float2*)(ws + WS_ROPE);
    for (int e = blockIdx.x * NTHR + tid; e < SEQ * 32; e += G * NTHR) { const int s = e >> 5, i = e & 31; const double rev = (double)s * INVREV[i]; const float fr = (float)(rev - rint(rev));
        rope[e] = make_float2(__builtin_amdgcn_cosf(fr), __builtin_amdgcn_sinf(fr)); }
    { GAS f32x4* z = (GAS f32x4*)(ws + WS_BIASQ); for (size_t i = (size_t)blockIdx.x * NTHR + tid; i < BIASQ_BYTES / 16; i += (size_t)G * NTHR) z[i] = (f32x4){0.f, 0.f, 0.f, 0.f};
      GAS f32x4* z2 = (GAS f32x4*)(ws + WS_SS); for (size_t i = (size_t)blockIdx.x * NTHR + tid; i < SS_BYTES / 16; i += (size_t)G * NTHR) z2[i] = (f32x4){0.f, 0.f, 0.f, 0.f}; }
}
__device__ __forceinline__ void prologue1(const Args& a, LAS unsigned char* lds, int lane, int wave, int G) {
    unsigned char* ws = a.ws;
    LAS float* scr = (LAS float*)(lds + wave * 10496);
    const float* cond = (const float*)(ws + WS_COND);
    const int gw = blockIdx.x * NWAVES + wave, NGW = G * NWAVES;
    constexpr int I_UP = (DM / 64) * (NUP / 32), I_DN = (DFF / 64) * (DM / 32), I_IN = (DM / 64) * (NPROJ / 32), I_OUT = (DM / 64) * (DM / 32), I_LAYER = 2 * I_UP + 2 * I_DN + I_IN + I_OUT;
    for (int it = gw; it < DEPTH * I_LAYER; it += NGW) {
        const int l = it / I_LAYER; int r = it % I_LAYER;
        unsigned char* wl = ws + WS_W + (size_t)l * LAYER_W; const float* cl = cond + (size_t)l * BATCH * NCOND; long long* bl = (long long*)(ws + WS_BIASQ + (size_t)l * 3 * 2 * BIAS_USE);
        if (r < I_UP) { tr_item<1>(a.in[5] + (size_t)l * DM * NUP, DM, NUP, (bf16*)(wl + OFF_UP1), r / (NUP / 32), r % (NUP / 32), scr, lane, cl + 0 * DM, bl, NUP); continue; } r -= I_UP;
        if (r < I_DN) { tr_item<0>(a.in[6] + (size_t)l * DFF * DM, DFF, DM, (bf16*)(wl + OFF_DN1), r / (DM / 32), r % (DM / 32), scr, lane, nullptr, nullptr, 0); continue; } r -= I_DN;
        if (r < I_UP) { tr_item<1>(a.in[7] + (size_t)l * DM * NUP, DM, NUP, (bf16*)(wl + OFF_UP2), r / (NUP / 32), r % (NUP / 32), scr, lane, cl + 6 * DM, bl + 2 * 8 * NUP, NUP); continue; } r -= I_UP;
        if (r < I_DN) { tr_item<0>(a.in[8] + (size_t)l * DFF * DM, DFF, DM, (bf16*)(wl + OFF_DN2), r / (DM / 32), r % (DM / 32), scr, lane, nullptr, nullptr, 0); continue; } r -= I_DN;
        if (r < I_IN) { tr_item<2>(a.in[9] + (size_t)l * DM * NIN_SRC, DM, NIN_SRC, (bf16*)(wl + OFF_IN), r / (NPROJ / 32), r % (NPROJ / 32), scr, lane, cl + 3 * DM, bl + 1 * 8 * NUP, NPROJ); continue; } r -= I_IN;
        tr_item<0>(a.in[10] + (size_t)l * DM * DM, DM, DM, (bf16*)(wl + OFF_OUT), r / (DM / 32), r % (DM / 32), scr, lane, nullptr, nullptr, 0);
    }
}
__device__ __forceinline__ void thin_xg(const float* x, bf16* hb, bf16* xb, const float* g, const float* cond_l, int sc_off, long long* ss, int gw, int NGW, int lane) {
    for (int m = gw; m < M; m += NGW) {
        const int b = m >> 11;
        const GAS f32x4* xr = (const GAS f32x4*)(x + (size_t)m * DM) + lane;
        f32x4 v[4]; float s = 0.f;
#pragma unroll
        for (int j = 0; j < 4; ++j) { v[j] = xr[64 * j]; s += (v[j].x * v[j].x + v[j].y * v[j].y) + (v[j].z * v[j].z + v[j].w * v[j].w); }
        s = wave_sum(s); if (lane == 0) ss[m] = __float2ll_rn(s * 16777216.0f);
        const f32x4* g4 = (const f32x4*)g + lane; const f32x4* sc4 = (const f32x4*)(cond_l + (size_t)b * NCOND + sc_off) + lane;
        GAS unsigned long long* o8 = (GAS unsigned long long*)(hb + (size_t)m * DM) + lane;
#pragma unroll
        for (int j = 0; j < 4; ++j) { const f32x4 o = v[j] * g4[64 * j] * (sc4[64 * j] + 1.0f);
            o8[64 * j] = (unsigned long long)pk2(o.x, o.y) | ((unsigned long long)pk2(o.z, o.w) << 32); }
        GAS unsigned long long* x8 = (GAS unsigned long long*)(xb + (size_t)m * DM) + lane;
#pragma unroll
        for (int j = 0; j < 4; ++j) x8[64 * j] = (unsigned long long)pk2(v[j].x, v[j].y) | ((unsigned long long)pk2(v[j].z, v[j].w) << 32);
    }
}
__device__ __forceinline__ void thin_norm(const float* x, bf16* hb, const float* g, const float* cond_l, int sh_off, int sc_off, int gw, int NGW, int lane) {
    for (int m = gw; m < M; m += NGW) {
        const int b = m >> 11;
        const GAS f32x4* xr = (const GAS f32x4*)(x + (size_t)m * DM) + lane;
        f32x4 v[4]; float s = 0.f;
#pragma unroll
        for (int j = 0; j < 4; ++j) { v[j] = xr[64 * j]; s += (v[j].x * v[j].x + v[j].y * v[j].y) + (v[j].z * v[j].z + v[j].w * v[j].w); }
        const float rstd = 1.0f / sqrtf(wave_sum(s) * (1.0f / DM) + RMS_EPS);
        const f32x4* g4 = (const f32x4*)g + lane; const f32x4* sh4 = (const f32x4*)(cond_l + (size_t)b * NCOND + sh_off) + lane; const f32x4* sc4 = (const f32x4*)(cond_l + (size_t)b * NCOND + sc_off) + lane;
        GAS unsigned long long* o8 = (GAS unsigned long long*)(hb + (size_t)m * DM) + lane;
#pragma unroll
        for (int j = 0; j < 4; ++j) { const f32x4 gg = g4[64 * j], sh = sh4[64 * j], sc = sc4[64 * j]; const f32x4 o = v[j] * rstd * gg * (sc + 1.0f) + sh;
            o8[64 * j] = (unsigned long long)pk2(o.x, o.y) | ((unsigned long long)pk2(o.z, o.w) << 32); }
    }
}

typedef float f32x16 __attribute__((ext_vector_type(16)));
typedef short s16x4 __attribute__((ext_vector_type(4)));
typedef float f32x2_t __attribute__((ext_vector_type(2))); typedef __bf16 bf16x2_t __attribute__((ext_vector_type(2)));
#define MFMA32(a, b, c) __builtin_amdgcn_mfma_f32_32x32x16_bf16((a), (b), (c), 0, 0, 0)
constexpr float LOG2E = 1.4426950408889634f;
__device__ __forceinline__ unsigned cvtpk(float lo, float hi) { f32x2_t v = {lo, hi}; bf16x2_t b = __builtin_convertvector(v, bf16x2_t); return __builtin_bit_cast(unsigned, b); }
template <int KAP> __device__ __forceinline__ bf16x8 pack8(const f32x16& x) {
    v4u p; p.x = cvtpk(x[8 * KAP + 0], x[8 * KAP + 1]); p.y = cvtpk(x[8 * KAP + 2], x[8 * KAP + 3]); p.z = cvtpk(x[8 * KAP + 4], x[8 * KAP + 5]); p.w = cvtpk(x[8 * KAP + 6], x[8 * KAP + 7]);
    return __builtin_bit_cast(bf16x8, p); }
__device__ __forceinline__ bf16x8 ld_perm(const bf16* p) { const s16x4 lo = *(const s16x4*)p, hi = *(const s16x4*)(p + 8); return __builtin_shufflevector(lo, hi, 0, 1, 2, 3, 4, 5, 6, 7); }
__device__ __forceinline__ float fmax16(const f32x16& a) { float m0 = fmaxf(fmaxf(a[0], a[1]), fmaxf(a[2], a[3])), m1 = fmaxf(fmaxf(a[4], a[5]), fmaxf(a[6], a[7])), m2 = fmaxf(fmaxf(a[8], a[9]), fmaxf(a[10], a[11])), m3 = fmaxf(fmaxf(a[12], a[13]), fmaxf(a[14], a[15])); return fmaxf(fmaxf(m0, m1), fmaxf(m2, m3)); }

struct MixBufs {
    const bf16* proj; const float* gates;
    bf16* vtf;
    float* lcum;
    float* ctot;
    bf16* ql;
    bf16* kl;
    bf16* kt;
    bf16* vtl;
    float* xs;
    float* a1; float* a2; float* beta;
    float* s1; float* s2;
    float* den;
    float* yraw;
};
__device__ __forceinline__ float wave_scan_add(float v, int lane) {
#pragma unroll
    for (int o = 1; o < 64; o <<= 1) { const float u = __shfl_up(v, o); if (lane >= o) v += u; }
    return v; }
__device__ __forceinline__ float wave_scan_max(float v, int lane) {
#pragma unroll
    for (int o = 1; o < 64; o <<= 1) { const float u = __shfl_up(v, o); if (lane >= o) v = fmaxf(v, u); }
    return v; }

struct PrepW { const float* mcw; const float* mcb; const float* scw; const float* scb; const float* fox_fb; const float* mib; const float* mfb; const float* dtb; const float* alog; const float2* rope; };
__device__ __forceinline__ void prep_unit(const MixBufs& B, const PrepW& W, int u, int wave, int lane) {
    const int b = u >> 5, c = u & 31, s0 = 64 * c; const size_t m0 = (size_t)b * SEQ + s0;
    for (int job = wave; job < 52; job += NWAVES) {
        if (job < 36) {
            const int kind = job < 32 ? (job >> 2) : (job < 34 ? 8 : 9), h = job < 32 ? (job & 3) : (job & 1);
            const int cg = lane & 7, tb = lane >> 3, tok0 = 8 * tb;
            const int pc = (kind == 0 ? PC_FV + h * 64 : kind == 1 ? PC_MV + h * 64 : kind == 2 ? PC_RV + h * 64 : kind == 3 ? PC_MQ + h * 64 : kind == 4 ? PC_MK + h * 64 : kind == 5 ? PC_RQ + h * 64 : kind == 6 ? PC_RK + h * 64
                         : kind == 7 ? PC_SX + h * 64 : kind == 8 ? PC_SX + 256 + h * 64 : PC_SX + 384 + h * 64);
            const bf16* src = B.proj + (m0 + tok0) * PROJ_LD + pc + 8 * cg;
            const bool is_conv = (kind == 3 || kind == 4 || kind >= 7), is_rot = (kind == 5 || kind == 6);
            v4u raw[8];
#pragma unroll
            for (int i = 0; i < 8; ++i) raw[i] = *(const GAS v4u*)(src + (size_t)i * PROJ_LD);
            float v[8][8];
#pragma unroll
            for (int i = 0; i < 8; ++i)
#pragma unroll
                for (int j = 0; j < 4; ++j) { v[i][2 * j] = __uint_as_float(raw[i][j] << 16); v[i][2 * j + 1] = __uint_as_float(raw[i][j] & 0xffff0000u); }
            if (is_conv) {
                const int cc = (kind == 3 ? h * 64 : kind == 4 ? 256 + h * 64 : kind == 7 ? h * 64 : kind == 8 ? 256 + h * 64 : 384 + h * 64) + 8 * cg; const float* cw = (kind <= 4) ? W.mcw : W.scw; const float* cbp = (kind <= 4) ? W.mcb : W.scb;
                float wt[4][8], cb[8], xh[3][8];
#pragma unroll
                for (int k = 0; k < 4; ++k) { const f32x4 a = *(const f32x4*)(cw + k * 512 + cc), d = *(const f32x4*)(cw + k * 512 + cc + 4);
#pragma unroll
                    for (int j = 0; j < 4; ++j) { wt[k][j] = a[j]; wt[k][4 + j] = d[j]; } }
                { const f32x4 a = *(const f32x4*)(cbp + cc), d = *(const f32x4*)(cbp + cc + 4);
#pragma unroll
                  for (int j = 0; j < 4; ++j) { cb[j] = a[j]; cb[4 + j] = d[j]; } }
                const bool has_halo = (c > 0) || (tb > 0);
#pragma unroll
                for (int k = 0; k < 3; ++k) { v4u hr = (v4u){0u, 0u, 0u, 0u}; if (has_halo) hr = *(const GAS v4u*)(src - (size_t)(3 - k) * PROJ_LD);
#pragma unroll
                    for (int j = 0; j < 4; ++j) { xh[k][2 * j] = __uint_as_float(hr[j] << 16); xh[k][2 * j + 1] = __uint_as_float(hr[j] & 0xffff0000u); } }
#pragma unroll
                for (int j = 0; j < 8; ++j) { float x0 = xh[0][j], x1 = xh[1][j], x2 = xh[2][j];
#pragma unroll
                    for (int i = 0; i < 8; ++i) { const float x3 = v[i][j]; float o = pg8::silu_f(cb[j] + wt[0][j] * x0 + wt[1][j] * x1 + wt[2][j] * x2 + wt[3][j] * x3); if (kind == 3) o *= 0.125f; v[i][j] = o; x0 = x1; x1 = x2; x2 = x3; } }
            } else if (is_rot) {
                const bf16* src2 = B.proj + (m0 + tok0) * PROJ_LD + pc + 8 * (cg ^ 4);
                const bool lowh = cg < 4; const float sc = (kind == 6) ? 0.125f : 1.0f;
#pragma unroll
                for (int i = 0; i < 8; ++i) { const v4u pr = *(const GAS v4u*)(src2 + (size_t)i * PROJ_LD); const float2* rp = W.rope + (size_t)(s0 + tok0 + i) * 32 + 8 * (cg & 3);
                    const f32x4 r0 = *(const GAS f32x4*)rp, r1 = *(const GAS f32x4*)(rp + 2), r2 = *(const GAS f32x4*)(rp + 4), r3 = *(const GAS f32x4*)(rp + 6);
                    const float cs[8] = {r0[0], r0[2], r1[0], r1[2], r2[0], r2[2], r3[0], r3[2]}, sn[8] = {r0[1], r0[3], r1[1], r1[3], r2[1], r2[3], r3[1], r3[3]};
#pragma unroll
                    for (int j = 0; j < 8; ++j) { const float pv = (j & 1) ? __uint_as_float(pr[j >> 1] & 0xffff0000u) : __uint_as_float(pr[j >> 1] << 16);
                        v[i][j] = (lowh ? v[i][j] * cs[j] - pv * sn[j] : pv * sn[j] + v[i][j] * cs[j]) * sc; } }
            }
            if (kind == 7) {
                const float dtb_h = W.dtb[h];
#pragma unroll
                for (int i = 0; i < 8; ++i) { bf16* xp = (bf16*)B.xs + (m0 + tok0 + i) * 256 + h * 64 + 8 * cg; *(GAS v4u*)xp = (v4u){cvtpk(v[i][0], v[i][1]), cvtpk(v[i][2], v[i][3]), cvtpk(v[i][4], v[i][5]), cvtpk(v[i][6], v[i][7])};
                    const float dt = softplus_f(((const GAS float*)B.gates)[(m0 + tok0 + i) * 16 + 12 + h] + dtb_h);
#pragma unroll
                    for (int j = 0; j < 8; ++j) v[i][j] *= dt; }
            }
            unsigned P[8][4];
#pragma unroll
            for (int i = 0; i < 8; ++i)
#pragma unroll
                for (int j = 0; j < 4; ++j) P[i][j] = cvtpk(v[i][2 * j], v[i][2 * j + 1]);
            bf16* rm = nullptr;
            if (kind == 3) rm = B.ql + (0 * (size_t)M + m0) * 256 + h * 64; else if (kind == 4) rm = B.kl + (0 * (size_t)M + m0) * 256 + h * 64;
            else if (kind == 5) rm = B.ql + (1 * (size_t)M + m0) * 256 + h * 64; else if (kind == 6) rm = B.kl + (1 * (size_t)M + m0) * 256 + h * 64;
            else if (kind == 8) rm = B.kl + (2 * (size_t)M + m0) * 256 + h * 64; else if (kind == 9) rm = B.ql + (2 * (size_t)M + m0) * 256 + h * 64;
            if (rm) {
#pragma unroll
                for (int i = 0; i < 8; ++i) *(GAS v4u*)(rm + (size_t)(tok0 + i) * 256 + 8 * cg) = (v4u){P[i][0], P[i][1], P[i][2], P[i][3]};
            }
            bf16* tr = nullptr;
            if (kind == 0) tr = B.vtf + ((size_t)(b * 4 + h) * 64) * SEQ;
            else if (kind == 1) tr = B.vtl + (((size_t)(0 * BATCH + b) * 4 + h) * 96) * SEQ;
            else if (kind == 2) tr = B.vtl + (((size_t)(1 * BATCH + b) * 4 + h) * 96) * SEQ;
            else if (kind == 7) tr = B.vtl + (((size_t)(2 * BATCH + b) * 4 + h) * 96) * SEQ;
            else if (kind == 4) tr = B.kt + (((size_t)(0 * BATCH + b) * 4 + h) * 64) * SEQ;
            else if (kind == 6) tr = B.kt + (((size_t)(1 * BATCH + b) * 4 + h) * 64) * SEQ;
            else if (kind == 8) tr = B.kt + (((size_t)(2 * BATCH + b) * 4 + h) * 64) * SEQ;
            if (tr) {
                tr += s0 + tok0;
#pragma unroll
                for (int j = 0; j < 8; ++j) { v4u o;
#pragma unroll
                    for (int ip = 0; ip < 4; ++ip) o[ip] = (j & 1) ? ((P[2 * ip][j >> 1] >> 16) | (P[2 * ip + 1][j >> 1] & 0xffff0000u)) : ((P[2 * ip][j >> 1] & 0xffffu) | (P[2 * ip + 1][j >> 1] << 16));
                    *(GAS v4u*)(tr + (size_t)(8 * cg + j) * SEQ) = o; }
                if (kind == 1 && cg < 4) {
#pragma unroll
                    for (int j = 0; j < 8; ++j) { const unsigned w = (cg == 0 && j == 0) ? 0x3f803f80u : 0u; *(GAS v4u*)(tr + (size_t)(64 + 8 * cg + j) * SEQ) = (v4u){w, w, w, w}; }
                }
            }
        } else {
            const int gj = job - 36, mixer = gj >> 2, h = gj & 3;
            const size_t m = m0 + lane;
            if (mixer == 0) {
                const float cum = wave_scan_add(log_sigmoid_f(((const GAS float*)B.gates)[m * 16 + h] + W.fox_fb[h]), lane);
                ((GAS float*)B.lcum)[(size_t)(b * 4 + h) * SEQ + s0 + lane] = cum; if (lane == 63) ((GAS float*)B.ctot)[(b * 4 + h) * 32 + c] = cum;
            } else {
                const int mx = mixer - 1; const size_t ci = ((size_t)(mx * BATCH + b) * 4 + h) * SEQ + s0 + lane; const int si = ((mx * BATCH + b) * 4 + h) * 32 + c;
                if (mx == 0) {
                    const float bb = wave_scan_add(log_sigmoid_f(((const GAS float*)B.gates)[m * 16 + 8 + h] + W.mfb[h]), lane), ic = ((const GAS float*)B.gates)[m * 16 + 4 + h] + W.mib[h], be = bb - ic, pm = wave_scan_max(-be, lane);
                    ((GAS float*)B.a1)[ci] = bb; ((GAS float*)B.a2)[ci] = bb + pm; ((GAS float*)B.beta)[ci] = be; if (lane == 63) { ((GAS float*)B.s1)[si] = bb; ((GAS float*)B.s2)[si] = bb + pm; }
                } else if (mx == 1) {
                    const float lg = log1pf(-exp2f(-5.0f - (float)h)), v = (float)(lane + 1) * lg;
                    ((GAS float*)B.a1)[ci] = v; ((GAS float*)B.a2)[ci] = 0.f; ((GAS float*)B.beta)[ci] = v; if (lane == 63) { ((GAS float*)B.s1)[si] = v; ((GAS float*)B.s2)[si] = 0.f; }
                } else {
                    const float dt = softplus_f(((const GAS float*)B.gates)[m * 16 + 12 + h] + W.dtb[h]), cum = wave_scan_add(dt * (-__expf(W.alog[h])), lane);
                    ((GAS float*)B.a1)[ci] = cum; ((GAS float*)B.a2)[ci] = 0.f; ((GAS float*)B.beta)[ci] = cum; if (lane == 63) { ((GAS float*)B.s1)[si] = cum; ((GAS float*)B.s2)[si] = 0.f; }
                }
            }
        }
    }
}

__device__ __forceinline__ int sig32(int i) { return (i & ~0xC) | ((i & 4) << 1) | ((i & 8) >> 1); }
#define GLDS16(gp, lp) __builtin_amdgcn_global_load_lds((const unsigned*)(gp), (LAS unsigned*)(lp), 16, 0, 0)
#define VMWAIT(n) asm volatile("s_waitcnt vmcnt(" #n ")" ::: "memory")
#define WGBAR() do { asm volatile("" ::: "memory"); __builtin_amdgcn_s_barrier(); asm volatile("" ::: "memory"); } while (0)
constexpr int FOX_SLOT = 16384, FOX_LC = 3 * FOX_SLOT;
__device__ __forceinline__ void fox_wg_unit(const MixBufs& B, bf16* ybf, LAS unsigned char* lds, int b, int h, int qb8, int wave, int lane) {
    const int col = lane & 31, hi = lane >> 5, t0 = 256 * qb8 + 32 * wave;
    const size_t rowq = (size_t)b * SEQ + t0 + col;
    bf16x8 qf[4];
#pragma unroll
    for (int ks = 0; ks < 4; ++ks) qf[ks] = *(const bf16x8*)(B.proj + rowq * PROJ_LD + PC_FQ + h * 64 + 16 * ks + 8 * hi);
    float offv; { const float cv = (lane < 32) ? B.ctot[(b * 4 + h) * 32 + lane] : 0.f; offv = wave_scan_add(cv, lane) - cv; }
    if (wave <= qb8) GLDS16(B.lcum + (size_t)(b * 4 + h) * SEQ + 256 * wave + 4 * lane, lds + FOX_LC + 1024 * wave);
    const bf16* ksrc = B.proj + ((size_t)b * SEQ + 32 * (wave >> 2) + sig32(col)) * PROJ_LD + PC_FK + h * 64 + 16 * (wave & 3) + 8 * hi;
    const bf16* vsrc = B.vtf + ((size_t)(b * 4 + h) * 64 + 32 * (wave >> 2) + col) * SEQ + 16 * (wave & 3) + 8 * hi;
    const int nkt = 4 * (qb8 + 1), tdiag = 4 * qb8 + (wave >> 1);
#define FOX_ISSUE(t, slot) do { GLDS16(ksrc + (size_t)(64 * (t)) * PROJ_LD, lds + (slot) * FOX_SLOT + 1024 * wave); GLDS16(vsrc + 64 * (t), lds + (slot) * FOX_SLOT + 8192 + 1024 * wave); } while (0)
    VMWAIT(0); WGBAR();
    if (wave <= qb8) {
        LAS f32x4* lp = (LAS f32x4*)(lds + FOX_LC + 1024 * wave) + lane; const f32x4 cv = *lp;
        const float o = __shfl(offv, 4 * wave + (lane >> 4));
        *lp = (cv + o) * (-LOG2E);
    }
    asm volatile("s_waitcnt lgkmcnt(0)" ::: "memory"); WGBAR();
    FOX_ISSUE(0, 0); FOX_ISSUE(1, 1);
    float mrun = -INFINITY, lsum = 0.f; f32x16 O0, O1;
#pragma unroll
    for (int r = 0; r < 16; ++r) { O0[r] = 0.f; O1[r] = 0.f; }
    int slot = 0;
    for (int kt = 0; kt < nkt; ++kt) {
        VMWAIT(2); WGBAR();
        { const int tn = (kt + 2 < nkt) ? kt + 2 : nkt - 1; const int sn = (slot == 0) ? 2 : slot - 1; FOX_ISSUE(tn, sn); }
        if (kt <= tdiag) {
            const int s0 = 64 * kt;
            const LAS unsigned char* sp = lds + slot * FOX_SLOT + 16 * lane;
            const LAS float* lc = (const LAS float*)(lds + FOX_LC) + s0 + 8 * hi;
            f32x16 S0, S1;
#pragma unroll
            for (int j = 0; j < 4; ++j) { const f32x4 c0 = *(const LAS f32x4*)(lc + 16 * j), c1 = *(const LAS f32x4*)(lc + 16 * j + 4);
#pragma unroll
                for (int i = 0; i < 4; ++i) { if (j < 2) { S0[8 * j + i] = c0[i]; S0[8 * j + 4 + i] = c1[i]; } else { S1[8 * (j - 2) + i] = c0[i]; S1[8 * (j - 2) + 4 + i] = c1[i]; } } }
#pragma unroll
            for (int ks = 0; ks < 4; ++ks) { S0 = MFMA32(*(const LAS bf16x8*)(sp + ks * 1024), qf[ks], S0); S1 = MFMA32(*(const LAS bf16x8*)(sp + (4 + ks) * 1024), qf[ks], S1); }
            if (kt == tdiag) {
                const int tq = t0 + col - s0;
#pragma unroll
                for (int r = 0; r < 16; ++r) { const int sl = 16 * (r >> 3) + 8 * hi + (r & 7); if (sl > tq) S0[r] = -INFINITY; if (sl + 32 > tq) S1[r] = -INFINITY; }
            }
            float mloc = fmaxf(fmax16(S0), fmax16(S1)); mloc = fmaxf(mloc, __shfl_xor(mloc, 32));
            const float mnew = fmaxf(mrun, mloc), alpha = __builtin_amdgcn_exp2f(mrun - mnew); mrun = mnew;
            float psum = 0.f;
#pragma unroll
            for (int r = 0; r < 16; ++r) { S0[r] = __builtin_amdgcn_exp2f(S0[r] - mnew); S1[r] = __builtin_amdgcn_exp2f(S1[r] - mnew); psum += S0[r] + S1[r]; }
            lsum = lsum * alpha + psum;
#pragma unroll
            for (int r = 0; r < 16; ++r) { O0[r] *= alpha; O1[r] *= alpha; }
            { const bf16x8 p00 = pack8<0>(S0), p01 = pack8<1>(S0), p10 = pack8<0>(S1), p11 = pack8<1>(S1);
              const LAS unsigned char* vp = sp + 8192;
              O0 = MFMA32(*(const LAS bf16x8*)(vp), p00, O0); O0 = MFMA32(*(const LAS bf16x8*)(vp + 1024), p01, O0); O0 = MFMA32(*(const LAS bf16x8*)(vp + 2048), p10, O0); O0 = MFMA32(*(const LAS bf16x8*)(vp + 3072), p11, O0);
              O1 = MFMA32(*(const LAS bf16x8*)(vp + 4096), p00, O1); O1 = MFMA32(*(const LAS bf16x8*)(vp + 5120), p01, O1); O1 = MFMA32(*(const LAS bf16x8*)(vp + 6144), p10, O1); O1 = MFMA32(*(const LAS bf16x8*)(vp + 7168), p11, O1); }
        }
        asm volatile("" ::: "memory");
        slot = (slot == 2) ? 0 : slot + 1;
    }
#undef FOX_ISSUE
    const float rl = 1.0f / (lsum + __shfl_xor(lsum, 32));
    bf16* yp = ybf + rowq * DM + h * 64 + 4 * hi;
#pragma unroll
    for (int g = 0; g < 4; ++g) { *(unsigned long long*)(yp + 8 * g) = (unsigned long long)cvtpk(O0[4 * g] * rl, O0[4 * g + 1] * rl) | ((unsigned long long)cvtpk(O0[4 * g + 2] * rl, O0[4 * g + 3] * rl) << 32);
                                  *(unsigned long long*)(yp + 32 + 8 * g) = (unsigned long long)cvtpk(O1[4 * g] * rl, O1[4 * g + 1] * rl) | ((unsigned long long)cvtpk(O1[4 * g + 2] * rl, O1[4 * g + 3] * rl) << 32); }
    VMWAIT(0); WGBAR();
}

constexpr int LIN_BUF = 30720, LIN_STF = 3 * LIN_BUF;
__device__ __forceinline__ void lin_wg_unit(const MixBufs& B, LAS unsigned char* lbuf, int mx, int b, int h, int es, int wave, int lane) {
    const int col = lane & 31, hi = lane >> 5, hk = (mx == 2) ? (h >> 1) : h; const bool ml = (mx == 0);
    const size_t cbase = (((size_t)mx * BATCH + b) * 4 + h) * SEQ; const int sbase = ((mx * BATCH + b) * 4 + h) * 32;
    if (wave >= 1 && wave <= 4) {
        const bf16* src; size_t step_c, step_hi, step_lo; int np, f0;
        if (wave == 1)      { src = B.ql + ((size_t)mx * M + (size_t)b * SEQ + col) * 256 + hk * 64 + 8 * hi;            step_c = 64 * 256; step_hi = 32 * 256; step_lo = 16; np = 8; f0 = 0; }
        else if (wave == 2) { src = B.kl + ((size_t)mx * M + (size_t)b * SEQ + sig32(col)) * 256 + hk * 64 + 8 * hi;     step_c = 64 * 256; step_hi = 32 * 256; step_lo = 16; np = 8; f0 = 8; }
        else if (wave == 3) { src = B.kt + ((((size_t)mx * BATCH + b) * 4 + hk) * 64 + sig32(col)) * SEQ + 8 * hi;      step_c = 64; step_hi = (size_t)32 * SEQ; step_lo = 16; np = 8; f0 = 16; }
        else                { src = B.vtl + ((((size_t)mx * BATCH + b) * 4 + h) * 96 + 32 * es + col) * SEQ + 8 * hi;   step_c = 64; step_hi = 0; step_lo = 16; np = 4; f0 = 24; }
        const int cl = lane & 15; const bool sc_lane = (lane == 48 || lane == 49);
        const float* cfp = (lane < 16) ? B.a1 + cbase + 4 * cl : (lane < 32) ? B.a2 + cbase + 4 * cl : (lane < 48) ? B.beta + cbase + 4 * cl : (lane == 48) ? B.s1 + sbase : (lane == 49) ? B.s2 + sbase : B.a1 + cbase;
#define LIN_ISSUE(c, bi) do { LAS unsigned char* bb_ = lbuf + (bi) * LIN_BUF + f0 * 1024; const bf16* sc_ = src + (size_t)(c) * step_c; \
            _Pragma("unroll") for (int f = 0; f < 8; ++f) if (f < np) GLDS16(sc_ + (size_t)(f >> 2) * step_hi + (size_t)(f & 3) * step_lo, bb_ + f * 1024); \
            if (wave == 4) GLDS16(cfp + (sc_lane ? 4 * ((c) >> 2) : 64 * (c)), lbuf + (bi) * LIN_BUF + 28 * 1024); } while (0)
        LIN_ISSUE(0, 0); LIN_ISSUE(1, 1);
        if (wave == 4) VMWAIT(5); else VMWAIT(8);
        WGBAR();
        int bi = 2;
        for (int c = 0; c < 32; ++c) {
            const int cc = (c + 2 < 32) ? c + 2 : 31;
            LIN_ISSUE(cc, bi);
            if (wave == 4) VMWAIT(5); else VMWAIT(8);
            WGBAR();
            bi = (bi == 2) ? 0 : bi + 1;
        }
#undef LIN_ISSUE
        VMWAIT(0);
    } else if (wave == 0 || wave == 5) {
        const int tt = (wave == 5) ? 1 : 0;
        float mst = 0.f; int bi = 0;
        WGBAR();
        for (int c = 0; c < 32; ++c) {
            const int s0 = 64 * c;
            const LAS unsigned char* bp = lbuf + bi * LIN_BUF + 16 * lane;
            const LAS unsigned char* sf = lbuf + LIN_STF + (c & 1) * 4096 + 16 * lane;
            const LAS float* cf = (const LAS float*)(lbuf + bi * LIN_BUF + 28 * 1024);
#define LFR(f) (*(const LAS bf16x8*)(bp + (f) * 1024))
            const float S1v = cf[192 + (c & 3)], S2v = cf[196 + (c & 3)];
            float mnew = 0.f;
            if (ml) mnew = fmaxf(S1v + mst, S2v);
            const float a1 = cf[32 * tt + col]; float al = a1, rho = a1, mt = 0.f;
            if (ml) { mt = fmaxf(a1 + mst, cf[64 + 32 * tt + col]); al = a1 - mt; rho = a1 + mst - mt; }
            f32x16 y;
#pragma unroll
            for (int r = 0; r < 16; ++r) y[r] = 0.f;
#pragma unroll
            for (int j = 0; j < 4; ++j) y = MFMA32(*(const LAS bf16x8*)(sf + j * 1024), LFR(tt * 4 + j), y);
            const float er = __expf(rho);
#pragma unroll
            for (int r = 0; r < 16; ++r) y[r] *= er;
            for (int st = 0; st <= tt; ++st) {
                f32x4 bD[2][2];
#pragma unroll
                for (int k = 0; k < 2; ++k) { bD[k][0] = *(const LAS f32x4*)(cf + 128 + 16 * (2 * st + k) + 8 * hi); bD[k][1] = *(const LAS f32x4*)(cf + 128 + 16 * (2 * st + k) + 8 * hi + 4); }
                f32x16 p;
#pragma unroll
                for (int r = 0; r < 16; ++r) p[r] = 0.f;
#pragma unroll
                for (int ks = 0; ks < 4; ++ks) p = MFMA32(LFR(8 + st * 4 + ks), LFR(tt * 4 + ks), p);
#pragma unroll
                for (int r = 0; r < 16; ++r) { float v = p[r] * __expf(al - bD[r >> 3][(r >> 2) & 1][r & 3]); if (st == tt && (16 * (r >> 3) + 8 * hi + (r & 7)) > col) v = 0.f; p[r] = v; }
                y = MFMA32(LFR(24 + 2 * st), pack8<0>(p), y); y = MFMA32(LFR(24 + 2 * st + 1), pack8<1>(p), y);
            }
            { const size_t row = (size_t)b * SEQ + s0 + 32 * tt + col;
              if (es < 2) { bf16* yp = (bf16*)B.yraw + row * 1024 + 256 * (mx + 1) + h * 64 + 32 * es + 4 * hi;
#pragma unroll
                  for (int g = 0; g < 4; ++g) *(unsigned long long*)(yp + 8 * g) = (unsigned long long)cvtpk(y[4 * g], y[4 * g + 1]) | ((unsigned long long)cvtpk(y[4 * g + 2], y[4 * g + 3]) << 32); }
              else if (hi == 0) { B.den[row * 8 + h * 2] = y[0]; B.den[row * 8 + h * 2 + 1] = mt; } }
#undef LFR
            if (ml) mst = mnew;
            asm volatile("s_waitcnt lgkmcnt(0)" ::: "memory");
            WGBAR();
            bi = (bi == 2) ? 0 : bi + 1;
        }
    } else if (wave == 6) {
        f32x16 st0, st1;
#pragma unroll
        for (int r = 0; r < 16; ++r) { st0[r] = 0.f; st1[r] = 0.f; }
        { LAS unsigned char* sf = lbuf + LIN_STF + 16 * lane;
#pragma unroll
          for (int j = 0; j < 4; ++j) *(LAS v4u*)(sf + j * 1024) = (v4u){0u, 0u, 0u, 0u}; }
        float mst = 0.f; int bi = 0;
        asm volatile("s_waitcnt lgkmcnt(0)" ::: "memory");
        WGBAR();
        for (int c = 0; c < 32; ++c) {
            const LAS unsigned char* bp = lbuf + bi * LIN_BUF + 16 * lane;
            const LAS float* cf = (const LAS float*)(lbuf + bi * LIN_BUF + 28 * 1024);
#define LFR(f) (*(const LAS bf16x8*)(bp + (f) * 1024))
            const float S1v = cf[192 + (c & 3)], S2v = cf[196 + (c & 3)];
            float gam = S1v, dlt = S1v, mnew = 0.f;
            if (ml) { mnew = fmaxf(S1v + mst, S2v); gam = S1v - mnew; dlt = S1v + mst - mnew; }
            const float ed = __expf(dlt);
#pragma unroll
            for (int r = 0; r < 16; ++r) { st0[r] *= ed; st1[r] *= ed; }
#pragma unroll
            for (int k4 = 0; k4 < 4; ++k4) {
                const bf16x8 vr = LFR(24 + k4); const f32x4 b0 = *(const LAS f32x4*)(cf + 128 + 16 * k4 + 8 * hi), b1 = *(const LAS f32x4*)(cf + 128 + 16 * k4 + 8 * hi + 4);
                v4u wv; wv.x = cvtpk(bf2f((unsigned short)vr[0]) * __expf(gam - b0[0]), bf2f((unsigned short)vr[1]) * __expf(gam - b0[1])); wv.y = cvtpk(bf2f((unsigned short)vr[2]) * __expf(gam - b0[2]), bf2f((unsigned short)vr[3]) * __expf(gam - b0[3]));
                wv.z = cvtpk(bf2f((unsigned short)vr[4]) * __expf(gam - b1[0]), bf2f((unsigned short)vr[5]) * __expf(gam - b1[1])); wv.w = cvtpk(bf2f((unsigned short)vr[6]) * __expf(gam - b1[2]), bf2f((unsigned short)vr[7]) * __expf(gam - b1[3]));
                const bf16x8 wvf = __builtin_bit_cast(bf16x8, wv);
                st0 = MFMA32(LFR(16 + k4), wvf, st0); st1 = MFMA32(LFR(20 + k4), wvf, st1);
            }
#undef LFR
            { LAS unsigned char* sf = lbuf + LIN_STF + ((c + 1) & 1) * 4096 + 16 * lane;
              *(LAS bf16x8*)(sf) = pack8<0>(st0); *(LAS bf16x8*)(sf + 1024) = pack8<1>(st0); *(LAS bf16x8*)(sf + 2048) = pack8<0>(st1); *(LAS bf16x8*)(sf + 3072) = pack8<1>(st1); }
            if (ml) mst = mnew;
            asm volatile("s_waitcnt lgkmcnt(0)" ::: "memory");
            WGBAR();
            bi = (bi == 2) ? 0 : bi + 1;
        }
    } else {
        for (int c = 0; c < 33; ++c) WGBAR();
    }
    VMWAIT(0); WGBAR();
}
constexpr int MX_LC = 3 * 16384, MX_LIN = MX_LC + 8192, MX_STF = MX_LIN + 3 * LIN_BUF;
static_assert(MX_STF + 8192 <= LDSCTL_OFF, "mixer LDS map");
__device__ __forceinline__ void mixer_phase(const MixBufs& B, bf16* ybf, LAS unsigned char* lds, int vcu, int wave, int lane) {
    const int G = gridDim.x;
    const int col = lane & 31, hi = lane >> 5;
    for (int v = vcu; v < 256; v += G) {
        const int bh = v >> 3, i8 = v & 7, fb = bh >> 2, fh = bh & 3;
        const int nktA = 2 * i8 + 2, NF = 34;
        const bool has_lin = i8 < 7; const int lj = (bh & 3) * 7 + i8;
        int mx, lh, es; const int lb = fb; if (lj < 12) { mx = 0; lh = lj / 3; es = lj % 3; } else { const int w2 = lj - 12; mx = 1 + (w2 >> 3); lh = (w2 >> 1) & 3; es = w2 & 1; }
        const int hk = (mx == 2) ? (lh >> 1) : lh; const bool ml = (mx == 0);
        const size_t cbase = (((size_t)mx * BATCH + lb) * 4 + lh) * SEQ; const int sbase = ((mx * BATCH + lb) * 4 + lh) * 32;
        if (wave < 4) {
            int qb16 = i8, t0 = 128 * qb16 + 32 * wave, tdiag = 2 * qb16 + (wave >> 1);
            size_t rowq = (size_t)fb * SEQ + t0 + col;
            bf16x8 qf[4];
#pragma unroll
            for (int ks = 0; ks < 4; ++ks) qf[ks] = *(const GAS bf16x8*)(B.proj + rowq * PROJ_LD + PC_FQ + fh * 64 + 16 * ks + 8 * hi);
            float offv; { const float cv = (lane < 32) ? ((const GAS float*)B.ctot)[(fb * 4 + fh) * 32 + lane] : 0.f; offv = wave_scan_add(cv, lane) - cv; }
            GLDS16(B.lcum + (size_t)(fb * 4 + fh) * SEQ + 256 * wave + 4 * lane, lds + MX_LC + 1024 * wave);
            GLDS16(B.lcum + (size_t)(fb * 4 + fh) * SEQ + 256 * (wave + 4) + 4 * lane, lds + MX_LC + 1024 * (wave + 4));
            const bf16* ksrc = B.proj + ((size_t)fb * SEQ + sig32(col)) * PROJ_LD + PC_FK + fh * 64 + 16 * wave + 8 * hi;
            const bf16* vsrc = B.vtf + ((size_t)(fb * 4 + fh) * 64 + col) * SEQ + 16 * wave + 8 * hi;
#define FOX_ISSUE(kt, slot) do { LAS unsigned char* d_ = lds + (slot) * FOX_SLOT + 1024 * wave; const bf16* k_ = ksrc + (size_t)(64 * (kt)) * PROJ_LD; const bf16* v_ = vsrc + 64 * (kt); \
                GLDS16(k_, d_); GLDS16(k_ + (size_t)32 * PROJ_LD, d_ + 4096); GLDS16(v_, d_ + 8192); GLDS16(v_ + (size_t)32 * SEQ, d_ + 12288); } while (0)
            FOX_ISSUE(0, 0); FOX_ISSUE(1, 1);
            VMWAIT(8); WGBAR();
#pragma unroll
            for (int pz = 0; pz < 2; ++pz) { const int pc_ = wave + 4 * pz;
                LAS f32x4* lp = (LAS f32x4*)(lds + MX_LC + 1024 * pc_) + lane; const f32x4 cv = *lp; const float o = __shfl(offv, 4 * pc_ + (lane >> 4)); *lp = (cv + o) * (-LOG2E); }
            asm volatile("s_waitcnt lgkmcnt(0)" ::: "memory"); WGBAR();
            float mrun = -INFINITY, lsum = 0.f; f32x16 O0, O1;
#pragma unroll
            for (int r = 0; r < 16; ++r) { O0[r] = 0.f; O1[r] = 0.f; }
            int sl = 0;
            for (int f = 0; f < NF; ++f) {
                if (f + 1 < NF) VMWAIT(4); else VMWAIT(0);
                WGBAR();
                if (f + 2 < NF) { const int kn = (f + 2 < nktA) ? f + 2 : f + 2 - nktA; FOX_ISSUE(kn, (sl == 0) ? 2 : sl - 1); }
                if (f == nktA) {
                    const float rl = 1.0f / (lsum + __shfl_xor(lsum, 32));
                    bf16* yp = ybf + rowq * DM + fh * 64 + 4 * hi;
#pragma unroll
                    for (int g = 0; g < 4; ++g) { *(GAS unsigned long long*)(yp + 8 * g) = (unsigned long long)cvtpk(O0[4 * g] * rl, O0[4 * g + 1] * rl) | ((unsigned long long)cvtpk(O0[4 * g + 2] * rl, O0[4 * g + 3] * rl) << 32);
                                                  *(GAS unsigned long long*)(yp + 32 + 8 * g) = (unsigned long long)cvtpk(O1[4 * g] * rl, O1[4 * g + 1] * rl) | ((unsigned long long)cvtpk(O1[4 * g + 2] * rl, O1[4 * g + 3] * rl) << 32); }
                    qb16 = 15 - i8; t0 = 128 * qb16 + 32 * wave; tdiag = 2 * qb16 + (wave >> 1); rowq = (size_t)fb * SEQ + t0 + col;
#pragma unroll
                    for (int ks = 0; ks < 4; ++ks) qf[ks] = *(const GAS bf16x8*)(B.proj + rowq * PROJ_LD + PC_FQ + fh * 64 + 16 * ks + 8 * hi);
                    mrun = -INFINITY; lsum = 0.f;
#pragma unroll
                    for (int r = 0; r < 16; ++r) { O0[r] = 0.f; O1[r] = 0.f; }
                }
                const int kt = (f < nktA) ? f : f - nktA;
                if (kt <= tdiag) {
                    const int s0 = 64 * kt;
                    const LAS unsigned char* sp = lds + sl * FOX_SLOT + 16 * lane;
                    const LAS float* lc = (const LAS float*)(lds + MX_LC) + s0 + 8 * hi;
                    f32x16 S0, S1;
#pragma unroll
                    for (int j = 0; j < 4; ++j) { const f32x4 c0 = *(const LAS f32x4*)(lc + 16 * j), c1 = *(const LAS f32x4*)(lc + 16 * j + 4);
#pragma unroll
                        for (int i = 0; i < 4; ++i) { if (j < 2) { S0[8 * j + i] = c0[i]; S0[8 * j + 4 + i] = c1[i]; } else { S1[8 * (j - 2) + i] = c0[i]; S1[8 * (j - 2) + 4 + i] = c1[i]; } } }
#pragma unroll
                    for (int ks = 0; ks < 4; ++ks) { S0 = MFMA32(*(const LAS bf16x8*)(sp + ks * 1024), qf[ks], S0); S1 = MFMA32(*(const LAS bf16x8*)(sp + (4 + ks) * 1024), qf[ks], S1); }
                    if (kt == tdiag) {
                        const int tq = t0 + col - s0;
#pragma unroll
                        for (int r = 0; r < 16; ++r) { const int sl = 16 * (r >> 3) + 8 * hi + (r & 7); if (sl > tq) S0[r] = -INFINITY; if (sl + 32 > tq) S1[r] = -INFINITY; }
                    }
                    float mloc = fmaxf(fmax16(S0), fmax16(S1)); mloc = fmaxf(mloc, __shfl_xor(mloc, 32));
                    const float mnew = fmaxf(mrun, mloc), alpha = __builtin_amdgcn_exp2f(mrun - mnew); mrun = mnew;
                    float psum = 0.f;
#pragma unroll
                    for (int r = 0; r < 16; ++r) { S0[r] = __builtin_amdgcn_exp2f(S0[r] - mnew); S1[r] = __builtin_amdgcn_exp2f(S1[r] - mnew); psum += S0[r] + S1[r]; }
                    lsum = lsum * alpha + psum;
#pragma unroll
                    for (int r = 0; r < 16; ++r) { O0[r] *= alpha; O1[r] *= alpha; }
                    { const bf16x8 p00 = pack8<0>(S0), p01 = pack8<1>(S0), p10 = pack8<0>(S1), p11 = pack8<1>(S1);
                      const LAS unsigned char* vp = sp + 8192;
                      O0 = MFMA32(*(const LAS bf16x8*)(vp), p00, O0); O0 = MFMA32(*(const LAS bf16x8*)(vp + 1024), p01, O0); O0 = MFMA32(*(const LAS bf16x8*)(vp + 2048), p10, O0); O0 = MFMA32(*(const LAS bf16x8*)(vp + 3072), p11, O0);
                      O1 = MFMA32(*(const LAS bf16x8*)(vp + 4096), p00, O1); O1 = MFMA32(*(const LAS bf16x8*)(vp + 5120), p01, O1); O1 = MFMA32(*(const LAS bf16x8*)(vp + 6144), p10, O1); O1 = MFMA32(*(const LAS bf16x8*)(vp + 7168), p11, O1); }
                }
                asm volatile("s_waitcnt lgkmcnt(0)" ::: "memory");
                sl = (sl == 2) ? 0 : sl + 1;
            }
#undef FOX_ISSUE
            { const float rl = 1.0f / (lsum + __shfl_xor(lsum, 32));
              bf16* yp = ybf + rowq * DM + fh * 64 + 4 * hi;
#pragma unroll
              for (int g = 0; g < 4; ++g) { *(GAS unsigned long long*)(yp + 8 * g) = (unsigned long long)cvtpk(O0[4 * g] * rl, O0[4 * g + 1] * rl) | ((unsigned long long)cvtpk(O0[4 * g + 2] * rl, O0[4 * g + 3] * rl) << 32);
                                            *(GAS unsigned long long*)(yp + 32 + 8 * g) = (unsigned long long)cvtpk(O1[4 * g] * rl, O1[4 * g + 1] * rl) | ((unsigned long long)cvtpk(O1[4 * g + 2] * rl, O1[4 * g + 3] * rl) << 32); } }
        } else {
            const bf16* src; size_t step_c, step_hi; int np, f0;
            if (wave == 4)      { src = B.ql + ((size_t)mx * M + (size_t)lb * SEQ + col) * 256 + hk * 64 + 8 * hi;            step_c = 64 * 256; step_hi = 32 * 256; np = 8; f0 = 0; }
            else if (wave == 6) { src = B.kt + ((((size_t)mx * BATCH + lb) * 4 + hk) * 64 + sig32(col)) * SEQ + 8 * hi;      step_c = 64; step_hi = (size_t)32 * SEQ; np = 8; f0 = 16; }
            else if (wave == 7) { src = B.vtl + ((((size_t)mx * BATCH + lb) * 4 + lh) * 96 + 32 * es + col) * SEQ + 8 * hi;  step_c = 64; step_hi = 0; np = 4; f0 = 24; }
            else                { src = B.ql; step_c = 0; step_hi = 0; np = 0; f0 = 0; }
            const bf16* srck = B.kl + ((size_t)mx * M + (size_t)lb * SEQ + sig32(col)) * 256 + hk * 64 + 8 * hi;
            const int cl = lane & 15; const bool sc_lane = (lane == 48 || lane == 49);
            const float* cfp = (lane < 16) ? B.a1 + cbase + 4 * cl : (lane < 32) ? B.a2 + cbase + 4 * cl : (lane < 48) ? B.beta + cbase + 4 * cl : (lane == 48) ? B.s1 + sbase : (lane == 49) ? B.s2 + sbase : B.a1 + cbase;
            LAS unsigned char* lbuf = lds + MX_LIN;
#define LIN_ISSUE(c, bi) do { LAS unsigned char* bb_ = lbuf + (bi) * LIN_BUF + f0 * 1024; const bf16* sc_ = src + (size_t)(c) * step_c; \
                _Pragma("unroll") for (int f = 0; f < 8; ++f) if (f < np) GLDS16(sc_ + (size_t)(f >> 2) * step_hi + (size_t)(f & 3) * 16, bb_ + f * 1024); \
                if (wave == 7) { const bf16* sk_ = srck + (size_t)(c) * (64 * 256); LAS unsigned char* bk_ = lbuf + (bi) * LIN_BUF + 8 * 1024; \
                    _Pragma("unroll") for (int f = 0; f < 8; ++f) GLDS16(sk_ + (size_t)(f >> 2) * (32 * 256) + (size_t)(f & 3) * 16, bk_ + f * 1024); \
                    GLDS16(cfp + (sc_lane ? 4 * ((c) >> 2) : 64 * (c)), lbuf + (bi) * LIN_BUF + 28 * 1024); } } while (0)
            if (has_lin) { LIN_ISSUE(0, 0); LIN_ISSUE(1, 1); }
            f32x16 st0, st1;
#pragma unroll
            for (int r = 0; r < 16; ++r) { st0[r] = 0.f; st1[r] = 0.f; }
            if (wave == 6) { LAS unsigned char* sf = lds + MX_STF + 16 * lane;
#pragma unroll
                for (int j = 0; j < 4; ++j) *(LAS v4u*)(sf + j * 1024) = (v4u){0u, 0u, 0u, 0u}; }
            asm volatile("s_waitcnt lgkmcnt(0)" ::: "memory"); WGBAR();
            WGBAR();
            float mst = 0.f; int bi = 0;
            for (int c = 0; c < NF; ++c) {
                if (c + 1 < 32) { if (wave == 7) VMWAIT(13); else if (wave == 5) VMWAIT(0); else VMWAIT(8); } else VMWAIT(0);
                WGBAR();
                if (has_lin && c < 32) {
                    if (c + 2 < 32) LIN_ISSUE(c + 2, (bi == 0) ? 2 : bi - 1);
                    const LAS unsigned char* bp = lbuf + bi * LIN_BUF + 16 * lane;
                    const LAS float* cf = (const LAS float*)(lbuf + bi * LIN_BUF + 28 * 1024);
#define LFR(f) (*(const LAS bf16x8*)(bp + (f) * 1024))
                    if (wave == 4 || wave == 5) {
                        const int tt = wave - 4, s0 = 64 * c;
                        const LAS unsigned char* sf = lds + MX_STF + (c & 1) * 4096 + 16 * lane;
                        const float S1v = cf[192 + (c & 3)], S2v = cf[196 + (c & 3)];
                        float mnew = 0.f;
                        if (ml) mnew = fmaxf(S1v + mst, S2v);
                        const float a1 = cf[32 * tt + col]; float al = a1, rho = a1, mt = 0.f;
                        if (ml) { mt = fmaxf(a1 + mst, cf[64 + 32 * tt + col]); al = a1 - mt; rho = a1 + mst - mt; }
                        f32x16 y;
#pragma unroll
                        for (int r = 0; r < 16; ++r) y[r] = 0.f;
#pragma unroll
                        for (int j = 0; j < 4; ++j) y = MFMA32(*(const LAS bf16x8*)(sf + j * 1024), LFR(tt * 4 + j), y);
                        const float er = __expf(rho);
#pragma unroll
                        for (int r = 0; r < 16; ++r) y[r] *= er;
                        for (int st = 0; st <= tt; ++st) {
                            f32x4 bD[2][2];
#pragma unroll
                            for (int k = 0; k < 2; ++k) { bD[k][0] = *(const LAS f32x4*)(cf + 128 + 16 * (2 * st + k) + 8 * hi); bD[k][1] = *(const LAS f32x4*)(cf + 128 + 16 * (2 * st + k) + 8 * hi + 4); }
                            f32x16 p;
#pragma unroll
                            for (int r = 0; r < 16; ++r) p[r] = 0.f;
#pragma unroll
                            for (int ks = 0; ks < 4; ++ks) p = MFMA32(LFR(8 + st * 4 + ks), LFR(tt * 4 + ks), p);
#pragma unroll
                            for (int r = 0; r < 16; ++r) { float vv = p[r] * __expf(al - bD[r >> 3][(r >> 2) & 1][r & 3]); if (st == tt && (16 * (r >> 3) + 8 * hi + (r & 7)) > col) vv = 0.f; p[r] = vv; }
                            y = MFMA32(LFR(24 + 2 * st), pack8<0>(p), y); y = MFMA32(LFR(24 + 2 * st + 1), pack8<1>(p), y);
                        }
                        { const size_t row = (size_t)lb * SEQ + s0 + 32 * tt + col;
                          if (es < 2) { bf16* yp = (bf16*)B.yraw + row * 1024 + 256 * (mx + 1) + lh * 64 + 32 * es + 4 * hi;
#pragma unroll
                              for (int g = 0; g < 4; ++g) *(GAS unsigned long long*)(yp + 8 * g) = (unsigned long long)cvtpk(y[4 * g], y[4 * g + 1]) | ((unsigned long long)cvtpk(y[4 * g + 2], y[4 * g + 3]) << 32); }
                          else if (hi == 0) { ((GAS float*)B.den)[row * 8 + lh * 2] = y[0]; ((GAS float*)B.den)[row * 8 + lh * 2 + 1] = mt; } }
                        if (ml) mst = mnew;
                    } else if (wave == 6) {
                        const float S1v = cf[192 + (c & 3)], S2v = cf[196 + (c & 3)];
                        float gam = S1v, dlt = S1v, mnew = 0.f;
                        if (ml) { mnew = fmaxf(S1v + mst, S2v); gam = S1v - mnew; dlt = S1v + mst - mnew; }
                        const float ed = __expf(dlt);
#pragma unroll
                        for (int r = 0; r < 16; ++r) { st0[r] *= ed; st1[r] *= ed; }
#pragma unroll
                        for (int k4 = 0; k4 < 4; ++k4) {
                            const bf16x8 vr = LFR(24 + k4); const f32x4 b0 = *(const LAS f32x4*)(cf + 128 + 16 * k4 + 8 * hi), b1 = *(const LAS f32x4*)(cf + 128 + 16 * k4 + 8 * hi + 4);
                            v4u wv; wv.x = cvtpk(bf2f((unsigned short)vr[0]) * __expf(gam - b0[0]), bf2f((unsigned short)vr[1]) * __expf(gam - b0[1])); wv.y = cvtpk(bf2f((unsigned short)vr[2]) * __expf(gam - b0[2]), bf2f((unsigned short)vr[3]) * __expf(gam - b0[3]));
                            wv.z = cvtpk(bf2f((unsigned short)vr[4]) * __expf(gam - b1[0]), bf2f((unsigned short)vr[5]) * __expf(gam - b1[1])); wv.w = cvtpk(bf2f((unsigned short)vr[6]) * __expf(gam - b1[2]), bf2f((unsigned short)vr[7]) * __expf(gam - b1[3]));
                            const bf16x8 wvf = __builtin_bit_cast(bf16x8, wv);
                            st0 = MFMA32(LFR(16 + k4), wvf, st0); st1 = MFMA32(LFR(20 + k4), wvf, st1);
                        }
                        { LAS unsigned char* sf = lds + MX_STF + ((c + 1) & 1) * 4096 + 16 * lane;
                          *(LAS bf16x8*)(sf) = pack8<0>(st0); *(LAS bf16x8*)(sf + 1024) = pack8<1>(st0); *(LAS bf16x8*)(sf + 2048) = pack8<0>(st1); *(LAS bf16x8*)(sf + 3072) = pack8<1>(st1); }
                        if (ml) mst = mnew;
                    }
#undef LFR
                }
                asm volatile("s_waitcnt lgkmcnt(0)" ::: "memory");
                bi = (bi == 2) ? 0 : bi + 1;
            }
#undef LIN_ISSUE
        }
        VMWAIT(0); WGBAR();
    }
}
__device__ __forceinline__ f32x4 unpack4bf(unsigned long long q) { return (f32x4){__uint_as_float((unsigned)q << 16), __uint_as_float((unsigned)q & 0xffff0000u), __uint_as_float((unsigned)(q >> 32) << 16), __uint_as_float((unsigned)(q >> 32) & 0xffff0000u)}; }
__device__ __forceinline__ void unpack8bf(const v4u q, f32x4& lo, f32x4& hi) {
    lo = (f32x4){__uint_as_float(q.x << 16), __uint_as_float(q.x & 0xffff0000u), __uint_as_float(q.y << 16), __uint_as_float(q.y & 0xffff0000u)};
    hi = (f32x4){__uint_as_float(q.z << 16), __uint_as_float(q.z & 0xffff0000u), __uint_as_float(q.w << 16), __uint_as_float(q.w & 0xffff0000u)}; }
__device__ __forceinline__ void post_new(const MixBufs& B, bf16* ybf, const float* mng, const float* rng, const float* sng, const float* sD, int gw, int NGW, int lane) {
    constexpr int P = 4;
    const int hl = lane >> 5, l5 = lane & 31, c8 = 8 * l5, hd = l5 >> 3;
    f32x4 gn[3][2];
#pragma unroll
    for (int h2 = 0; h2 < 2; ++h2) { gn[0][h2] = *(const f32x4*)(mng + c8 + 4 * h2); gn[1][h2] = *(const f32x4*)(rng + c8 + 4 * h2); gn[2][h2] = *(const f32x4*)(sng + c8 + 4 * h2); }
    const float Dh = sD[hd];
    for (int k0 = 0; k0 < M / NGW; k0 += 2 * P) {
        v4u yq[P][3], gq[P][3], xq[P]; float dn[P], mt[P];
#pragma unroll
        for (int j = 0; j < P; ++j) { const int kk = k0 + 2 * j + hl; const int m = (NGW == 2048) ? ((gw >> 8) * SEQ + (gw & 255) + 256 * kk) : (gw + kk * NGW); const size_t r = (size_t)m;
#pragma unroll
            for (int mx = 0; mx < 3; ++mx) yq[j][mx] = *(const GAS v4u*)((const bf16*)B.yraw + r * 1024 + 256 * (mx + 1) + c8);
            gq[j][0] = *(const GAS v4u*)(B.proj + r * PROJ_LD + PC_MO + c8); gq[j][1] = *(const GAS v4u*)(B.proj + r * PROJ_LD + PC_RG + c8); gq[j][2] = *(const GAS v4u*)(B.proj + r * PROJ_LD + PC_SZ + c8);
            xq[j] = *(const GAS v4u*)((const bf16*)B.xs + r * 256 + c8); dn[j] = ((const GAS float*)B.den)[r * 8 + hd * 2]; mt[j] = ((const GAS float*)B.den)[r * 8 + hd * 2 + 1]; }
#pragma unroll
        for (int j = 0; j < P; ++j) { const int kk = k0 + 2 * j + hl; const int m = (NGW == 2048) ? ((gw >> 8) * SEQ + (gw & 255) + 256 * kk) : (gw + kk * NGW); const size_t r = (size_t)m;
            bf16* orow = ybf + r * DM + c8;
#pragma unroll
            for (int mx = 0; mx < 2; ++mx) {
                f32x4 v0, v1; unpack8bf(yq[j][mx], v0, v1);
                if (mx == 0) { const float sc = 1.0f / fmaxf(fabsf(dn[j]), __expf(-mt[j])); v0 = v0 * sc; v1 = v1 * sc; }
                float ss = ((v0.x * v0.x + v0.y * v0.y) + (v0.z * v0.z + v0.w * v0.w)) + ((v1.x * v1.x + v1.y * v1.y) + (v1.z * v1.z + v1.w * v1.w));
                ss += __shfl_xor(ss, 1); ss += __shfl_xor(ss, 2); ss += __shfl_xor(ss, 4);
                const float rstd = 1.0f / sqrtf(ss * (1.0f / 64.0f) + RMS_EPS);
                f32x4 g0, g1; unpack8bf(gq[j][mx], g0, g1);
#pragma unroll
                for (int i = 0; i < 4; ++i) { g0[i] = mx == 0 ? sigmoid_f(g0[i]) : silu_acc(g0[i]); g1[i] = mx == 0 ? sigmoid_f(g1[i]) : silu_acc(g1[i]); }
                const f32x4 o0 = g0 * (v0 * rstd * gn[mx][0]), o1 = g1 * (v1 * rstd * gn[mx][1]);
                *(GAS v4u*)(orow + 256 * (mx + 1)) = (v4u){pk2(o0.x, o0.y), pk2(o0.z, o0.w), pk2(o1.x, o1.y), pk2(o1.z, o1.w)};
            }
            { f32x4 h0, h1, z0, z1, x0, x1; unpack8bf(yq[j][2], h0, h1); unpack8bf(gq[j][2], z0, z1); unpack8bf(xq[j], x0, x1); f32x4 v0, v1;
#pragma unroll
              for (int i = 0; i < 4; ++i) { v0[i] = (h0[i] + Dh * x0[i]) * silu_acc(z0[i]); v1[i] = (h1[i] + Dh * x1[i]) * silu_acc(z1[i]); }
              float ss = ((v0.x * v0.x + v0.y * v0.y) + (v0.z * v0.z + v0.w * v0.w)) + ((v1.x * v1.x + v1.y * v1.y) + (v1.z * v1.z + v1.w * v1.w));
              ss += __shfl_xor(ss, 1); ss += __shfl_xor(ss, 2); ss += __shfl_xor(ss, 4); ss += __shfl_xor(ss, 8); ss += __shfl_xor(ss, 16);
              const float rstd = 1.0f / sqrtf(ss * (1.0f / 256.0f) + RMS_EPS);
              const f32x4 o0 = v0 * rstd * gn[2][0], o1 = v1 * rstd * gn[2][1];
              *(GAS v4u*)(orow + 768) = (v4u){pk2(o0.x, o0.y), pk2(o0.z, o0.w), pk2(o1.x, o1.y), pk2(o1.z, o1.w)}; }
        }
    }
}
__device__ __forceinline__ void final_norm(float* x, const float* g, int gw, int NGW, int lane) {
    constexpr int R = 4;
    f32x4 gv[4];
#pragma unroll
    for (int j = 0; j < 4; ++j) gv[j] = ((const f32x4*)g)[lane + 64 * j];
    for (int k0 = 0; k0 < M / NGW; k0 += R) {
        f32x4 v[R][4];
#pragma unroll
        for (int q = 0; q < R; ++q) { const int m = (NGW == 2048) ? ((gw >> 8) * SEQ + (gw & 255) + 256 * (k0 + q)) : (gw + (k0 + q) * NGW);
            const GAS f32x4* xr = (const GAS f32x4*)(x + (size_t)m * DM) + lane;
#pragma unroll
            for (int j = 0; j < 4; ++j) v[q][j] = xr[64 * j]; }
#pragma unroll
        for (int q = 0; q < R; ++q) { const int m = (NGW == 2048) ? ((gw >> 8) * SEQ + (gw & 255) + 256 * (k0 + q)) : (gw + (k0 + q) * NGW);
            GAS f32x4* xr = (GAS f32x4*)(x + (size_t)m * DM) + lane; float s = 0.f;
#pragma unroll
            for (int j = 0; j < 4; ++j) s += (v[q][j].x * v[q][j].x + v[q][j].y * v[q][j].y) + (v[q][j].z * v[q][j].z + v[q][j].w * v[q][j].w);
            const float rstd = 1.0f / sqrtf(wave_sum(s) * (1.0f / DM) + RMS_EPS);
#pragma unroll
            for (int j = 0; j < 4; ++j) xr[64 * j] = v[q][j] * rstd * gv[j]; }
    }
}

__global__ void __launch_bounds__(NTHR, 2) fwd(Args a) {
    extern __shared__ __attribute__((aligned(16))) unsigned char lds_raw[];
    LAS unsigned char* lds = (LAS unsigned char*)lds_raw;
    const int tid = threadIdx.x, lane = tid & 63, wave = __builtin_amdgcn_readfirstlane(tid >> 6), G = gridDim.x;
    const int gw = blockIdx.x * NWAVES + wave, NGW = G * NWAVES;
    unsigned char* ws = a.ws;
    for (int u = tid; u < (LDS_BYTES - LDSCTL_OFF) / 4; u += NTHR) ((LAS unsigned*)(lds + LDSCTL_OFF))[u] = 0u;
    __syncthreads();
    const int lo = a.ph_lo, hi = a.ph_hi;
    XcdBarrier bar; bar.bar = (unsigned*)(ws + WS_CTL) + CW_BAR; bar.x = 0; bar.st = nullptr;
    if (hi - lo > 1) bar = xcd_barrier_post((unsigned*)(ws + WS_CTL) + CW_BAR, (volatile LAS unsigned*)(lds + MISC_OFF) + 8);
    volatile LAS unsigned* MISCW = (volatile LAS unsigned*)(lds + MISC_OFF);
    if (hi - lo > 1 && tid == 0) MISCW[16] = xb_add(&bar.bar[XB_RANK(bar.x)], 1u);
    int bid = (int)blockIdx.x; bool loc = false;
#define IN(k) (lo <= (k) && (k) < hi)
#define PH_IDS int t_ = threadIdx.x; asm volatile("" : "+v"(t_)); const int lane_ = t_ & 63, wave_ = __builtin_amdgcn_readfirstlane(t_ >> 6), gw_ = blockIdx.x * NWAVES + wave_; (void)lane_; (void)gw_; (void)wave_;
#define SEAM(k) do { if ((k) + 1 < hi) { if (loc) xcd_local_barrier(bar.bar, bar.x, 32u); else xcd_barrier(bar); } } while (0)
    float* xres = a.out;
    float* cond = (float*)(ws + WS_COND); const float2* rope = (const float2*)(ws + WS_ROPE);
    bf16* HB = (bf16*)(ws + WS_HB); bf16* ACT = (bf16*)(ws + WS_ACT); bf16* PROJ = (bf16*)(ws + WS_PROJ); float* GATES = (float*)(ws + WS_GATES);
    bf16* YBF = (bf16*)(ws + WS_YBF);
#define MK_MB unsigned char* ws_ = a.ws; asm volatile("" : "+s"(ws_)); MixBufs MB; MB.proj = (const bf16*)(ws_ + WS_PROJ); MB.gates = (const float*)(ws_ + WS_GATES); MB.vtf = (bf16*)(ws_ + WS_VTF); MB.lcum = (float*)(ws_ + WS_COEF + COEF_LCUM); MB.ctot = (float*)(ws_ + WS_COEF + COEF_CTOT); \
    MB.ql = (bf16*)(ws_ + WS_QL); MB.kl = (bf16*)(ws_ + WS_KL); MB.kt = (bf16*)(ws_ + WS_KT); MB.vtl = (bf16*)(ws_ + WS_VTL); MB.xs = (float*)(ws_ + WS_XS); \
    MB.a1 = (float*)(ws_ + WS_COEF + COEF_A1); MB.a2 = (float*)(ws_ + WS_COEF + COEF_A2); MB.beta = (float*)(ws_ + WS_COEF + COEF_BETA); MB.s1 = (float*)(ws_ + WS_COEF + COEF_S1); MB.s2 = (float*)(ws_ + WS_COEF + COEF_S2); \
    MB.den = (float*)(ws_ + WS_DEN); MB.yraw = (float*)(ws_ + WS_YRAW); bf16* YBF_ = (bf16*)(ws_ + WS_YBF); (void)YBF_;
    long long* SS = (long long*)(ws + WS_SS);
    if (IN(0)) { PH_IDS prologue0(a, lds, t_, lane_, wave_, G); SEAM(0); }
    if (IN(1)) { PH_IDS prologue1(a, lds, lane_, wave_, G); thin_xg(a.in[0], HB, (bf16*)(ws + WS_XB), a.in[4], cond, 1 * DM, SS, gw_, NGW, lane_); SEAM(1);
        { const long long* q = (const long long*)(ws + WS_BIASQ); float* bf = (float*)(ws + WS_BIAS);
          for (int i = blockIdx.x * NTHR + t_; i < (int)(BIAS_BYTES / 4); i += G * NTHR) bf[i] = (float)((double)q[i] * (1.0 / 4294967296.0)); }
        SEAM(1); }
    if (lo == 0 && hi == PH_END && G == 256) {
        if (tid == 0) { bool ok = true;
#pragma unroll
            for (unsigned j = 0; j < 16; ++j) { const unsigned cnt = xb_ld(&bar.bar[XB_RANK(j)]); ok = ok && (cnt == (j < 8 ? 32u : 0u)); }
            MISCW[17] = ok ? 1u : 0u; }
        __syncthreads();
        if (MISCW[17]) { loc = true; bid = __builtin_amdgcn_readfirstlane((int)(MISCW[16] * 8u + bar.x)); }
    }
    const int vcu = (G % 8 == 0) ? (bid % 8) * (G / 8) + bid / 8 : bid;
    for (int l = 0; l < DEPTH; ++l) {
        const int pb = PH_LAYER0 + PH_PER_LAYER * l;
        if (hi <= pb || lo >= pb + PH_PER_LAYER) continue;
        const float* cond_l = cond + (size_t)l * BATCH * NCOND;
        unsigned char* wl = ws + WS_W + (size_t)l * LAYER_W;
        const float* xin = (l == 0) ? a.in[0] : xres;
        const float* bias_l = (const float*)(ws + WS_BIAS + (size_t)l * 3 * BIAS_USE);
        long long* ss0 = SS + (size_t)(3 * l) * M;
        const float* ng = a.in[4] + (size_t)(l * 3) * DM;
        if (IN(pb + 0)) { pg8::Gemm g{HB, (const bf16*)(wl + OFF_UP1), M, NUP, DM}; pg8::StaticOrder S; S.init(M, NUP, G, bid); pg8::EpiSwigluN E{ACT, PROJ_LD, ss0, bias_l, NUP};
            pg8::gemm_phase<pg8::EpiSwigluN, pg8::StaticOrder, true, true>(lds, g, S, E); if (REP_UP > 1) { __syncthreads(); pg8::gemm_phase<pg8::EpiSwigluN, pg8::StaticOrder, true, true>(lds, g, S, E); } SEAM(pb + 0); }
        if (IN(pb + 1)) { pg8::Gemm g{ACT, (const bf16*)(wl + OFF_DN1), M, DM, DFF, PROJ_LD}; pg8::StaticOrder S; S.init(M, DM, G, bid);
            pg8::EpiResidNorm E{cond_l, ng + DM, ws, 2 * DM, 4 * DM, (int)(WS_HB / MiB), (int)(WS_XB / MiB), (int)(WS_SS / 8) + (3 * l + 1) * M, 0.5f};
            pg8::gemm_phase<pg8::EpiResidNorm, pg8::StaticOrder, true, true>(lds, g, S, E); SEAM(pb + 1); }
        if (IN(pb + 2)) { pg8::Gemm g{HB, (const bf16*)(wl + OFF_IN), M, NPROJ, DM}; pg8::StaticOrder S; S.init(M, NPROJ, G, bid); pg8::EpiProjN E{PROJ, PROJ_LD, GATES, PROJ_LD / 256, 0.125f * LOG2E, ss0 + M, bias_l + 8 * NUP, NPROJ};
            pg8::gemm_phase<pg8::EpiProjN, pg8::StaticOrder, true, true>(lds, g, S, E); SEAM(pb + 2); }
        if (IN(pb + 3)) { PH_IDS MK_MB PrepW PW{a.in[12] + (size_t)l * 4 * 512, a.in[13] + (size_t)l * 512, a.in[18] + (size_t)l * 4 * 512, a.in[19] + (size_t)l * 512, a.in[11] + l * 4, a.in[14] + l * 4, a.in[15] + l * 4, a.in[20] + l * 4, a.in[21] + l * 4, (const float2*)(ws_ + WS_ROPE)};
            for (int rep = 0; rep < REP_PREP; ++rep) for (int u = vcu; u < BATCH * 32; u += G) prep_unit(MB, PW, u, wave_, lane_); SEAM(pb + 3); }
        if (IN(pb + 4)) { PH_IDS MK_MB mixer_phase(MB, YBF_, lds, vcu, wave_, lane_); if (REP_MIX > 1) { asm volatile("" ::: "memory"); mixer_phase(MB, YBF_, lds, vcu, wave_, lane_); } SEAM(pb + 4); }
        if (IN(pb + 5)) { PH_IDS MK_MB for (int rep = 0; rep < REP_POST; ++rep) post_new(MB, YBF_, a.in[16] + (size_t)l * 256, a.in[17] + (size_t)l * 256, a.in[23] + (size_t)l * 256, a.in[22] + l * 4, vcu * NWAVES + wave_, NGW, lane_); SEAM(pb + 5); }
        if (IN(pb + 6)) { pg8::Gemm g{YBF, (const bf16*)(wl + OFF_OUT), M, DM, DM}; pg8::StaticOrder S; S.init(M, DM, G, bid);
            pg8::EpiResidNorm E{cond_l, ng + 2 * DM, ws, 5 * DM, 7 * DM, (int)(WS_HB / MiB), (int)(WS_XB / MiB), (int)(WS_SS / 8) + (3 * l + 2) * M, 1.0f};
            pg8::gemm_phase<pg8::EpiResidNorm, pg8::StaticOrder, true, true>(lds, g, S, E); SEAM(pb + 6); }
        if (IN(pb + 7)) { pg8::Gemm g{HB, (const bf16*)(wl + OFF_UP2), M, NUP, DM}; pg8::StaticOrder S; S.init(M, NUP, G, bid); pg8::EpiSwigluN E{ACT, PROJ_LD, ss0 + 2 * M, bias_l + 2 * 8 * NUP, NUP};
            pg8::gemm_phase<pg8::EpiSwigluN, pg8::StaticOrder, true, true>(lds, g, S, E); SEAM(pb + 7); }
        if (IN(pb + 8)) { pg8::Gemm g{ACT, (const bf16*)(wl + OFF_DN2), M, DM, DFF, PROJ_LD}; pg8::StaticOrder S; S.init(M, DM, G, bid);
            if (l + 1 < DEPTH) { pg8::EpiResidNorm E{cond_l, ng + 3 * DM, ws, 8 * DM, BATCH * NCOND + 1 * DM, (int)(WS_HB / MiB), (int)(WS_XB / MiB), (int)(WS_SS / 8) + (3 * l + 3) * M, 0.5f};
                pg8::gemm_phase<pg8::EpiResidNorm, pg8::StaticOrder, true, true>(lds, g, S, E); }
            else { pg8::EpiResid E{(const bf16*)(ws + WS_XB), xres, DM, cond_l + 8 * DM, NCOND, SEQ, 0.5f}; pg8::gemm_phase<pg8::EpiResid, pg8::StaticOrder, true, true>(lds, g, S, E); }
            SEAM(pb + 8); }
    }
    if (IN(PH_FINAL)) { PH_IDS final_norm(xres, a.in[24], vcu * NWAVES + wave_, NGW, lane_); }
#undef IN
#undef SEAM
}

#ifndef N_SPLIT
#define N_SPLIT 0
#endif
extern "C" void kernel_launch(void* const* d_in, const int* in_sizes, int n_in, void* d_out, int out_size, void* d_ws, size_t ws_size, hipStream_t stream) {
    static int grid = 0;
    if (grid == 0) {
        if (n_in != 25 || in_sizes[0] != M * DM || out_size != M * DM || ws_size < WS_END) { fprintf(stderr, "kernel_launch: unexpected problem (n_in %d, in0 %d, out %d, ws %zu)\n", n_in, n_in > 0 ? in_sizes[0] : -1, out_size, ws_size); grid = -1; return; }
        int dev = 0, cus = 0, per_cu = 0;
        if (hipGetDevice(&dev) != hipSuccess || hipDeviceGetAttribute(&cus, hipDeviceAttributeMultiprocessorCount, dev) != hipSuccess) { grid = -1; return; }
        if (hipFuncSetAttribute((const void*)fwd, hipFuncAttributeMaxDynamicSharedMemorySize, LDS_BYTES) != hipSuccess) { fprintf(stderr, "kernel_launch: hipFuncSetAttribute failed\n"); grid = -1; return; }
        if (hipOccupancyMaxActiveBlocksPerMultiprocessor(&per_cu, (const void*)fwd, NTHR, LDS_BYTES) != hipSuccess || per_cu < 1) fprintf(stderr, "kernel_launch: occupancy query says %d\n", per_cu);
        (void)hipGetLastError();
        grid = cus;
    }
    if (grid < 0) return;
    if (hipMemsetAsync((char*)d_ws + WS_CTL, 0, CTL_ZERO_BYTES, stream) != hipSuccess) return;
    Args a{};
    for (int i = 0; i < 25; ++i) a.in[i] = (const float*)d_in[i];
    a.out = (float*)d_out; a.ws = (unsigned char*)d_ws;
#if N_SPLIT
    for (int p = 0; p < PH_END; ++p) { a.ph_lo = p; a.ph_hi = p + 1; hipLaunchKernelGGL(fwd, dim3(grid), dim3(NTHR), LDS_BYTES, stream, a); }
#else
    a.ph_lo = 0; a.ph_hi = PH_END; hipLaunchKernelGGL(fwd, dim3(grid), dim3(NTHR), LDS_BYTES, stream, a);
#endif
}
```
